# Optimizing an MI355X kernel written in HIP

```python
import numpy as np
import jax
import jax.numpy as jnp
from jax import lax

D_MODEL = 1024
BATCH = 4
SEQ = 4096
DEPTH = 1

NSA_HEADS = 8
NSA_HEAD_DIM = 64
NSA_KV_GROUPS = 2
NSA_HEADS_PER_GROUP = NSA_HEADS // NSA_KV_GROUPS
NSA_KV_DIM = NSA_KV_GROUPS * NSA_HEAD_DIM
CMP_BLOCK = 32
CMP_STRIDE = 16
CMP_HIDDEN = 256
SLC_BLOCK = 64
SLC_TOPK = 16
WINDOW = 512
SLC_Q_BLOCK = 64
WIN_Q_BLOCK = 128
RET_HEADS = 4
RET_DK = 128
RET_DV = 256
RET_V_DIM = RET_HEADS * RET_DV
RET_CHUNK = 128
MOE_GROUPS = 4
EXPERTS_PER_GROUP = 8
N_EXPERTS = MOE_GROUPS * EXPERTS_PER_GROUP
D_FF_EXPERT = 512
INNER_TOP_K = 2
ROPE_THETA = 10000.0
LN_EPS = 1e-5
GN_EPS = 1e-5
NEG_INF = -1e30
DEEPNORM_ALPHA = (2.0 * DEPTH) ** 0.25
DEEPNORM_BETA = (8.0 * DEPTH) ** -0.25

IN_LAYOUT = (
    ("nsa_q", NSA_HEADS * NSA_HEAD_DIM),
    ("cmp_k", NSA_KV_DIM), ("cmp_v", NSA_KV_DIM),
    ("slc_k", NSA_KV_DIM), ("slc_v", NSA_KV_DIM),
    ("win_k", NSA_KV_DIM), ("win_v", NSA_KV_DIM),
    ("nsa_gate", 3 * NSA_HEADS),
    ("ret_q", RET_HEADS * RET_DK), ("ret_k", RET_HEADS * RET_DK),
    ("ret_v", RET_V_DIM), ("ret_gate", RET_V_DIM),
    ("merge_gate", 2 * D_MODEL),
)
IN_DIM = sum(w for _, w in IN_LAYOUT)
VALUE_SLOTS = ("cmp_v", "slc_v", "win_v", "ret_v")

kernel_name = "hybrid_nsa_retention_hmoe_deepnorm"


def split_projection(h):
    out = {}
    off = 0
    for name, width in IN_LAYOUT:
        out[name] = h[..., off:off + width]
        off += width
    return out


def layer_norm(x, g, b):
    x32 = x.astype(jnp.float32)
    mu = jnp.mean(x32, -1, keepdims=True)
    var = jnp.mean(jnp.square(x32 - mu), -1, keepdims=True)
    return ((x32 - mu) * lax.rsqrt(var + LN_EPS) * g + b).astype(x.dtype)


def rope(x, pos):
    d = x.shape[-1]
    half = d // 2
    inv_freq = ROPE_THETA ** (-jnp.arange(half, dtype=jnp.float32) * 2.0 / d)
    ang = pos.astype(jnp.float32)[:, None] * inv_freq[None, :]
    cos = jnp.cos(ang)[:, None, :]
    sin = jnp.sin(ang)[:, None, :]
    x32 = x.astype(jnp.float32)
    x1, x2 = x32[..., :half], x32[..., half:]
    return jnp.concatenate([x1 * cos - x2 * sin, x1 * sin + x2 * cos], -1).astype(x.dtype)


def masked_softmax(s, mask):
    s = jnp.where(mask, s.astype(jnp.float32), NEG_INF)
    return jnp.where(mask, jax.nn.softmax(s, axis=-1), 0.0)


def compress_blocks(t, pos_emb, w1, b1, w2, b2):
    B, T, G, hd = t.shape
    n_cmp = (T - CMP_BLOCK) // CMP_STRIDE + 1
    tok = np.arange(n_cmp)[:, None] * CMP_STRIDE + np.arange(CMP_BLOCK)[None, :]
    blk = t[:, tok] + pos_emb[None, None, :, None, :]
    blk = blk.transpose(0, 1, 3, 2, 4).reshape(B, n_cmp, G, CMP_BLOCK * hd)
    return jax.nn.gelu(blk @ w1 + b1) @ w2 + b2


def nsa_attention(q, k_c, v_c, k_s, v_s, k_w, v_w, gate_logits, cmp_k_params, cmp_v_params):
    B, T = q.shape[:2]
    G, HPG, hd = NSA_KV_GROUPS, NSA_HEADS_PER_GROUP, NSA_HEAD_DIM
    pos = jnp.arange(T)
    qg = (rope(q, pos) * hd ** -0.5).reshape(B, T, G, HPG, hd).transpose(0, 2, 3, 1, 4)
    k_s = rope(k_s, pos)
    k_w = rope(k_w, pos)

    n_cmp = (T - CMP_BLOCK) // CMP_STRIDE + 1
    cmp_start = np.arange(n_cmp) * CMP_STRIDE
    cmp_end = cmp_start + CMP_BLOCK - 1
    k_cmp = rope(compress_blocks(k_c, *cmp_k_params), jnp.asarray(cmp_end))
    v_cmp = compress_blocks(v_c, *cmp_v_params)
    s_cmp = jnp.einsum('bghtd,bngd->bghtn', qg, k_cmp)
    mask_cmp = jnp.asarray(cmp_end)[None, :] <= pos[:, None]
    p_cmp = masked_softmax(s_cmp, mask_cmp)
    o_cmp = jnp.einsum('bghtn,bngd->bghtd', p_cmp.astype(v_cmp.dtype), v_cmp)

    n_sel = T // SLC_BLOCK
    k_top = min(SLC_TOPK, n_sel)
    sel_start = np.arange(n_sel) * SLC_BLOCK
    overlap = np.clip(np.minimum(cmp_start[None, :] + CMP_BLOCK, sel_start[:, None] + SLC_BLOCK)
                      - np.maximum(cmp_start[None, :], sel_start[:, None]), 0, None)
    overlap = jnp.asarray(overlap.astype(np.float32) / CMP_STRIDE)
    importance = jnp.einsum('bghtn,sn->bgts', p_cmp, overlap)
    blk_t = pos // SLC_BLOCK
    j = jnp.arange(n_sel)
    forced = (j[None, :] == 0) | (j[None, :] == blk_t[:, None]) | (j[None, :] == blk_t[:, None] - 1)
    causal = j[None, :] <= blk_t[:, None]
    score = jnp.where(forced, jnp.float32(1e9), jnp.where(causal, importance, jnp.float32(-1e9)))
    _, sel_idx = lax.top_k(score, k_top)

    k_blocks = k_s.reshape(B, n_sel, SLC_BLOCK, G, hd).transpose(0, 3, 1, 2, 4)
    v_blocks = v_s.reshape(B, n_sel, SLC_BLOCK, G, hd).transpose(0, 3, 1, 2, 4)
    nq = T // SLC_Q_BLOCK
    q_b = qg.reshape(B, G, HPG, nq, SLC_Q_BLOCK, hd).transpose(3, 0, 1, 2, 4, 5)
    idx_b = sel_idx.reshape(B, G, nq, SLC_Q_BLOCK, k_top).transpose(2, 0, 1, 3, 4)
    t_b = pos.reshape(nq, SLC_Q_BLOCK)
    bi = jnp.arange(B)[:, None, None, None]
    gi = jnp.arange(G)[None, :, None, None]

    def slc_block(args):
        qb, ib, tb = args
        kg = k_blocks[bi, gi, ib]
        vg = v_blocks[bi, gi, ib]
        s = jnp.einsum('bghqd,bgqskd->bghqsk', qb, kg)
        key_pos = ib[..., None] * SLC_BLOCK + jnp.arange(SLC_BLOCK)
        mask = (key_pos <= tb[:, None, None])[:, :, None]
        p = masked_softmax(s.reshape(B, G, HPG, SLC_Q_BLOCK, -1),
                           mask.reshape(B, G, 1, SLC_Q_BLOCK, -1)).reshape(s.shape)
        return jnp.einsum('bghqsk,bgqskd->bghqd', p.astype(vg.dtype), vg)

    o_slc = lax.map(slc_block, (q_b, idx_b, t_b))
    o_slc = o_slc.transpose(1, 2, 3, 0, 4, 5).reshape(B, G, HPG, T, hd)

    k_wp = jnp.pad(k_w, ((0, 0), (WINDOW, 0), (0, 0), (0, 0)))
    v_wp = jnp.pad(v_w, ((0, 0), (WINDOW, 0), (0, 0), (0, 0)))
    nqw = T // WIN_Q_BLOCK

    def win_block(n):
        start = n * WIN_Q_BLOCK
        qb = lax.dynamic_slice_in_dim(qg, start, WIN_Q_BLOCK, axis=3)
        kb = lax.dynamic_slice_in_dim(k_wp, start, WINDOW + WIN_Q_BLOCK, axis=1)
        vb = lax.dynamic_slice_in_dim(v_wp, start, WINDOW + WIN_Q_BLOCK, axis=1)
        s = jnp.einsum('bghqd,bkgd->bghqk', qb, kb)
        tq = start + jnp.arange(WIN_Q_BLOCK)
        tk = start - WINDOW + jnp.arange(WINDOW + WIN_Q_BLOCK)
        mask = (tk[None, :] <= tq[:, None]) & (tq[:, None] - tk[None, :] < WINDOW) & (tk[None, :] >= 0)
        p = masked_softmax(s, mask)
        return jnp.einsum('bghqk,bkgd->bghqd', p.astype(vb.dtype), vb)

    o_win = lax.map(win_block, jnp.arange(nqw))
    o_win = o_win.transpose(1, 2, 3, 0, 4, 5).reshape(B, G, HPG, T, hd)

    gates = jax.nn.sigmoid(gate_logits.astype(jnp.float32)).reshape(B, T, G, HPG, 3).transpose(0, 2, 3, 1, 4)
    o = gates[..., 0:1] * o_cmp + gates[..., 1:2] * o_slc + gates[..., 2:3] * o_win
    return o.transpose(0, 3, 1, 2, 4).reshape(B, T, NSA_HEADS * hd).astype(q.dtype)


def retention(q, k, v, gn_g, gn_b):
    B, T = q.shape[:2]
    C = RET_CHUNK
    N = T // C
    pos = jnp.arange(T)
    q = rope(q, pos).astype(jnp.float32)
    k = (rope(k, pos).astype(jnp.float32)) * RET_DK ** -0.5
    v = v.astype(jnp.float32)
    qc = q.reshape(B, N, C, RET_HEADS, RET_DK).transpose(1, 0, 3, 2, 4)
    kc = k.reshape(B, N, C, RET_HEADS, RET_DK).transpose(1, 0, 3, 2, 4)
    vc = v.reshape(B, N, C, RET_HEADS, RET_DV).transpose(1, 0, 3, 2, 4)
    gamma = 1.0 - 2.0 ** (-5.0 - jnp.arange(RET_HEADS, dtype=jnp.float32))
    log_g = jnp.log(gamma)
    i = jnp.arange(C, dtype=jnp.float32)
    diff = i[:, None] - i[None, :]
    decay_intra = jnp.where(diff >= 0, jnp.exp(jnp.maximum(diff, 0.0) * log_g[:, None, None]), 0.0)
    xi = jnp.exp((i + 1.0) * log_g[:, None])
    zeta = jnp.exp((C - 1.0 - i) * log_g[:, None])
    chunk_decay = jnp.exp(C * log_g)

    scores = jnp.einsum('nbhcd,nbhmd->nbhcm', qc, kc) * decay_intra
    intra = jnp.einsum('nbhcm,nbhme->nbhce', scores, vc)

    def step(R, xs):
        qn, kn, vn = xs
        cross = jnp.einsum('bhcd,bhde->bhce', qn, R) * xi[None, :, :, None]
        R_new = R * chunk_decay[None, :, None, None] + jnp.einsum('bhmd,bhme->bhde', kn * zeta[None, :, :, None], vn)
        return R_new, cross

    R0 = jnp.zeros((B, RET_HEADS, RET_DK, RET_DV), jnp.float32)
    _, cross = lax.scan(step, R0, (qc, kc, vc))
    o = (intra + cross).transpose(1, 0, 3, 2, 4).reshape(B, T, RET_HEADS, RET_DV)
    mu = jnp.mean(o, -1, keepdims=True)
    var = jnp.mean(jnp.square(o - mu), -1, keepdims=True)
    o = (o - mu) * lax.rsqrt(var + GN_EPS)
    o = o * gn_g.astype(jnp.float32).reshape(RET_HEADS, RET_DV) + gn_b.astype(jnp.float32).reshape(RET_HEADS, RET_DV)
    return o.reshape(B, T, RET_V_DIM)


def hier_moe(xt, rg_w, rg_b, ri_w, ri_b, w_gate, w_up, w_down):
    group_logits = (xt @ rg_w).astype(jnp.float32) + rg_b.astype(jnp.float32)
    p_group = jax.nn.softmax(group_logits, axis=-1)
    g_prob, g_idx = lax.top_k(p_group, 1)
    g_prob, g_idx = g_prob[:, 0], g_idx[:, 0]
    inner_all = jnp.einsum('md,gde->mge', xt, ri_w).astype(jnp.float32) + ri_b.astype(jnp.float32)
    inner = jnp.take_along_axis(inner_all, g_idx[:, None, None], axis=1)[:, 0]
    e_logit, e_idx = lax.top_k(inner, INNER_TOP_K)
    w = jax.nn.softmax(e_logit, axis=-1) * g_prob[:, None]
    expert_id = g_idx[:, None] * EXPERTS_PER_GROUP + e_idx
    combine = jnp.sum(jax.nn.one_hot(expert_id, N_EXPERTS, dtype=jnp.float32) * w[..., None], axis=1)
    out = jnp.zeros(xt.shape, jnp.float32)
    for g in range(MOE_GROUPS):
        sl = slice(g * EXPERTS_PER_GROUP, (g + 1) * EXPERTS_PER_GROUP)
        hg = jax.nn.silu(jnp.einsum('md,edf->mef', xt, w_gate[sl])) * jnp.einsum('md,edf->mef', xt, w_up[sl])
        hg = hg * combine[:, sl, None].astype(hg.dtype)
        out = out + jnp.einsum('mef,efd->md', hg, w_down[sl])
    return out


def setup_inputs(seed: int = 0) -> dict:
    key = jax.random.key(seed)
    ks = jax.random.split(key, 32)
    f32 = jnp.float32
    L, D, hd = DEPTH, D_MODEL, NSA_HEAD_DIM

    def nrm(k, shape, scale):
        return jax.random.normal(k, shape, f32) * scale

    col_scale = np.concatenate([np.full((w,), DEEPNORM_BETA if name in VALUE_SLOTS else 1.0, np.float32)
                                for name, w in IN_LAYOUT])
    cmp_in = CMP_BLOCK * hd
    return {
        "x": nrm(ks[0], (BATCH, SEQ, D), 1.0),
        "w_in": nrm(ks[1], (L, D, IN_DIM), D ** -0.5) * jnp.asarray(col_scale),
        "cmp_pos_k": nrm(ks[2], (L, CMP_BLOCK, hd), 0.1),
        "cmp_k_w1": nrm(ks[3], (L, cmp_in, CMP_HIDDEN), cmp_in ** -0.5),
        "cmp_k_b1": nrm(ks[4], (L, CMP_HIDDEN), 0.01),
        "cmp_k_w2": nrm(ks[5], (L, CMP_HIDDEN, hd), CMP_HIDDEN ** -0.5),
        "cmp_k_b2": nrm(ks[6], (L, hd), 0.01),
        "cmp_pos_v": nrm(ks[7], (L, CMP_BLOCK, hd), 0.1),
        "cmp_v_w1": nrm(ks[8], (L, cmp_in, CMP_HIDDEN), cmp_in ** -0.5),
        "cmp_v_b1": nrm(ks[9], (L, CMP_HIDDEN), 0.01),
        "cmp_v_w2": nrm(ks[10], (L, CMP_HIDDEN, hd), CMP_HIDDEN ** -0.5),
        "cmp_v_b2": nrm(ks[11], (L, hd), 0.01),
        "ret_gn_g": 1.0 + nrm(ks[12], (L, RET_V_DIM), 0.05),
        "ret_gn_b": nrm(ks[13], (L, RET_V_DIM), 0.01),
        "w_up_attn": nrm(ks[14], (L, NSA_HEADS * hd, D), (NSA_HEADS * hd) ** -0.5 * DEEPNORM_BETA),
        "w_up_ret": nrm(ks[15], (L, RET_V_DIM, D), RET_V_DIM ** -0.5 * DEEPNORM_BETA),
        "w_out": nrm(ks[16], (L, D, D), D ** -0.5 * DEEPNORM_BETA),
        "ln1_g": 1.0 + nrm(ks[17], (L, D), 0.05),
        "ln1_b": nrm(ks[18], (L, D), 0.01),
        "router_group_w": nrm(ks[19], (L, D, MOE_GROUPS), D ** -0.5),
        "router_group_b": nrm(ks[20], (L, MOE_GROUPS), 0.01),
        "router_inner_w": nrm(ks[21], (L, MOE_GROUPS, D, EXPERTS_PER_GROUP), D ** -0.5),
        "router_inner_b": nrm(ks[22], (L, MOE_GROUPS, EXPERTS_PER_GROUP), 0.01),
        "expert_w_gate": nrm(ks[23], (L, N_EXPERTS, D, D_FF_EXPERT), D ** -0.5),
        "expert_w_up": nrm(ks[24], (L, N_EXPERTS, D, D_FF_EXPERT), D ** -0.5 * DEEPNORM_BETA),
        "expert_w_down": nrm(ks[25], (L, N_EXPERTS, D_FF_EXPERT, D), D_FF_EXPERT ** -0.5 * DEEPNORM_BETA),
        "ln2_g": 1.0 + nrm(ks[26], (L, D), 0.05),
        "ln2_b": nrm(ks[27], (L, D), 0.01),
    }


def reference(x, w_in, cmp_pos_k, cmp_k_w1, cmp_k_b1, cmp_k_w2, cmp_k_b2,
              cmp_pos_v, cmp_v_w1, cmp_v_b1, cmp_v_w2, cmp_v_b2,
              ret_gn_g, ret_gn_b, w_up_attn, w_up_ret, w_out, ln1_g, ln1_b,
              router_group_w, router_group_b, router_inner_w, router_inner_b,
              expert_w_gate, expert_w_up, expert_w_down, ln2_g, ln2_b):
    B, T, D = x.shape
    G, hd = NSA_KV_GROUPS, NSA_HEAD_DIM
    for l in range(DEPTH):
        p = split_projection(x @ w_in[l])
        o_attn = nsa_attention(
            p["nsa_q"].reshape(B, T, NSA_HEADS, hd),
            p["cmp_k"].reshape(B, T, G, hd), p["cmp_v"].reshape(B, T, G, hd),
            p["slc_k"].reshape(B, T, G, hd), p["slc_v"].reshape(B, T, G, hd),
            p["win_k"].reshape(B, T, G, hd), p["win_v"].reshape(B, T, G, hd),
            p["nsa_gate"],
            (cmp_pos_k[l], cmp_k_w1[l], cmp_k_b1[l], cmp_k_w2[l], cmp_k_b2[l]),
            (cmp_pos_v[l], cmp_v_w1[l], cmp_v_b1[l], cmp_v_w2[l], cmp_v_b2[l]))
        o_ret = retention(p["ret_q"].reshape(B, T, RET_HEADS, RET_DK),
                          p["ret_k"].reshape(B, T, RET_HEADS, RET_DK),
                          p["ret_v"].reshape(B, T, RET_HEADS, RET_DV),
                          ret_gn_g[l], ret_gn_b[l])
        o_ret = (o_ret * jax.nn.silu(p["ret_gate"].astype(jnp.float32))).astype(x.dtype)
        gate = jax.nn.sigmoid(p["merge_gate"].astype(jnp.float32)).reshape(B, T, 2, D)
        merged = gate[:, :, 0] * (o_attn @ w_up_attn[l]) + gate[:, :, 1] * (o_ret @ w_up_ret[l])
        mix = merged.astype(x.dtype) @ w_out[l]
        x = layer_norm(DEEPNORM_ALPHA * x + mix.astype(x.dtype), ln1_g[l], ln1_b[l])
        moe = hier_moe(x.reshape(B * T, D), router_group_w[l], router_group_b[l],
                       router_inner_w[l], router_inner_b[l],
                       expert_w_gate[l], expert_w_up[l], expert_w_down[l]).reshape(B, T, D)
        x = layer_norm(DEEPNORM_ALPHA * x + moe.astype(x.dtype), ln2_g[l], ln2_b[l])
    return x
```

```cpp
#include <hip/hip_runtime.h>
#include <hip/hip_cooperative_groups.h>
#include <cstdio>
#include <cstdint>
namespace cg = cooperative_groups;

#ifndef FUSED
#define FUSED 0
#endif

#define DI __device__ __forceinline__
typedef unsigned short bf16_t;
typedef short bf16x8 __attribute__((ext_vector_type(8)));
typedef float f32x4 __attribute__((ext_vector_type(4)));

constexpr int Bn = 4, T = 4096, D = 1024, M = Bn * T;
constexpr int NINP = 6528;
constexpr int NEXP = 32, DFF = 512;
constexpr int HROWS = 36864;
constexpr float ALPHA = 1.189207115002721f;

struct Params {
  const float *x, *w_in, *cmp_pos_k, *cmp_k_w1, *cmp_k_b1, *cmp_k_w2, *cmp_k_b2;
  const float *cmp_pos_v, *cmp_v_w1, *cmp_v_b1, *cmp_v_w2, *cmp_v_b2;
  const float *gn_g, *gn_b, *w_up_attn, *w_up_ret, *w_out, *ln1_g, *ln1_b;
  const float *rg_w, *rg_b, *ri_w, *ri_b, *e_wg, *e_wu, *e_wd, *ln2_g, *ln2_b;
  float* out;
  bf16_t *Qn, *CK, *CV, *SK, *SVt, *WK, *WVt; float* NG;
  bf16_t *RQ, *RK, *RKzT, *RVt, *RG, *MG;
  bf16_t *WinT  , *oattn, *oret;
  bf16_t *WaT, *WrT, *WoT, *W1kT, *W1vT;
  float *ropeN, *ropeR, *posb;
  bf16_t *H1, *kcmp, *vcmpT;
  unsigned long long* selmask;
  int* cnt; int* lists; float* routew;
  bf16_t *merged, *x1b, *EgT  , *EdT  , *Hh, *part;
  bf16_t *xb, *Rt;
};

DI float bf2f(bf16_t v) { return __uint_as_float(((unsigned)v) << 16); }
DI bf16_t f2bf(float f) { unsigned u = __float_as_uint(f); u += 0x7fffu + ((u >> 16) & 1u); return (bf16_t)(u >> 16); }
DI unsigned pack2(float a, float b) { return (unsigned)f2bf(a) | ((unsigned)f2bf(b) << 16); }
DI float lo2f(unsigned u) { return __uint_as_float(u << 16); }
DI float hi2f(unsigned u) { return __uint_as_float(u & 0xffff0000u); }
DI float wsum(float v) { for (int o = 32; o > 0; o >>= 1) v += __shfl_xor(v, o); return v; }
DI float wmax(float v) { for (int o = 32; o > 0; o >>= 1) v = fmaxf(v, __shfl_xor(v, o)); return v; }
DI float sigmoidf_(float x) { return 1.f / (1.f + __expf(-x)); }
#define WSYNC() asm volatile("s_waitcnt lgkmcnt(0)" ::: "memory")

template <bool SWAP, class AR, class BR>
DI void gemm128(f32x4 (&acc)[4][4], AR arow, BR brow, int K, char* smem) {
  const int tid = threadIdx.x, lane = tid & 63, wave = tid >> 6, wr = wave >> 1, wc = wave & 1;
  const int srow = tid >> 3, sch = tid & 7;
  const bf16_t* ap[4]; const bf16_t* bp[4];
#pragma unroll
  for (int i = 0; i < 4; i++) { ap[i] = arow(srow + 32 * i) + sch * 8; bp[i] = brow(srow + 32 * i) + sch * 8; }
  const int woff = srow * 128 + ((sch ^ (srow & 7)) << 4);
  char* As = smem; char* Bs = smem + 32768;
  uint4 ra[4], rb[4];
#pragma unroll
  for (int i = 0; i < 4; i++) { ra[i] = *(const uint4*)(ap[i]); rb[i] = *(const uint4*)(bp[i]); }
#pragma unroll
  for (int i = 0; i < 4; i++) { *(uint4*)(As + woff + i * 4096) = ra[i]; *(uint4*)(Bs + woff + i * 4096) = rb[i]; }
  __syncthreads();
  const int nk = K >> 6;
  const int fr = lane & 15, fq = lane >> 4;
  const int aoff0 = (wr * 64 + fr) * 128, boff0 = (wc * 64 + fr) * 128;
  for (int kt = 0; kt < nk; kt++) {
    const int cur = kt & 1;
    if (kt + 1 < nk) {
#pragma unroll
      for (int i = 0; i < 4; i++) { ra[i] = *(const uint4*)(ap[i] + (kt + 1) * 64); rb[i] = *(const uint4*)(bp[i] + (kt + 1) * 64); }
    }
    const char* Ac = As + cur * 16384; const char* Bc = Bs + cur * 16384;
#pragma unroll
    for (int ks = 0; ks < 2; ks++) {
      const int chs = ((ks * 4 + fq) ^ (fr & 7)) << 4;
      bf16x8 a[4], b[4];
#pragma unroll
      for (int mt = 0; mt < 4; mt++) a[mt] = *(const bf16x8*)(Ac + aoff0 + mt * 2048 + chs);
#pragma unroll
      for (int nt = 0; nt < 4; nt++) b[nt] = *(const bf16x8*)(Bc + boff0 + nt * 2048 + chs);
#pragma unroll
      for (int mt = 0; mt < 4; mt++)
#pragma unroll
        for (int nt = 0; nt < 4; nt++)
          acc[mt][nt] = SWAP ? __builtin_amdgcn_mfma_f32_16x16x32_bf16(b[nt], a[mt], acc[mt][nt], 0, 0, 0)
                             : __builtin_amdgcn_mfma_f32_16x16x32_bf16(a[mt], b[nt], acc[mt][nt], 0, 0, 0);
    }
    if (kt + 1 < nk) {
      char* An = As + (cur ^ 1) * 16384; char* Bn_ = Bs + (cur ^ 1) * 16384;
#pragma unroll
      for (int i = 0; i < 4; i++) { *(uint4*)(An + woff + i * 4096) = ra[i]; *(uint4*)(Bn_ + woff + i * 4096) = rb[i]; }
    }
    __syncthreads();
  }
}
DI void zero_acc(f32x4 (&acc)[4][4]) {
#pragma unroll
  for (int i = 0; i < 4; i++)
#pragma unroll
    for (int j = 0; j < 4; j++) acc[i][j] = (f32x4){0.f, 0.f, 0.f, 0.f};
}
template <bool SWAP, class F>
DI void epilogue(const f32x4 (&acc)[4][4], F f) {
  const int lane = threadIdx.x & 63, wave = threadIdx.x >> 6, wr = wave >> 1, wc = wave & 1, fr = lane & 15, fq = lane >> 4;
#pragma unroll
  for (int mt = 0; mt < 4; mt++)
#pragma unroll
    for (int nt = 0; nt < 4; nt++) {
      if (SWAP) f(wr * 64 + mt * 16 + fr, wc * 64 + nt * 16 + fq * 4, acc[mt][nt]);
      else f(wr * 64 + mt * 16 + fq * 4, wc * 64 + nt * 16 + fr, acc[mt][nt]);
    }
}

template <class CP>
DI void tcvt_tile(CP colptr, int ldsrc, bf16_t* dst, int K, int kt, int jt, float* tile) {
  const int tx = threadIdx.x & 63, ty = threadIdx.x >> 6;
  const float* sp = colptr(jt * 64 + tx);
  for (int i = ty; i < 64; i += 4) tile[i * 65 + tx] = sp ? sp[(size_t)(kt * 64 + i) * ldsrc] : 0.f;
  __syncthreads();
  for (int i = ty * 2 + (tx >> 5); i < 64; i += 8) {
    const int kk = (tx & 31) * 2;
    *(unsigned*)(dst + (size_t)(jt * 64 + i) * K + kt * 64 + kk) = pack2(tile[kk * 65 + i], tile[(kk + 1) * 65 + i]);
  }
  __syncthreads();
}
template <class CP>
DI void tcvt_all(CP colptr, int ldsrc, bf16_t* dst, int K, int N, float* tile, int bid, int nb) {
  const int nkt = K / 64, njt = N / 64;
  for (int t = bid; t < nkt * njt; t += nb) tcvt_tile(colptr, ldsrc, dst, K, t / njt, t % njt, tile);
}

DI int perm_half(int p, int d) { return (p & 1) ? (d / 2 + (p >> 1)) : (p >> 1); }
DI int inproj_col(int j) {
  if (j < 512) return (j & ~63) + perm_half(j & 63, 64);
  if (j < 1280) { const int grp = (j - 512) >> 7;
    if (grp == 2 || grp == 4) return (j & ~63) + perm_half(j & 63, 64);
    return j; }
  if (j < 1792) { const int q = j - 1280; return 1304 + (q & ~127) + perm_half(q & 127, 128); }
  if (j < 2304) { const int q = j - 1792; return 1816 + (q & ~127) + perm_half(q & 127, 128); }
  if (j < 3328) return 2328 + (j - 2304);
  if (j < 4352) return 3352 + (j - 3328);
  if (j < 6400) return 4376 + (j - 4352);
  const int q = j - 6400; return q < 24 ? 1280 + q : -1;
}

DI void phase0(const Params& p, char* smem) {
  const int bid = blockIdx.x, nb = gridDim.x, tid = threadIdx.x;
  const size_t gtid = (size_t)bid * 256 + tid, gsz = (size_t)nb * 256;
  for (size_t i = gtid; i < (size_t)M * D / 4; i += gsz) {
    const float4 v = ((const float4*)p.x)[i];
    uint2 o; o.x = pack2(v.x, v.y); o.y = pack2(v.z, v.w);
    ((uint2*)p.xb)[i] = o;
  }
  float* tile = (float*)smem;
  { const float* w = p.w_in; tcvt_all([=](int j) -> const float* { const int c = inproj_col(j); return c >= 0 ? w + c : nullptr; }, 6424, p.WinT, 1024, NINP, tile, bid, nb); }
  { const float* w = p.w_up_attn; tcvt_all([=](int j) -> const float* { return w + j; }, 1024, p.WaT, 512, 1024, tile, bid, nb); }
  { const float* w = p.w_up_ret; tcvt_all([=](int j) -> const float* { return w + j; }, 1024, p.WrT, 1024, 1024, tile, bid, nb); }
  { const float* w = p.w_out; tcvt_all([=](int j) -> const float* { return w + j; }, 1024, p.WoT, 1024, 1024, tile, bid, nb); }
  { const float* w = p.cmp_k_w1; tcvt_all([=](int j) -> const float* { return w + j; }, 256, p.W1kT, 2048, 256, tile, bid, nb); }
  { const float* w = p.cmp_v_w1; tcvt_all([=](int j) -> const float* { return w + j; }, 256, p.W1vT, 2048, 256, tile, bid, nb); }
  for (size_t i = gtid; i < (size_t)T * 96; i += gsz) {
    const int t = (int)(i / 96), r = (int)(i % 96);
    float invf; float* dst;
    if (r < 32) { invf = (float)pow(10000.0, -2.0 * r / 64.0); dst = p.ropeN + ((size_t)t * 32 + r) * 2; }
    else { const int q = r - 32; invf = (float)pow(10000.0, -2.0 * q / 128.0); dst = p.ropeR + ((size_t)t * 64 + q) * 2; }
    const float ang = (float)t * invf;
    dst[0] = (float)cos((double)ang); dst[1] = (float)sin((double)ang);
  }
  for (size_t i = gtid; i < 512; i += gsz) {
    const int kv = (int)(i >> 8), j = (int)(i & 255);
    const float* pos = kv ? p.cmp_pos_v : p.cmp_pos_k; const float* w1 = kv ? p.cmp_v_w1 : p.cmp_k_w1; const float* b1 = kv ? p.cmp_v_b1 : p.cmp_k_b1;
    float s = b1[j];
    for (int q = 0; q < 2048; q++) s += pos[q] * w1[(size_t)q * 256 + j];
    p.posb[i] = s;
  }
  if (gtid < 32) p.cnt[gtid] = 0;
}

DI void inproj_tile(const Params& p, int mt_, int nt_, char* smem) {
  const int m0 = mt_ * 128;
  const bf16_t* A = p.xb + (size_t)m0 * D; const bf16_t* Bt = p.WinT + (size_t)nt_ * 128 * D;
  f32x4 acc[4][4]; zero_acc(acc);
  auto ar = [=](int r) { return A + (size_t)r * D; };
  auto br = [=](int r) { return Bt + (size_t)r * D; };
  const bool transposed = (nt_ == 7 || nt_ == 9 || (nt_ >= 18 && nt_ < 26));
  if (transposed) {
    gemm128<false>(acc, ar, br, D, smem);
    epilogue<false>(acc, [&](int r, int c, f32x4 v) {
      const int m = m0 + r, b = m >> 12, t = m & 4095;
      uint2 o; o.x = pack2(v[0], v[1]); o.y = pack2(v[2], v[3]);
      if (nt_ < 18) { bf16_t* dst = (nt_ == 7) ? p.SVt : p.WVt; const int g = c >> 6, d = c & 63;
        *(uint2*)(dst + ((size_t)((b * 2 + g) * 64 + d)) * T + t) = o; }
      else { const int h = (nt_ - 18) >> 1, e = ((nt_ - 18) & 1) * 128 + c;
        *(uint2*)(p.RVt + ((size_t)((b * 4 + h) * 256 + e)) * T + t) = o; }
    });
    return;
  }
  gemm128<true>(acc, ar, br, D, smem);
  epilogue<true>(acc, [&](int r, int c, f32x4 v) {
    const int m = m0 + r, b = m >> 12, t = m & 4095;
    if (nt_ < 4 || nt_ == 6 || nt_ == 8) {
      const int pp = c & 63;
      const float4 cs = *(const float4*)(p.ropeN + ((size_t)t * 32 + (pp >> 1)) * 2);
      const float sc = nt_ < 4 ? 0.125f : 1.f;
      const float a0 = (v[0] * cs.x - v[1] * cs.y) * sc, a1 = (v[0] * cs.y + v[1] * cs.x) * sc;
      const float a2 = (v[2] * cs.z - v[3] * cs.w) * sc, a3 = (v[2] * cs.w + v[3] * cs.z) * sc;
      uint2 o; o.x = pack2(a0, a1); o.y = pack2(a2, a3);
      if (nt_ < 4) { const int head = nt_ * 2 + (c >> 6); *(uint2*)(p.Qn + ((size_t)(b * 8 + head) * T + t) * 64 + pp) = o; }
      else { bf16_t* dst = nt_ == 6 ? p.SK : p.WK; const int g = c >> 6; *(uint2*)(dst + ((size_t)(b * 2 + g) * T + t) * 64 + pp) = o; }
    } else if (nt_ == 4 || nt_ == 5) {
      bf16_t* dst = nt_ == 4 ? p.CK : p.CV; const int g = c >> 6, pp = c & 63;
      uint2 o; o.x = pack2(v[0], v[1]); o.y = pack2(v[2], v[3]);
      *(uint2*)(dst + ((size_t)(b * 2 + g) * T + t) * 64 + pp) = o;
    } else if (nt_ >= 10 && nt_ < 18) {
      const bool isk = nt_ >= 14; const int h = (nt_ - 10) & 3;
      const float4 cs = *(const float4*)(p.ropeR + ((size_t)t * 64 + (c >> 1)) * 2);
      const float sc = isk ? 0.08838834764831845f : 1.f;
      const float a0 = (v[0] * cs.x - v[1] * cs.y) * sc, a1 = (v[0] * cs.y + v[1] * cs.x) * sc;
      const float a2 = (v[2] * cs.z - v[3] * cs.w) * sc, a3 = (v[2] * cs.w + v[3] * cs.z) * sc;
      uint2 o; o.x = pack2(a0, a1); o.y = pack2(a2, a3);
      *(uint2*)((isk ? p.RK : p.RQ) + ((size_t)(b * 4 + h) * T + t) * 128 + c) = o;
      if (isk) {
        const float lg = log2f(1.f - exp2f(-5.f - (float)h));
        const float z = exp2f((float)(127 - (t & 127)) * lg);
        bf16_t* dst = p.RKzT + ((size_t)((b * 4 + h) * 128 + c)) * T + t;
        dst[0] = f2bf(a0 * z); dst[T] = f2bf(a1 * z); dst[2 * T] = f2bf(a2 * z); dst[3 * T] = f2bf(a3 * z);
      }
    } else if (nt_ >= 26 && nt_ < 34) {
      uint2 o; o.x = pack2(v[0], v[1]); o.y = pack2(v[2], v[3]);
      *(uint2*)(p.RG + (size_t)m * 1024 + (nt_ - 26) * 128 + c) = o;
    } else if (nt_ >= 34 && nt_ < 50) {
      uint2 o; o.x = pack2(v[0], v[1]); o.y = pack2(v[2], v[3]);
      *(uint2*)(p.MG + (size_t)m * 2048 + (nt_ - 34) * 128 + c) = o;
    } else if (nt_ == 50) {
      if (c < 24) { float4 o; o.x = sigmoidf_(v[0]); o.y = sigmoidf_(v[1]); o.z = sigmoidf_(v[2]); o.w = sigmoidf_(v[3]);
        *(float4*)(p.NG + (size_t)m * 24 + c) = o; }
    }
  });
}
DI void phase1(const Params& p, char* smem) {
  const int xcd = blockIdx.x & 7, lb = blockIdx.x >> 3, nlb = gridDim.x >> 3;
  for (int li = lb; li < 16 * 51; li += nlb) {
    const int mi = li & 7, rest = li >> 3, nt_ = rest % 51, half = rest / 51;
    inproj_tile(p, xcd * 16 + half * 8 + mi, nt_, smem);
  }
}

struct WaveAttn { float m[4], l[4], o[4]; };
DI void wa_init(WaveAttn& s) { for (int h = 0; h < 4; h++) { s.m[h] = -1e30f; s.l[h] = 0.f; s.o[h] = 0.f; } }
DI void wa_block(WaveAttn& s, const float* qs, float* ps, const bf16_t* Kb, const bf16_t* Vt, int ldv, int key0, int lo, int hi, int lane) {
  const int key = key0 + lane; const bool valid = key >= lo && key <= hi;
  float sc[4] = {0.f, 0.f, 0.f, 0.f};
  const uint4* kr = (const uint4*)(Kb + (size_t)key * 64);
#pragma unroll
  for (int c8 = 0; c8 < 8; c8++) {
    const uint4 kv = kr[c8];
    float kf[8] = {lo2f(kv.x), hi2f(kv.x), lo2f(kv.y), hi2f(kv.y), lo2f(kv.z), hi2f(kv.z), lo2f(kv.w), hi2f(kv.w)};
#pragma unroll
    for (int h = 0; h < 4; h++) {
      const float4 q0 = *(const float4*)(qs + h * 64 + c8 * 8), q1 = *(const float4*)(qs + h * 64 + c8 * 8 + 4);
      sc[h] += q0.x * kf[0] + q0.y * kf[1] + q0.z * kf[2] + q0.w * kf[3] + q1.x * kf[4] + q1.y * kf[5] + q1.z * kf[6] + q1.w * kf[7];
    }
  }
  WSYNC();
#pragma unroll
  for (int h = 0; h < 4; h++) {
    const float sv = valid ? sc[h] : -1e30f;
    const float mn = fmaxf(s.m[h], wmax(sv));
    const float alpha = __expf(s.m[h] - mn);
    const float pv = valid ? __expf(sv - mn) : 0.f;
    s.l[h] = s.l[h] * alpha + wsum(pv); s.o[h] *= alpha; s.m[h] = mn;
    ps[h * 64 + lane] = pv;
  }
  WSYNC();
  const uint4* vr = (const uint4*)(Vt + (size_t)lane * ldv + key0);
#pragma unroll
  for (int c8 = 0; c8 < 8; c8++) {
    const uint4 vv = vr[c8];
    float vf[8] = {lo2f(vv.x), hi2f(vv.x), lo2f(vv.y), hi2f(vv.y), lo2f(vv.z), hi2f(vv.z), lo2f(vv.w), hi2f(vv.w)};
#pragma unroll
    for (int h = 0; h < 4; h++) {
      const float4 p0 = *(const float4*)(ps + h * 64 + c8 * 8), p1 = *(const float4*)(ps + h * 64 + c8 * 8 + 4);
      s.o[h] += p0.x * vf[0] + p0.y * vf[1] + p0.z * vf[2] + p0.w * vf[3] + p1.x * vf[4] + p1.y * vf[5] + p1.z * vf[6] + p1.w * vf[7];
    }
  }
  WSYNC();
}
DI void load_q(const Params& p, float* qs, int b, int g, int t, int lane) {
#pragma unroll
  for (int h = 0; h < 4; h++) qs[h * 64 + lane] = bf2f(p.Qn[((size_t)(b * 8 + g * 4 + h) * T + t) * 64 + lane]);
  WSYNC();
}
DI void naive_sparse(const Params& p, int item, int branch, char* wsm, int lane) {
  const int bg = item >> 12, t = item & 4095, b = bg >> 1, g = bg & 1;
  float* qs = (float*)wsm; float* ps = qs + 256;
  load_q(p, qs, b, g, t, lane);
  unsigned long long mask; int lo;
  const int blk = t >> 6;
  if (branch == 1) { mask = p.selmask[item]; mask &= (blk == 63) ? ~0ull : ((1ull << (blk + 1)) - 1ull); lo = 0; }
  else { lo = t - 511; if (lo < 0) lo = 0; const int b0 = lo >> 6; mask = ((blk == 63) ? ~0ull : ((1ull << (blk + 1)) - 1ull)) & ~((1ull << b0) - 1ull); }
  const bf16_t* Kb = (branch == 1 ? p.SK : p.WK) + (size_t)bg * T * 64;
  const bf16_t* Vt = (branch == 1 ? p.SVt : p.WVt) + (size_t)bg * 64 * T;
  WaveAttn s; wa_init(s);
  while (mask) {
    const int j = __ffsll((long long)mask) - 1; mask &= mask - 1;
    wa_block(s, qs, ps, Kb, Vt, T, j * 64, lo, t, lane);
  }
  const int m = b * T + t;
#pragma unroll
  for (int h = 0; h < 4; h++) {
    const int hh = g * 4 + h;
    const float gate = p.NG[(size_t)m * 24 + hh * 3 + branch];
    const float val = s.l[h] > 0.f ? gate * s.o[h] / s.l[h] : 0.f;
    bf16_t* dst = p.oattn + (size_t)m * 512 + hh * 64 + lane;
    if (branch == 2) *dst = f2bf(val); else *dst = f2bf(bf2f(*dst) + val);
  }
}
DI void naive_cmp(const Params& p, int item, char* wsm, int lane) {
  const int bg = item >> 12, t = item & 4095, b = bg >> 1, g = bg & 1;
  float* qs = (float*)wsm; float* pn = qs + 256; float* scr = pn + 1024;
  load_q(p, qs, b, g, t, lane);
  const int nvalid = t >= 31 ? ((t - 31) >> 4) + 1 : 0;
  const bf16_t* Kb = p.kcmp + (size_t)bg * 256 * 64;
#pragma unroll 1
  for (int jj = 0; jj < 4; jj++) {
    const int n = lane + 64 * jj;
    const uint4* kr = (const uint4*)(Kb + (size_t)n * 64);
    float a[4] = {0.f, 0.f, 0.f, 0.f};
#pragma unroll 2
    for (int c8 = 0; c8 < 8; c8++) {
      const uint4 kv = kr[c8];
      float kf[8] = {lo2f(kv.x), hi2f(kv.x), lo2f(kv.y), hi2f(kv.y), lo2f(kv.z), hi2f(kv.z), lo2f(kv.w), hi2f(kv.w)};
#pragma unroll
      for (int h = 0; h < 4; h++) {
        const float4 q0 = *(const float4*)(qs + h * 64 + c8 * 8), q1 = *(const float4*)(qs + h * 64 + c8 * 8 + 4);
        a[h] += q0.x * kf[0] + q0.y * kf[1] + q0.z * kf[2] + q0.w * kf[3] + q1.x * kf[4] + q1.y * kf[5] + q1.z * kf[6] + q1.w * kf[7];
      }
    }
#pragma unroll
    for (int h = 0; h < 4; h++) pn[h * 256 + n] = (n < nvalid) ? a[h] : -1e30f;
  }
  WSYNC();
#pragma unroll 1
  for (int h = 0; h < 4; h++) {
    float sv[4];
#pragma unroll
    for (int jj = 0; jj < 4; jj++) sv[jj] = pn[h * 256 + lane + 64 * jj];
    float mx = fmaxf(fmaxf(sv[0], sv[1]), fmaxf(sv[2], sv[3])); mx = wmax(mx);
    float e[4], sum = 0.f;
#pragma unroll
    for (int jj = 0; jj < 4; jj++) { e[jj] = (lane + 64 * jj < nvalid) ? __expf(sv[jj] - mx) : 0.f; sum += e[jj]; }
    sum = wsum(sum);
    const float inv = sum > 0.f ? 1.f / sum : 0.f;
#pragma unroll
    for (int jj = 0; jj < 4; jj++) pn[h * 256 + lane + 64 * jj] = e[jj] * inv;
  }
  WSYNC();
  float imp = 0.f;
  {
    const int s4 = lane * 4;
#pragma unroll
    for (int h = 0; h < 4; h++) {
      const float* ph = pn + h * 256;
      float v = 2.f * (ph[s4] + ph[s4 + 1] + ph[s4 + 2]);
      if (s4 > 0) v += ph[s4 - 1];
      if (s4 + 3 < 255) v += ph[s4 + 3];
      imp += v;
    }
  }
  const int blk = t >> 6;
  const float score = (lane == 0 || lane == blk || lane == blk - 1) ? 1e9f : (lane <= blk ? imp : -1e9f);
  scr[lane] = score;
  WSYNC();
  int rank = 0;
  for (int i = 0; i < 64; i++) { const float si = scr[i]; rank += (si > score || (si == score && i < lane)) ? 1 : 0; }
  const unsigned long long sel = __ballot(rank < 16);
  if (lane == 0) p.selmask[item] = sel;
  float o[4] = {0.f, 0.f, 0.f, 0.f};
  const bf16_t* Vt = p.vcmpT + (size_t)(bg * 64 + lane) * 256;
  const int nch = (nvalid + 7) >> 3;
  for (int c8 = 0; c8 < nch; c8++) {
    const uint4 vv = ((const uint4*)Vt)[c8];
    float vf[8] = {lo2f(vv.x), hi2f(vv.x), lo2f(vv.y), hi2f(vv.y), lo2f(vv.z), hi2f(vv.z), lo2f(vv.w), hi2f(vv.w)};
#pragma unroll
    for (int h = 0; h < 4; h++) {
      const float4 p0 = *(const float4*)(pn + h * 256 + c8 * 8), p1 = *(const float4*)(pn + h * 256 + c8 * 8 + 4);
      o[h] += p0.x * vf[0] + p0.y * vf[1] + p0.z * vf[2] + p0.w * vf[3] + p1.x * vf[4] + p1.y * vf[5] + p1.z * vf[6] + p1.w * vf[7];
    }
  }
  const int m = b * T + t;
#pragma unroll
  for (int h = 0; h < 4; h++) {
    const int hh = g * 4 + h;
    const float gate = p.NG[(size_t)m * 24 + hh * 3 + 0];
    bf16_t* dst = p.oattn + (size_t)m * 512 + hh * 64 + lane;
    *dst = f2bf(bf2f(*dst) + gate * o[h]);
  }
  WSYNC();
}

DI float gelu_tanh(float x) { const float u = 0.7978845608028654f * (x + 0.044715f * x * x * x); return 0.5f * x * (1.f + tanhf(u)); }
DI void compress1_tile(const Params& p, int tile, char* smem) {
  const int ntl = tile & 1, mtile = tile >> 1, half = mtile & 1, bg = (mtile >> 1) & 7, kv = mtile >> 4;
  const bf16_t* src = (kv ? p.CV : p.CK) + (size_t)bg * T * 64 + (size_t)half * 128 * 1024;
  const bf16_t* Bt = (kv ? p.W1vT : p.W1kT) + (size_t)ntl * 128 * 2048;
  f32x4 acc[4][4]; zero_acc(acc);
  gemm128<true>(acc, [=](int r) { return src + (size_t)r * 1024; }, [=](int r) { return Bt + (size_t)r * 2048; }, 2048, smem);
  epilogue<true>(acc, [&](int r, int c, f32x4 v) {
    const int n = half * 128 + r;
    if (n < 255) {
      const int j = ntl * 128 + c;
      const float4 pb = *(const float4*)(p.posb + kv * 256 + j);
      uint2 o; o.x = pack2(gelu_tanh(v[0] + pb.x), gelu_tanh(v[1] + pb.y)); o.y = pack2(gelu_tanh(v[2] + pb.z), gelu_tanh(v[3] + pb.w));
      *(uint2*)(p.H1 + ((size_t)((kv * 8 + bg) * 256 + n)) * 256 + j) = o;
    }
  });
}
DI void compress2(const Params& p) {
  const size_t gtid = (size_t)blockIdx.x * 256 + threadIdx.x, gsz = (size_t)gridDim.x * 256;
  for (size_t i = gtid; i < (size_t)2 * 8 * 256 * 32; i += gsz) {
    const int ii = (int)(i & 31), n = (int)((i >> 5) & 255), bg = (int)((i >> 13) & 7), kv = (int)(i >> 16);
    float a0 = 0.f, a1 = 0.f;
    if (n < 255) {
      const bf16_t* h = p.H1 + ((size_t)((kv * 8 + bg) * 256 + n)) * 256;
      const float* w2 = kv ? p.cmp_v_w2 : p.cmp_k_w2; const float* b2 = kv ? p.cmp_v_b2 : p.cmp_k_b2;
      a0 = b2[ii]; a1 = b2[ii + 32];
      for (int j = 0; j < 256; j++) { const float hv = bf2f(h[j]); a0 += hv * w2[j * 64 + ii]; a1 += hv * w2[j * 64 + ii + 32]; }
    }
    if (kv == 0) {
      float r0 = 0.f, r1 = 0.f;
      if (n < 255) { const int pos = 16 * n + 31; const float c = p.ropeN[((size_t)pos * 32 + ii) * 2], s = p.ropeN[((size_t)pos * 32 + ii) * 2 + 1];
        r0 = a0 * c - a1 * s; r1 = a0 * s + a1 * c; }
      *(unsigned*)(p.kcmp + ((size_t)(bg * 256 + n)) * 64 + 2 * ii) = pack2(r0, r1);
    } else {
      p.vcmpT[((size_t)(bg * 64 + ii)) * 256 + n] = f2bf(a0);
      p.vcmpT[((size_t)(bg * 64 + ii + 32)) * 256 + n] = f2bf(a1);
    }
  }
}

DI void ret_scan(const Params& p) {
  const size_t gtid = (size_t)blockIdx.x * 256 + threadIdx.x, gsz = (size_t)gridDim.x * 256;
  for (size_t i = gtid; i < (size_t)16 * 256 * 128; i += gsz) {
    const int dk = (int)(i & 127), e = (int)((i >> 7) & 255), bh = (int)(i >> 15), h = bh & 3;
    const float cd = exp2f(128.f * log2f(1.f - exp2f(-5.f - (float)h)));
    const bf16_t* kz = p.RKzT + ((size_t)(bh * 128 + dk)) * T;
    const bf16_t* vt = p.RVt + ((size_t)(bh * 256 + e)) * T;
    float R = 0.f;
    for (int n = 0; n < 32; n++) {
      p.Rt[(((size_t)bh * 32 + n) * 256 + e) * 128 + dk] = f2bf(R);
      if (n == 31) break;
      float s = 0.f;
      const uint4* k4 = (const uint4*)(kz + n * 128); const uint4* v4 = (const uint4*)(vt + n * 128);
#pragma unroll 4
      for (int c = 0; c < 16; c++) {
        const uint4 a = k4[c], bq = v4[c];
        s += lo2f(a.x) * lo2f(bq.x) + hi2f(a.x) * hi2f(bq.x) + lo2f(a.y) * lo2f(bq.y) + hi2f(a.y) * hi2f(bq.y)
           + lo2f(a.z) * lo2f(bq.z) + hi2f(a.z) * hi2f(bq.z) + lo2f(a.w) * lo2f(bq.w) + hi2f(a.w) * hi2f(bq.w);
      }
      R = R * cd + s;
    }
  }
}
DI void ret_out(const Params& p, int item, char* wsm, int lane) {
  const int bh = item >> 12, t = item & 4095, b = bh >> 2, h = bh & 3, n = t >> 7, c = t & 127;
  float* qs = (float*)wsm; float* ss = qs + 128;
  const bf16_t* qrow = p.RQ + ((size_t)bh * T + t) * 128;
  qs[lane] = bf2f(qrow[lane]); qs[lane + 64] = bf2f(qrow[lane + 64]);
  WSYNC();
  const float lg = log2f(1.f - exp2f(-5.f - (float)h));
#pragma unroll 1
  for (int jj = 0; jj < 2; jj++) {
    const int mm = lane + 64 * jj;
    const uint4* kr = (const uint4*)(p.RK + ((size_t)bh * T + n * 128 + mm) * 128);
    float a = 0.f;
#pragma unroll 4
    for (int c8 = 0; c8 < 16; c8++) {
      const uint4 kv = kr[c8];
      const float4 q0 = *(const float4*)(qs + c8 * 8), q1 = *(const float4*)(qs + c8 * 8 + 4);
      a += q0.x * lo2f(kv.x) + q0.y * hi2f(kv.x) + q0.z * lo2f(kv.y) + q0.w * hi2f(kv.y) + q1.x * lo2f(kv.z) + q1.y * hi2f(kv.z) + q1.z * lo2f(kv.w) + q1.w * hi2f(kv.w);
    }
    ss[mm] = (mm <= c) ? a * exp2f((float)(c - mm) * lg) : 0.f;
  }
  WSYNC();
  const float xi = exp2f((float)(c + 1) * lg);
  float o[4];
#pragma unroll
  for (int jj = 0; jj < 4; jj++) {
    asm volatile("" ::: "memory");
    const int e = lane + 64 * jj;
    const uint4* vr = (const uint4*)(p.RVt + ((size_t)(bh * 256 + e)) * T + n * 128);
    const uint4* rr = (const uint4*)(p.Rt + (((size_t)bh * 32 + n) * 256 + e) * 128);
    float a = 0.f, cr = 0.f;
    const int nch = (c >> 3) + 1;
#pragma unroll 2
    for (int c8 = 0; c8 < nch; c8++) {
      const uint4 vv = vr[c8];
      const float4 s0 = *(const float4*)(ss + c8 * 8), s1 = *(const float4*)(ss + c8 * 8 + 4);
      a += s0.x * lo2f(vv.x) + s0.y * hi2f(vv.x) + s0.z * lo2f(vv.y) + s0.w * hi2f(vv.y) + s1.x * lo2f(vv.z) + s1.y * hi2f(vv.z) + s1.z * lo2f(vv.w) + s1.w * hi2f(vv.w);
    }
#pragma unroll 4
    for (int c8 = 0; c8 < 16; c8++) {
      const uint4 rv = rr[c8];
      const float4 q0 = *(const float4*)(qs + c8 * 8), q1 = *(const float4*)(qs + c8 * 8 + 4);
      cr += q0.x * lo2f(rv.x) + q0.y * hi2f(rv.x) + q0.z * lo2f(rv.y) + q0.w * hi2f(rv.y) + q1.x * lo2f(rv.z) + q1.y * hi2f(rv.z) + q1.z * lo2f(rv.w) + q1.w * hi2f(rv.w);
    }
    o[jj] = a + xi * cr;
  }
  float mu = wsum(o[0] + o[1] + o[2] + o[3]) * (1.f / 256.f);
  float var = 0.f;
#pragma unroll
  for (int jj = 0; jj < 4; jj++) { const float d = o[jj] - mu; var += d * d; }
  var = wsum(var) * (1.f / 256.f);
  const float rs = rsqrtf(var + 1e-5f);
  const int m = b * T + t;
#pragma unroll
  for (int jj = 0; jj < 4; jj++) {
    const int col = h * 256 + lane + 64 * jj;
    const float y = (o[jj] - mu) * rs * p.gn_g[col] + p.gn_b[col];
    const float gt = bf2f(p.RG[(size_t)m * 1024 + col]);
    p.oret[(size_t)m * 1024 + col] = f2bf(y * gt * sigmoidf_(gt));
  }
  WSYNC();
}

DI void upproj_tile(const Params& p, int tile, char* smem) {
  const int nt_ = tile & 7, mt_ = tile >> 3, m0 = mt_ * 128, n0 = nt_ * 128;
  f32x4 acc[4][4];
  zero_acc(acc);
  { const bf16_t* A = p.oattn + (size_t)m0 * 512; const bf16_t* Bt = p.WaT + (size_t)n0 * 512;
    gemm128<true>(acc, [=](int r) { return A + (size_t)r * 512; }, [=](int r) { return Bt + (size_t)r * 512; }, 512, smem); }
  epilogue<true>(acc, [&](int r, int c, f32x4 v) {
    const size_t m = m0 + r; const int cc = n0 + c;
    const uint2 gv = *(const uint2*)(p.MG + m * 2048 + cc);
    uint2 o; o.x = pack2(sigmoidf_(lo2f(gv.x)) * v[0], sigmoidf_(hi2f(gv.x)) * v[1]); o.y = pack2(sigmoidf_(lo2f(gv.y)) * v[2], sigmoidf_(hi2f(gv.y)) * v[3]);
    *(uint2*)(p.merged + m * 1024 + cc) = o;
  });
  zero_acc(acc);
  { const bf16_t* A = p.oret + (size_t)m0 * 1024; const bf16_t* Bt = p.WrT + (size_t)n0 * 1024;
    gemm128<true>(acc, [=](int r) { return A + (size_t)r * 1024; }, [=](int r) { return Bt + (size_t)r * 1024; }, 1024, smem); }
  epilogue<true>(acc, [&](int r, int c, f32x4 v) {
    const size_t m = m0 + r; const int cc = n0 + c;
    const uint2 gv = *(const uint2*)(p.MG + m * 2048 + 1024 + cc);
    const uint2 pr = *(const uint2*)(p.merged + m * 1024 + cc);
    uint2 o; o.x = pack2(lo2f(pr.x) + sigmoidf_(lo2f(gv.x)) * v[0], hi2f(pr.x) + sigmoidf_(hi2f(gv.x)) * v[1]);
    o.y = pack2(lo2f(pr.y) + sigmoidf_(lo2f(gv.y)) * v[2], hi2f(pr.y) + sigmoidf_(hi2f(gv.y)) * v[3]);
    *(uint2*)(p.merged + m * 1024 + cc) = o;
  });
}
DI void wout_tile(const Params& p, int tile, char* smem) {
  const int nt_ = tile & 7, mt_ = tile >> 3, m0 = mt_ * 128, n0 = nt_ * 128;
  f32x4 acc[4][4]; zero_acc(acc);
  const bf16_t* A = p.merged + (size_t)m0 * 1024; const bf16_t* Bt = p.WoT + (size_t)n0 * 1024;
  gemm128<true>(acc, [=](int r) { return A + (size_t)r * 1024; }, [=](int r) { return Bt + (size_t)r * 1024; }, 1024, smem);
  epilogue<true>(acc, [&](int r, int c, f32x4 v) {
    const size_t idx = (size_t)(m0 + r) * 1024 + n0 + c;
    const float4 xv = *(const float4*)(p.x + idx);
    float4 o; o.x = ALPHA * xv.x + v[0]; o.y = ALPHA * xv.y + v[1]; o.z = ALPHA * xv.z + v[2]; o.w = ALPHA * xv.w + v[3];
    *(float4*)(p.out + idx) = o;
  });
}
DI void expert_cvt(const Params& p, char* smem) {
  float* tile = (float*)smem;
  const int bid = blockIdx.x, nb = gridDim.x;
  for (int e = 0; e < NEXP; e++) {
    const float* wg = p.e_wg + (size_t)e * 1024 * 512; const float* wu = p.e_wu + (size_t)e * 1024 * 512; const float* wd = p.e_wd + (size_t)e * 512 * 1024;
    tcvt_all([=](int j) -> const float* { const int f = (j >> 7) * 64 + ((j >> 5) & 3) * 16 + (j & 15); return (((j >> 4) & 1) ? wu : wg) + f; },
             512, p.EgT + (size_t)e * 1024 * 1024, 1024, 1024, tile, (bid + e * 37) % nb, nb);
    tcvt_all([=](int j) -> const float* { return wd + j; }, 1024, p.EdT + (size_t)e * 1024 * 512, 512, 1024, tile, (bid + e * 37 + 19) % nb, nb);
  }
}

DI void ln1_router(const Params& p, int m, int lane) {
  float* row = p.out + (size_t)m * 1024;
  float4 v[4];
#pragma unroll
  for (int i = 0; i < 4; i++) v[i] = *(const float4*)(row + i * 256 + lane * 4);
  float s = 0.f;
#pragma unroll
  for (int i = 0; i < 4; i++) s += v[i].x + v[i].y + v[i].z + v[i].w;
  const float mu = wsum(s) * (1.f / 1024.f);
  float q = 0.f;
#pragma unroll
  for (int i = 0; i < 4; i++) { const float a = v[i].x - mu, b = v[i].y - mu, c = v[i].z - mu, d = v[i].w - mu; q += a * a + b * b + c * c + d * d; }
  const float rs = rsqrtf(wsum(q) * (1.f / 1024.f) + 1e-5f);
  float gl[4] = {0.f, 0.f, 0.f, 0.f};
#pragma unroll
  for (int i = 0; i < 4; i++) {
    const int k = i * 256 + lane * 4;
    const float4 g = *(const float4*)(p.ln1_g + k), bb = *(const float4*)(p.ln1_b + k);
    v[i].x = (v[i].x - mu) * rs * g.x + bb.x; v[i].y = (v[i].y - mu) * rs * g.y + bb.y;
    v[i].z = (v[i].z - mu) * rs * g.z + bb.z; v[i].w = (v[i].w - mu) * rs * g.w + bb.w;
    *(float4*)(row + k) = v[i];
    uint2 o; o.x = pack2(v[i].x, v[i].y); o.y = pack2(v[i].z, v[i].w);
    *(uint2*)(p.x1b + (size_t)m * 1024 + k) = o;
    const float xs[4] = {v[i].x, v[i].y, v[i].z, v[i].w};
#pragma unroll
    for (int kk = 0; kk < 4; kk++) {
      const float4 w = *(const float4*)(p.rg_w + (size_t)(k + kk) * 4);
      gl[0] += xs[kk] * w.x; gl[1] += xs[kk] * w.y; gl[2] += xs[kk] * w.z; gl[3] += xs[kk] * w.w;
    }
  }
#pragma unroll
  for (int j = 0; j < 4; j++) gl[j] = wsum(gl[j]) + p.rg_b[j];
  int gi = 0; float gm = gl[0];
#pragma unroll
  for (int j = 1; j < 4; j++) if (gl[j] > gm) { gm = gl[j]; gi = j; }
  float gs = 0.f;
#pragma unroll
  for (int j = 0; j < 4; j++) gs += __expf(gl[j] - gm);
  const float gprob = 1.f / gs;
  float il[8] = {0.f, 0.f, 0.f, 0.f, 0.f, 0.f, 0.f, 0.f};
  const float* riw = p.ri_w + (size_t)gi * 1024 * 8;
#pragma unroll
  for (int i = 0; i < 4; i++) {
    const int k = i * 256 + lane * 4;
    const float xs[4] = {v[i].x, v[i].y, v[i].z, v[i].w};
#pragma unroll
    for (int kk = 0; kk < 4; kk++) {
      const float4 w0 = *(const float4*)(riw + (size_t)(k + kk) * 8), w1 = *(const float4*)(riw + (size_t)(k + kk) * 8 + 4);
      il[0] += xs[kk] * w0.x; il[1] += xs[kk] * w0.y; il[2] += xs[kk] * w0.z; il[3] += xs[kk] * w0.w;
      il[4] += xs[kk] * w1.x; il[5] += xs[kk] * w1.y; il[6] += xs[kk] * w1.z; il[7] += xs[kk] * w1.w;
    }
  }
#pragma unroll
  for (int j = 0; j < 8; j++) il[j] = wsum(il[j]) + p.ri_b[gi * 8 + j];
  int e1 = 0; float l1 = il[0];
#pragma unroll
  for (int j = 1; j < 8; j++) if (il[j] > l1) { l1 = il[j]; e1 = j; }
  int e2 = -1; float l2 = -3e38f;
#pragma unroll
  for (int j = 0; j < 8; j++) if (j != e1 && il[j] > l2) { l2 = il[j]; e2 = j; }
  const float ex = __expf(l2 - l1);
  const float w1 = gprob / (1.f + ex), w2 = gprob * ex / (1.f + ex);
  if (lane == 0) {
    const int ea = gi * 8 + e1, eb = gi * 8 + e2;
    const int pa = atomicAdd(p.cnt + ea, 1); p.lists[ea * 16384 + pa] = m * 2;
    const int pb = atomicAdd(p.cnt + eb, 1); p.lists[eb * 16384 + pb] = m * 2 + 1;
    p.routew[m * 2] = w1; p.routew[m * 2 + 1] = w2;
  }
}
DI void ln2_final(const Params& p, int m, int lane) {
  float* row = p.out + (size_t)m * 1024;
  float4 v[4];
  float s = 0.f;
#pragma unroll
  for (int i = 0; i < 4; i++) {
    const int k = i * 256 + lane * 4;
    const float4 xv = *(const float4*)(row + k);
    const uint2 a = *(const uint2*)(p.part + (size_t)(2 * m) * 1024 + k), b = *(const uint2*)(p.part + (size_t)(2 * m + 1) * 1024 + k);
    v[i].x = ALPHA * xv.x + lo2f(a.x) + lo2f(b.x); v[i].y = ALPHA * xv.y + hi2f(a.x) + hi2f(b.x);
    v[i].z = ALPHA * xv.z + lo2f(a.y) + lo2f(b.y); v[i].w = ALPHA * xv.w + hi2f(a.y) + hi2f(b.y);
    s += v[i].x + v[i].y + v[i].z + v[i].w;
  }
  const float mu = wsum(s) * (1.f / 1024.f);
  float q = 0.f;
#pragma unroll
  for (int i = 0; i < 4; i++) { const float a = v[i].x - mu, b = v[i].y - mu, c = v[i].z - mu, d = v[i].w - mu; q += a * a + b * b + c * c + d * d; }
  const float rs = rsqrtf(wsum(q) * (1.f / 1024.f) + 1e-5f);
#pragma unroll
  for (int i = 0; i < 4; i++) {
    const int k = i * 256 + lane * 4;
    const float4 g = *(const float4*)(p.ln2_g + k), bb = *(const float4*)(p.ln2_b + k);
    float4 o; o.x = (v[i].x - mu) * rs * g.x + bb.x; o.y = (v[i].y - mu) * rs * g.y + bb.y; o.z = (v[i].z - mu) * rs * g.z + bb.z; o.w = (v[i].w - mu) * rs * g.w + bb.w;
    *(float4*)(row + k) = o;
  }
}

struct MoeMap { int e, mi, cnt, hoff; };
DI bool moe_map(const Params& p, int mtile, MoeMap& mm) {
  int acc = 0;
  for (int e = 0; e < NEXP; e++) {
    const int c = p.cnt[e], nt = (c + 127) >> 7;
    if (mtile < acc + nt) { mm.e = e; mm.mi = mtile - acc; mm.cnt = c; mm.hoff = acc * 128; return true; }
    acc += nt;
  }
  return false;
}
DI int moe_total(const Params& p) { int acc = 0; for (int e = 0; e < NEXP; e++) acc += (p.cnt[e] + 127) >> 7; return acc; }
DI void moe_up_tile(const Params& p, const MoeMap& mm, int nt_, char* smem) {
  const int* lst = p.lists + mm.e * 16384 + mm.mi * 128; const int nrow = mm.cnt - mm.mi * 128;
  const bf16_t* Bt = p.EgT + ((size_t)mm.e * 1024 + nt_ * 128) * 1024;
  const bf16_t* X = p.x1b;
  f32x4 acc[4][4]; zero_acc(acc);
  gemm128<true>(acc, [=](int r) { const int tk = r < nrow ? (lst[r] >> 1) : 0; return X + (size_t)tk * 1024; }, [=](int r) { return Bt + (size_t)r * 1024; }, 1024, smem);
  const int lane = threadIdx.x & 63, wave = threadIdx.x >> 6, wr = wave >> 1, wc = wave & 1, fr = lane & 15, fq = lane >> 4;
#pragma unroll
  for (int mt = 0; mt < 4; mt++) {
    const int r = wr * 64 + mt * 16 + fr;
    if (r < nrow) {
      const float w = p.routew[lst[r]];
#pragma unroll
      for (int np = 0; np < 2; np++) {
        const f32x4 g = acc[mt][np * 2], u = acc[mt][np * 2 + 1];
        float hv[4];
#pragma unroll
        for (int i = 0; i < 4; i++) hv[i] = g[i] * sigmoidf_(g[i]) * u[i] * w;
        const int f = nt_ * 64 + wc * 32 + np * 16 + fq * 4;
        uint2 o; o.x = pack2(hv[0], hv[1]); o.y = pack2(hv[2], hv[3]);
        *(uint2*)(p.Hh + (size_t)(mm.hoff + mm.mi * 128 + r) * 512 + f) = o;
      }
    }
  }
}
DI void moe_down_tile(const Params& p, const MoeMap& mm, int nt_, char* smem) {
  const int* lst = p.lists + mm.e * 16384 + mm.mi * 128; const int nrow = mm.cnt - mm.mi * 128;
  const bf16_t* A = p.Hh + (size_t)(mm.hoff + mm.mi * 128) * 512;
  const bf16_t* Bt = p.EdT + ((size_t)mm.e * 1024 + nt_ * 128) * 512;
  f32x4 acc[4][4]; zero_acc(acc);
  gemm128<true>(acc, [=](int r) { return A + (size_t)r * 512; }, [=](int r) { return Bt + (size_t)r * 512; }, 512, smem);
  epilogue<true>(acc, [&](int r, int c, f32x4 v) {
    if (r < nrow) {
      const int ts = lst[r];
      uint2 o; o.x = pack2(v[0], v[1]); o.y = pack2(v[2], v[3]);
      *(uint2*)(p.part + (size_t)ts * 1024 + nt_ * 128 + c) = o;
    }
  });
}

constexpr int NPHASE = 12;
DI void run_phase(const Params& p, const int ph, char* smem) {
  const int bid = blockIdx.x, nb = gridDim.x, tid = threadIdx.x, lane = tid & 63, wave = tid >> 6;
  const int gw = bid * 4 + wave, nw = nb * 4;
  char* wsm = smem + wave * 8192;
  switch (ph) {
    case 0: phase0(p, smem); break;
    case 1: phase1(p, smem); break;
    case 2:
      for (int t = bid; t < 64; t += nb) compress1_tile(p, t, smem);
      ret_scan(p);
      for (int it = gw; it < 8 * T; it += nw) naive_sparse(p, it, 2, wsm, lane);
      break;
    case 3: compress2(p); break;
    case 4:
      for (int it = gw; it < 8 * T; it += nw) naive_cmp(p, it, wsm, lane);
      for (int it = gw; it < 16 * T; it += nw) ret_out(p, it, wsm, lane);
      break;
    case 5:
      for (int it = gw; it < 8 * T; it += nw) naive_sparse(p, it, 1, wsm, lane);
      break;
    case 6: for (int t = bid; t < 1024; t += nb) upproj_tile(p, t, smem); break;
    case 7: for (int t = bid; t < 1024; t += nb) wout_tile(p, t, smem); expert_cvt(p, smem); break;
    case 8: for (int m = gw; m < M; m += nw) ln1_router(p, m, lane); break;
    case 9: { const int tot = moe_total(p);
      for (int t = bid; t < tot * 8; t += nb) { MoeMap mm; if (moe_map(p, t >> 3, mm)) moe_up_tile(p, mm, t & 7, smem); } } break;
    case 10: { const int tot = moe_total(p);
      for (int t = bid; t < tot * 8; t += nb) { MoeMap mm; if (moe_map(p, t >> 3, mm)) moe_down_tile(p, mm, t & 7, smem); } } break;
    case 11: for (int m = gw; m < M; m += nw) ln2_final(p, m, lane); break;
  }
}

template <int PH>
__global__ void __launch_bounds__(256, 2) phase_kernel(Params p) {
  __shared__ __attribute__((aligned(16))) char smem[65536];
  run_phase(p, PH, smem);
}
#if FUSED
__global__ void __launch_bounds__(256, 2) mega_kernel(Params p) {
  __shared__ __attribute__((aligned(16))) char smem[65536];
  cg::grid_group grid = cg::this_grid();
  for (int ph = 0; ph < NPHASE; ph++) { run_phase(p, ph, smem); if (ph + 1 < NPHASE) grid.sync(); }
}
#endif

extern "C" void kernel_launch(void* const* d_in, const int* in_sizes, int n_in, void* d_out, int out_size,
                              void* d_ws, size_t ws_size, hipStream_t stream) {
  Params p{};
  const float** ins = (const float**)&p;
  for (int i = 0; i < 28; i++) ins[i] = (const float*)d_in[i];
  p.out = (float*)d_out;
  char* ws = (char*)d_ws; size_t off = 0;
  auto alloc = [&](size_t bytes) { char* r = ws + off; off += (bytes + 255) & ~(size_t)255; return r; };
  const size_t MiB = 1 << 20;
  char* regionP = ws;
  p.Qn = (bf16_t*)alloc(16 * MiB);
  p.CK = (bf16_t*)alloc(4 * MiB); p.CV = (bf16_t*)alloc(4 * MiB); p.SK = (bf16_t*)alloc(4 * MiB); p.SVt = (bf16_t*)alloc(4 * MiB);
  p.WK = (bf16_t*)alloc(4 * MiB); p.WVt = (bf16_t*)alloc(4 * MiB);
  p.NG = (float*)alloc((size_t)M * 24 * 4);
  p.RQ = (bf16_t*)alloc(16 * MiB); p.RK = (bf16_t*)alloc(16 * MiB); p.RKzT = (bf16_t*)alloc(16 * MiB);
  p.RVt = (bf16_t*)alloc(32 * MiB); p.RG = (bf16_t*)alloc(32 * MiB); p.MG = (bf16_t*)alloc(64 * MiB);
  p.oattn = (bf16_t*)alloc(16 * MiB); p.WinT = p.oattn;
  p.oret = (bf16_t*)alloc(32 * MiB);
  p.WaT = (bf16_t*)alloc(1 * MiB); p.WrT = (bf16_t*)alloc(2 * MiB); p.WoT = (bf16_t*)alloc(2 * MiB);
  p.W1kT = (bf16_t*)alloc(1 * MiB); p.W1vT = (bf16_t*)alloc(1 * MiB);
  p.ropeN = (float*)alloc((size_t)T * 32 * 8); p.ropeR = (float*)alloc((size_t)T * 64 * 8); p.posb = (float*)alloc(512 * 4);
  p.H1 = (bf16_t*)alloc(2 * MiB); p.kcmp = (bf16_t*)alloc(8 * 256 * 64 * 2); p.vcmpT = (bf16_t*)alloc(8 * 64 * 256 * 2);
  p.selmask = (unsigned long long*)alloc((size_t)8 * T * 8);
  p.cnt = (int*)alloc(256); p.lists = (int*)alloc((size_t)NEXP * 16384 * 4); p.routew = (float*)alloc((size_t)M * 2 * 4);
  p.merged = (bf16_t*)(regionP); p.x1b = (bf16_t*)(regionP + 32 * MiB);
  p.EgT = (bf16_t*)(regionP + 64 * MiB); p.EdT = (bf16_t*)(regionP + 128 * MiB);
  p.Hh = (bf16_t*)(regionP + 160 * MiB); p.part = (bf16_t*)(regionP + 196 * MiB);
  p.xb = (bf16_t*)d_out; p.Rt = (bf16_t*)d_out;
  if (off > ws_size) { fprintf(stderr, "workspace too small: need %zu have %zu\n", off, ws_size); return; }
#if FUSED
  static int grid_blocks = 0;
  if (!grid_blocks) {
    int dev = 0, cus = 0, per_cu = 0;
    (void)hipGetDevice(&dev);
    (void)hipDeviceGetAttribute(&cus, hipDeviceAttributeMultiprocessorCount, dev);
    (void)hipOccupancyMaxActiveBlocksPerMultiprocessor(&per_cu, mega_kernel, 256, 0);
    if (per_cu > 2) per_cu = 2;
    grid_blocks = cus * per_cu;
  }
  void* args[] = {&p};
  hipError_t e = hipLaunchCooperativeKernel((void*)mega_kernel, dim3(grid_blocks), dim3(256), args, 0, stream);
  if (e != hipSuccess) fprintf(stderr, "coop launch failed: %s\n", hipGetErrorString(e));
#else
#define LAUNCH_PH(N) phase_kernel<N><<<512, 256, 0, stream>>>(p)
  LAUNCH_PH(0); LAUNCH_PH(1); LAUNCH_PH(2); LAUNCH_PH(3); LAUNCH_PH(4); LAUNCH_PH(5);
  LAUNCH_PH(6); LAUNCH_PH(7); LAUNCH_PH(8); LAUNCH_PH(9); LAUNCH_PH(10); LAUNCH_PH(11);
#endif
}
```

```cpp
#include <hip/hip_runtime.h>
#include <hip/hip_cooperative_groups.h>
#include <cstdio>
#include <cstdint>
namespace cg = cooperative_groups;

#ifndef FUSED
#define FUSED 1
#endif

#define DI __device__ __forceinline__
typedef unsigned short bf16_t;
typedef short bf16x8 __attribute__((ext_vector_type(8)));
typedef float f32x4 __attribute__((ext_vector_type(4)));

constexpr int Bn = 4, T = 4096, D = 1024, M = Bn * T;
constexpr int NINP = 6528;
constexpr int NEXP = 32, DFF = 512;
constexpr int HROWS = 36864;
constexpr float ALPHA = 1.189207115002721f;

struct Params {
  const float *x, *w_in, *cmp_pos_k, *cmp_k_w1, *cmp_k_b1, *cmp_k_w2, *cmp_k_b2;
  const float *cmp_pos_v, *cmp_v_w1, *cmp_v_b1, *cmp_v_w2, *cmp_v_b2;
  const float *gn_g, *gn_b, *w_up_attn, *w_up_ret, *w_out, *ln1_g, *ln1_b;
  const float *rg_w, *rg_b, *ri_w, *ri_b, *e_wg, *e_wu, *e_wd, *ln2_g, *ln2_b;
  float* out;
  bf16_t *Qn, *CK, *CV, *SK, *SVt, *WK, *WVt; float* NG;
  bf16_t *RQ, *RK, *RKzT, *RVt, *RG, *MG;
  bf16_t *WinT  , *oattn, *oret;
  bf16_t *WaT, *WrT, *WoT, *W1kT, *W1vT;
  float *ropeN, *ropeR, *posb;
  bf16_t *H1, *kcmp, *vcmpT;
  unsigned long long* selmask;
  int* cnt; int* lists; float* routew;
  bf16_t *merged, *x1b, *EgT  , *EdT  , *Hh, *part;
  bf16_t *xb, *Rt;
};

DI float bf2f(bf16_t v) { return __uint_as_float(((unsigned)v) << 16); }
DI bf16_t f2bf(float f) { unsigned u = __float_as_uint(f); u += 0x7fffu + ((u >> 16) & 1u); return (bf16_t)(u >> 16); }
DI unsigned pack2(float a, float b) { return (unsigned)f2bf(a) | ((unsigned)f2bf(b) << 16); }
DI float lo2f(unsigned u) { return __uint_as_float(u << 16); }
DI float hi2f(unsigned u) { return __uint_as_float(u & 0xffff0000u); }
DI float wsum(float v) { for (int o = 32; o > 0; o >>= 1) v += __shfl_xor(v, o); return v; }
DI float wmax(float v) { for (int o = 32; o > 0; o >>= 1) v = fmaxf(v, __shfl_xor(v, o)); return v; }
DI float sigmoidf_(float x) { return 1.f / (1.f + __expf(-x)); }
#define WSYNC() asm volatile("s_waitcnt lgkmcnt(0)" ::: "memory")

template <bool SWAP, class AR, class BR>
DI void gemm128(f32x4 (&acc)[4][4], AR arow, BR brow, int K, char* smem) {
  const int tid = threadIdx.x, lane = tid & 63, wave = tid >> 6, wr = wave >> 1, wc = wave & 1;
  const int srow = tid >> 3, sch = tid & 7;
  const bf16_t* ap[4]; const bf16_t* bp[4];
#pragma unroll
  for (int i = 0; i < 4; i++) { ap[i] = arow(srow + 32 * i) + sch * 8; bp[i] = brow(srow + 32 * i) + sch * 8; }
  const int woff = srow * 128 + ((sch ^ (srow & 7)) << 4);
  char* As = smem; char* Bs = smem + 32768;
  uint4 ra[4], rb[4];
#pragma unroll
  for (int i = 0; i < 4; i++) { ra[i] = *(const uint4*)(ap[i]); rb[i] = *(const uint4*)(bp[i]); }
#pragma unroll
  for (int i = 0; i < 4; i++) { *(uint4*)(As + woff + i * 4096) = ra[i]; *(uint4*)(Bs + woff + i * 4096) = rb[i]; }
  __syncthreads();
  const int nk = K >> 6;
  const int fr = lane & 15, fq = lane >> 4;
  const int aoff0 = (wr * 64 + fr) * 128, boff0 = (wc * 64 + fr) * 128;
  for (int kt = 0; kt < nk; kt++) {
    const int cur = kt & 1;
    if (kt + 1 < nk) {
#pragma unroll
      for (int i = 0; i < 4; i++) { ra[i] = *(const uint4*)(ap[i] + (kt + 1) * 64); rb[i] = *(const uint4*)(bp[i] + (kt + 1) * 64); }
    }
    const char* Ac = As + cur * 16384; const char* Bc = Bs + cur * 16384;
#pragma unroll
    for (int ks = 0; ks < 2; ks++) {
      const int chs = ((ks * 4 + fq) ^ (fr & 7)) << 4;
      bf16x8 a[4], b[4];
#pragma unroll
      for (int mt = 0; mt < 4; mt++) a[mt] = *(const bf16x8*)(Ac + aoff0 + mt * 2048 + chs);
#pragma unroll
      for (int nt = 0; nt < 4; nt++) b[nt] = *(const bf16x8*)(Bc + boff0 + nt * 2048 + chs);
#pragma unroll
      for (int mt = 0; mt < 4; mt++)
#pragma unroll
        for (int nt = 0; nt < 4; nt++)
          acc[mt][nt] = SWAP ? __builtin_amdgcn_mfma_f32_16x16x32_bf16(b[nt], a[mt], acc[mt][nt], 0, 0, 0)
                             : __builtin_amdgcn_mfma_f32_16x16x32_bf16(a[mt], b[nt], acc[mt][nt], 0, 0, 0);
    }
    if (kt + 1 < nk) {
      char* An = As + (cur ^ 1) * 16384; char* Bn_ = Bs + (cur ^ 1) * 16384;
#pragma unroll
      for (int i = 0; i < 4; i++) { *(uint4*)(An + woff + i * 4096) = ra[i]; *(uint4*)(Bn_ + woff + i * 4096) = rb[i]; }
    }
    __syncthreads();
  }
}
DI void zero_acc(f32x4 (&acc)[4][4]) {
#pragma unroll
  for (int i = 0; i < 4; i++)
#pragma unroll
    for (int j = 0; j < 4; j++) acc[i][j] = (f32x4){0.f, 0.f, 0.f, 0.f};
}
template <bool SWAP, class F>
DI void epilogue(const f32x4 (&acc)[4][4], F f) {
  const int lane = threadIdx.x & 63, wave = threadIdx.x >> 6, wr = wave >> 1, wc = wave & 1, fr = lane & 15, fq = lane >> 4;
#pragma unroll
  for (int mt = 0; mt < 4; mt++)
#pragma unroll
    for (int nt = 0; nt < 4; nt++) {
      if (SWAP) f(wr * 64 + mt * 16 + fr, wc * 64 + nt * 16 + fq * 4, acc[mt][nt]);
      else f(wr * 64 + mt * 16 + fq * 4, wc * 64 + nt * 16 + fr, acc[mt][nt]);
    }
}

template <class CP>
DI void tcvt_tile(CP colptr, int ldsrc, bf16_t* dst, int K, int kt, int jt, float* tile) {
  const int tx = threadIdx.x & 63, ty = threadIdx.x >> 6;
  const float* sp = colptr(jt * 64 + tx);
  for (int i = ty; i < 64; i += 4) tile[i * 65 + tx] = sp ? sp[(size_t)(kt * 64 + i) * ldsrc] : 0.f;
  __syncthreads();
  for (int i = ty * 2 + (tx >> 5); i < 64; i += 8) {
    const int kk = (tx & 31) * 2;
    *(unsigned*)(dst + (size_t)(jt * 64 + i) * K + kt * 64 + kk) = pack2(tile[kk * 65 + i], tile[(kk + 1) * 65 + i]);
  }
  __syncthreads();
}
template <class CP>
DI void tcvt_all(CP colptr, int ldsrc, bf16_t* dst, int K, int N, float* tile, int bid, int nb) {
  const int nkt = K / 64, njt = N / 64;
  for (int t = bid; t < nkt * njt; t += nb) tcvt_tile(colptr, ldsrc, dst, K, t / njt, t % njt, tile);
}

DI int perm_half(int p, int d) { return (p & 1) ? (d / 2 + (p >> 1)) : (p >> 1); }
DI int inproj_col(int j) {
  if (j < 512) return (j & ~63) + perm_half(j & 63, 64);
  if (j < 1280) { const int grp = (j - 512) >> 7;
    if (grp == 2 || grp == 4) return (j & ~63) + perm_half(j & 63, 64);
    return j; }
  if (j < 1792) { const int q = j - 1280; return 1304 + (q & ~127) + perm_half(q & 127, 128); }
  if (j < 2304) { const int q = j - 1792; return 1816 + (q & ~127) + perm_half(q & 127, 128); }
  if (j < 3328) return 2328 + (j - 2304);
  if (j < 4352) return 3352 + (j - 3328);
  if (j < 6400) return 4376 + (j - 4352);
  const int q = j - 6400; return q < 24 ? 1280 + q : -1;
}

DI void phase0(const Params& p, char* smem) {
  const int bid = blockIdx.x, nb = gridDim.x, tid = threadIdx.x;
  const size_t gtid = (size_t)bid * 256 + tid, gsz = (size_t)nb * 256;
  for (size_t i = gtid; i < (size_t)M * D / 4; i += gsz) {
    const float4 v = ((const float4*)p.x)[i];
    uint2 o; o.x = pack2(v.x, v.y); o.y = pack2(v.z, v.w);
    ((uint2*)p.xb)[i] = o;
  }
  float* tile = (float*)smem;
  { const float* w = p.w_in; tcvt_all([=](int j) -> const float* { const int c = inproj_col(j); return c >= 0 ? w + c : nullptr; }, 6424, p.WinT, 1024, NINP, tile, bid, nb); }
  { const float* w = p.w_up_attn; tcvt_all([=](int j) -> const float* { return w + j; }, 1024, p.WaT, 512, 1024, tile, bid, nb); }
  { const float* w = p.w_up_ret; tcvt_all([=](int j) -> const float* { return w + j; }, 1024, p.WrT, 1024, 1024, tile, bid, nb); }
  { const float* w = p.w_out; tcvt_all([=](int j) -> const float* { return w + j; }, 1024, p.WoT, 1024, 1024, tile, bid, nb); }
  { const float* w = p.cmp_k_w1; tcvt_all([=](int j) -> const float* { return w + j; }, 256, p.W1kT, 2048, 256, tile, bid, nb); }
  { const float* w = p.cmp_v_w1; tcvt_all([=](int j) -> const float* { return w + j; }, 256, p.W1vT, 2048, 256, tile, bid, nb); }
  for (size_t i = gtid; i < (size_t)T * 96; i += gsz) {
    const int t = (int)(i / 96), r = (int)(i % 96);
    float invf; float* dst;
    if (r < 32) { invf = (float)pow(10000.0, -2.0 * r / 64.0); dst = p.ropeN + ((size_t)t * 32 + r) * 2; }
    else { const int q = r - 32; invf = (float)pow(10000.0, -2.0 * q / 128.0); dst = p.ropeR + ((size_t)t * 64 + q) * 2; }
    const float ang = (float)t * invf;
    dst[0] = (float)cos((double)ang); dst[1] = (float)sin((double)ang);
  }
  for (size_t i = gtid; i < 512; i += gsz) {
    const int kv = (int)(i >> 8), j = (int)(i & 255);
    const float* pos = kv ? p.cmp_pos_v : p.cmp_pos_k; const float* w1 = kv ? p.cmp_v_w1 : p.cmp_k_w1; const float* b1 = kv ? p.cmp_v_b1 : p.cmp_k_b1;
    float s = b1[j];
    for (int q = 0; q < 2048; q++) s += pos[q] * w1[(size_t)q * 256 + j];
    p.posb[i] = s;
  }
  if (gtid < 32) p.cnt[gtid] = 0;
}

DI void inproj_tile(const Params& p, int mt_, int nt_, char* smem) {
  const int m0 = mt_ * 128;
  const bf16_t* A = p.xb + (size_t)m0 * D; const bf16_t* Bt = p.WinT + (size_t)nt_ * 128 * D;
  f32x4 acc[4][4]; zero_acc(acc);
  auto ar = [=](int r) { return A + (size_t)r * D; };
  auto br = [=](int r) { return Bt + (size_t)r * D; };
  const bool transposed = (nt_ == 7 || nt_ == 9 || (nt_ >= 18 && nt_ < 26));
  if (transposed) {
    gemm128<false>(acc, ar, br, D, smem);
    epilogue<false>(acc, [&](int r, int c, f32x4 v) {
      const int m = m0 + r, b = m >> 12, t = m & 4095;
      uint2 o; o.x = pack2(v[0], v[1]); o.y = pack2(v[2], v[3]);
      if (nt_ < 18) { bf16_t* dst = (nt_ == 7) ? p.SVt : p.WVt; const int g = c >> 6, d = c & 63;
        *(uint2*)(dst + ((size_t)((b * 2 + g) * 64 + d)) * T + t) = o; }
      else { const int h = (nt_ - 18) >> 1, e = ((nt_ - 18) & 1) * 128 + c;
        *(uint2*)(p.RVt + ((size_t)((b * 4 + h) * 256 + e)) * T + t) = o; }
    });
    return;
  }
  gemm128<true>(acc, ar, br, D, smem);
  epilogue<true>(acc, [&](int r, int c, f32x4 v) {
    const int m = m0 + r, b = m >> 12, t = m & 4095;
    if (nt_ < 4 || nt_ == 6 || nt_ == 8) {
      const int pp = c & 63;
      const float4 cs = *(const float4*)(p.ropeN + ((size_t)t * 32 + (pp >> 1)) * 2);
      const float sc = nt_ < 4 ? 0.125f : 1.f;
      const float a0 = (v[0] * cs.x - v[1] * cs.y) * sc, a1 = (v[0] * cs.y + v[1] * cs.x) * sc;
      const float a2 = (v[2] * cs.z - v[3] * cs.w) * sc, a3 = (v[2] * cs.w + v[3] * cs.z) * sc;
      uint2 o; o.x = pack2(a0, a1); o.y = pack2(a2, a3);
      if (nt_ < 4) { const int head = nt_ * 2 + (c >> 6); *(uint2*)(p.Qn + ((size_t)(b * 8 + head) * T + t) * 64 + pp) = o; }
      else { bf16_t* dst = nt_ == 6 ? p.SK : p.WK; const int g = c >> 6; *(uint2*)(dst + ((size_t)(b * 2 + g) * T + t) * 64 + pp) = o; }
    } else if (nt_ == 4 || nt_ == 5) {
      bf16_t* dst = nt_ == 4 ? p.CK : p.CV; const int g = c >> 6, pp = c & 63;
      uint2 o; o.x = pack2(v[0], v[1]); o.y = pack2(v[2], v[3]);
      *(uint2*)(dst + ((size_t)(b * 2 + g) * T + t) * 64 + pp) = o;
    } else if (nt_ >= 10 && nt_ < 18) {
      const bool isk = nt_ >= 14; const int h = (nt_ - 10) & 3;
      const float4 cs = *(const float4*)(p.ropeR + ((size_t)t * 64 + (c >> 1)) * 2);
      const float sc = isk ? 0.08838834764831845f : 1.f;
      const float a0 = (v[0] * cs.x - v[1] * cs.y) * sc, a1 = (v[0] * cs.y + v[1] * cs.x) * sc;
      const float a2 = (v[2] * cs.z - v[3] * cs.w) * sc, a3 = (v[2] * cs.w + v[3] * cs.z) * sc;
      uint2 o; o.x = pack2(a0, a1); o.y = pack2(a2, a3);
      *(uint2*)((isk ? p.RK : p.RQ) + ((size_t)(b * 4 + h) * T + t) * 128 + c) = o;
      if (isk) {
        const float lg = log2f(1.f - exp2f(-5.f - (float)h));
        const float z = exp2f((float)(127 - (t & 127)) * lg);
        bf16_t* dst = p.RKzT + ((size_t)((b * 4 + h) * 128 + c)) * T + t;
        dst[0] = f2bf(a0 * z); dst[T] = f2bf(a1 * z); dst[2 * T] = f2bf(a2 * z); dst[3 * T] = f2bf(a3 * z);
      }
    } else if (nt_ >= 26 && nt_ < 34) {
      uint2 o; o.x = pack2(v[0], v[1]); o.y = pack2(v[2], v[3]);
      *(uint2*)(p.RG + (size_t)m * 1024 + (nt_ - 26) * 128 + c) = o;
    } else if (nt_ >= 34 && nt_ < 50) {
      uint2 o; o.x = pack2(v[0], v[1]); o.y = pack2(v[2], v[3]);
      *(uint2*)(p.MG + (size_t)m * 2048 + (nt_ - 34) * 128 + c) = o;
    } else if (nt_ == 50) {
      if (c < 24) { float4 o; o.x = sigmoidf_(v[0]); o.y = sigmoidf_(v[1]); o.z = sigmoidf_(v[2]); o.w = sigmoidf_(v[3]);
        *(float4*)(p.NG + (size_t)m * 24 + c) = o; }
    }
  });
}
DI void phase1(const Params& p, char* smem) {
  const int xcd = blockIdx.x & 7, lb = blockIdx.x >> 3, nlb = gridDim.x >> 3;
  for (int li = lb; li < 16 * 51; li += nlb) {
    const int mi = li & 7, rest = li >> 3, nt_ = rest % 51, half = rest / 51;
    inproj_tile(p, xcd * 16 + half * 8 + mi, nt_, smem);
  }
}

struct WaveAttn { float m[4], l[4], o[4]; };
DI void wa_init(WaveAttn& s) { for (int h = 0; h < 4; h++) { s.m[h] = -1e30f; s.l[h] = 0.f; s.o[h] = 0.f; } }
DI void wa_block(WaveAttn& s, const float* qs, float* ps, const bf16_t* Kb, const bf16_t* Vt, int ldv, int key0, int lo, int hi, int lane) {
  const int key = key0 + lane; const bool valid = key >= lo && key <= hi;
  float sc[4] = {0.f, 0.f, 0.f, 0.f};
  const uint4* kr = (const uint4*)(Kb + (size_t)key * 64);
#pragma unroll
  for (int c8 = 0; c8 < 8; c8++) {
    const uint4 kv = kr[c8];
    float kf[8] = {lo2f(kv.x), hi2f(kv.x), lo2f(kv.y), hi2f(kv.y), lo2f(kv.z), hi2f(kv.z), lo2f(kv.w), hi2f(kv.w)};
#pragma unroll
    for (int h = 0; h < 4; h++) {
      const float4 q0 = *(const float4*)(qs + h * 64 + c8 * 8), q1 = *(const float4*)(qs + h * 64 + c8 * 8 + 4);
      sc[h] += q0.x * kf[0] + q0.y * kf[1] + q0.z * kf[2] + q0.w * kf[3] + q1.x * kf[4] + q1.y * kf[5] + q1.z * kf[6] + q1.w * kf[7];
    }
  }
  WSYNC();
#pragma unroll
  for (int h = 0; h < 4; h++) {
    const float sv = valid ? sc[h] : -1e30f;
    const float mn = fmaxf(s.m[h], wmax(sv));
    const float alpha = __expf(s.m[h] - mn);
    const float pv = valid ? __expf(sv - mn) : 0.f;
    s.l[h] = s.l[h] * alpha + wsum(pv); s.o[h] *= alpha; s.m[h] = mn;
    ps[h * 64 + lane] = pv;
  }
  WSYNC();
  const uint4* vr = (const uint4*)(Vt + (size_t)lane * ldv + key0);
#pragma unroll
  for (int c8 = 0; c8 < 8; c8++) {
    const uint4 vv = vr[c8];
    float vf[8] = {lo2f(vv.x), hi2f(vv.x), lo2f(vv.y), hi2f(vv.y), lo2f(vv.z), hi2f(vv.z), lo2f(vv.w), hi2f(vv.w)};
#pragma unroll
    for (int h = 0; h < 4; h++) {
      const float4 p0 = *(const float4*)(ps + h * 64 + c8 * 8), p1 = *(const float4*)(ps + h * 64 + c8 * 8 + 4);
      s.o[h] += p0.x * vf[0] + p0.y * vf[1] + p0.z * vf[2] + p0.w * vf[3] + p1.x * vf[4] + p1.y * vf[5] + p1.z * vf[6] + p1.w * vf[7];
    }
  }
  WSYNC();
}
DI void load_q(const Params& p, float* qs, int b, int g, int t, int lane) {
#pragma unroll
  for (int h = 0; h < 4; h++) qs[h * 64 + lane] = bf2f(p.Qn[((size_t)(b * 8 + g * 4 + h) * T + t) * 64 + lane]);
  WSYNC();
}
DI void naive_sparse(const Params& p, int item, int branch, char* wsm, int lane) {
  const int bg = item >> 12, t = item & 4095, b = bg >> 1, g = bg & 1;
  float* qs = (float*)wsm; float* ps = qs + 256;
  load_q(p, qs, b, g, t, lane);
  unsigned long long mask; int lo;
  const int blk = t >> 6;
  if (branch == 1) { mask = p.selmask[item]; mask &= (blk == 63) ? ~0ull : ((1ull << (blk + 1)) - 1ull); lo = 0; }
  else { lo = t - 511; if (lo < 0) lo = 0; const int b0 = lo >> 6; mask = ((blk == 63) ? ~0ull : ((1ull << (blk + 1)) - 1ull)) & ~((1ull << b0) - 1ull); }
  const bf16_t* Kb = (branch == 1 ? p.SK : p.WK) + (size_t)bg * T * 64;
  const bf16_t* Vt = (branch == 1 ? p.SVt : p.WVt) + (size_t)bg * 64 * T;
  WaveAttn s; wa_init(s);
  while (mask) {
    const int j = __ffsll((long long)mask) - 1; mask &= mask - 1;
    wa_block(s, qs, ps, Kb, Vt, T, j * 64, lo, t, lane);
  }
  const int m = b * T + t;
#pragma unroll
  for (int h = 0; h < 4; h++) {
    const int hh = g * 4 + h;
    const float gate = p.NG[(size_t)m * 24 + hh * 3 + branch];
    const float val = s.l[h] > 0.f ? gate * s.o[h] / s.l[h] : 0.f;
    bf16_t* dst = p.oattn + (size_t)m * 512 + hh * 64 + lane;
    if (branch == 2) *dst = f2bf(val); else *dst = f2bf(bf2f(*dst) + val);
  }
}
DI void naive_cmp(const Params& p, int item, char* wsm, int lane) {
  const int bg = item >> 12, t = item & 4095, b = bg >> 1, g = bg & 1;
  float* qs = (float*)wsm; float* pn = qs + 256; float* scr = pn + 1024;
  load_q(p, qs, b, g, t, lane);
  const int nvalid = t >= 31 ? ((t - 31) >> 4) + 1 : 0;
  const bf16_t* Kb = p.kcmp + (size_t)bg * 256 * 64;
#pragma unroll 1
  for (int jj = 0; jj < 4; jj++) {
    const int n = lane + 64 * jj;
    const uint4* kr = (const uint4*)(Kb + (size_t)n * 64);
    float a[4] = {0.f, 0.f, 0.f, 0.f};
#pragma unroll 2
    for (int c8 = 0; c8 < 8; c8++) {
      const uint4 kv = kr[c8];
      float kf[8] = {lo2f(kv.x), hi2f(kv.x), lo2f(kv.y), hi2f(kv.y), lo2f(kv.z), hi2f(kv.z), lo2f(kv.w), hi2f(kv.w)};
#pragma unroll
      for (int h = 0; h < 4; h++) {
        const float4 q0 = *(const float4*)(qs + h * 64 + c8 * 8), q1 = *(const float4*)(qs + h * 64 + c8 * 8 + 4);
        a[h] += q0.x * kf[0] + q0.y * kf[1] + q0.z * kf[2] + q0.w * kf[3] + q1.x * kf[4] + q1.y * kf[5] + q1.z * kf[6] + q1.w * kf[7];
      }
    }
#pragma unroll
    for (int h = 0; h < 4; h++) pn[h * 256 + n] = (n < nvalid) ? a[h] : -1e30f;
  }
  WSYNC();
#pragma unroll 1
  for (int h = 0; h < 4; h++) {
    float sv[4];
#pragma unroll
    for (int jj = 0; jj < 4; jj++) sv[jj] = pn[h * 256 + lane + 64 * jj];
    float mx = fmaxf(fmaxf(sv[0], sv[1]), fmaxf(sv[2], sv[3])); mx = wmax(mx);
    float e[4], sum = 0.f;
#pragma unroll
    for (int jj = 0; jj < 4; jj++) { e[jj] = (lane + 64 * jj < nvalid) ? __expf(sv[jj] - mx) : 0.f; sum += e[jj]; }
    sum = wsum(sum);
    const float inv = sum > 0.f ? 1.f / sum : 0.f;
#pragma unroll
    for (int jj = 0; jj < 4; jj++) pn[h * 256 + lane + 64 * jj] = e[jj] * inv;
  }
  WSYNC();
  float imp = 0.f;
  {
    const int s4 = lane * 4;
#pragma unroll
    for (int h = 0; h < 4; h++) {
      const float* ph = pn + h * 256;
      float v = 2.f * (ph[s4] + ph[s4 + 1] + ph[s4 + 2]);
      if (s4 > 0) v += ph[s4 - 1];
      if (s4 + 3 < 255) v += ph[s4 + 3];
      imp += v;
    }
  }
  const int blk = t >> 6;
  const float score = (lane == 0 || lane == blk || lane == blk - 1) ? 1e9f : (lane <= blk ? imp : -1e9f);
  scr[lane] = score;
  WSYNC();
  int rank = 0;
  for (int i = 0; i < 64; i++) { const float si = scr[i]; rank += (si > score || (si == score && i < lane)) ? 1 : 0; }
  const unsigned long long sel = __ballot(rank < 16);
  if (lane == 0) p.selmask[item] = sel;
  float o[4] = {0.f, 0.f, 0.f, 0.f};
  const bf16_t* Vt = p.vcmpT + (size_t)(bg * 64 + lane) * 256;
  const int nch = (nvalid + 7) >> 3;
  for (int c8 = 0; c8 < nch; c8++) {
    const uint4 vv = ((const uint4*)Vt)[c8];
    float vf[8] = {lo2f(vv.x), hi2f(vv.x), lo2f(vv.y), hi2f(vv.y), lo2f(vv.z), hi2f(vv.z), lo2f(vv.w), hi2f(vv.w)};
#pragma unroll
    for (int h = 0; h < 4; h++) {
      const float4 p0 = *(const float4*)(pn + h * 256 + c8 * 8), p1 = *(const float4*)(pn + h * 256 + c8 * 8 + 4);
      o[h] += p0.x * vf[0] + p0.y * vf[1] + p0.z * vf[2] + p0.w * vf[3] + p1.x * vf[4] + p1.y * vf[5] + p1.z * vf[6] + p1.w * vf[7];
    }
  }
  const int m = b * T + t;
#pragma unroll
  for (int h = 0; h < 4; h++) {
    const int hh = g * 4 + h;
    const float gate = p.NG[(size_t)m * 24 + hh * 3 + 0];
    bf16_t* dst = p.oattn + (size_t)m * 512 + hh * 64 + lane;
    *dst = f2bf(bf2f(*dst) + gate * o[h]);
  }
  WSYNC();
}

DI float gelu_tanh(float x) { const float u = 0.7978845608028654f * (x + 0.044715f * x * x * x); return 0.5f * x * (1.f + tanhf(u)); }
DI void compress1_tile(const Params& p, int tile, char* smem) {
  const int ntl = tile & 1, mtile = tile >> 1, half = mtile & 1, bg = (mtile >> 1) & 7, kv = mtile >> 4;
  const bf16_t* src = (kv ? p.CV : p.CK) + (size_t)bg * T * 64 + (size_t)half * 128 * 1024;
  const bf16_t* Bt = (kv ? p.W1vT : p.W1kT) + (size_t)ntl * 128 * 2048;
  f32x4 acc[4][4]; zero_acc(acc);
  gemm128<true>(acc, [=](int r) { return src + (size_t)r * 1024; }, [=](int r) { return Bt + (size_t)r * 2048; }, 2048, smem);
  epilogue<true>(acc, [&](int r, int c, f32x4 v) {
    const int n = half * 128 + r;
    if (n < 255) {
      const int j = ntl * 128 + c;
      const float4 pb = *(const float4*)(p.posb + kv * 256 + j);
      uint2 o; o.x = pack2(gelu_tanh(v[0] + pb.x), gelu_tanh(v[1] + pb.y)); o.y = pack2(gelu_tanh(v[2] + pb.z), gelu_tanh(v[3] + pb.w));
      *(uint2*)(p.H1 + ((size_t)((kv * 8 + bg) * 256 + n)) * 256 + j) = o;
    }
  });
}
DI void compress2(const Params& p) {
  const size_t gtid = (size_t)blockIdx.x * 256 + threadIdx.x, gsz = (size_t)gridDim.x * 256;
  for (size_t i = gtid; i < (size_t)2 * 8 * 256 * 32; i += gsz) {
    const int ii = (int)(i & 31), n = (int)((i >> 5) & 255), bg = (int)((i >> 13) & 7), kv = (int)(i >> 16);
    float a0 = 0.f, a1 = 0.f;
    if (n < 255) {
      const bf16_t* h = p.H1 + ((size_t)((kv * 8 + bg) * 256 + n)) * 256;
      const float* w2 = kv ? p.cmp_v_w2 : p.cmp_k_w2; const float* b2 = kv ? p.cmp_v_b2 : p.cmp_k_b2;
      a0 = b2[ii]; a1 = b2[ii + 32];
      for (int j = 0; j < 256; j++) { const float hv = bf2f(h[j]); a0 += hv * w2[j * 64 + ii]; a1 += hv * w2[j * 64 + ii + 32]; }
    }
    if (kv == 0) {
      float r0 = 0.f, r1 = 0.f;
      if (n < 255) { const int pos = 16 * n + 31; const float c = p.ropeN[((size_t)pos * 32 + ii) * 2], s = p.ropeN[((size_t)pos * 32 + ii) * 2 + 1];
        r0 = a0 * c - a1 * s; r1 = a0 * s + a1 * c; }
      *(unsigned*)(p.kcmp + ((size_t)(bg * 256 + n)) * 64 + 2 * ii) = pack2(r0, r1);
    } else {
      p.vcmpT[((size_t)(bg * 64 + ii)) * 256 + n] = f2bf(a0);
      p.vcmpT[((size_t)(bg * 64 + ii + 32)) * 256 + n] = f2bf(a1);
    }
  }
}

DI void ret_scan(const Params& p) {
  const size_t gtid = (size_t)blockIdx.x * 256 + threadIdx.x, gsz = (size_t)gridDim.x * 256;
  for (size_t i = gtid; i < (size_t)16 * 256 * 128; i += gsz) {
    const int dk = (int)(i & 127), e = (int)((i >> 7) & 255), bh = (int)(i >> 15), h = bh & 3;
    const float cd = exp2f(128.f * log2f(1.f - exp2f(-5.f - (float)h)));
    const bf16_t* kz = p.RKzT + ((size_t)(bh * 128 + dk)) * T;
    const bf16_t* vt = p.RVt + ((size_t)(bh * 256 + e)) * T;
    float R = 0.f;
    for (int n = 0; n < 32; n++) {
      p.Rt[(((size_t)bh * 32 + n) * 256 + e) * 128 + dk] = f2bf(R);
      if (n == 31) break;
      float s = 0.f;
      const uint4* k4 = (const uint4*)(kz + n * 128); const uint4* v4 = (const uint4*)(vt + n * 128);
#pragma unroll 4
      for (int c = 0; c < 16; c++) {
        const uint4 a = k4[c], bq = v4[c];
        s += lo2f(a.x) * lo2f(bq.x) + hi2f(a.x) * hi2f(bq.x) + lo2f(a.y) * lo2f(bq.y) + hi2f(a.y) * hi2f(bq.y)
           + lo2f(a.z) * lo2f(bq.z) + hi2f(a.z) * hi2f(bq.z) + lo2f(a.w) * lo2f(bq.w) + hi2f(a.w) * hi2f(bq.w);
      }
      R = R * cd + s;
    }
  }
}
DI void ret_out(const Params& p, int item, char* wsm, int lane) {
  const int bh = item >> 12, t = item & 4095, b = bh >> 2, h = bh & 3, n = t >> 7, c = t & 127;
  float* qs = (float*)wsm; float* ss = qs + 128;
  const bf16_t* qrow = p.RQ + ((size_t)bh * T + t) * 128;
  qs[lane] = bf2f(qrow[lane]); qs[lane + 64] = bf2f(qrow[lane + 64]);
  WSYNC();
  const float lg = log2f(1.f - exp2f(-5.f - (float)h));
#pragma unroll 1
  for (int jj = 0; jj < 2; jj++) {
    const int mm = lane + 64 * jj;
    const uint4* kr = (const uint4*)(p.RK + ((size_t)bh * T + n * 128 + mm) * 128);
    float a = 0.f;
#pragma unroll 4
    for (int c8 = 0; c8 < 16; c8++) {
      const uint4 kv = kr[c8];
      const float4 q0 = *(const float4*)(qs + c8 * 8), q1 = *(const float4*)(qs + c8 * 8 + 4);
      a += q0.x * lo2f(kv.x) + q0.y * hi2f(kv.x) + q0.z * lo2f(kv.y) + q0.w * hi2f(kv.y) + q1.x * lo2f(kv.z) + q1.y * hi2f(kv.z) + q1.z * lo2f(kv.w) + q1.w * hi2f(kv.w);
    }
    ss[mm] = (mm <= c) ? a * exp2f((float)(c - mm) * lg) : 0.f;
  }
  WSYNC();
  const float xi = exp2f((float)(c + 1) * lg);
  float o[4];
#pragma unroll
  for (int jj = 0; jj < 4; jj++) {
    asm volatile("" ::: "memory");
    const int e = lane + 64 * jj;
    const uint4* vr = (const uint4*)(p.RVt + ((size_t)(bh * 256 + e)) * T + n * 128);
    const uint4* rr = (const uint4*)(p.Rt + (((size_t)bh * 32 + n) * 256 + e) * 128);
    float a = 0.f, cr = 0.f;
    const int nch = (c >> 3) + 1;
#pragma unroll 2
    for (int c8 = 0; c8 < nch; c8++) {
      const uint4 vv = vr[c8];
      const float4 s0 = *(const float4*)(ss + c8 * 8), s1 = *(const float4*)(ss + c8 * 8 + 4);
      a += s0.x * lo2f(vv.x) + s0.y * hi2f(vv.x) + s0.z * lo2f(vv.y) + s0.w * hi2f(vv.y) + s1.x * lo2f(vv.z) + s1.y * hi2f(vv.z) + s1.z * lo2f(vv.w) + s1.w * hi2f(vv.w);
    }
#pragma unroll 4
    for (int c8 = 0; c8 < 16; c8++) {
      const uint4 rv = rr[c8];
      const float4 q0 = *(const float4*)(qs + c8 * 8), q1 = *(const float4*)(qs + c8 * 8 + 4);
      cr += q0.x * lo2f(rv.x) + q0.y * hi2f(rv.x) + q0.z * lo2f(rv.y) + q0.w * hi2f(rv.y) + q1.x * lo2f(rv.z) + q1.y * hi2f(rv.z) + q1.z * lo2f(rv.w) + q1.w * hi2f(rv.w);
    }
    o[jj] = a + xi * cr;
  }
  float mu = wsum(o[0] + o[1] + o[2] + o[3]) * (1.f / 256.f);
  float var = 0.f;
#pragma unroll
  for (int jj = 0; jj < 4; jj++) { const float d = o[jj] - mu; var += d * d; }
  var = wsum(var) * (1.f / 256.f);
  const float rs = rsqrtf(var + 1e-5f);
  const int m = b * T + t;
#pragma unroll
  for (int jj = 0; jj < 4; jj++) {
    const int col = h * 256 + lane + 64 * jj;
    const float y = (o[jj] - mu) * rs * p.gn_g[col] + p.gn_b[col];
    const float gt = bf2f(p.RG[(size_t)m * 1024 + col]);
    p.oret[(size_t)m * 1024 + col] = f2bf(y * gt * sigmoidf_(gt));
  }
  WSYNC();
}

DI void upproj_tile(const Params& p, int tile, char* smem) {
  const int nt_ = tile & 7, mt_ = tile >> 3, m0 = mt_ * 128, n0 = nt_ * 128;
  f32x4 acc[4][4];
  zero_acc(acc);
  { const bf16_t* A = p.oattn + (size_t)m0 * 512; const bf16_t* Bt = p.WaT + (size_t)n0 * 512;
    gemm128<true>(acc, [=](int r) { return A + (size_t)r * 512; }, [=](int r) { return Bt + (size_t)r * 512; }, 512, smem); }
  epilogue<true>(acc, [&](int r, int c, f32x4 v) {
    const size_t m = m0 + r; const int cc = n0 + c;
    const uint2 gv = *(const uint2*)(p.MG + m * 2048 + cc);
    uint2 o; o.x = pack2(sigmoidf_(lo2f(gv.x)) * v[0], sigmoidf_(hi2f(gv.x)) * v[1]); o.y = pack2(sigmoidf_(lo2f(gv.y)) * v[2], sigmoidf_(hi2f(gv.y)) * v[3]);
    *(uint2*)(p.merged + m * 1024 + cc) = o;
  });
  zero_acc(acc);
  { const bf16_t* A = p.oret + (size_t)m0 * 1024; const bf16_t* Bt = p.WrT + (size_t)n0 * 1024;
    gemm128<true>(acc, [=](int r) { return A + (size_t)r * 1024; }, [=](int r) { return Bt + (size_t)r * 1024; }, 1024, smem); }
  epilogue<true>(acc, [&](int r, int c, f32x4 v) {
    const size_t m = m0 + r; const int cc = n0 + c;
    const uint2 gv = *(const uint2*)(p.MG + m * 2048 + 1024 + cc);
    const uint2 pr = *(const uint2*)(p.merged + m * 1024 + cc);
    uint2 o; o.x = pack2(lo2f(pr.x) + sigmoidf_(lo2f(gv.x)) * v[0], hi2f(pr.x) + sigmoidf_(hi2f(gv.x)) * v[1]);
    o.y = pack2(lo2f(pr.y) + sigmoidf_(lo2f(gv.y)) * v[2], hi2f(pr.y) + sigmoidf_(hi2f(gv.y)) * v[3]);
    *(uint2*)(p.merged + m * 1024 + cc) = o;
  });
}
DI void wout_tile(const Params& p, int tile, char* smem) {
  const int nt_ = tile & 7, mt_ = tile >> 3, m0 = mt_ * 128, n0 = nt_ * 128;
  f32x4 acc[4][4]; zero_acc(acc);
  const bf16_t* A = p.merged + (size_t)m0 * 1024; const bf16_t* Bt = p.WoT + (size_t)n0 * 1024;
  gemm128<true>(acc, [=](int r) { return A + (size_t)r * 1024; }, [=](int r) { return Bt + (size_t)r * 1024; }, 1024, smem);
  epilogue<true>(acc, [&](int r, int c, f32x4 v) {
    const size_t idx = (size_t)(m0 + r) * 1024 + n0 + c;
    const float4 xv = *(const float4*)(p.x + idx);
    float4 o; o.x = ALPHA * xv.x + v[0]; o.y = ALPHA * xv.y + v[1]; o.z = ALPHA * xv.z + v[2]; o.w = ALPHA * xv.w + v[3];
    *(float4*)(p.out + idx) = o;
  });
}
DI void expert_cvt(const Params& p, char* smem) {
  float* tile = (float*)smem;
  const int bid = blockIdx.x, nb = gridDim.x;
  for (int e = 0; e < NEXP; e++) {
    const float* wg = p.e_wg + (size_t)e * 1024 * 512; const float* wu = p.e_wu + (size_t)e * 1024 * 512; const float* wd = p.e_wd + (size_t)e * 512 * 1024;
    tcvt_all([=](int j) -> const float* { const int f = (j >> 7) * 64 + ((j >> 5) & 3) * 16 + (j & 15); return (((j >> 4) & 1) ? wu : wg) + f; },
             512, p.EgT + (size_t)e * 1024 * 1024, 1024, 1024, tile, (bid + e * 37) % nb, nb);
    tcvt_all([=](int j) -> const float* { return wd + j; }, 1024, p.EdT + (size_t)e * 1024 * 512, 512, 1024, tile, (bid + e * 37 + 19) % nb, nb);
  }
}

DI void ln1_router(const Params& p, int m, int lane) {
  float* row = p.out + (size_t)m * 1024;
  float4 v[4];
#pragma unroll
  for (int i = 0; i < 4; i++) v[i] = *(const float4*)(row + i * 256 + lane * 4);
  float s = 0.f;
#pragma unroll
  for (int i = 0; i < 4; i++) s += v[i].x + v[i].y + v[i].z + v[i].w;
  const float mu = wsum(s) * (1.f / 1024.f);
  float q = 0.f;
#pragma unroll
  for (int i = 0; i < 4; i++) { const float a = v[i].x - mu, b = v[i].y - mu, c = v[i].z - mu, d = v[i].w - mu; q += a * a + b * b + c * c + d * d; }
  const float rs = rsqrtf(wsum(q) * (1.f / 1024.f) + 1e-5f);
  float gl[4] = {0.f, 0.f, 0.f, 0.f};
#pragma unroll
  for (int i = 0; i < 4; i++) {
    const int k = i * 256 + lane * 4;
    const float4 g = *(const float4*)(p.ln1_g + k), bb = *(const float4*)(p.ln1_b + k);
    v[i].x = (v[i].x - mu) * rs * g.x + bb.x; v[i].y = (v[i].y - mu) * rs * g.y + bb.y;
    v[i].z = (v[i].z - mu) * rs * g.z + bb.z; v[i].w = (v[i].w - mu) * rs * g.w + bb.w;
    *(float4*)(row + k) = v[i];
    uint2 o; o.x = pack2(v[i].x, v[i].y); o.y = pack2(v[i].z, v[i].w);
    *(uint2*)(p.x1b + (size_t)m * 1024 + k) = o;
    const float xs[4] = {v[i].x, v[i].y, v[i].z, v[i].w};
#pragma unroll
    for (int kk = 0; kk < 4; kk++) {
      const float4 w = *(const float4*)(p.rg_w + (size_t)(k + kk) * 4);
      gl[0] += xs[kk] * w.x; gl[1] += xs[kk] * w.y; gl[2] += xs[kk] * w.z; gl[3] += xs[kk] * w.w;
    }
  }
#pragma unroll
  for (int j = 0; j < 4; j++) gl[j] = wsum(gl[j]) + p.rg_b[j];
  int gi = 0; float gm = gl[0];
#pragma unroll
  for (int j = 1; j < 4; j++) if (gl[j] > gm) { gm = gl[j]; gi = j; }
  float gs = 0.f;
#pragma unroll
  for (int j = 0; j < 4; j++) gs += __expf(gl[j] - gm);
  const float gprob = 1.f / gs;
  float il[8] = {0.f, 0.f, 0.f, 0.f, 0.f, 0.f, 0.f, 0.f};
  const float* riw = p.ri_w + (size_t)gi * 1024 * 8;
#pragma unroll
  for (int i = 0; i < 4; i++) {
    const int k = i * 256 + lane * 4;
    const float xs[4] = {v[i].x, v[i].y, v[i].z, v[i].w};
#pragma unroll
    for (int kk = 0; kk < 4; kk++) {
      const float4 w0 = *(const float4*)(riw + (size_t)(k + kk) * 8), w1 = *(const float4*)(riw + (size_t)(k + kk) * 8 + 4);
      il[0] += xs[kk] * w0.x; il[1] += xs[kk] * w0.y; il[2] += xs[kk] * w0.z; il[3] += xs[kk] * w0.w;
      il[4] += xs[kk] * w1.x; il[5] += xs[kk] * w1.y; il[6] += xs[kk] * w1.z; il[7] += xs[kk] * w1.w;
    }
  }
#pragma unroll
  for (int j = 0; j < 8; j++) il[j] = wsum(il[j]) + p.ri_b[gi * 8 + j];
  int e1 = 0; float l1 = il[0];
#pragma unroll
  for (int j = 1; j < 8; j++) if (il[j] > l1) { l1 = il[j]; e1 = j; }
  int e2 = -1; float l2 = -3e38f;
#pragma unroll
  for (int j = 0; j < 8; j++) if (j != e1 && il[j] > l2) { l2 = il[j]; e2 = j; }
  const float ex = __expf(l2 - l1);
  const float w1 = gprob / (1.f + ex), w2 = gprob * ex / (1.f + ex);
  if (lane == 0) {
    const int ea = gi * 8 + e1, eb = gi * 8 + e2;
    const int pa = atomicAdd(p.cnt + ea, 1); p.lists[ea * 16384 + pa] = m * 2;
    const int pb = atomicAdd(p.cnt + eb, 1); p.lists[eb * 16384 + pb] = m * 2 + 1;
    p.routew[m * 2] = w1; p.routew[m * 2 + 1] = w2;
  }
}
DI void ln2_final(const Params& p, int m, int lane) {
  float* row = p.out + (size_t)m * 1024;
  float4 v[4];
  float s = 0.f;
#pragma unroll
  for (int i = 0; i < 4; i++) {
    const int k = i * 256 + lane * 4;
    const float4 xv = *(const float4*)(row + k);
    const uint2 a = *(const uint2*)(p.part + (size_t)(2 * m) * 1024 + k), b = *(const uint2*)(p.part + (size_t)(2 * m + 1) * 1024 + k);
    v[i].x = ALPHA * xv.x + lo2f(a.x) + lo2f(b.x); v[i].y = ALPHA * xv.y + hi2f(a.x) + hi2f(b.x);
    v[i].z = ALPHA * xv.z + lo2f(a.y) + lo2f(b.y); v[i].w = ALPHA * xv.w + hi2f(a.y) + hi2f(b.y);
    s += v[i].x + v[i].y + v[i].z + v[i].w;
  }
  const float mu = wsum(s) * (1.f / 1024.f);
  float q = 0.f;
#pragma unroll
  for (int i = 0; i < 4; i++) { const float a = v[i].x - mu, b = v[i].y - mu, c = v[i].z - mu, d = v[i].w - mu; q += a * a + b * b + c * c + d * d; }
  const float rs = rsqrtf(wsum(q) * (1.f / 1024.f) + 1e-5f);
#pragma unroll
  for (int i = 0; i < 4; i++) {
    const int k = i * 256 + lane * 4;
    const float4 g = *(const float4*)(p.ln2_g + k), bb = *(const float4*)(p.ln2_b + k);
    float4 o; o.x = (v[i].x - mu) * rs * g.x + bb.x; o.y = (v[i].y - mu) * rs * g.y + bb.y; o.z = (v[i].z - mu) * rs * g.z + bb.z; o.w = (v[i].w - mu) * rs * g.w + bb.w;
    *(float4*)(row + k) = o;
  }
}

struct MoeMap { int e, mi, cnt, hoff; };
DI bool moe_map(const Params& p, int mtile, MoeMap& mm) {
  int acc = 0;
  for (int e = 0; e < NEXP; e++) {
    const int c = p.cnt[e], nt = (c + 127) >> 7;
    if (mtile < acc + nt) { mm.e = e; mm.mi = mtile - acc; mm.cnt = c; mm.hoff = acc * 128; return true; }
    acc += nt;
  }
  return false;
}
DI int moe_total(const Params& p) { int acc = 0; for (int e = 0; e < NEXP; e++) acc += (p.cnt[e] + 127) >> 7; return acc; }
DI void moe_up_tile(const Params& p, const MoeMap& mm, int nt_, char* smem) {
  const int* lst = p.lists + mm.e * 16384 + mm.mi * 128; const int nrow = mm.cnt - mm.mi * 128;
  const bf16_t* Bt = p.EgT + ((size_t)mm.e * 1024 + nt_ * 128) * 1024;
  const bf16_t* X = p.x1b;
  f32x4 acc[4][4]; zero_acc(acc);
  gemm128<true>(acc, [=](int r) { const int tk = r < nrow ? (lst[r] >> 1) : 0; return X + (size_t)tk * 1024; }, [=](int r) { return Bt + (size_t)r * 1024; }, 1024, smem);
  const int lane = threadIdx.x & 63, wave = threadIdx.x >> 6, wr = wave >> 1, wc = wave & 1, fr = lane & 15, fq = lane >> 4;
#pragma unroll
  for (int mt = 0; mt < 4; mt++) {
    const int r = wr * 64 + mt * 16 + fr;
    if (r < nrow) {
      const float w = p.routew[lst[r]];
#pragma unroll
      for (int np = 0; np < 2; np++) {
        const f32x4 g = acc[mt][np * 2], u = acc[mt][np * 2 + 1];
        float hv[4];
#pragma unroll
        for (int i = 0; i < 4; i++) hv[i] = g[i] * sigmoidf_(g[i]) * u[i] * w;
        const int f = nt_ * 64 + wc * 32 + np * 16 + fq * 4;
        uint2 o; o.x = pack2(hv[0], hv[1]); o.y = pack2(hv[2], hv[3]);
        *(uint2*)(p.Hh + (size_t)(mm.hoff + mm.mi * 128 + r) * 512 + f) = o;
      }
    }
  }
}
DI void moe_down_tile(const Params& p, const MoeMap& mm, int nt_, char* smem) {
  const int* lst = p.lists + mm.e * 16384 + mm.mi * 128; const int nrow = mm.cnt - mm.mi * 128;
  const bf16_t* A = p.Hh + (size_t)(mm.hoff + mm.mi * 128) * 512;
  const bf16_t* Bt = p.EdT + ((size_t)mm.e * 1024 + nt_ * 128) * 512;
  f32x4 acc[4][4]; zero_acc(acc);
  gemm128<true>(acc, [=](int r) { return A + (size_t)r * 512; }, [=](int r) { return Bt + (size_t)r * 512; }, 512, smem);
  epilogue<true>(acc, [&](int r, int c, f32x4 v) {
    if (r < nrow) {
      const int ts = lst[r];
      uint2 o; o.x = pack2(v[0], v[1]); o.y = pack2(v[2], v[3]);
      *(uint2*)(p.part + (size_t)ts * 1024 + nt_ * 128 + c) = o;
    }
  });
}

constexpr int NPHASE = 12;
#if FUSED
#define PHFN DI
#else
#define PHFN DI
#endif
#define PH_PRE const int bid = blockIdx.x, nb = gridDim.x, tid = threadIdx.x, lane = tid & 63, wave = tid >> 6; \
  const int gw = bid * 4 + wave, nw = nb * 4; char* wsm = smem + wave * 8192; (void)bid; (void)nb; (void)lane; (void)gw; (void)nw; (void)wsm;
PHFN void ph0(const Params& p, char* smem) { phase0(p, smem); }
PHFN void ph1(const Params& p, char* smem) { phase1(p, smem); }
PHFN void ph2(const Params& p, char* smem) { PH_PRE
  for (int t = bid; t < 64; t += nb) compress1_tile(p, t, smem);
  ret_scan(p);
  for (int it = gw; it < 8 * T; it += nw) naive_sparse(p, it, 2, wsm, lane);
}
PHFN void ph3(const Params& p, char* smem) { compress2(p); }
PHFN void ph4(const Params& p, char* smem) { PH_PRE
  for (int it = gw; it < 8 * T; it += nw) naive_cmp(p, it, wsm, lane);
  for (int it = gw; it < 16 * T; it += nw) ret_out(p, it, wsm, lane);
}
PHFN void ph5(const Params& p, char* smem) { PH_PRE
  for (int it = gw; it < 8 * T; it += nw) naive_sparse(p, it, 1, wsm, lane);
}
PHFN void ph6(const Params& p, char* smem) { PH_PRE for (int t = bid; t < 1024; t += nb) upproj_tile(p, t, smem); }
PHFN void ph7(const Params& p, char* smem) { PH_PRE for (int t = bid; t < 1024; t += nb) wout_tile(p, t, smem); expert_cvt(p, smem); }
PHFN void ph8(const Params& p, char* smem) { PH_PRE for (int m = gw; m < M; m += nw) ln1_router(p, m, lane); }
PHFN void ph9(const Params& p, char* smem) { PH_PRE const int tot = moe_total(p);
  for (int t = bid; t < tot * 8; t += nb) { MoeMap mm; if (moe_map(p, t >> 3, mm)) moe_up_tile(p, mm, t & 7, smem); } }
PHFN void ph10(const Params& p, char* smem) { PH_PRE const int tot = moe_total(p);
  for (int t = bid; t < tot * 8; t += nb) { MoeMap mm; if (moe_map(p, t >> 3, mm)) moe_down_tile(p, mm, t & 7, smem); } }
PHFN void ph11(const Params& p, char* smem) { PH_PRE for (int m = gw; m < M; m += nw) ln2_final(p, m, lane); }
DI void run_phase(const Params& p, const int ph, char* smem) {
  switch (ph) {
    case 0: ph0(p, smem); break; case 1: ph1(p, smem); break; case 2: ph2(p, smem); break; case 3: ph3(p, smem); break;
    case 4: ph4(p, smem); break; case 5: ph5(p, smem); break; case 6: ph6(p, smem); break; case 7: ph7(p, smem); break;
    case 8: ph8(p, smem); break; case 9: ph9(p, smem); break; case 10: ph10(p, smem); break; case 11: ph11(p, smem); break;
  }
}

template <int PH>
__global__ void __launch_bounds__(256, 2) phase_kernel(Params p) {
  __shared__ __attribute__((aligned(16))) char smem[65536];
  run_phase(p, PH, smem);
}
#if FUSED
__global__ void __launch_bounds__(256, 2) mega_kernel(Params p_arg) {
  __shared__ __attribute__((aligned(16))) char smem[65536];
  cg::grid_group grid = cg::this_grid();
  const Params& p = *(const Params*)__builtin_amdgcn_kernarg_segment_ptr();
  ph0(p, smem); grid.sync(); ph1(p, smem); grid.sync(); ph2(p, smem); grid.sync(); ph3(p, smem); grid.sync();
  ph4(p, smem); grid.sync(); ph5(p, smem); grid.sync(); ph6(p, smem); grid.sync(); ph7(p, smem); grid.sync();
  ph8(p, smem); grid.sync(); ph9(p, smem); grid.sync(); ph10(p, smem); grid.sync(); ph11(p, smem);
}
#endif

extern "C" void kernel_launch(void* const* d_in, const int* in_sizes, int n_in, void* d_out, int out_size,
                              void* d_ws, size_t ws_size, hipStream_t stream) {
  Params p{};
  const float** ins = (const float**)&p;
  for (int i = 0; i < 28; i++) ins[i] = (const float*)d_in[i];
  p.out = (float*)d_out;
  char* ws = (char*)d_ws; size_t off = 0;
  auto alloc = [&](size_t bytes) { char* r = ws + off; off += (bytes + 255) & ~(size_t)255; return r; };
  const size_t MiB = 1 << 20;
  char* regionP = ws;
  p.Qn = (bf16_t*)alloc(16 * MiB);
  p.CK = (bf16_t*)alloc(4 * MiB); p.CV = (bf16_t*)alloc(4 * MiB); p.SK = (bf16_t*)alloc(4 * MiB); p.SVt = (bf16_t*)alloc(4 * MiB);
  p.WK = (bf16_t*)alloc(4 * MiB); p.WVt = (bf16_t*)alloc(4 * MiB);
  p.NG = (float*)alloc((size_t)M * 24 * 4);
  p.RQ = (bf16_t*)alloc(16 * MiB); p.RK = (bf16_t*)alloc(16 * MiB); p.RKzT = (bf16_t*)alloc(16 * MiB);
  p.RVt = (bf16_t*)alloc(32 * MiB); p.RG = (bf16_t*)alloc(32 * MiB); p.MG = (bf16_t*)alloc(64 * MiB);
  p.oattn = (bf16_t*)alloc(16 * MiB); p.WinT = p.oattn;
  p.oret = (bf16_t*)alloc(32 * MiB);
  p.WaT = (bf16_t*)alloc(1 * MiB); p.WrT = (bf16_t*)alloc(2 * MiB); p.WoT = (bf16_t*)alloc(2 * MiB);
  p.W1kT = (bf16_t*)alloc(1 * MiB); p.W1vT = (bf16_t*)alloc(1 * MiB);
  p.ropeN = (float*)alloc((size_t)T * 32 * 8); p.ropeR = (float*)alloc((size_t)T * 64 * 8); p.posb = (float*)alloc(512 * 4);
  p.H1 = (bf16_t*)alloc(2 * MiB); p.kcmp = (bf16_t*)alloc(8 * 256 * 64 * 2); p.vcmpT = (bf16_t*)alloc(8 * 64 * 256 * 2);
  p.selmask = (unsigned long long*)alloc((size_t)8 * T * 8);
  p.cnt = (int*)alloc(256); p.lists = (int*)alloc((size_t)NEXP * 16384 * 4); p.routew = (float*)alloc((size_t)M * 2 * 4);
  p.merged = (bf16_t*)(regionP); p.x1b = (bf16_t*)(regionP + 32 * MiB);
  p.EgT = (bf16_t*)(regionP + 64 * MiB); p.EdT = (bf16_t*)(regionP + 128 * MiB);
  p.Hh = (bf16_t*)(regionP + 160 * MiB); p.part = (bf16_t*)(regionP + 196 * MiB);
  p.xb = (bf16_t*)d_out; p.Rt = (bf16_t*)d_out;
  if (off > ws_size) { fprintf(stderr, "workspace too small: need %zu have %zu\n", off, ws_size); return; }
#if FUSED
  static int grid_blocks = 0;
  if (!grid_blocks) {
    int dev = 0, cus = 0, per_cu = 0;
    (void)hipGetDevice(&dev);
    (void)hipDeviceGetAttribute(&cus, hipDeviceAttributeMultiprocessorCount, dev);
    (void)hipOccupancyMaxActiveBlocksPerMultiprocessor(&per_cu, mega_kernel, 256, 0);
    if (per_cu > 2) per_cu = 2;
    grid_blocks = cus * per_cu;
  }
  void* args[] = {&p};
  hipError_t e = hipLaunchCooperativeKernel((void*)mega_kernel, dim3(grid_blocks), dim3(256), args, 0, stream);
  if (e != hipSuccess) fprintf(stderr, "coop launch failed: %s\n", hipGetErrorString(e));
#else
#define LAUNCH_PH(N) phase_kernel<N><<<512, 256, 0, stream>>>(p)
  LAUNCH_PH(0); LAUNCH_PH(1); LAUNCH_PH(2); LAUNCH_PH(3); LAUNCH_PH(4); LAUNCH_PH(5);
  LAUNCH_PH(6); LAUNCH_PH(7); LAUNCH_PH(8); LAUNCH_PH(9); LAUNCH_PH(10); LAUNCH_PH(11);
#endif
}
```

```cpp
#include <hip/hip_runtime.h>
#include <hip/hip_cooperative_groups.h>
#include <cstdio>
#include <cstdint>
namespace cg = cooperative_groups;

#ifndef FUSED
#define FUSED 1
#endif

#define DI __device__ __forceinline__
typedef unsigned short bf16_t;
typedef short bf16x8 __attribute__((ext_vector_type(8)));
typedef float f32x4 __attribute__((ext_vector_type(4)));

constexpr int Bn = 4, T = 4096, D = 1024, M = Bn * T;
constexpr int NINP = 6528;
constexpr int NEXP = 32, DFF = 512;
constexpr int HROWS = 36864;
constexpr float ALPHA = 1.189207115002721f;

struct Params {
  const float *x, *w_in, *cmp_pos_k, *cmp_k_w1, *cmp_k_b1, *cmp_k_w2, *cmp_k_b2;
  const float *cmp_pos_v, *cmp_v_w1, *cmp_v_b1, *cmp_v_w2, *cmp_v_b2;
  const float *gn_g, *gn_b, *w_up_attn, *w_up_ret, *w_out, *ln1_g, *ln1_b;
  const float *rg_w, *rg_b, *ri_w, *ri_b, *e_wg, *e_wu, *e_wd, *ln2_g, *ln2_b;
  float* out;
  bf16_t *Qn, *CK, *CV, *SK, *SVt, *WK, *WVt; float* NG;
  bf16_t *RQ, *RK, *RKzT, *RVt, *RG, *MG;
  bf16_t *WinT  , *oattn, *oret;
  bf16_t *WaT, *WrT, *WoT, *W1kT, *W1vT;
  float *ropeN, *ropeR, *posb;
  bf16_t *H1, *kcmp, *vcmpT;
  unsigned long long* selmask;
  int* cnt; int* lists; float* routew;
  bf16_t *merged, *x1b, *EgT  , *EdT  , *Hh, *part;
  bf16_t *xb, *Rt;
  unsigned* bar;
};

DI float bf2f(bf16_t v) { return __uint_as_float(((unsigned)v) << 16); }
DI bf16_t f2bf(float f) { unsigned u = __float_as_uint(f); u += 0x7fffu + ((u >> 16) & 1u); return (bf16_t)(u >> 16); }
DI unsigned pack2(float a, float b) { return (unsigned)f2bf(a) | ((unsigned)f2bf(b) << 16); }
DI float lo2f(unsigned u) { return __uint_as_float(u << 16); }
DI float hi2f(unsigned u) { return __uint_as_float(u & 0xffff0000u); }
DI float wsum(float v) { for (int o = 32; o > 0; o >>= 1) v += __shfl_xor(v, o); return v; }
DI float wmax(float v) { for (int o = 32; o > 0; o >>= 1) v = fmaxf(v, __shfl_xor(v, o)); return v; }
DI float sigmoidf_(float x) { return 1.f / (1.f + __expf(-x)); }
#define WSYNC() asm volatile("s_waitcnt lgkmcnt(0)" ::: "memory")


#define XB_TMO      128
#define XB_XCNT(j)  (256  + 64 * (j))
#define XB_XSUB(j)  (1280 + 64 * (j))
#define XB_XGEN(j)  (2304 + 64 * (j))
#define XB_TOP      3328
#define XB_TOPGEN   3392
#define XCD_BAR_WORDS 3456
#define XB_SPIN_CAP (1u << 20)
#define LAS __attribute__((address_space(3)))
DI unsigned xb_ld(unsigned* p) { return __hip_atomic_load(p, __ATOMIC_RELAXED, __HIP_MEMORY_SCOPE_AGENT); }
DI unsigned xb_add(unsigned* p, unsigned v) { return __hip_atomic_fetch_add(p, v, __ATOMIC_RELAXED, __HIP_MEMORY_SCOPE_AGENT); }
DI unsigned xb_xcc_id() { return (unsigned)__builtin_amdgcn_s_getreg((3 << 11) | 20) & 0xFu; }
#define XB_SPIN(cond, bar) do { unsigned _sp = 0; while (cond) { __builtin_amdgcn_s_sleep(1); \
    if ((++_sp & 255u) == 0u) { if (xb_ld(&(bar)[XB_TMO])) break; if (_sp > XB_SPIN_CAP) { atomicAdd(&(bar)[XB_TMO], 1u); break; } } } } while (0)
struct XcdBarrier { unsigned* bar; unsigned x; volatile LAS unsigned* st; };
DI XcdBarrier xcd_barrier_post(unsigned* bar, volatile LAS unsigned* st) {
  XcdBarrier b; b.bar = bar; b.x = xb_xcc_id(); b.st = st;
  if (threadIdx.x == 0) (void)xb_add(&bar[XB_XCNT(b.x)], 1u);
  return b;
}
DI void xcd_barrier_complete(unsigned* bar, unsigned x, unsigned& nloc, unsigned& nx) {
  const unsigned G = gridDim.x * gridDim.y * gridDim.z;
  unsigned sum, cnt, mine, sp = 0u;
  for (;;) {
    sum = 0u; cnt = 0u; mine = 0u;
#pragma unroll
    for (unsigned j = 0; j < 16; ++j) { const unsigned c = xb_ld(&bar[XB_XCNT(j)]); sum += c; cnt += (c > 0u) ? 1u : 0u; mine = (j == x) ? c : mine; }
    if (sum == G) break;
    __builtin_amdgcn_s_sleep(1);
    if ((++sp & 255u) == 0u) { if (xb_ld(&bar[XB_TMO])) break; if (sp > XB_SPIN_CAP) { atomicAdd(&bar[XB_TMO], 1u); break; } }
  }
  nloc = mine > 0u ? mine : 1u; nx = cnt > 0u ? cnt : 1u;
}
DI void xcd_barrier(const XcdBarrier& b) {
  asm volatile("s_waitcnt vmcnt(0)" ::: "memory");
  __syncthreads();
  if (threadIdx.x == 0) {
    unsigned* bar = b.bar;
    __builtin_amdgcn_s_waitcnt(0);
    unsigned nloc = b.st[0], nx = b.st[1];
    if (nloc == 0u) { xcd_barrier_complete(bar, b.x, nloc, nx); b.st[0] = nloc; b.st[1] = nx; }
    const unsigned old = xb_add(&bar[XB_XSUB(b.x)], 1u);
    const unsigned gen = old / nloc;
    if (old + 1u == (gen + 1u) * nloc) {
      __builtin_amdgcn_fence(__ATOMIC_RELEASE, "agent");
      asm volatile("s_waitcnt vmcnt(0)" ::: "memory");
      const unsigned og = xb_add(&bar[XB_TOP], 1u);
      const unsigned tg = og / nx;
      if (og + 1u == (tg + 1u) * nx) xb_add(&bar[XB_TOPGEN], 1u);
      else XB_SPIN(xb_ld(&bar[XB_TOPGEN]) == tg, bar);
      __builtin_amdgcn_fence(__ATOMIC_ACQUIRE, "agent");
      xb_add(&bar[XB_XGEN(b.x)], 1u);
      asm volatile("s_waitcnt vmcnt(0)" ::: "memory");
    } else {
      XB_SPIN(xb_ld(&bar[XB_XGEN(b.x)]) == gen, bar);
      __builtin_amdgcn_fence(__ATOMIC_ACQUIRE, "agent");
      asm volatile("s_waitcnt vmcnt(0)" ::: "memory");
    }
  }
  __syncthreads();
}

template <bool SWAP, class AR, class BR>
DI void gemm128(f32x4 (&acc)[4][4], AR arow, BR brow, int K, char* smem) {
  const int tid = threadIdx.x, lane = tid & 63, wave = tid >> 6, wr = wave >> 1, wc = wave & 1;
  const int srow = tid >> 3, sch = tid & 7;
  const bf16_t* ap[4]; const bf16_t* bp[4];
#pragma unroll
  for (int i = 0; i < 4; i++) { ap[i] = arow(srow + 32 * i) + sch * 8; bp[i] = brow(srow + 32 * i) + sch * 8; }
  const int woff = srow * 128 + ((sch ^ (srow & 7)) << 4);
  char* As = smem; char* Bs = smem + 32768;
  uint4 ra[4], rb[4];
#pragma unroll
  for (int i = 0; i < 4; i++) { ra[i] = *(const uint4*)(ap[i]); rb[i] = *(const uint4*)(bp[i]); }
#pragma unroll
  for (int i = 0; i < 4; i++) { *(uint4*)(As + woff + i * 4096) = ra[i]; *(uint4*)(Bs + woff + i * 4096) = rb[i]; }
  __syncthreads();
  const int nk = K >> 6;
  const int fr = lane & 15, fq = lane >> 4;
  const int aoff0 = (wr * 64 + fr) * 128, boff0 = (wc * 64 + fr) * 128;
  for (int kt = 0; kt < nk; kt++) {
    const int cur = kt & 1;
    if (kt + 1 < nk) {
#pragma unroll
      for (int i = 0; i < 4; i++) { ra[i] = *(const uint4*)(ap[i] + (kt + 1) * 64); rb[i] = *(const uint4*)(bp[i] + (kt + 1) * 64); }
    }
    const char* Ac = As + cur * 16384; const char* Bc = Bs + cur * 16384;
#pragma unroll
    for (int ks = 0; ks < 2; ks++) {
      const int chs = ((ks * 4 + fq) ^ (fr & 7)) << 4;
      bf16x8 a[4], b[4];
#pragma unroll
      for (int mt = 0; mt < 4; mt++) a[mt] = *(const bf16x8*)(Ac + aoff0 + mt * 2048 + chs);
#pragma unroll
      for (int nt = 0; nt < 4; nt++) b[nt] = *(const bf16x8*)(Bc + boff0 + nt * 2048 + chs);
#pragma unroll
      for (int mt = 0; mt < 4; mt++)
#pragma unroll
        for (int nt = 0; nt < 4; nt++)
          acc[mt][nt] = SWAP ? __builtin_amdgcn_mfma_f32_16x16x32_bf16(b[nt], a[mt], acc[mt][nt], 0, 0, 0)
                             : __builtin_amdgcn_mfma_f32_16x16x32_bf16(a[mt], b[nt], acc[mt][nt], 0, 0, 0);
    }
    if (kt + 1 < nk) {
      char* An = As + (cur ^ 1) * 16384; char* Bn_ = Bs + (cur ^ 1) * 16384;
#pragma unroll
      for (int i = 0; i < 4; i++) { *(uint4*)(An + woff + i * 4096) = ra[i]; *(uint4*)(Bn_ + woff + i * 4096) = rb[i]; }
    }
    __syncthreads();
  }
}
DI void zero_acc(f32x4 (&acc)[4][4]) {
#pragma unroll
  for (int i = 0; i < 4; i++)
#pragma unroll
    for (int j = 0; j < 4; j++) acc[i][j] = (f32x4){0.f, 0.f, 0.f, 0.f};
}
template <bool SWAP, class F>
DI void epilogue(const f32x4 (&acc)[4][4], F f) {
  const int lane = threadIdx.x & 63, wave = threadIdx.x >> 6, wr = wave >> 1, wc = wave & 1, fr = lane & 15, fq = lane >> 4;
#pragma unroll
  for (int mt = 0; mt < 4; mt++)
#pragma unroll
    for (int nt = 0; nt < 4; nt++) {
      if (SWAP) f(wr * 64 + mt * 16 + fr, wc * 64 + nt * 16 + fq * 4, acc[mt][nt]);
      else f(wr * 64 + mt * 16 + fq * 4, wc * 64 + nt * 16 + fr, acc[mt][nt]);
    }
}

template <class CP>
DI void tcvt_tile(CP colptr, int ldsrc, bf16_t* dst, int K, int kt, int jt, float* tile) {
  const int tx = threadIdx.x & 63, ty = threadIdx.x >> 6;
  const float* sp = colptr(jt * 64 + tx);
  for (int i = ty; i < 64; i += 4) tile[i * 65 + tx] = sp ? sp[(size_t)(kt * 64 + i) * ldsrc] : 0.f;
  __syncthreads();
  for (int i = ty * 2 + (tx >> 5); i < 64; i += 8) {
    const int kk = (tx & 31) * 2;
    *(unsigned*)(dst + (size_t)(jt * 64 + i) * K + kt * 64 + kk) = pack2(tile[kk * 65 + i], tile[(kk + 1) * 65 + i]);
  }
  __syncthreads();
}
template <class CP>
DI void tcvt_all(CP colptr, int ldsrc, bf16_t* dst, int K, int N, float* tile, int bid, int nb) {
  const int nkt = K / 64, njt = N / 64;
  for (int t = bid; t < nkt * njt; t += nb) tcvt_tile(colptr, ldsrc, dst, K, t / njt, t % njt, tile);
}

DI int perm_half(int p, int d) { return (p & 1) ? (d / 2 + (p >> 1)) : (p >> 1); }
DI int inproj_col(int j) {
  if (j < 512) return (j & ~63) + perm_half(j & 63, 64);
  if (j < 1280) { const int grp = (j - 512) >> 7;
    if (grp == 2 || grp == 4) return (j & ~63) + perm_half(j & 63, 64);
    return j; }
  if (j < 1792) { const int q = j - 1280; return 1304 + (q & ~127) + perm_half(q & 127, 128); }
  if (j < 2304) { const int q = j - 1792; return 1816 + (q & ~127) + perm_half(q & 127, 128); }
  if (j < 3328) return 2328 + (j - 2304);
  if (j < 4352) return 3352 + (j - 3328);
  if (j < 6400) return 4376 + (j - 4352);
  const int q = j - 6400; return q < 24 ? 1280 + q : -1;
}

DI void phase0(const Params& p, char* smem) {
  const int bid = blockIdx.x, nb = gridDim.x, tid = threadIdx.x;
  const size_t gtid = (size_t)bid * 256 + tid, gsz = (size_t)nb * 256;
  for (size_t i = gtid; i < (size_t)M * D / 4; i += gsz) {
    const float4 v = ((const float4*)p.x)[i];
    uint2 o; o.x = pack2(v.x, v.y); o.y = pack2(v.z, v.w);
    ((uint2*)p.xb)[i] = o;
  }
  float* tile = (float*)smem;
  { const float* w = p.w_in; tcvt_all([=](int j) -> const float* { const int c = inproj_col(j); return c >= 0 ? w + c : nullptr; }, 6424, p.WinT, 1024, NINP, tile, bid, nb); }
  { const float* w = p.w_up_attn; tcvt_all([=](int j) -> const float* { return w + j; }, 1024, p.WaT, 512, 1024, tile, bid, nb); }
  { const float* w = p.w_up_ret; tcvt_all([=](int j) -> const float* { return w + j; }, 1024, p.WrT, 1024, 1024, tile, bid, nb); }
  { const float* w = p.w_out; tcvt_all([=](int j) -> const float* { return w + j; }, 1024, p.WoT, 1024, 1024, tile, bid, nb); }
  { const float* w = p.cmp_k_w1; tcvt_all([=](int j) -> const float* { return w + j; }, 256, p.W1kT, 2048, 256, tile, bid, nb); }
  { const float* w = p.cmp_v_w1; tcvt_all([=](int j) -> const float* { return w + j; }, 256, p.W1vT, 2048, 256, tile, bid, nb); }
  for (size_t i = gtid; i < (size_t)T * 96; i += gsz) {
    const int t = (int)(i / 96), r = (int)(i % 96);
    float invf; float* dst;
    if (r < 32) { invf = (float)pow(10000.0, -2.0 * r / 64.0); dst = p.ropeN + ((size_t)t * 32 + r) * 2; }
    else { const int q = r - 32; invf = (float)pow(10000.0, -2.0 * q / 128.0); dst = p.ropeR + ((size_t)t * 64 + q) * 2; }
    const float ang = (float)t * invf;
    dst[0] = (float)cos((double)ang); dst[1] = (float)sin((double)ang);
  }
  for (size_t i = gtid; i < 512; i += gsz) {
    const int kv = (int)(i >> 8), j = (int)(i & 255);
    const float* pos = kv ? p.cmp_pos_v : p.cmp_pos_k; const float* w1 = kv ? p.cmp_v_w1 : p.cmp_k_w1; const float* b1 = kv ? p.cmp_v_b1 : p.cmp_k_b1;
    float s = b1[j];
    for (int q = 0; q < 2048; q++) s += pos[q] * w1[(size_t)q * 256 + j];
    p.posb[i] = s;
  }
  if (gtid < 32) p.cnt[gtid] = 0;
}

DI void inproj_tile(const Params& p, int mt_, int nt_, char* smem) {
  const int m0 = mt_ * 128;
  const bf16_t* A = p.xb + (size_t)m0 * D; const bf16_t* Bt = p.WinT + (size_t)nt_ * 128 * D;
  f32x4 acc[4][4]; zero_acc(acc);
  auto ar = [=](int r) { return A + (size_t)r * D; };
  auto br = [=](int r) { return Bt + (size_t)r * D; };
  const bool transposed = (nt_ == 7 || nt_ == 9 || (nt_ >= 18 && nt_ < 26));
  if (transposed) {
    gemm128<false>(acc, ar, br, D, smem);
    epilogue<false>(acc, [&](int r, int c, f32x4 v) {
      const int m = m0 + r, b = m >> 12, t = m & 4095;
      uint2 o; o.x = pack2(v[0], v[1]); o.y = pack2(v[2], v[3]);
      if (nt_ < 18) { bf16_t* dst = (nt_ == 7) ? p.SVt : p.WVt; const int g = c >> 6, d = c & 63;
        *(uint2*)(dst + ((size_t)((b * 2 + g) * 64 + d)) * T + t) = o; }
      else { const int h = (nt_ - 18) >> 1, e = ((nt_ - 18) & 1) * 128 + c;
        *(uint2*)(p.RVt + ((size_t)((b * 4 + h) * 256 + e)) * T + t) = o; }
    });
    return;
  }
  gemm128<true>(acc, ar, br, D, smem);
  epilogue<true>(acc, [&](int r, int c, f32x4 v) {
    const int m = m0 + r, b = m >> 12, t = m & 4095;
    if (nt_ < 4 || nt_ == 6 || nt_ == 8) {
      const int pp = c & 63;
      const float4 cs = *(const float4*)(p.ropeN + ((size_t)t * 32 + (pp >> 1)) * 2);
      const float sc = nt_ < 4 ? 0.125f : 1.f;
      const float a0 = (v[0] * cs.x - v[1] * cs.y) * sc, a1 = (v[0] * cs.y + v[1] * cs.x) * sc;
      const float a2 = (v[2] * cs.z - v[3] * cs.w) * sc, a3 = (v[2] * cs.w + v[3] * cs.z) * sc;
      uint2 o; o.x = pack2(a0, a1); o.y = pack2(a2, a3);
      if (nt_ < 4) { const int head = nt_ * 2 + (c >> 6); *(uint2*)(p.Qn + ((size_t)(b * 8 + head) * T + t) * 64 + pp) = o; }
      else { bf16_t* dst = nt_ == 6 ? p.SK : p.WK; const int g = c >> 6; *(uint2*)(dst + ((size_t)(b * 2 + g) * T + t) * 64 + pp) = o; }
    } else if (nt_ == 4 || nt_ == 5) {
      bf16_t* dst = nt_ == 4 ? p.CK : p.CV; const int g = c >> 6, pp = c & 63;
      uint2 o; o.x = pack2(v[0], v[1]); o.y = pack2(v[2], v[3]);
      *(uint2*)(dst + ((size_t)(b * 2 + g) * T + t) * 64 + pp) = o;
    } else if (nt_ >= 10 && nt_ < 18) {
      const bool isk = nt_ >= 14; const int h = (nt_ - 10) & 3;
      const float4 cs = *(const float4*)(p.ropeR + ((size_t)t * 64 + (c >> 1)) * 2);
      const float sc = isk ? 0.08838834764831845f : 1.f;
      const float a0 = (v[0] * cs.x - v[1] * cs.y) * sc, a1 = (v[0] * cs.y + v[1] * cs.x) * sc;
      const float a2 = (v[2] * cs.z - v[3] * cs.w) * sc, a3 = (v[2] * cs.w + v[3] * cs.z) * sc;
      uint2 o; o.x = pack2(a0, a1); o.y = pack2(a2, a3);
      *(uint2*)((isk ? p.RK : p.RQ) + ((size_t)(b * 4 + h) * T + t) * 128 + c) = o;
      if (isk) {
        const float lg = log2f(1.f - exp2f(-5.f - (float)h));
        const float z = exp2f((float)(127 - (t & 127)) * lg);
        bf16_t* dst = p.RKzT + ((size_t)((b * 4 + h) * 128 + c)) * T + t;
        dst[0] = f2bf(a0 * z); dst[T] = f2bf(a1 * z); dst[2 * T] = f2bf(a2 * z); dst[3 * T] = f2bf(a3 * z);
      }
    } else if (nt_ >= 26 && nt_ < 34) {
      uint2 o; o.x = pack2(v[0], v[1]); o.y = pack2(v[2], v[3]);
      *(uint2*)(p.RG + (size_t)m * 1024 + (nt_ - 26) * 128 + c) = o;
    } else if (nt_ >= 34 && nt_ < 50) {
      uint2 o; o.x = pack2(v[0], v[1]); o.y = pack2(v[2], v[3]);
      *(uint2*)(p.MG + (size_t)m * 2048 + (nt_ - 34) * 128 + c) = o;
    } else if (nt_ == 50) {
      if (c < 24) { float4 o; o.x = sigmoidf_(v[0]); o.y = sigmoidf_(v[1]); o.z = sigmoidf_(v[2]); o.w = sigmoidf_(v[3]);
        *(float4*)(p.NG + (size_t)m * 24 + c) = o; }
    }
  });
}
DI void phase1(const Params& p, char* smem) {
  const int xcd = blockIdx.x & 7, lb = blockIdx.x >> 3, nlb = gridDim.x >> 3;
  for (int li = lb; li < 16 * 51; li += nlb) {
    const int mi = li & 7, rest = li >> 3, nt_ = rest % 51, half = rest / 51;
    inproj_tile(p, xcd * 16 + half * 8 + mi, nt_, smem);
  }
}

struct WaveAttn { float m[4], l[4], o[4]; };
DI void wa_init(WaveAttn& s) { for (int h = 0; h < 4; h++) { s.m[h] = -1e30f; s.l[h] = 0.f; s.o[h] = 0.f; } }
DI void wa_block(WaveAttn& s, const float* qs, float* ps, const bf16_t* Kb, const bf16_t* Vt, int ldv, int key0, int lo, int hi, int lane) {
  const int key = key0 + lane; const bool valid = key >= lo && key <= hi;
  float sc[4] = {0.f, 0.f, 0.f, 0.f};
  const uint4* kr = (const uint4*)(Kb + (size_t)key * 64);
#pragma unroll
  for (int c8 = 0; c8 < 8; c8++) {
    const uint4 kv = kr[c8];
    float kf[8] = {lo2f(kv.x), hi2f(kv.x), lo2f(kv.y), hi2f(kv.y), lo2f(kv.z), hi2f(kv.z), lo2f(kv.w), hi2f(kv.w)};
#pragma unroll
    for (int h = 0; h < 4; h++) {
      const float4 q0 = *(const float4*)(qs + h * 64 + c8 * 8), q1 = *(const float4*)(qs + h * 64 + c8 * 8 + 4);
      sc[h] += q0.x * kf[0] + q0.y * kf[1] + q0.z * kf[2] + q0.w * kf[3] + q1.x * kf[4] + q1.y * kf[5] + q1.z * kf[6] + q1.w * kf[7];
    }
  }
  WSYNC();
#pragma unroll
  for (int h = 0; h < 4; h++) {
    const float sv = valid ? sc[h] : -1e30f;
    const float mn = fmaxf(s.m[h], wmax(sv));
    const float alpha = __expf(s.m[h] - mn);
    const float pv = valid ? __expf(sv - mn) : 0.f;
    s.l[h] = s.l[h] * alpha + wsum(pv); s.o[h] *= alpha; s.m[h] = mn;
    ps[h * 64 + lane] = pv;
  }
  WSYNC();
  const uint4* vr = (const uint4*)(Vt + (size_t)lane * ldv + key0);
#pragma unroll
  for (int c8 = 0; c8 < 8; c8++) {
    const uint4 vv = vr[c8];
    float vf[8] = {lo2f(vv.x), hi2f(vv.x), lo2f(vv.y), hi2f(vv.y), lo2f(vv.z), hi2f(vv.z), lo2f(vv.w), hi2f(vv.w)};
#pragma unroll
    for (int h = 0; h < 4; h++) {
      const float4 p0 = *(const float4*)(ps + h * 64 + c8 * 8), p1 = *(const float4*)(ps + h * 64 + c8 * 8 + 4);
      s.o[h] += p0.x * vf[0] + p0.y * vf[1] + p0.z * vf[2] + p0.w * vf[3] + p1.x * vf[4] + p1.y * vf[5] + p1.z * vf[6] + p1.w * vf[7];
    }
  }
  WSYNC();
}
DI void load_q(const Params& p, float* qs, int b, int g, int t, int lane) {
#pragma unroll
  for (int h = 0; h < 4; h++) qs[h * 64 + lane] = bf2f(p.Qn[((size_t)(b * 8 + g * 4 + h) * T + t) * 64 + lane]);
  WSYNC();
}
DI void naive_sparse(const Params& p, int item, int branch, char* wsm, int lane) {
  const int bg = item >> 12, t = item & 4095, b = bg >> 1, g = bg & 1;
  float* qs = (float*)wsm; float* ps = qs + 256;
  load_q(p, qs, b, g, t, lane);
  unsigned long long mask; int lo;
  const int blk = t >> 6;
  if (branch == 1) { mask = p.selmask[item]; mask &= (blk == 63) ? ~0ull : ((1ull << (blk + 1)) - 1ull); lo = 0; }
  else { lo = t - 511; if (lo < 0) lo = 0; const int b0 = lo >> 6; mask = ((blk == 63) ? ~0ull : ((1ull << (blk + 1)) - 1ull)) & ~((1ull << b0) - 1ull); }
  const bf16_t* Kb = (branch == 1 ? p.SK : p.WK) + (size_t)bg * T * 64;
  const bf16_t* Vt = (branch == 1 ? p.SVt : p.WVt) + (size_t)bg * 64 * T;
  WaveAttn s; wa_init(s);
  while (mask) {
    const int j = __ffsll((long long)mask) - 1; mask &= mask - 1;
    wa_block(s, qs, ps, Kb, Vt, T, j * 64, lo, t, lane);
  }
  const int m = b * T + t;
#pragma unroll
  for (int h = 0; h < 4; h++) {
    const int hh = g * 4 + h;
    const float gate = p.NG[(size_t)m * 24 + hh * 3 + branch];
    const float val = s.l[h] > 0.f ? gate * s.o[h] / s.l[h] : 0.f;
    bf16_t* dst = p.oattn + (size_t)m * 512 + hh * 64 + lane;
    if (branch == 2) *dst = f2bf(val); else *dst = f2bf(bf2f(*dst) + val);
  }
}
DI void naive_cmp(const Params& p, int item, char* wsm, int lane) {
  const int bg = item >> 12, t = item & 4095, b = bg >> 1, g = bg & 1;
  float* qs = (float*)wsm; float* pn = qs + 256; float* scr = pn + 1024;
  load_q(p, qs, b, g, t, lane);
  const int nvalid = t >= 31 ? ((t - 31) >> 4) + 1 : 0;
  const bf16_t* Kb = p.kcmp + (size_t)bg * 256 * 64;
#pragma unroll 1
  for (int jj = 0; jj < 4; jj++) {
    const int n = lane + 64 * jj;
    const uint4* kr = (const uint4*)(Kb + (size_t)n * 64);
    float a[4] = {0.f, 0.f, 0.f, 0.f};
#pragma unroll 2
    for (int c8 = 0; c8 < 8; c8++) {
      const uint4 kv = kr[c8];
      float kf[8] = {lo2f(kv.x), hi2f(kv.x), lo2f(kv.y), hi2f(kv.y), lo2f(kv.z), hi2f(kv.z), lo2f(kv.w), hi2f(kv.w)};
#pragma unroll
      for (int h = 0; h < 4; h++) {
        const float4 q0 = *(const float4*)(qs + h * 64 + c8 * 8), q1 = *(const float4*)(qs + h * 64 + c8 * 8 + 4);
        a[h] += q0.x * kf[0] + q0.y * kf[1] + q0.z * kf[2] + q0.w * kf[3] + q1.x * kf[4] + q1.y * kf[5] + q1.z * kf[6] + q1.w * kf[7];
      }
    }
#pragma unroll
    for (int h = 0; h < 4; h++) pn[h * 256 + n] = (n < nvalid) ? a[h] : -1e30f;
  }
  WSYNC();
#pragma unroll 1
  for (int h = 0; h < 4; h++) {
    float sv[4];
#pragma unroll
    for (int jj = 0; jj < 4; jj++) sv[jj] = pn[h * 256 + lane + 64 * jj];
    float mx = fmaxf(fmaxf(sv[0], sv[1]), fmaxf(sv[2], sv[3])); mx = wmax(mx);
    float e[4], sum = 0.f;
#pragma unroll
    for (int jj = 0; jj < 4; jj++) { e[jj] = (lane + 64 * jj < nvalid) ? __expf(sv[jj] - mx) : 0.f; sum += e[jj]; }
    sum = wsum(sum);
    const float inv = sum > 0.f ? 1.f / sum : 0.f;
#pragma unroll
    for (int jj = 0; jj < 4; jj++) pn[h * 256 + lane + 64 * jj] = e[jj] * inv;
  }
  WSYNC();
  float imp = 0.f;
  {
    const int s4 = lane * 4;
#pragma unroll
    for (int h = 0; h < 4; h++) {
      const float* ph = pn + h * 256;
      float v = 2.f * (ph[s4] + ph[s4 + 1] + ph[s4 + 2]);
      if (s4 > 0) v += ph[s4 - 1];
      if (s4 + 3 < 255) v += ph[s4 + 3];
      imp += v;
    }
  }
  const int blk = t >> 6;
  const float score = (lane == 0 || lane == blk || lane == blk - 1) ? 1e9f : (lane <= blk ? imp : -1e9f);
  scr[lane] = score;
  WSYNC();
  int rank = 0;
  for (int i = 0; i < 64; i++) { const float si = scr[i]; rank += (si > score || (si == score && i < lane)) ? 1 : 0; }
  const unsigned long long sel = __ballot(rank < 16);
  if (lane == 0) p.selmask[item] = sel;
  float o[4] = {0.f, 0.f, 0.f, 0.f};
  const bf16_t* Vt = p.vcmpT + (size_t)(bg * 64 + lane) * 256;
  const int nch = (nvalid + 7) >> 3;
  for (int c8 = 0; c8 < nch; c8++) {
    const uint4 vv = ((const uint4*)Vt)[c8];
    float vf[8] = {lo2f(vv.x), hi2f(vv.x), lo2f(vv.y), hi2f(vv.y), lo2f(vv.z), hi2f(vv.z), lo2f(vv.w), hi2f(vv.w)};
#pragma unroll
    for (int h = 0; h < 4; h++) {
      const float4 p0 = *(const float4*)(pn + h * 256 + c8 * 8), p1 = *(const float4*)(pn + h * 256 + c8 * 8 + 4);
      o[h] += p0.x * vf[0] + p0.y * vf[1] + p0.z * vf[2] + p0.w * vf[3] + p1.x * vf[4] + p1.y * vf[5] + p1.z * vf[6] + p1.w * vf[7];
    }
  }
  const int m = b * T + t;
#pragma unroll
  for (int h = 0; h < 4; h++) {
    const int hh = g * 4 + h;
    const float gate = p.NG[(size_t)m * 24 + hh * 3 + 0];
    bf16_t* dst = p.oattn + (size_t)m * 512 + hh * 64 + lane;
    *dst = f2bf(bf2f(*dst) + gate * o[h]);
  }
  WSYNC();
}

DI float gelu_tanh(float x) { const float u = 0.7978845608028654f * (x + 0.044715f * x * x * x); return 0.5f * x * (1.f + tanhf(u)); }
DI void compress1_tile(const Params& p, int tile, char* smem) {
  const int ntl = tile & 1, mtile = tile >> 1, half = mtile & 1, bg = (mtile >> 1) & 7, kv = mtile >> 4;
  const bf16_t* src = (kv ? p.CV : p.CK) + (size_t)bg * T * 64 + (size_t)half * 128 * 1024;
  const bf16_t* Bt = (kv ? p.W1vT : p.W1kT) + (size_t)ntl * 128 * 2048;
  f32x4 acc[4][4]; zero_acc(acc);
  gemm128<true>(acc, [=](int r) { return src + (size_t)r * 1024; }, [=](int r) { return Bt + (size_t)r * 2048; }, 2048, smem);
  epilogue<true>(acc, [&](int r, int c, f32x4 v) {
    const int n = half * 128 + r;
    if (n < 255) {
      const int j = ntl * 128 + c;
      const float4 pb = *(const float4*)(p.posb + kv * 256 + j);
      uint2 o; o.x = pack2(gelu_tanh(v[0] + pb.x), gelu_tanh(v[1] + pb.y)); o.y = pack2(gelu_tanh(v[2] + pb.z), gelu_tanh(v[3] + pb.w));
      *(uint2*)(p.H1 + ((size_t)((kv * 8 + bg) * 256 + n)) * 256 + j) = o;
    }
  });
}
DI void compress2(const Params& p) {
  const size_t gtid = (size_t)blockIdx.x * 256 + threadIdx.x, gsz = (size_t)gridDim.x * 256;
  for (size_t i = gtid; i < (size_t)2 * 8 * 256 * 32; i += gsz) {
    const int ii = (int)(i & 31), n = (int)((i >> 5) & 255), bg = (int)((i >> 13) & 7), kv = (int)(i >> 16);
    float a0 = 0.f, a1 = 0.f;
    if (n < 255) {
      const bf16_t* h = p.H1 + ((size_t)((kv * 8 + bg) * 256 + n)) * 256;
      const float* w2 = kv ? p.cmp_v_w2 : p.cmp_k_w2; const float* b2 = kv ? p.cmp_v_b2 : p.cmp_k_b2;
      a0 = b2[ii]; a1 = b2[ii + 32];
      for (int j = 0; j < 256; j++) { const float hv = bf2f(h[j]); a0 += hv * w2[j * 64 + ii]; a1 += hv * w2[j * 64 + ii + 32]; }
    }
    if (kv == 0) {
      float r0 = 0.f, r1 = 0.f;
      if (n < 255) { const int pos = 16 * n + 31; const float c = p.ropeN[((size_t)pos * 32 + ii) * 2], s = p.ropeN[((size_t)pos * 32 + ii) * 2 + 1];
        r0 = a0 * c - a1 * s; r1 = a0 * s + a1 * c; }
      *(unsigned*)(p.kcmp + ((size_t)(bg * 256 + n)) * 64 + 2 * ii) = pack2(r0, r1);
    } else {
      p.vcmpT[((size_t)(bg * 64 + ii)) * 256 + n] = f2bf(a0);
      p.vcmpT[((size_t)(bg * 64 + ii + 32)) * 256 + n] = f2bf(a1);
    }
  }
}

DI void ret_scan(const Params& p) {
  const size_t gtid = (size_t)blockIdx.x * 256 + threadIdx.x, gsz = (size_t)gridDim.x * 256;
  for (size_t i = gtid; i < (size_t)16 * 256 * 128; i += gsz) {
    const int dk = (int)(i & 127), e = (int)((i >> 7) & 255), bh = (int)(i >> 15), h = bh & 3;
    const float cd = exp2f(128.f * log2f(1.f - exp2f(-5.f - (float)h)));
    const bf16_t* kz = p.RKzT + ((size_t)(bh * 128 + dk)) * T;
    const bf16_t* vt = p.RVt + ((size_t)(bh * 256 + e)) * T;
    float R = 0.f;
    for (int n = 0; n < 32; n++) {
      p.Rt[(((size_t)bh * 32 + n) * 256 + e) * 128 + dk] = f2bf(R);
      if (n == 31) break;
      float s = 0.f;
      const uint4* k4 = (const uint4*)(kz + n * 128); const uint4* v4 = (const uint4*)(vt + n * 128);
#pragma unroll 4
      for (int c = 0; c < 16; c++) {
        const uint4 a = k4[c], bq = v4[c];
        s += lo2f(a.x) * lo2f(bq.x) + hi2f(a.x) * hi2f(bq.x) + lo2f(a.y) * lo2f(bq.y) + hi2f(a.y) * hi2f(bq.y)
           + lo2f(a.z) * lo2f(bq.z) + hi2f(a.z) * hi2f(bq.z) + lo2f(a.w) * lo2f(bq.w) + hi2f(a.w) * hi2f(bq.w);
      }
      R = R * cd + s;
    }
  }
}
DI void ret_out(const Params& p, int item, char* wsm, int lane) {
  const int bh = item >> 12, t = item & 4095, b = bh >> 2, h = bh & 3, n = t >> 7, c = t & 127;
  float* qs = (float*)wsm; float* ss = qs + 128;
  const bf16_t* qrow = p.RQ + ((size_t)bh * T + t) * 128;
  qs[lane] = bf2f(qrow[lane]); qs[lane + 64] = bf2f(qrow[lane + 64]);
  WSYNC();
  const float lg = log2f(1.f - exp2f(-5.f - (float)h));
#pragma unroll 1
  for (int jj = 0; jj < 2; jj++) {
    const int mm = lane + 64 * jj;
    const uint4* kr = (const uint4*)(p.RK + ((size_t)bh * T + n * 128 + mm) * 128);
    float a = 0.f;
#pragma unroll 4
    for (int c8 = 0; c8 < 16; c8++) {
      const uint4 kv = kr[c8];
      const float4 q0 = *(const float4*)(qs + c8 * 8), q1 = *(const float4*)(qs + c8 * 8 + 4);
      a += q0.x * lo2f(kv.x) + q0.y * hi2f(kv.x) + q0.z * lo2f(kv.y) + q0.w * hi2f(kv.y) + q1.x * lo2f(kv.z) + q1.y * hi2f(kv.z) + q1.z * lo2f(kv.w) + q1.w * hi2f(kv.w);
    }
    ss[mm] = (mm <= c) ? a * exp2f((float)(c - mm) * lg) : 0.f;
  }
  WSYNC();
  const float xi = exp2f((float)(c + 1) * lg);
  float o[4];
#pragma unroll
  for (int jj = 0; jj < 4; jj++) {
    asm volatile("" ::: "memory");
    const int e = lane + 64 * jj;
    const uint4* vr = (const uint4*)(p.RVt + ((size_t)(bh * 256 + e)) * T + n * 128);
    const uint4* rr = (const uint4*)(p.Rt + (((size_t)bh * 32 + n) * 256 + e) * 128);
    float a = 0.f, cr = 0.f;
    const int nch = (c >> 3) + 1;
#pragma unroll 2
    for (int c8 = 0; c8 < nch; c8++) {
      const uint4 vv = vr[c8];
      const float4 s0 = *(const float4*)(ss + c8 * 8), s1 = *(const float4*)(ss + c8 * 8 + 4);
      a += s0.x * lo2f(vv.x) + s0.y * hi2f(vv.x) + s0.z * lo2f(vv.y) + s0.w * hi2f(vv.y) + s1.x * lo2f(vv.z) + s1.y * hi2f(vv.z) + s1.z * lo2f(vv.w) + s1.w * hi2f(vv.w);
    }
#pragma unroll 4
    for (int c8 = 0; c8 < 16; c8++) {
      const uint4 rv = rr[c8];
      const float4 q0 = *(const float4*)(qs + c8 * 8), q1 = *(const float4*)(qs + c8 * 8 + 4);
      cr += q0.x * lo2f(rv.x) + q0.y * hi2f(rv.x) + q0.z * lo2f(rv.y) + q0.w * hi2f(rv.y) + q1.x * lo2f(rv.z) + q1.y * hi2f(rv.z) + q1.z * lo2f(rv.w) + q1.w * hi2f(rv.w);
    }
    o[jj] = a + xi * cr;
  }
  float mu = wsum(o[0] + o[1] + o[2] + o[3]) * (1.f / 256.f);
  float var = 0.f;
#pragma unroll
  for (int jj = 0; jj < 4; jj++) { const float d = o[jj] - mu; var += d * d; }
  var = wsum(var) * (1.f / 256.f);
  const float rs = rsqrtf(var + 1e-5f);
  const int m = b * T + t;
#pragma unroll
  for (int jj = 0; jj < 4; jj++) {
    const int col = h * 256 + lane + 64 * jj;
    const float y = (o[jj] - mu) * rs * p.gn_g[col] + p.gn_b[col];
    const float gt = bf2f(p.RG[(size_t)m * 1024 + col]);
    p.oret[(size_t)m * 1024 + col] = f2bf(y * gt * sigmoidf_(gt));
  }
  WSYNC();
}

DI void upproj_tile(const Params& p, int tile, char* smem) {
  const int nt_ = tile & 7, mt_ = tile >> 3, m0 = mt_ * 128, n0 = nt_ * 128;
  f32x4 acc[4][4];
  zero_acc(acc);
  { const bf16_t* A = p.oattn + (size_t)m0 * 512; const bf16_t* Bt = p.WaT + (size_t)n0 * 512;
    gemm128<true>(acc, [=](int r) { return A + (size_t)r * 512; }, [=](int r) { return Bt + (size_t)r * 512; }, 512, smem); }
  epilogue<true>(acc, [&](int r, int c, f32x4 v) {
    const size_t m = m0 + r; const int cc = n0 + c;
    const uint2 gv = *(const uint2*)(p.MG + m * 2048 + cc);
    uint2 o; o.x = pack2(sigmoidf_(lo2f(gv.x)) * v[0], sigmoidf_(hi2f(gv.x)) * v[1]); o.y = pack2(sigmoidf_(lo2f(gv.y)) * v[2], sigmoidf_(hi2f(gv.y)) * v[3]);
    *(uint2*)(p.merged + m * 1024 + cc) = o;
  });
  zero_acc(acc);
  { const bf16_t* A = p.oret + (size_t)m0 * 1024; const bf16_t* Bt = p.WrT + (size_t)n0 * 1024;
    gemm128<true>(acc, [=](int r) { return A + (size_t)r * 1024; }, [=](int r) { return Bt + (size_t)r * 1024; }, 1024, smem); }
  epilogue<true>(acc, [&](int r, int c, f32x4 v) {
    const size_t m = m0 + r; const int cc = n0 + c;
    const uint2 gv = *(const uint2*)(p.MG + m * 2048 + 1024 + cc);
    const uint2 pr = *(const uint2*)(p.merged + m * 1024 + cc);
    uint2 o; o.x = pack2(lo2f(pr.x) + sigmoidf_(lo2f(gv.x)) * v[0], hi2f(pr.x) + sigmoidf_(hi2f(gv.x)) * v[1]);
    o.y = pack2(lo2f(pr.y) + sigmoidf_(lo2f(gv.y)) * v[2], hi2f(pr.y) + sigmoidf_(hi2f(gv.y)) * v[3]);
    *(uint2*)(p.merged + m * 1024 + cc) = o;
  });
}
DI void wout_tile(const Params& p, int tile, char* smem) {
  const int nt_ = tile & 7, mt_ = tile >> 3, m0 = mt_ * 128, n0 = nt_ * 128;
  f32x4 acc[4][4]; zero_acc(acc);
  const bf16_t* A = p.merged + (size_t)m0 * 1024; const bf16_t* Bt = p.WoT + (size_t)n0 * 1024;
  gemm128<true>(acc, [=](int r) { return A + (size_t)r * 1024; }, [=](int r) { return Bt + (size_t)r * 1024; }, 1024, smem);
  epilogue<true>(acc, [&](int r, int c, f32x4 v) {
    const size_t idx = (size_t)(m0 + r) * 1024 + n0 + c;
    const float4 xv = *(const float4*)(p.x + idx);
    float4 o; o.x = ALPHA * xv.x + v[0]; o.y = ALPHA * xv.y + v[1]; o.z = ALPHA * xv.z + v[2]; o.w = ALPHA * xv.w + v[3];
    *(float4*)(p.out + idx) = o;
  });
}
DI void expert_cvt(const Params& p, char* smem) {
  float* tile = (float*)smem;
  const int bid = blockIdx.x, nb = gridDim.x;
  for (int e = 0; e < NEXP; e++) {
    const float* wg = p.e_wg + (size_t)e * 1024 * 512; const float* wu = p.e_wu + (size_t)e * 1024 * 512; const float* wd = p.e_wd + (size_t)e * 512 * 1024;
    tcvt_all([=](int j) -> const float* { const int f = (j >> 7) * 64 + ((j >> 5) & 3) * 16 + (j & 15); return (((j >> 4) & 1) ? wu : wg) + f; },
             512, p.EgT + (size_t)e * 1024 * 1024, 1024, 1024, tile, (bid + e * 37) % nb, nb);
    tcvt_all([=](int j) -> const float* { return wd + j; }, 1024, p.EdT + (size_t)e * 1024 * 512, 512, 1024, tile, (bid + e * 37 + 19) % nb, nb);
  }
}

DI void ln1_router(const Params& p, int m, int lane) {
  float* row = p.out + (size_t)m * 1024;
  float4 v[4];
#pragma unroll
  for (int i = 0; i < 4; i++) v[i] = *(const float4*)(row + i * 256 + lane * 4);
  float s = 0.f;
#pragma unroll
  for (int i = 0; i < 4; i++) s += v[i].x + v[i].y + v[i].z + v[i].w;
  const float mu = wsum(s) * (1.f / 1024.f);
  float q = 0.f;
#pragma unroll
  for (int i = 0; i < 4; i++) { const float a = v[i].x - mu, b = v[i].y - mu, c = v[i].z - mu, d = v[i].w - mu; q += a * a + b * b + c * c + d * d; }
  const float rs = rsqrtf(wsum(q) * (1.f / 1024.f) + 1e-5f);
  float gl[4] = {0.f, 0.f, 0.f, 0.f};
#pragma unroll
  for (int i = 0; i < 4; i++) {
    const int k = i * 256 + lane * 4;
    const float4 g = *(const float4*)(p.ln1_g + k), bb = *(const float4*)(p.ln1_b + k);
    v[i].x = (v[i].x - mu) * rs * g.x + bb.x; v[i].y = (v[i].y - mu) * rs * g.y + bb.y;
    v[i].z = (v[i].z - mu) * rs * g.z + bb.z; v[i].w = (v[i].w - mu) * rs * g.w + bb.w;
    *(float4*)(row + k) = v[i];
    uint2 o; o.x = pack2(v[i].x, v[i].y); o.y = pack2(v[i].z, v[i].w);
    *(uint2*)(p.x1b + (size_t)m * 1024 + k) = o;
    const float xs[4] = {v[i].x, v[i].y, v[i].z, v[i].w};
#pragma unroll
    for (int kk = 0; kk < 4; kk++) {
      const float4 w = *(const float4*)(p.rg_w + (size_t)(k + kk) * 4);
      gl[0] += xs[kk] * w.x; gl[1] += xs[kk] * w.y; gl[2] += xs[kk] * w.z; gl[3] += xs[kk] * w.w;
    }
  }
#pragma unroll
  for (int j = 0; j < 4; j++) gl[j] = wsum(gl[j]) + p.rg_b[j];
  int gi = 0; float gm = gl[0];
#pragma unroll
  for (int j = 1; j < 4; j++) if (gl[j] > gm) { gm = gl[j]; gi = j; }
  float gs = 0.f;
#pragma unroll
  for (int j = 0; j < 4; j++) gs += __expf(gl[j] - gm);
  const float gprob = 1.f / gs;
  float il[8] = {0.f, 0.f, 0.f, 0.f, 0.f, 0.f, 0.f, 0.f};
  const float* riw = p.ri_w + (size_t)gi * 1024 * 8;
#pragma unroll
  for (int i = 0; i < 4; i++) {
    const int k = i * 256 + lane * 4;
    const float xs[4] = {v[i].x, v[i].y, v[i].z, v[i].w};
#pragma unroll
    for (int kk = 0; kk < 4; kk++) {
      const float4 w0 = *(const float4*)(riw + (size_t)(k + kk) * 8), w1 = *(const float4*)(riw + (size_t)(k + kk) * 8 + 4);
      il[0] += xs[kk] * w0.x; il[1] += xs[kk] * w0.y; il[2] += xs[kk] * w0.z; il[3] += xs[kk] * w0.w;
      il[4] += xs[kk] * w1.x; il[5] += xs[kk] * w1.y; il[6] += xs[kk] * w1.z; il[7] += xs[kk] * w1.w;
    }
  }
#pragma unroll
  for (int j = 0; j < 8; j++) il[j] = wsum(il[j]) + p.ri_b[gi * 8 + j];
  int e1 = 0; float l1 = il[0];
#pragma unroll
  for (int j = 1; j < 8; j++) if (il[j] > l1) { l1 = il[j]; e1 = j; }
  int e2 = -1; float l2 = -3e38f;
#pragma unroll
  for (int j = 0; j < 8; j++) if (j != e1 && il[j] > l2) { l2 = il[j]; e2 = j; }
  const float ex = __expf(l2 - l1);
  const float w1 = gprob / (1.f + ex), w2 = gprob * ex / (1.f + ex);
  if (lane == 0) {
    const int ea = gi * 8 + e1, eb = gi * 8 + e2;
    const int pa = atomicAdd(p.cnt + ea, 1); p.lists[ea * 16384 + pa] = m * 2;
    const int pb = atomicAdd(p.cnt + eb, 1); p.lists[eb * 16384 + pb] = m * 2 + 1;
    p.routew[m * 2] = w1; p.routew[m * 2 + 1] = w2;
  }
}
DI void ln2_final(const Params& p, int m, int lane) {
  float* row = p.out + (size_t)m * 1024;
  float4 v[4];
  float s = 0.f;
#pragma unroll
  for (int i = 0; i < 4; i++) {
    const int k = i * 256 + lane * 4;
    const float4 xv = *(const float4*)(row + k);
    const uint2 a = *(const uint2*)(p.part + (size_t)(2 * m) * 1024 + k), b = *(const uint2*)(p.part + (size_t)(2 * m + 1) * 1024 + k);
    v[i].x = ALPHA * xv.x + lo2f(a.x) + lo2f(b.x); v[i].y = ALPHA * xv.y + hi2f(a.x) + hi2f(b.x);
    v[i].z = ALPHA * xv.z + lo2f(a.y) + lo2f(b.y); v[i].w = ALPHA * xv.w + hi2f(a.y) + hi2f(b.y);
    s += v[i].x + v[i].y + v[i].z + v[i].w;
  }
  const float mu = wsum(s) * (1.f / 1024.f);
  float q = 0.f;
#pragma unroll
  for (int i = 0; i < 4; i++) { const float a = v[i].x - mu, b = v[i].y - mu, c = v[i].z - mu, d = v[i].w - mu; q += a * a + b * b + c * c + d * d; }
  const float rs = rsqrtf(wsum(q) * (1.f / 1024.f) + 1e-5f);
#pragma unroll
  for (int i = 0; i < 4; i++) {
    const int k = i * 256 + lane * 4;
    const float4 g = *(const float4*)(p.ln2_g + k), bb = *(const float4*)(p.ln2_b + k);
    float4 o; o.x = (v[i].x - mu) * rs * g.x + bb.x; o.y = (v[i].y - mu) * rs * g.y + bb.y; o.z = (v[i].z - mu) * rs * g.z + bb.z; o.w = (v[i].w - mu) * rs * g.w + bb.w;
    *(float4*)(row + k) = o;
  }
}

struct MoeMap { int e, mi, cnt, hoff; };
DI bool moe_map(const Params& p, int mtile, MoeMap& mm) {
  int acc = 0;
  for (int e = 0; e < NEXP; e++) {
    const int c = p.cnt[e], nt = (c + 127) >> 7;
    if (mtile < acc + nt) { mm.e = e; mm.mi = mtile - acc; mm.cnt = c; mm.hoff = acc * 128; return true; }
    acc += nt;
  }
  return false;
}
DI int moe_total(const Params& p) { int acc = 0; for (int e = 0; e < NEXP; e++) acc += (p.cnt[e] + 127) >> 7; return acc; }
DI void moe_up_tile(const Params& p, const MoeMap& mm, int nt_, char* smem) {
  const int* lst = p.lists + mm.e * 16384 + mm.mi * 128; const int nrow = mm.cnt - mm.mi * 128;
  const bf16_t* Bt = p.EgT + ((size_t)mm.e * 1024 + nt_ * 128) * 1024;
  const bf16_t* X = p.x1b;
  f32x4 acc[4][4]; zero_acc(acc);
  gemm128<true>(acc, [=](int r) { const int tk = r < nrow ? (lst[r] >> 1) : 0; return X + (size_t)tk * 1024; }, [=](int r) { return Bt + (size_t)r * 1024; }, 1024, smem);
  const int lane = threadIdx.x & 63, wave = threadIdx.x >> 6, wr = wave >> 1, wc = wave & 1, fr = lane & 15, fq = lane >> 4;
#pragma unroll
  for (int mt = 0; mt < 4; mt++) {
    const int r = wr * 64 + mt * 16 + fr;
    if (r < nrow) {
      const float w = p.routew[lst[r]];
#pragma unroll
      for (int np = 0; np < 2; np++) {
        const f32x4 g = acc[mt][np * 2], u = acc[mt][np * 2 + 1];
        float hv[4];
#pragma unroll
        for (int i = 0; i < 4; i++) hv[i] = g[i] * sigmoidf_(g[i]) * u[i] * w;
        const int f = nt_ * 64 + wc * 32 + np * 16 + fq * 4;
        uint2 o; o.x = pack2(hv[0], hv[1]); o.y = pack2(hv[2], hv[3]);
        *(uint2*)(p.Hh + (size_t)(mm.hoff + mm.mi * 128 + r) * 512 + f) = o;
      }
    }
  }
}
DI void moe_down_tile(const Params& p, const MoeMap& mm, int nt_, char* smem) {
  const int* lst = p.lists + mm.e * 16384 + mm.mi * 128; const int nrow = mm.cnt - mm.mi * 128;
  const bf16_t* A = p.Hh + (size_t)(mm.hoff + mm.mi * 128) * 512;
  const bf16_t* Bt = p.EdT + ((size_t)mm.e * 1024 + nt_ * 128) * 512;
  f32x4 acc[4][4]; zero_acc(acc);
  gemm128<true>(acc, [=](int r) { return A + (size_t)r * 512; }, [=](int r) { return Bt + (size_t)r * 512; }, 512, smem);
  epilogue<true>(acc, [&](int r, int c, f32x4 v) {
    if (r < nrow) {
      const int ts = lst[r];
      uint2 o; o.x = pack2(v[0], v[1]); o.y = pack2(v[2], v[3]);
      *(uint2*)(p.part + (size_t)ts * 1024 + nt_ * 128 + c) = o;
    }
  });
}

constexpr int NPHASE = 12;
#if FUSED
#define PHFN DI
#else
#define PHFN DI
#endif
#define PH_PRE const int bid = blockIdx.x, nb = gridDim.x, tid = threadIdx.x, lane = tid & 63, wave = tid >> 6; \
  const int gw = bid * 4 + wave, nw = nb * 4; char* wsm = smem + wave * 8192; (void)bid; (void)nb; (void)lane; (void)gw; (void)nw; (void)wsm;
PHFN void ph0(const Params& p, char* smem) { phase0(p, smem); }
PHFN void ph1(const Params& p, char* smem) { phase1(p, smem); }
PHFN void ph2(const Params& p, char* smem) { PH_PRE
  for (int t = bid; t < 64; t += nb) compress1_tile(p, t, smem);
  ret_scan(p);
  for (int it = gw; it < 8 * T; it += nw) naive_sparse(p, it, 2, wsm, lane);
}
PHFN void ph3(const Params& p, char* smem) { compress2(p); }
PHFN void ph4(const Params& p, char* smem) { PH_PRE
  for (int it = gw; it < 8 * T; it += nw) naive_cmp(p, it, wsm, lane);
  for (int it = gw; it < 16 * T; it += nw) ret_out(p, it, wsm, lane);
}
PHFN void ph5(const Params& p, char* smem) { PH_PRE
  for (int it = gw; it < 8 * T; it += nw) naive_sparse(p, it, 1, wsm, lane);
}
PHFN void ph6(const Params& p, char* smem) { PH_PRE for (int t = bid; t < 1024; t += nb) upproj_tile(p, t, smem); }
PHFN void ph7(const Params& p, char* smem) { PH_PRE for (int t = bid; t < 1024; t += nb) wout_tile(p, t, smem); expert_cvt(p, smem); }
PHFN void ph8(const Params& p, char* smem) { PH_PRE for (int m = gw; m < M; m += nw) ln1_router(p, m, lane); }
PHFN void ph9(const Params& p, char* smem) { PH_PRE const int tot = moe_total(p);
  for (int t = bid; t < tot * 8; t += nb) { MoeMap mm; if (moe_map(p, t >> 3, mm)) moe_up_tile(p, mm, t & 7, smem); } }
PHFN void ph10(const Params& p, char* smem) { PH_PRE const int tot = moe_total(p);
  for (int t = bid; t < tot * 8; t += nb) { MoeMap mm; if (moe_map(p, t >> 3, mm)) moe_down_tile(p, mm, t & 7, smem); } }
PHFN void ph11(const Params& p, char* smem) { PH_PRE for (int m = gw; m < M; m += nw) ln2_final(p, m, lane); }
DI void run_phase(const Params& p, const int ph, char* smem) {
  switch (ph) {
    case 0: ph0(p, smem); break; case 1: ph1(p, smem); break; case 2: ph2(p, smem); break; case 3: ph3(p, smem); break;
    case 4: ph4(p, smem); break; case 5: ph5(p, smem); break; case 6: ph6(p, smem); break; case 7: ph7(p, smem); break;
    case 8: ph8(p, smem); break; case 9: ph9(p, smem); break; case 10: ph10(p, smem); break; case 11: ph11(p, smem); break;
  }
}

template <int PH>
__global__ void __launch_bounds__(256, 2) phase_kernel(Params p) {
  __shared__ __attribute__((aligned(16))) char smem[65536];
  run_phase(p, PH, smem);
}
#if FUSED
__global__ void __launch_bounds__(256, 2) mega_kernel(Params p_arg) {
  __shared__ __attribute__((aligned(16))) char smem[65536 + 16];
  const Params& p = *(const Params*)__builtin_amdgcn_kernarg_segment_ptr();
  volatile LAS unsigned* st = (volatile LAS unsigned*)(smem + 65536);
  if (threadIdx.x == 0) { st[0] = 0u; st[1] = 0u; }
  __syncthreads();
  const XcdBarrier xb = xcd_barrier_post(p.bar, st);
#define GSYNC() xcd_barrier(xb)
  ph0(p, smem); GSYNC(); ph1(p, smem); GSYNC(); ph2(p, smem); GSYNC(); ph3(p, smem); GSYNC();
  ph4(p, smem); GSYNC(); ph5(p, smem); GSYNC(); ph6(p, smem); GSYNC(); ph7(p, smem); GSYNC();
  ph8(p, smem); GSYNC(); ph9(p, smem); GSYNC(); ph10(p, smem); GSYNC(); ph11(p, smem);
}
#endif

extern "C" void kernel_launch(void* const* d_in, const int* in_sizes, int n_in, void* d_out, int out_size,
                              void* d_ws, size_t ws_size, hipStream_t stream) {
  Params p{};
  const float** ins = (const float**)&p;
  for (int i = 0; i < 28; i++) ins[i] = (const float*)d_in[i];
  p.out = (float*)d_out;
  char* ws = (char*)d_ws; size_t off = 0;
  auto alloc = [&](size_t bytes) { char* r = ws + off; off += (bytes + 255) & ~(size_t)255; return r; };
  const size_t MiB = 1 << 20;
  char* regionP = ws;
  p.Qn = (bf16_t*)alloc(16 * MiB);
  p.CK = (bf16_t*)alloc(4 * MiB); p.CV = (bf16_t*)alloc(4 * MiB); p.SK = (bf16_t*)alloc(4 * MiB); p.SVt = (bf16_t*)alloc(4 * MiB);
  p.WK = (bf16_t*)alloc(4 * MiB); p.WVt = (bf16_t*)alloc(4 * MiB);
  p.NG = (float*)alloc((size_t)M * 24 * 4);
  p.RQ = (bf16_t*)alloc(16 * MiB); p.RK = (bf16_t*)alloc(16 * MiB); p.RKzT = (bf16_t*)alloc(16 * MiB);
  p.RVt = (bf16_t*)alloc(32 * MiB); p.RG = (bf16_t*)alloc(32 * MiB); p.MG = (bf16_t*)alloc(64 * MiB);
  p.oattn = (bf16_t*)alloc(16 * MiB); p.WinT = p.oattn;
  p.oret = (bf16_t*)alloc(32 * MiB);
  p.WaT = (bf16_t*)alloc(1 * MiB); p.WrT = (bf16_t*)alloc(2 * MiB); p.WoT = (bf16_t*)alloc(2 * MiB);
  p.W1kT = (bf16_t*)alloc(1 * MiB); p.W1vT = (bf16_t*)alloc(1 * MiB);
  p.ropeN = (float*)alloc((size_t)T * 32 * 8); p.ropeR = (float*)alloc((size_t)T * 64 * 8); p.posb = (float*)alloc(512 * 4);
  p.H1 = (bf16_t*)alloc(2 * MiB); p.kcmp = (bf16_t*)alloc(8 * 256 * 64 * 2); p.vcmpT = (bf16_t*)alloc(8 * 64 * 256 * 2);
  p.selmask = (unsigned long long*)alloc((size_t)8 * T * 8);
  p.cnt = (int*)alloc(256); p.lists = (int*)alloc((size_t)NEXP * 16384 * 4); p.routew = (float*)alloc((size_t)M * 2 * 4);
  p.merged = (bf16_t*)(regionP); p.x1b = (bf16_t*)(regionP + 32 * MiB);
  p.EgT = (bf16_t*)(regionP + 64 * MiB); p.EdT = (bf16_t*)(regionP + 128 * MiB);
  p.Hh = (bf16_t*)(regionP + 160 * MiB); p.part = (bf16_t*)(regionP + 196 * MiB);
  p.bar = (unsigned*)alloc(XCD_BAR_WORDS * 4);
  p.xb = (bf16_t*)d_out; p.Rt = (bf16_t*)d_out;
  if (off > ws_size) { fprintf(stderr, "workspace too small: need %zu have %zu\n", off, ws_size); return; }
#if FUSED
  static int grid_blocks = 0;
  if (!grid_blocks) {
    int dev = 0, cus = 0, per_cu = 0;
    (void)hipGetDevice(&dev);
    (void)hipDeviceGetAttribute(&cus, hipDeviceAttributeMultiprocessorCount, dev);
    (void)hipOccupancyMaxActiveBlocksPerMultiprocessor(&per_cu, mega_kernel, 256, 0);
    if (per_cu > 2) per_cu = 2;
    grid_blocks = cus * per_cu;
  }
  (void)hipMemsetAsync(p.bar, 0, XCD_BAR_WORDS * 4, stream);
  void* args[] = {&p};
  hipError_t e = hipLaunchCooperativeKernel((void*)mega_kernel, dim3(grid_blocks), dim3(256), args, 0, stream);
  if (e != hipSuccess) fprintf(stderr, "coop launch failed: %s\n", hipGetErrorString(e));
#else
#define LAUNCH_PH(N) phase_kernel<N><<<512, 256, 0, stream>>>(p)
  LAUNCH_PH(0); LAUNCH_PH(1); LAUNCH_PH(2); LAUNCH_PH(3); LAUNCH_PH(4); LAUNCH_PH(5);
  LAUNCH_PH(6); LAUNCH_PH(7); LAUNCH_PH(8); LAUNCH_PH(9); LAUNCH_PH(10); LAUNCH_PH(11);
#endif
}
```

```cpp
#include <hip/hip_runtime.h>
#include <hip/hip_cooperative_groups.h>
#include <cstdio>
#include <cstdint>
namespace cg = cooperative_groups;

#ifndef FUSED
#define FUSED 1
#endif

#define DI __device__ __forceinline__
typedef unsigned short bf16_t;
typedef short bf16x8 __attribute__((ext_vector_type(8)));
typedef float f32x4 __attribute__((ext_vector_type(4)));

constexpr int Bn = 4, T = 4096, D = 1024, M = Bn * T;
constexpr int NINP = 6528;
constexpr int NEXP = 32, DFF = 512;
constexpr int HROWS = 36864;
constexpr float ALPHA = 1.189207115002721f;

struct Params {
  const float *x, *w_in, *cmp_pos_k, *cmp_k_w1, *cmp_k_b1, *cmp_k_w2, *cmp_k_b2;
  const float *cmp_pos_v, *cmp_v_w1, *cmp_v_b1, *cmp_v_w2, *cmp_v_b2;
  const float *gn_g, *gn_b, *w_up_attn, *w_up_ret, *w_out, *ln1_g, *ln1_b;
  const float *rg_w, *rg_b, *ri_w, *ri_b, *e_wg, *e_wu, *e_wd, *ln2_g, *ln2_b;
  float* out;
  bf16_t *Qn, *CK, *CV, *SK, *SVt, *WK, *WVt; float* NG;
  bf16_t *RQ, *RK, *RKzT, *RVt, *RG, *MG;
  bf16_t *WinT  , *oattn, *oret;
  bf16_t *WaT, *WrT, *WoT, *W1kT, *W1vT;
  float *ropeN, *ropeR, *posb;
  bf16_t *H1, *kcmp, *vcmpT;
  unsigned long long* selmask;
  int* cnt; int* lists; float* routew;
  bf16_t *merged, *x1b, *EgT  , *EdT  , *Hh, *part;
  bf16_t *xb, *Rt;
  unsigned* bar;
};

DI float bf2f(bf16_t v) { return __uint_as_float(((unsigned)v) << 16); }
typedef __bf16 bf16x2_t __attribute__((ext_vector_type(2)));
DI bf16_t f2bf(float f) { return __builtin_bit_cast(bf16_t, (__bf16)f); }
DI unsigned pack2(float a, float b) { bf16x2_t v = {(__bf16)a, (__bf16)b}; return __builtin_bit_cast(unsigned, v); }
typedef float f32x16 __attribute__((ext_vector_type(16)));
#define MFMA32(a, b, c) __builtin_amdgcn_mfma_f32_32x32x16_bf16((a), (b), (c), 0, 0, 0)
DI float lo2f(unsigned u) { return __uint_as_float(u << 16); }
DI float hi2f(unsigned u) { return __uint_as_float(u & 0xffff0000u); }
DI float wsum(float v) { for (int o = 32; o > 0; o >>= 1) v += __shfl_xor(v, o); return v; }
DI float wmax(float v) { for (int o = 32; o > 0; o >>= 1) v = fmaxf(v, __shfl_xor(v, o)); return v; }
DI float sigmoidf_(float x) { return 1.f / (1.f + __expf(-x)); }
#define WSYNC() asm volatile("s_waitcnt lgkmcnt(0)" ::: "memory")
DI int opq(int x) { asm volatile("" : "+v"(x)); return x; }


#define XB_TMO      128
#define XB_XCNT(j)  (256  + 64 * (j))
#define XB_XSUB(j)  (1280 + 64 * (j))
#define XB_XGEN(j)  (2304 + 64 * (j))
#define XB_TOP      3328
#define XB_TOPGEN   3392
#define XCD_BAR_WORDS 3456
#define XB_SPIN_CAP (1u << 20)
#define LAS __attribute__((address_space(3)))
DI unsigned xb_ld(unsigned* p) { return __hip_atomic_load(p, __ATOMIC_RELAXED, __HIP_MEMORY_SCOPE_AGENT); }
DI unsigned xb_add(unsigned* p, unsigned v) { return __hip_atomic_fetch_add(p, v, __ATOMIC_RELAXED, __HIP_MEMORY_SCOPE_AGENT); }
DI unsigned xb_xcc_id() { return (unsigned)__builtin_amdgcn_s_getreg((3 << 11) | 20) & 0xFu; }
#define XB_SPIN(cond, bar) do { unsigned _sp = 0; while (cond) { __builtin_amdgcn_s_sleep(1); \
    if ((++_sp & 255u) == 0u) { if (xb_ld(&(bar)[XB_TMO])) break; if (_sp > XB_SPIN_CAP) { atomicAdd(&(bar)[XB_TMO], 1u); break; } } } } while (0)
struct XcdBarrier { unsigned* bar; unsigned x; volatile LAS unsigned* st; };
DI XcdBarrier xcd_barrier_post(unsigned* bar, volatile LAS unsigned* st) {
  XcdBarrier b; b.bar = bar; b.x = xb_xcc_id(); b.st = st;
  if (threadIdx.x == 0) (void)xb_add(&bar[XB_XCNT(b.x)], 1u);
  return b;
}
DI void xcd_barrier_complete(unsigned* bar, unsigned x, unsigned& nloc, unsigned& nx) {
  const unsigned G = gridDim.x * gridDim.y * gridDim.z;
  unsigned sum, cnt, mine, sp = 0u;
  for (;;) {
    sum = 0u; cnt = 0u; mine = 0u;
#pragma unroll
    for (unsigned j = 0; j < 16; ++j) { const unsigned c = xb_ld(&bar[XB_XCNT(j)]); sum += c; cnt += (c > 0u) ? 1u : 0u; mine = (j == x) ? c : mine; }
    if (sum == G) break;
    __builtin_amdgcn_s_sleep(1);
    if ((++sp & 255u) == 0u) { if (xb_ld(&bar[XB_TMO])) break; if (sp > XB_SPIN_CAP) { atomicAdd(&bar[XB_TMO], 1u); break; } }
  }
  nloc = mine > 0u ? mine : 1u; nx = cnt > 0u ? cnt : 1u;
}
DI void xcd_barrier(const XcdBarrier& b) {
  asm volatile("s_waitcnt vmcnt(0)" ::: "memory");
  __syncthreads();
  if (threadIdx.x == 0) {
    unsigned* bar = b.bar;
    __builtin_amdgcn_s_waitcnt(0);
    unsigned nloc = b.st[0], nx = b.st[1];
    if (nloc == 0u) { xcd_barrier_complete(bar, b.x, nloc, nx); b.st[0] = nloc; b.st[1] = nx; }
    const unsigned old = xb_add(&bar[XB_XSUB(b.x)], 1u);
    const unsigned gen = old / nloc;
    if (old + 1u == (gen + 1u) * nloc) {
      __builtin_amdgcn_fence(__ATOMIC_RELEASE, "agent");
      asm volatile("s_waitcnt vmcnt(0)" ::: "memory");
      const unsigned og = xb_add(&bar[XB_TOP], 1u);
      const unsigned tg = og / nx;
      if (og + 1u == (tg + 1u) * nx) xb_add(&bar[XB_TOPGEN], 1u);
      else XB_SPIN(xb_ld(&bar[XB_TOPGEN]) == tg, bar);
      __builtin_amdgcn_fence(__ATOMIC_ACQUIRE, "agent");
      xb_add(&bar[XB_XGEN(b.x)], 1u);
      asm volatile("s_waitcnt vmcnt(0)" ::: "memory");
    } else {
      XB_SPIN(xb_ld(&bar[XB_XGEN(b.x)]) == gen, bar);
      __builtin_amdgcn_fence(__ATOMIC_ACQUIRE, "agent");
      asm volatile("s_waitcnt vmcnt(0)" ::: "memory");
    }
  }
  __syncthreads();
}

template <bool SWAP, class AR, class BR>
DI void gemm128(f32x4 (&acc)[4][4], AR arow, BR brow, int K, char* smem) {
  const int tid = threadIdx.x, lane = tid & 63, wave = tid >> 6, wr = wave >> 1, wc = wave & 1;
  const int srow = tid >> 3, sch = tid & 7;
  const bf16_t* ap[4]; const bf16_t* bp[4];
#pragma unroll
  for (int i = 0; i < 4; i++) { ap[i] = arow(srow + 32 * i) + sch * 8; bp[i] = brow(srow + 32 * i) + sch * 8; }
  const int woff = srow * 128 + ((sch ^ (srow & 7)) << 4);
  char* As = smem; char* Bs = smem + 32768;
  uint4 ra[4], rb[4];
#pragma unroll
  for (int i = 0; i < 4; i++) { ra[i] = *(const uint4*)(ap[i]); rb[i] = *(const uint4*)(bp[i]); }
#pragma unroll
  for (int i = 0; i < 4; i++) { *(uint4*)(As + woff + i * 4096) = ra[i]; *(uint4*)(Bs + woff + i * 4096) = rb[i]; }
  __syncthreads();
  const int nk = K >> 6;
  const int fr = lane & 15, fq = lane >> 4;
  const int aoff0 = (wr * 64 + fr) * 128, boff0 = (wc * 64 + fr) * 128;
  for (int kt = 0; kt < nk; kt++) {
    const int cur = kt & 1;
    if (kt + 1 < nk) {
#pragma unroll
      for (int i = 0; i < 4; i++) { ra[i] = *(const uint4*)(ap[i] + (kt + 1) * 64); rb[i] = *(const uint4*)(bp[i] + (kt + 1) * 64); }
    }
    const char* Ac = As + cur * 16384; const char* Bc = Bs + cur * 16384;
#pragma unroll
    for (int ks = 0; ks < 2; ks++) {
      const int chs = ((ks * 4 + fq) ^ (fr & 7)) << 4;
      bf16x8 a[4], b[4];
#pragma unroll
      for (int mt = 0; mt < 4; mt++) a[mt] = *(const bf16x8*)(Ac + aoff0 + mt * 2048 + chs);
#pragma unroll
      for (int nt = 0; nt < 4; nt++) b[nt] = *(const bf16x8*)(Bc + boff0 + nt * 2048 + chs);
#pragma unroll
      for (int mt = 0; mt < 4; mt++)
#pragma unroll
        for (int nt = 0; nt < 4; nt++)
          acc[mt][nt] = SWAP ? __builtin_amdgcn_mfma_f32_16x16x32_bf16(b[nt], a[mt], acc[mt][nt], 0, 0, 0)
                             : __builtin_amdgcn_mfma_f32_16x16x32_bf16(a[mt], b[nt], acc[mt][nt], 0, 0, 0);
    }
    if (kt + 1 < nk) {
      char* An = As + (cur ^ 1) * 16384; char* Bn_ = Bs + (cur ^ 1) * 16384;
#pragma unroll
      for (int i = 0; i < 4; i++) { *(uint4*)(An + woff + i * 4096) = ra[i]; *(uint4*)(Bn_ + woff + i * 4096) = rb[i]; }
    }
    __syncthreads();
  }
}
DI void zero_acc(f32x4 (&acc)[4][4]) {
#pragma unroll
  for (int i = 0; i < 4; i++)
#pragma unroll
    for (int j = 0; j < 4; j++) acc[i][j] = (f32x4){0.f, 0.f, 0.f, 0.f};
}
template <bool SWAP, class F>
DI void epilogue(const f32x4 (&acc)[4][4], F f) {
  const int lane = threadIdx.x & 63, wave = threadIdx.x >> 6, wr = wave >> 1, wc = wave & 1, fr = lane & 15, fq = lane >> 4;
#pragma unroll
  for (int mt = 0; mt < 4; mt++)
#pragma unroll
    for (int nt = 0; nt < 4; nt++) {
      if (SWAP) f(wr * 64 + mt * 16 + fr, wc * 64 + nt * 16 + fq * 4, acc[mt][nt]);
      else f(wr * 64 + mt * 16 + fq * 4, wc * 64 + nt * 16 + fr, acc[mt][nt]);
    }
}

template <class CP>
DI void tcvt_tile(CP colptr, int ldsrc, bf16_t* dst, int K, int kt, int jt, float* tile) {
  const int tx = threadIdx.x & 63, ty = threadIdx.x >> 6;
  const float* sp = colptr(jt * 64 + tx);
  for (int i = ty; i < 64; i += 4) tile[i * 65 + tx] = sp ? sp[(size_t)(kt * 64 + i) * ldsrc] : 0.f;
  __syncthreads();
  for (int i = ty * 2 + (tx >> 5); i < 64; i += 8) {
    const int kk = (tx & 31) * 2;
    *(unsigned*)(dst + (size_t)(jt * 64 + i) * K + kt * 64 + kk) = pack2(tile[kk * 65 + i], tile[(kk + 1) * 65 + i]);
  }
  __syncthreads();
}
template <class CP>
DI void tcvt_all(CP colptr, int ldsrc, bf16_t* dst, int K, int N, float* tile, int bid, int nb) {
  const int nkt = K / 64, njt = N / 64;
  for (int t = bid; t < nkt * njt; t += nb) tcvt_tile(colptr, ldsrc, dst, K, t / njt, t % njt, tile);
}

DI int perm_half(int p, int d) { return (p & 1) ? (d / 2 + (p >> 1)) : (p >> 1); }
DI int inproj_col(int j) {
  if (j < 512) return (j & ~63) + perm_half(j & 63, 64);
  if (j < 1280) { const int grp = (j - 512) >> 7;
    if (grp == 2 || grp == 4) return (j & ~63) + perm_half(j & 63, 64);
    return j; }
  if (j < 1792) { const int q = j - 1280; return 1304 + (q & ~127) + perm_half(q & 127, 128); }
  if (j < 2304) { const int q = j - 1792; return 1816 + (q & ~127) + perm_half(q & 127, 128); }
  if (j < 3328) return 2328 + (j - 2304);
  if (j < 4352) return 3352 + (j - 3328);
  if (j < 6400) return 4376 + (j - 4352);
  const int q = j - 6400; return q < 24 ? 1280 + q : -1;
}

DI void phase0(const Params& p, char* smem) {
  const int bid = blockIdx.x, nb = gridDim.x, tid = opq(threadIdx.x);
  const size_t gtid = (size_t)bid * 256 + tid, gsz = (size_t)nb * 256;
  for (size_t i = gtid; i < (size_t)M * D / 4; i += gsz) {
    const float4 v = ((const float4*)p.x)[i];
    uint2 o; o.x = pack2(v.x, v.y); o.y = pack2(v.z, v.w);
    ((uint2*)p.xb)[i] = o;
  }
  float* tile = (float*)smem;
  { const float* w = p.w_in; tcvt_all([=](int j) -> const float* { const int c = inproj_col(j); return c >= 0 ? w + c : nullptr; }, 6424, p.WinT, 1024, NINP, tile, bid, nb); }
  { const float* w = p.w_up_attn; tcvt_all([=](int j) -> const float* { return w + j; }, 1024, p.WaT, 512, 1024, tile, bid, nb); }
  { const float* w = p.w_up_ret; tcvt_all([=](int j) -> const float* { return w + j; }, 1024, p.WrT, 1024, 1024, tile, bid, nb); }
  { const float* w = p.w_out; tcvt_all([=](int j) -> const float* { return w + j; }, 1024, p.WoT, 1024, 1024, tile, bid, nb); }
  { const float* w = p.cmp_k_w1; tcvt_all([=](int j) -> const float* { return w + j; }, 256, p.W1kT, 2048, 256, tile, bid, nb); }
  { const float* w = p.cmp_v_w1; tcvt_all([=](int j) -> const float* { return w + j; }, 256, p.W1vT, 2048, 256, tile, bid, nb); }
  for (size_t i = gtid; i < (size_t)T * 96; i += gsz) {
    const int t = (int)(i / 96), r = (int)(i % 96);
    float invf; float* dst;
    if (r < 32) { invf = (float)pow(10000.0, -2.0 * r / 64.0); dst = p.ropeN + ((size_t)t * 32 + r) * 2; }
    else { const int q = r - 32; invf = (float)pow(10000.0, -2.0 * q / 128.0); dst = p.ropeR + ((size_t)t * 64 + q) * 2; }
    const float ang = (float)t * invf;
    dst[0] = (float)cos((double)ang); dst[1] = (float)sin((double)ang);
  }
  for (size_t i = gtid; i < 512; i += gsz) {
    const int kv = (int)(i >> 8), j = (int)(i & 255);
    const float* pos = kv ? p.cmp_pos_v : p.cmp_pos_k; const float* w1 = kv ? p.cmp_v_w1 : p.cmp_k_w1; const float* b1 = kv ? p.cmp_v_b1 : p.cmp_k_b1;
    float s = b1[j];
    for (int q = 0; q < 2048; q++) s += pos[q] * w1[(size_t)q * 256 + j];
    p.posb[i] = s;
  }
  if (gtid < 32) p.cnt[gtid] = 0;
}

DI void inproj_tile(const Params& p, int mt_, int nt_, char* smem) {
  const int m0 = mt_ * 128;
  const bf16_t* A = p.xb + (size_t)m0 * D; const bf16_t* Bt = p.WinT + (size_t)nt_ * 128 * D;
  f32x4 acc[4][4]; zero_acc(acc);
  auto ar = [=](int r) { return A + (size_t)r * D; };
  auto br = [=](int r) { return Bt + (size_t)r * D; };
  const bool transposed = (nt_ == 7 || nt_ == 9 || (nt_ >= 18 && nt_ < 26));
  if (transposed) {
    gemm128<false>(acc, ar, br, D, smem);
    epilogue<false>(acc, [&](int r, int c, f32x4 v) {
      const int m = m0 + r, b = m >> 12, t = m & 4095;
      uint2 o; o.x = pack2(v[0], v[1]); o.y = pack2(v[2], v[3]);
      if (nt_ < 18) { bf16_t* dst = (nt_ == 7) ? p.SVt : p.WVt; const int g = c >> 6, d = c & 63;
        *(uint2*)(dst + ((size_t)((b * 2 + g) * 64 + d)) * T + t) = o; }
      else { const int h = (nt_ - 18) >> 1, e = ((nt_ - 18) & 1) * 128 + c;
        *(uint2*)(p.RVt + ((size_t)((b * 4 + h) * 256 + e)) * T + t) = o; }
    });
    return;
  }
  gemm128<true>(acc, ar, br, D, smem);
  epilogue<true>(acc, [&](int r, int c, f32x4 v) {
    const int m = m0 + r, b = m >> 12, t = m & 4095;
    if (nt_ < 4 || nt_ == 6 || nt_ == 8) {
      const int pp = c & 63;
      const float4 cs = *(const float4*)(p.ropeN + ((size_t)t * 32 + (pp >> 1)) * 2);
      const float sc = nt_ < 4 ? 0.125f : 1.f;
      const float a0 = (v[0] * cs.x - v[1] * cs.y) * sc, a1 = (v[0] * cs.y + v[1] * cs.x) * sc;
      const float a2 = (v[2] * cs.z - v[3] * cs.w) * sc, a3 = (v[2] * cs.w + v[3] * cs.z) * sc;
      uint2 o; o.x = pack2(a0, a1); o.y = pack2(a2, a3);
      if (nt_ < 4) { const int head = nt_ * 2 + (c >> 6); *(uint2*)(p.Qn + ((size_t)(b * 8 + head) * T + t) * 64 + pp) = o; }
      else { bf16_t* dst = nt_ == 6 ? p.SK : p.WK; const int g = c >> 6; *(uint2*)(dst + ((size_t)(b * 2 + g) * T + t) * 64 + pp) = o; }
    } else if (nt_ == 4 || nt_ == 5) {
      bf16_t* dst = nt_ == 4 ? p.CK : p.CV; const int g = c >> 6, pp = c & 63;
      uint2 o; o.x = pack2(v[0], v[1]); o.y = pack2(v[2], v[3]);
      *(uint2*)(dst + ((size_t)(b * 2 + g) * T + t) * 64 + pp) = o;
    } else if (nt_ >= 10 && nt_ < 18) {
      const bool isk = nt_ >= 14; const int h = (nt_ - 10) & 3;
      const float4 cs = *(const float4*)(p.ropeR + ((size_t)t * 64 + (c >> 1)) * 2);
      const float sc = isk ? 0.08838834764831845f : 1.f;
      const float a0 = (v[0] * cs.x - v[1] * cs.y) * sc, a1 = (v[0] * cs.y + v[1] * cs.x) * sc;
      const float a2 = (v[2] * cs.z - v[3] * cs.w) * sc, a3 = (v[2] * cs.w + v[3] * cs.z) * sc;
      uint2 o; o.x = pack2(a0, a1); o.y = pack2(a2, a3);
      *(uint2*)((isk ? p.RK : p.RQ) + ((size_t)(b * 4 + h) * T + t) * 128 + c) = o;
      if (isk) {
        const float lg = log2f(1.f - exp2f(-5.f - (float)h));
        const float z = exp2f((float)(127 - (t & 127)) * lg);
        bf16_t* dst = p.RKzT + ((size_t)((b * 4 + h) * 128 + c)) * T + t;
        dst[0] = f2bf(a0 * z); dst[T] = f2bf(a1 * z); dst[2 * T] = f2bf(a2 * z); dst[3 * T] = f2bf(a3 * z);
      }
    } else if (nt_ >= 26 && nt_ < 34) {
      uint2 o; o.x = pack2(v[0], v[1]); o.y = pack2(v[2], v[3]);
      *(uint2*)(p.RG + (size_t)m * 1024 + (nt_ - 26) * 128 + c) = o;
    } else if (nt_ >= 34 && nt_ < 50) {
      uint2 o; o.x = pack2(v[0], v[1]); o.y = pack2(v[2], v[3]);
      *(uint2*)(p.MG + (size_t)m * 2048 + (nt_ - 34) * 128 + c) = o;
    } else if (nt_ == 50) {
      if (c < 24) { float4 o; o.x = sigmoidf_(v[0]); o.y = sigmoidf_(v[1]); o.z = sigmoidf_(v[2]); o.w = sigmoidf_(v[3]);
        *(float4*)(p.NG + (size_t)m * 24 + c) = o; }
    }
  });
}
DI void phase1(const Params& p, char* smem) {
  const int xcd = blockIdx.x & 7, lb = blockIdx.x >> 3, nlb = gridDim.x >> 3;
  for (int li = lb; li < 16 * 51; li += nlb) {
    const int mi = li & 7, rest = li >> 3, nt_ = rest % 51, half = rest / 51;
    inproj_tile(p, xcd * 16 + half * 8 + mi, nt_, smem);
  }
}

struct WaveAttn { float m[4], l[4], o[4]; };
DI void wa_init(WaveAttn& s) { for (int h = 0; h < 4; h++) { s.m[h] = -1e30f; s.l[h] = 0.f; s.o[h] = 0.f; } }
DI void wa_block(WaveAttn& s, const float* qs, float* ps, const bf16_t* Kb, const bf16_t* Vt, int ldv, int key0, int lo, int hi, int lane) {
  const int key = key0 + lane; const bool valid = key >= lo && key <= hi;
  float sc[4] = {0.f, 0.f, 0.f, 0.f};
  const uint4* kr = (const uint4*)(Kb + (size_t)key * 64);
#pragma unroll
  for (int c8 = 0; c8 < 8; c8++) {
    const uint4 kv = kr[c8];
    float kf[8] = {lo2f(kv.x), hi2f(kv.x), lo2f(kv.y), hi2f(kv.y), lo2f(kv.z), hi2f(kv.z), lo2f(kv.w), hi2f(kv.w)};
#pragma unroll
    for (int h = 0; h < 4; h++) {
      const float4 q0 = *(const float4*)(qs + h * 64 + c8 * 8), q1 = *(const float4*)(qs + h * 64 + c8 * 8 + 4);
      sc[h] += q0.x * kf[0] + q0.y * kf[1] + q0.z * kf[2] + q0.w * kf[3] + q1.x * kf[4] + q1.y * kf[5] + q1.z * kf[6] + q1.w * kf[7];
    }
  }
  WSYNC();
#pragma unroll
  for (int h = 0; h < 4; h++) {
    const float sv = valid ? sc[h] : -1e30f;
    const float mn = fmaxf(s.m[h], wmax(sv));
    const float alpha = __expf(s.m[h] - mn);
    const float pv = valid ? __expf(sv - mn) : 0.f;
    s.l[h] = s.l[h] * alpha + wsum(pv); s.o[h] *= alpha; s.m[h] = mn;
    ps[h * 64 + lane] = pv;
  }
  WSYNC();
  const uint4* vr = (const uint4*)(Vt + (size_t)lane * ldv + key0);
#pragma unroll
  for (int c8 = 0; c8 < 8; c8++) {
    const uint4 vv = vr[c8];
    float vf[8] = {lo2f(vv.x), hi2f(vv.x), lo2f(vv.y), hi2f(vv.y), lo2f(vv.z), hi2f(vv.z), lo2f(vv.w), hi2f(vv.w)};
#pragma unroll
    for (int h = 0; h < 4; h++) {
      const float4 p0 = *(const float4*)(ps + h * 64 + c8 * 8), p1 = *(const float4*)(ps + h * 64 + c8 * 8 + 4);
      s.o[h] += p0.x * vf[0] + p0.y * vf[1] + p0.z * vf[2] + p0.w * vf[3] + p1.x * vf[4] + p1.y * vf[5] + p1.z * vf[6] + p1.w * vf[7];
    }
  }
  WSYNC();
}
DI void load_q(const Params& p, float* qs, int b, int g, int t, int lane) {
#pragma unroll
  for (int h = 0; h < 4; h++) qs[h * 64 + lane] = bf2f(p.Qn[((size_t)(b * 8 + g * 4 + h) * T + t) * 64 + lane]);
  WSYNC();
}
DI void naive_sparse(const Params& p, int item, int branch, char* wsm, int lane) {
  const int bg = item >> 12, t = item & 4095, b = bg >> 1, g = bg & 1;
  float* qs = (float*)wsm; float* ps = qs + 256;
  load_q(p, qs, b, g, t, lane);
  unsigned long long mask; int lo;
  const int blk = t >> 6;
  if (branch == 1) { mask = p.selmask[item]; mask &= (blk == 63) ? ~0ull : ((1ull << (blk + 1)) - 1ull); lo = 0; }
  else { lo = t - 511; if (lo < 0) lo = 0; const int b0 = lo >> 6; mask = ((blk == 63) ? ~0ull : ((1ull << (blk + 1)) - 1ull)) & ~((1ull << b0) - 1ull); }
  const bf16_t* Kb = (branch == 1 ? p.SK : p.WK) + (size_t)bg * T * 64;
  const bf16_t* Vt = (branch == 1 ? p.SVt : p.WVt) + (size_t)bg * 64 * T;
  WaveAttn s; wa_init(s);
  while (mask) {
    const int j = __ffsll((long long)mask) - 1; mask &= mask - 1;
    wa_block(s, qs, ps, Kb, Vt, T, j * 64, lo, t, lane);
  }
  const int m = b * T + t;
#pragma unroll
  for (int h = 0; h < 4; h++) {
    const int hh = g * 4 + h;
    const float gate = p.NG[(size_t)m * 24 + hh * 3 + branch];
    const float val = s.l[h] > 0.f ? gate * s.o[h] / s.l[h] : 0.f;
    bf16_t* dst = p.oattn + (size_t)m * 512 + hh * 64 + lane;
    if (branch == 2) *dst = f2bf(val); else *dst = f2bf(bf2f(*dst) + val);
  }
}
DI void naive_cmp(const Params& p, int item, char* wsm, int lane) {
  const int bg = item >> 12, t = item & 4095, b = bg >> 1, g = bg & 1;
  float* qs = (float*)wsm; float* pn = qs + 256; float* scr = pn + 1024;
  load_q(p, qs, b, g, t, lane);
  const int nvalid = t >= 31 ? ((t - 31) >> 4) + 1 : 0;
  const bf16_t* Kb = p.kcmp + (size_t)bg * 256 * 64;
#pragma unroll 1
  for (int jj = 0; jj < 4; jj++) {
    const int n = lane + 64 * jj;
    const uint4* kr = (const uint4*)(Kb + (size_t)n * 64);
    float a[4] = {0.f, 0.f, 0.f, 0.f};
#pragma unroll 2
    for (int c8 = 0; c8 < 8; c8++) {
      const uint4 kv = kr[c8];
      float kf[8] = {lo2f(kv.x), hi2f(kv.x), lo2f(kv.y), hi2f(kv.y), lo2f(kv.z), hi2f(kv.z), lo2f(kv.w), hi2f(kv.w)};
#pragma unroll
      for (int h = 0; h < 4; h++) {
        const float4 q0 = *(const float4*)(qs + h * 64 + c8 * 8), q1 = *(const float4*)(qs + h * 64 + c8 * 8 + 4);
        a[h] += q0.x * kf[0] + q0.y * kf[1] + q0.z * kf[2] + q0.w * kf[3] + q1.x * kf[4] + q1.y * kf[5] + q1.z * kf[6] + q1.w * kf[7];
      }
    }
#pragma unroll
    for (int h = 0; h < 4; h++) pn[h * 256 + n] = (n < nvalid) ? a[h] : -1e30f;
  }
  WSYNC();
#pragma unroll 1
  for (int h = 0; h < 4; h++) {
    float sv[4];
#pragma unroll
    for (int jj = 0; jj < 4; jj++) sv[jj] = pn[h * 256 + lane + 64 * jj];
    float mx = fmaxf(fmaxf(sv[0], sv[1]), fmaxf(sv[2], sv[3])); mx = wmax(mx);
    float e[4], sum = 0.f;
#pragma unroll
    for (int jj = 0; jj < 4; jj++) { e[jj] = (lane + 64 * jj < nvalid) ? __expf(sv[jj] - mx) : 0.f; sum += e[jj]; }
    sum = wsum(sum);
    const float inv = sum > 0.f ? 1.f / sum : 0.f;
#pragma unroll
    for (int jj = 0; jj < 4; jj++) pn[h * 256 + lane + 64 * jj] = e[jj] * inv;
  }
  WSYNC();
  float imp = 0.f;
  {
    const int s4 = lane * 4;
#pragma unroll
    for (int h = 0; h < 4; h++) {
      const float* ph = pn + h * 256;
      float v = 2.f * (ph[s4] + ph[s4 + 1] + ph[s4 + 2]);
      if (s4 > 0) v += ph[s4 - 1];
      if (s4 + 3 < 255) v += ph[s4 + 3];
      imp += v;
    }
  }
  const int blk = t >> 6;
  const float score = (lane == 0 || lane == blk || lane == blk - 1) ? 1e9f : (lane <= blk ? imp : -1e9f);
  scr[lane] = score;
  WSYNC();
  int rank = 0;
  for (int i = 0; i < 64; i++) { const float si = scr[i]; rank += (si > score || (si == score && i < lane)) ? 1 : 0; }
  const unsigned long long sel = __ballot(rank < 16);
  if (lane == 0) p.selmask[item] = sel;
  float o[4] = {0.f, 0.f, 0.f, 0.f};
  const bf16_t* Vt = p.vcmpT + (size_t)(bg * 64 + lane) * 256;
  const int nch = (nvalid + 7) >> 3;
  for (int c8 = 0; c8 < nch; c8++) {
    const uint4 vv = ((const uint4*)Vt)[c8];
    float vf[8] = {lo2f(vv.x), hi2f(vv.x), lo2f(vv.y), hi2f(vv.y), lo2f(vv.z), hi2f(vv.z), lo2f(vv.w), hi2f(vv.w)};
#pragma unroll
    for (int h = 0; h < 4; h++) {
      const float4 p0 = *(const float4*)(pn + h * 256 + c8 * 8), p1 = *(const float4*)(pn + h * 256 + c8 * 8 + 4);
      o[h] += p0.x * vf[0] + p0.y * vf[1] + p0.z * vf[2] + p0.w * vf[3] + p1.x * vf[4] + p1.y * vf[5] + p1.z * vf[6] + p1.w * vf[7];
    }
  }
  const int m = b * T + t;
#pragma unroll
  for (int h = 0; h < 4; h++) {
    const int hh = g * 4 + h;
    const float gate = p.NG[(size_t)m * 24 + hh * 3 + 0];
    p.oattn[(size_t)m * 512 + hh * 64 + lane] = f2bf(gate * o[h]);
  }
  WSYNC();
}


DI void attn_unit(const Params& p, int unit, char* smem) {
  const int tid = opq(threadIdx.x), lane = tid & 63, w = tid >> 6, r = lane & 31, h2 = lane >> 5;
  const int bg = unit >> 6, jq = unit & 63, b = bg >> 1, g = bg & 1, hh = g * 4 + w, t0 = jq * 64;
  bf16x8 qf[2][4];
#pragma unroll
  for (int qt = 0; qt < 2; qt++)
#pragma unroll
    for (int ks = 0; ks < 4; ks++)
      qf[qt][ks] = *(const bf16x8*)(p.Qn + ((size_t)(b * 8 + hh) * T + t0 + qt * 32 + r) * 64 + ks * 16 + h2 * 8);
  unsigned long long* sell = (unsigned long long*)(smem + 32768) + tid * 2;
#pragma unroll
  for (int qt = 0; qt < 2; qt++) sell[qt] = p.selmask[(size_t)bg * T + t0 + qt * 32 + r];
  const int wlo = jq > 8 ? jq - 8 : 0, nwin = jq - wlo + 1, nsteps = nwin + jq + 1;
  char* Kl = smem; char* Vl = smem + 16384;
  const int grow = lane >> 3, gch = (lane & 7) ^ grow;
  auto gload = [&](int i, int buf) {
    const int br = i < nwin ? 2 : 1, j = i < nwin ? wlo + i : i - nwin;
    const bf16_t* Kp = (br == 1 ? p.SK : p.WK) + ((size_t)bg * T + j * 64) * 64;
    const bf16_t* Vp = (br == 1 ? p.SVt : p.WVt) + (size_t)bg * 64 * T + j * 64;
#pragma unroll
    for (int pc = 0; pc < 2; pc++) {
      const int row = (w * 2 + pc) * 8 + grow;
      __builtin_amdgcn_global_load_lds((const unsigned*)(Kp + row * 64 + gch * 8), (LAS unsigned*)(Kl + buf * 8192 + (w * 2 + pc) * 1024), 16, 0, 0);
      __builtin_amdgcn_global_load_lds((const unsigned*)(Vp + (size_t)row * T + gch * 8), (LAS unsigned*)(Vl + buf * 8192 + (w * 2 + pc) * 1024), 16, 0, 0);
    }
  };
  float mrow[2], lrow[2]; f32x16 O[2][2];
  auto reset = [&]() {
#pragma unroll
    for (int qt = 0; qt < 2; qt++) { mrow[qt] = -1e30f; lrow[qt] = 0.f;
#pragma unroll
      for (int dt = 0; dt < 2; dt++)
#pragma unroll
        for (int i = 0; i < 16; i++) O[dt][qt][i] = 0.f; }
  };
  auto flush = [&](int br) {
#pragma unroll
    for (int qt = 0; qt < 2; qt++) {
      const int m = b * T + t0 + qt * 32 + r;
      const float gate = p.NG[(size_t)m * 24 + hh * 3 + br];
      const float sc = lrow[qt] > 0.f ? gate / lrow[qt] : 0.f;
#pragma unroll
      for (int dt = 0; dt < 2; dt++)
#pragma unroll
        for (int q4 = 0; q4 < 4; q4++) {
          bf16_t* dst = p.oattn + (size_t)m * 512 + hh * 64 + dt * 32 + q4 * 8 + h2 * 4;
          const uint2 old = *(const uint2*)dst;
          uint2 o; o.x = pack2(lo2f(old.x) + sc * O[dt][qt][q4 * 4], hi2f(old.x) + sc * O[dt][qt][q4 * 4 + 1]);
          o.y = pack2(lo2f(old.y) + sc * O[dt][qt][q4 * 4 + 2], hi2f(old.y) + sc * O[dt][qt][q4 * 4 + 3]);
          *(uint2*)dst = o;
        }
    }
  };
  reset();
  gload(0, 0);
  __syncthreads();
#pragma unroll 1
  for (int i = 0; i < nsteps; i++) {
    const int br = i < nwin ? 2 : 1, j = i < nwin ? wlo + i : i - nwin;
    if (i == nwin) { flush(2); reset(); }
    if (i + 1 < nsteps) gload(i + 1, (i + 1) & 1);
    const char* Kc = Kl + (i & 1) * 8192; const char* Vc = Vl + (i & 1) * 8192;
#pragma unroll
    for (int qt = 0; qt < 2; qt++) {
      f32x16 S[2];
#pragma unroll
      for (int kt2 = 0; kt2 < 2; kt2++) {
#pragma unroll
        for (int ii = 0; ii < 16; ii++) S[kt2][ii] = 0.f;
#pragma unroll
        for (int ks = 0; ks < 4; ks++) {
          const bf16x8 a = *(const bf16x8*)(Kc + (kt2 * 32 + r) * 128 + (((ks * 2 + h2) ^ (r & 7)) << 4));
          S[kt2] = MFMA32(a, qf[qt][ks], S[kt2]);
        }
      }
      __builtin_amdgcn_sched_barrier(0);
      const int t = t0 + qt * 32 + r;
      const bool selb = (br == 2) || ((sell[qt] >> j) & 1ull);
      const int khi = t, klo = (br == 2) ? t - 511 : 0;
      float mx = -1e30f;
#pragma unroll
      for (int kt2 = 0; kt2 < 2; kt2++)
#pragma unroll
        for (int ii = 0; ii < 16; ii++) {
          const int key = j * 64 + kt2 * 32 + (ii & 3) + 8 * (ii >> 2) + 4 * h2;
          const bool valid = selb && key <= khi && key >= klo;
          const float sv = valid ? S[kt2][ii] : -1e30f;
          S[kt2][ii] = sv; mx = fmaxf(mx, sv);
        }
      mx = fmaxf(mx, __shfl_xor(mx, 32));
      const float mn = fmaxf(mrow[qt], mx);
      const float alpha = __expf(mrow[qt] - mn);
      float rs = 0.f;
#pragma unroll
      for (int kt2 = 0; kt2 < 2; kt2++)
#pragma unroll
        for (int ii = 0; ii < 16; ii++) {
          const float sv = S[kt2][ii];
          const float pv = sv > -1e29f ? __expf(sv - mn) : 0.f;
          S[kt2][ii] = pv; rs += pv;
        }
      rs += __shfl_xor(rs, 32);
      lrow[qt] = lrow[qt] * alpha + rs; mrow[qt] = mn;
#pragma unroll
      for (int dt = 0; dt < 2; dt++)
#pragma unroll
        for (int ii = 0; ii < 16; ii++) O[dt][qt][ii] *= alpha;
      __builtin_amdgcn_sched_barrier(0);
#pragma unroll
      for (int kt2 = 0; kt2 < 2; kt2++)
#pragma unroll
        for (int s2 = 0; s2 < 2; s2++) {
          uint4 u;
          u.x = pack2(S[kt2][8 * s2 + 0], S[kt2][8 * s2 + 1]); u.y = pack2(S[kt2][8 * s2 + 2], S[kt2][8 * s2 + 3]);
          u.z = pack2(S[kt2][8 * s2 + 4], S[kt2][8 * s2 + 5]); u.w = pack2(S[kt2][8 * s2 + 6], S[kt2][8 * s2 + 7]);
          const bf16x8 pfr = __builtin_bit_cast(bf16x8, u);
#pragma unroll
          for (int dt = 0; dt < 2; dt++) {
            const int d = dt * 32 + r;
            const int ch = kt2 * 4 + s2 * 2;
            const uint2 v0 = *(const uint2*)(Vc + d * 128 + ((ch ^ (d & 7)) << 4) + 8 * h2);
            const uint2 v1 = *(const uint2*)(Vc + d * 128 + (((ch + 1) ^ (d & 7)) << 4) + 8 * h2);
            uint4 uv; uv.x = v0.x; uv.y = v0.y; uv.z = v1.x; uv.w = v1.y;
            O[dt][qt] = MFMA32(__builtin_bit_cast(bf16x8, uv), pfr, O[dt][qt]);
          }
        }
      __builtin_amdgcn_sched_barrier(0);
    }
    __syncthreads();
  }
  flush(1);
}

DI float gelu_tanh(float x) { const float u = 0.7978845608028654f * (x + 0.044715f * x * x * x); return 0.5f * x * (1.f + tanhf(u)); }
DI void compress1_tile(const Params& p, int tile, char* smem) {
  const int ntl = tile & 1, mtile = tile >> 1, half = mtile & 1, bg = (mtile >> 1) & 7, kv = mtile >> 4;
  const bf16_t* src = (kv ? p.CV : p.CK) + (size_t)bg * T * 64 + (size_t)half * 128 * 1024;
  const bf16_t* Bt = (kv ? p.W1vT : p.W1kT) + (size_t)ntl * 128 * 2048;
  f32x4 acc[4][4]; zero_acc(acc);
  gemm128<true>(acc, [=](int r) { return src + (size_t)r * 1024; }, [=](int r) { return Bt + (size_t)r * 2048; }, 2048, smem);
  epilogue<true>(acc, [&](int r, int c, f32x4 v) {
    const int n = half * 128 + r;
    if (n < 255) {
      const int j = ntl * 128 + c;
      const float4 pb = *(const float4*)(p.posb + kv * 256 + j);
      uint2 o; o.x = pack2(gelu_tanh(v[0] + pb.x), gelu_tanh(v[1] + pb.y)); o.y = pack2(gelu_tanh(v[2] + pb.z), gelu_tanh(v[3] + pb.w));
      *(uint2*)(p.H1 + ((size_t)((kv * 8 + bg) * 256 + n)) * 256 + j) = o;
    }
  });
}
DI void compress2(const Params& p) {
  const size_t gtid = (size_t)blockIdx.x * 256 + opq(threadIdx.x), gsz = (size_t)gridDim.x * 256;
  for (size_t i = gtid; i < (size_t)2 * 8 * 256 * 32; i += gsz) {
    const int ii = (int)(i & 31), n = (int)((i >> 5) & 255), bg = (int)((i >> 13) & 7), kv = (int)(i >> 16);
    float a0 = 0.f, a1 = 0.f;
    if (n < 255) {
      const bf16_t* h = p.H1 + ((size_t)((kv * 8 + bg) * 256 + n)) * 256;
      const float* w2 = kv ? p.cmp_v_w2 : p.cmp_k_w2; const float* b2 = kv ? p.cmp_v_b2 : p.cmp_k_b2;
      a0 = b2[ii]; a1 = b2[ii + 32];
      for (int j = 0; j < 256; j++) { const float hv = bf2f(h[j]); a0 += hv * w2[j * 64 + ii]; a1 += hv * w2[j * 64 + ii + 32]; }
    }
    if (kv == 0) {
      float r0 = 0.f, r1 = 0.f;
      if (n < 255) { const int pos = 16 * n + 31; const float c = p.ropeN[((size_t)pos * 32 + ii) * 2], s = p.ropeN[((size_t)pos * 32 + ii) * 2 + 1];
        r0 = a0 * c - a1 * s; r1 = a0 * s + a1 * c; }
      *(unsigned*)(p.kcmp + ((size_t)(bg * 256 + n)) * 64 + 2 * ii) = pack2(r0, r1);
    } else {
      p.vcmpT[((size_t)(bg * 64 + ii)) * 256 + n] = f2bf(a0);
      p.vcmpT[((size_t)(bg * 64 + ii + 32)) * 256 + n] = f2bf(a1);
    }
  }
}

DI void ret_scan(const Params& p) {
  const size_t gtid = (size_t)blockIdx.x * 256 + opq(threadIdx.x), gsz = (size_t)gridDim.x * 256;
  for (size_t i = gtid; i < (size_t)16 * 256 * 128; i += gsz) {
    const int dk = (int)(i & 127), e = (int)((i >> 7) & 255), bh = (int)(i >> 15), h = bh & 3;
    const float cd = exp2f(128.f * log2f(1.f - exp2f(-5.f - (float)h)));
    const bf16_t* kz = p.RKzT + ((size_t)(bh * 128 + dk)) * T;
    const bf16_t* vt = p.RVt + ((size_t)(bh * 256 + e)) * T;
    float R = 0.f;
    for (int n = 0; n < 32; n++) {
      p.Rt[(((size_t)bh * 32 + n) * 256 + e) * 128 + dk] = f2bf(R);
      if (n == 31) break;
      float s = 0.f;
      const uint4* k4 = (const uint4*)(kz + n * 128); const uint4* v4 = (const uint4*)(vt + n * 128);
#pragma unroll 4
      for (int c = 0; c < 16; c++) {
        const uint4 a = k4[c], bq = v4[c];
        s += lo2f(a.x) * lo2f(bq.x) + hi2f(a.x) * hi2f(bq.x) + lo2f(a.y) * lo2f(bq.y) + hi2f(a.y) * hi2f(bq.y)
           + lo2f(a.z) * lo2f(bq.z) + hi2f(a.z) * hi2f(bq.z) + lo2f(a.w) * lo2f(bq.w) + hi2f(a.w) * hi2f(bq.w);
      }
      R = R * cd + s;
    }
  }
}
DI void ret_out(const Params& p, int item, char* wsm, int lane) {
  const int bh = item >> 12, t = item & 4095, b = bh >> 2, h = bh & 3, n = t >> 7, c = t & 127;
  float* qs = (float*)wsm; float* ss = qs + 128;
  const bf16_t* qrow = p.RQ + ((size_t)bh * T + t) * 128;
  qs[lane] = bf2f(qrow[lane]); qs[lane + 64] = bf2f(qrow[lane + 64]);
  WSYNC();
  const float lg = log2f(1.f - exp2f(-5.f - (float)h));
#pragma unroll 1
  for (int jj = 0; jj < 2; jj++) {
    const int mm = lane + 64 * jj;
    const uint4* kr = (const uint4*)(p.RK + ((size_t)bh * T + n * 128 + mm) * 128);
    float a = 0.f;
#pragma unroll 4
    for (int c8 = 0; c8 < 16; c8++) {
      const uint4 kv = kr[c8];
      const float4 q0 = *(const float4*)(qs + c8 * 8), q1 = *(const float4*)(qs + c8 * 8 + 4);
      a += q0.x * lo2f(kv.x) + q0.y * hi2f(kv.x) + q0.z * lo2f(kv.y) + q0.w * hi2f(kv.y) + q1.x * lo2f(kv.z) + q1.y * hi2f(kv.z) + q1.z * lo2f(kv.w) + q1.w * hi2f(kv.w);
    }
    ss[mm] = (mm <= c) ? a * exp2f((float)(c - mm) * lg) : 0.f;
  }
  WSYNC();
  const float xi = exp2f((float)(c + 1) * lg);
  float o[4];
#pragma unroll
  for (int jj = 0; jj < 4; jj++) {
    asm volatile("" ::: "memory");
    const int e = lane + 64 * jj;
    const uint4* vr = (const uint4*)(p.RVt + ((size_t)(bh * 256 + e)) * T + n * 128);
    const uint4* rr = (const uint4*)(p.Rt + (((size_t)bh * 32 + n) * 256 + e) * 128);
    float a = 0.f, cr = 0.f;
    const int nch = (c >> 3) + 1;
#pragma unroll 2
    for (int c8 = 0; c8 < nch; c8++) {
      const uint4 vv = vr[c8];
      const float4 s0 = *(const float4*)(ss + c8 * 8), s1 = *(const float4*)(ss + c8 * 8 + 4);
      a += s0.x * lo2f(vv.x) + s0.y * hi2f(vv.x) + s0.z * lo2f(vv.y) + s0.w * hi2f(vv.y) + s1.x * lo2f(vv.z) + s1.y * hi2f(vv.z) + s1.z * lo2f(vv.w) + s1.w * hi2f(vv.w);
    }
#pragma unroll 4
    for (int c8 = 0; c8 < 16; c8++) {
      const uint4 rv = rr[c8];
      const float4 q0 = *(const float4*)(qs + c8 * 8), q1 = *(const float4*)(qs + c8 * 8 + 4);
      cr += q0.x * lo2f(rv.x) + q0.y * hi2f(rv.x) + q0.z * lo2f(rv.y) + q0.w * hi2f(rv.y) + q1.x * lo2f(rv.z) + q1.y * hi2f(rv.z) + q1.z * lo2f(rv.w) + q1.w * hi2f(rv.w);
    }
    o[jj] = a + xi * cr;
  }
  float mu = wsum(o[0] + o[1] + o[2] + o[3]) * (1.f / 256.f);
  float var = 0.f;
#pragma unroll
  for (int jj = 0; jj < 4; jj++) { const float d = o[jj] - mu; var += d * d; }
  var = wsum(var) * (1.f / 256.f);
  const float rs = rsqrtf(var + 1e-5f);
  const int m = b * T + t;
#pragma unroll
  for (int jj = 0; jj < 4; jj++) {
    const int col = h * 256 + lane + 64 * jj;
    const float y = (o[jj] - mu) * rs * p.gn_g[col] + p.gn_b[col];
    const float gt = bf2f(p.RG[(size_t)m * 1024 + col]);
    p.oret[(size_t)m * 1024 + col] = f2bf(y * gt * sigmoidf_(gt));
  }
  WSYNC();
}


DI void ret_scan_unit(const Params& p, int unit) {
  const int tid = opq(threadIdx.x), lane = tid & 63, w = tid >> 6, r = lane & 31, h2 = lane >> 5;
  const int bh = unit >> 3, dvs = unit & 7, h = bh & 3;
  const float cd = exp2f(128.f * log2f(1.f - exp2f(-5.f - (float)h)));
  const bf16_t* kz = p.RKzT + ((size_t)(bh * 128 + w * 32 + r)) * T + h2 * 8;
  const bf16_t* vt = p.RVt + ((size_t)(bh * 256 + dvs * 32 + r)) * T + h2 * 8;
  bf16_t* rt = p.Rt + (((size_t)bh * 32) * 256 + dvs * 32 + r) * 128 + w * 32 + 4 * h2;
  f32x16 R;
#pragma unroll
  for (int i = 0; i < 16; i++) R[i] = 0.f;
  bf16x8 a0[8], b0[8], a1[8], b1[8];
  auto store = [&](int n) {
#pragma unroll
    for (int q4 = 0; q4 < 4; q4++) {
      uint2 o; o.x = pack2(R[q4 * 4], R[q4 * 4 + 1]); o.y = pack2(R[q4 * 4 + 2], R[q4 * 4 + 3]);
      *(uint2*)(rt + (size_t)n * 256 * 128 + q4 * 8) = o;
    }
  };
#define RS_LOAD(A, B, n) _Pragma("unroll") for (int ks = 0; ks < 8; ks++) { A[ks] = *(const bf16x8*)(kz + (n) * 128 + ks * 16); B[ks] = *(const bf16x8*)(vt + (n) * 128 + ks * 16); }
#define RS_COMP(A, B) { _Pragma("unroll") for (int i = 0; i < 16; i++) R[i] *= cd; _Pragma("unroll") for (int ks = 0; ks < 8; ks++) R = MFMA32(A[ks], B[ks], R); }
  store(0);
  RS_LOAD(a0, b0, 0);
#pragma unroll 1
  for (int n = 0; n < 30; n += 2) {
    RS_LOAD(a1, b1, n + 1); RS_COMP(a0, b0); store(n + 1);
    RS_LOAD(a0, b0, n + 2); RS_COMP(a1, b1); store(n + 2);
  }
  RS_COMP(a0, b0); store(31);
#undef RS_LOAD
#undef RS_COMP
}

DI void ret_out_unit(const Params& p, int unit, char* smem) {
  const int tid = opq(threadIdx.x), lane = tid & 63, w = tid >> 6, r = lane & 31, h2 = lane >> 5, tq = w >> 1, dh = w & 1;
  const int th = unit & 1, n = (unit >> 1) & 31, bh = unit >> 6, b = bh >> 2, h = bh & 3;
  const int qt = th * 2 + tq, c = qt * 32 + r;
  const float lg = log2f(1.f - exp2f(-5.f - (float)h));
  const bf16_t* qp = p.RQ + ((size_t)bh * T + n * 128 + c) * 128 + h2 * 8;
  f32x16 O[4];
  {
    const bf16_t* rp = p.Rt + (((size_t)bh * 32 + n) * 256 + dh * 128 + r) * 128 + h2 * 8;
#pragma unroll
    for (int dvt = 0; dvt < 4; dvt++)
#pragma unroll
      for (int i = 0; i < 16; i++) O[dvt][i] = 0.f;
#pragma unroll
    for (int ks = 0; ks < 8; ks++) {
      const bf16x8 qk = *(const bf16x8*)(qp + ks * 16);
#pragma unroll
      for (int dvt = 0; dvt < 4; dvt++) {
        const bf16x8 rf = *(const bf16x8*)(rp + (size_t)dvt * 32 * 128 + ks * 16);
        O[dvt] = MFMA32(rf, qk, O[dvt]);
      }
    }
    const float xi = exp2f((float)(c + 1) * lg);
#pragma unroll
    for (int dvt = 0; dvt < 4; dvt++)
#pragma unroll
      for (int i = 0; i < 16; i++) O[dvt][i] *= xi;
  }
#pragma unroll 1
  for (int kt = 0; kt <= qt; kt++) {
    f32x16 S;
#pragma unroll
    for (int i = 0; i < 16; i++) S[i] = 0.f;
    const bf16_t* kp = p.RK + ((size_t)bh * T + n * 128 + kt * 32 + r) * 128 + h2 * 8;
#pragma unroll
    for (int ks = 0; ks < 8; ks++) { const bf16x8 kf = *(const bf16x8*)(kp + ks * 16); const bf16x8 qk = *(const bf16x8*)(qp + ks * 16); S = MFMA32(kf, qk, S); }
    bf16x8 pf[2];
#pragma unroll
    for (int s2 = 0; s2 < 2; s2++) {
      float v[8];
#pragma unroll
      for (int jj = 0; jj < 8; jj++) {
        const int i = 8 * s2 + jj;
        const int mkey = kt * 32 + (i & 3) + 8 * (i >> 2) + 4 * h2;
        v[jj] = (mkey <= c) ? S[i] * exp2f((float)(c - mkey) * lg) : 0.f;
      }
      uint4 u; u.x = pack2(v[0], v[1]); u.y = pack2(v[2], v[3]); u.z = pack2(v[4], v[5]); u.w = pack2(v[6], v[7]);
      pf[s2] = __builtin_bit_cast(bf16x8, u);
    }
    const bf16_t* vp = p.RVt + ((size_t)(bh * 256 + dh * 128 + r)) * T + n * 128 + kt * 32 + 4 * h2;
#pragma unroll
    for (int dvt = 0; dvt < 4; dvt++)
#pragma unroll
      for (int s2 = 0; s2 < 2; s2++) {
        const uint2 v0 = *(const uint2*)(vp + (size_t)dvt * 32 * T + 16 * s2);
        const uint2 v1 = *(const uint2*)(vp + (size_t)dvt * 32 * T + 16 * s2 + 8);
        uint4 u; u.x = v0.x; u.y = v0.y; u.z = v1.x; u.w = v1.y;
        O[dvt] = MFMA32(__builtin_bit_cast(bf16x8, u), pf[s2], O[dvt]);
      }
  }
  float s1 = 0.f, s2s = 0.f;
#pragma unroll
  for (int dvt = 0; dvt < 4; dvt++)
#pragma unroll
    for (int i = 0; i < 16; i++) { s1 += O[dvt][i]; s2s += O[dvt][i] * O[dvt][i]; }
  s1 += __shfl_xor(s1, 32); s2s += __shfl_xor(s2s, 32);
  float* red = (float*)smem;
  __syncthreads();
  if (h2 == 0) { red[(w * 32 + r) * 2] = s1; red[(w * 32 + r) * 2 + 1] = s2s; }
  __syncthreads();
  s1 += red[((w ^ 1) * 32 + r) * 2]; s2s += red[((w ^ 1) * 32 + r) * 2 + 1];
  const float mu = s1 * (1.f / 256.f);
  const float var = fmaxf(s2s * (1.f / 256.f) - mu * mu, 0.f);
  const float rs = rsqrtf(var + 1e-5f);
  const size_t m = (size_t)b * T + n * 128 + c;
#pragma unroll
  for (int dvt = 0; dvt < 4; dvt++)
#pragma unroll
    for (int q4 = 0; q4 < 4; q4++) {
      const int col = h * 256 + dh * 128 + dvt * 32 + q4 * 8 + 4 * h2;
      const float4 gg = *(const float4*)(p.gn_g + col), bb = *(const float4*)(p.gn_b + col);
      const uint2 rg = *(const uint2*)(p.RG + m * 1024 + col);
      const float g0 = lo2f(rg.x), g1 = hi2f(rg.x), g2 = lo2f(rg.y), g3 = hi2f(rg.y);
      const float y0 = ((O[dvt][q4 * 4] - mu) * rs * gg.x + bb.x) * g0 * sigmoidf_(g0);
      const float y1 = ((O[dvt][q4 * 4 + 1] - mu) * rs * gg.y + bb.y) * g1 * sigmoidf_(g1);
      const float y2 = ((O[dvt][q4 * 4 + 2] - mu) * rs * gg.z + bb.z) * g2 * sigmoidf_(g2);
      const float y3 = ((O[dvt][q4 * 4 + 3] - mu) * rs * gg.w + bb.w) * g3 * sigmoidf_(g3);
      uint2 o; o.x = pack2(y0, y1); o.y = pack2(y2, y3);
      *(uint2*)(p.oret + m * 1024 + col) = o;
    }
}

DI void upproj_tile(const Params& p, int tile, char* smem) {
  const int nt_ = tile & 7, mt_ = tile >> 3, m0 = mt_ * 128, n0 = nt_ * 128;
  f32x4 acc[4][4];
  zero_acc(acc);
  { const bf16_t* A = p.oattn + (size_t)m0 * 512; const bf16_t* Bt = p.WaT + (size_t)n0 * 512;
    gemm128<true>(acc, [=](int r) { return A + (size_t)r * 512; }, [=](int r) { return Bt + (size_t)r * 512; }, 512, smem); }
  epilogue<true>(acc, [&](int r, int c, f32x4 v) {
    const size_t m = m0 + r; const int cc = n0 + c;
    const uint2 gv = *(const uint2*)(p.MG + m * 2048 + cc);
    uint2 o; o.x = pack2(sigmoidf_(lo2f(gv.x)) * v[0], sigmoidf_(hi2f(gv.x)) * v[1]); o.y = pack2(sigmoidf_(lo2f(gv.y)) * v[2], sigmoidf_(hi2f(gv.y)) * v[3]);
    *(uint2*)(p.merged + m * 1024 + cc) = o;
  });
  zero_acc(acc);
  { const bf16_t* A = p.oret + (size_t)m0 * 1024; const bf16_t* Bt = p.WrT + (size_t)n0 * 1024;
    gemm128<true>(acc, [=](int r) { return A + (size_t)r * 1024; }, [=](int r) { return Bt + (size_t)r * 1024; }, 1024, smem); }
  epilogue<true>(acc, [&](int r, int c, f32x4 v) {
    const size_t m = m0 + r; const int cc = n0 + c;
    const uint2 gv = *(const uint2*)(p.MG + m * 2048 + 1024 + cc);
    const uint2 pr = *(const uint2*)(p.merged + m * 1024 + cc);
    uint2 o; o.x = pack2(lo2f(pr.x) + sigmoidf_(lo2f(gv.x)) * v[0], hi2f(pr.x) + sigmoidf_(hi2f(gv.x)) * v[1]);
    o.y = pack2(lo2f(pr.y) + sigmoidf_(lo2f(gv.y)) * v[2], hi2f(pr.y) + sigmoidf_(hi2f(gv.y)) * v[3]);
    *(uint2*)(p.merged + m * 1024 + cc) = o;
  });
}
DI void wout_tile(const Params& p, int tile, char* smem) {
  const int nt_ = tile & 7, mt_ = tile >> 3, m0 = mt_ * 128, n0 = nt_ * 128;
  f32x4 acc[4][4]; zero_acc(acc);
  const bf16_t* A = p.merged + (size_t)m0 * 1024; const bf16_t* Bt = p.WoT + (size_t)n0 * 1024;
  gemm128<true>(acc, [=](int r) { return A + (size_t)r * 1024; }, [=](int r) { return Bt + (size_t)r * 1024; }, 1024, smem);
  epilogue<true>(acc, [&](int r, int c, f32x4 v) {
    const size_t idx = (size_t)(m0 + r) * 1024 + n0 + c;
    const float4 xv = *(const float4*)(p.x + idx);
    float4 o; o.x = ALPHA * xv.x + v[0]; o.y = ALPHA * xv.y + v[1]; o.z = ALPHA * xv.z + v[2]; o.w = ALPHA * xv.w + v[3];
    *(float4*)(p.out + idx) = o;
  });
}
DI void expert_cvt(const Params& p, char* smem) {
  float* tile = (float*)smem;
  const int bid = blockIdx.x, nb = gridDim.x;
  for (int e = 0; e < NEXP; e++) {
    const float* wg = p.e_wg + (size_t)e * 1024 * 512; const float* wu = p.e_wu + (size_t)e * 1024 * 512; const float* wd = p.e_wd + (size_t)e * 512 * 1024;
    tcvt_all([=](int j) -> const float* { const int f = (j >> 7) * 64 + ((j >> 5) & 3) * 16 + (j & 15); return (((j >> 4) & 1) ? wu : wg) + f; },
             512, p.EgT + (size_t)e * 1024 * 1024, 1024, 1024, tile, (bid + e * 37) % nb, nb);
    tcvt_all([=](int j) -> const float* { return wd + j; }, 1024, p.EdT + (size_t)e * 1024 * 512, 512, 1024, tile, (bid + e * 37 + 19) % nb, nb);
  }
}

DI void ln1_router(const Params& p, int m, int lane) {
  float* row = p.out + (size_t)m * 1024;
  float4 v[4];
#pragma unroll
  for (int i = 0; i < 4; i++) v[i] = *(const float4*)(row + i * 256 + lane * 4);
  float s = 0.f;
#pragma unroll
  for (int i = 0; i < 4; i++) s += v[i].x + v[i].y + v[i].z + v[i].w;
  const float mu = wsum(s) * (1.f / 1024.f);
  float q = 0.f;
#pragma unroll
  for (int i = 0; i < 4; i++) { const float a = v[i].x - mu, b = v[i].y - mu, c = v[i].z - mu, d = v[i].w - mu; q += a * a + b * b + c * c + d * d; }
  const float rs = rsqrtf(wsum(q) * (1.f / 1024.f) + 1e-5f);
  float gl[4] = {0.f, 0.f, 0.f, 0.f};
#pragma unroll
  for (int i = 0; i < 4; i++) {
    const int k = i * 256 + lane * 4;
    const float4 g = *(const float4*)(p.ln1_g + k), bb = *(const float4*)(p.ln1_b + k);
    v[i].x = (v[i].x - mu) * rs * g.x + bb.x; v[i].y = (v[i].y - mu) * rs * g.y + bb.y;
    v[i].z = (v[i].z - mu) * rs * g.z + bb.z; v[i].w = (v[i].w - mu) * rs * g.w + bb.w;
    *(float4*)(row + k) = v[i];
    uint2 o; o.x = pack2(v[i].x, v[i].y); o.y = pack2(v[i].z, v[i].w);
    *(uint2*)(p.x1b + (size_t)m * 1024 + k) = o;
    const float xs[4] = {v[i].x, v[i].y, v[i].z, v[i].w};
#pragma unroll
    for (int kk = 0; kk < 4; kk++) {
      const float4 w = *(const float4*)(p.rg_w + (size_t)(k + kk) * 4);
      gl[0] += xs[kk] * w.x; gl[1] += xs[kk] * w.y; gl[2] += xs[kk] * w.z; gl[3] += xs[kk] * w.w;
    }
  }
#pragma unroll
  for (int j = 0; j < 4; j++) gl[j] = wsum(gl[j]) + p.rg_b[j];
  int gi = 0; float gm = gl[0];
#pragma unroll
  for (int j = 1; j < 4; j++) if (gl[j] > gm) { gm = gl[j]; gi = j; }
  float gs = 0.f;
#pragma unroll
  for (int j = 0; j < 4; j++) gs += __expf(gl[j] - gm);
  const float gprob = 1.f / gs;
  float il[8] = {0.f, 0.f, 0.f, 0.f, 0.f, 0.f, 0.f, 0.f};
  const float* riw = p.ri_w + (size_t)gi * 1024 * 8;
#pragma unroll
  for (int i = 0; i < 4; i++) {
    const int k = i * 256 + lane * 4;
    const float xs[4] = {v[i].x, v[i].y, v[i].z, v[i].w};
#pragma unroll
    for (int kk = 0; kk < 4; kk++) {
      const float4 w0 = *(const float4*)(riw + (size_t)(k + kk) * 8), w1 = *(const float4*)(riw + (size_t)(k + kk) * 8 + 4);
      il[0] += xs[kk] * w0.x; il[1] += xs[kk] * w0.y; il[2] += xs[kk] * w0.z; il[3] += xs[kk] * w0.w;
      il[4] += xs[kk] * w1.x; il[5] += xs[kk] * w1.y; il[6] += xs[kk] * w1.z; il[7] += xs[kk] * w1.w;
    }
  }
#pragma unroll
  for (int j = 0; j < 8; j++) il[j] = wsum(il[j]) + p.ri_b[gi * 8 + j];
  int e1 = 0; float l1 = il[0];
#pragma unroll
  for (int j = 1; j < 8; j++) if (il[j] > l1) { l1 = il[j]; e1 = j; }
  int e2 = -1; float l2 = -3e38f;
#pragma unroll
  for (int j = 0; j < 8; j++) if (j != e1 && il[j] > l2) { l2 = il[j]; e2 = j; }
  const float ex = __expf(l2 - l1);
  const float w1 = gprob / (1.f + ex), w2 = gprob * ex / (1.f + ex);
  if (lane == 0) {
    const int ea = gi * 8 + e1, eb = gi * 8 + e2;
    const int pa = atomicAdd(p.cnt + ea, 1); p.lists[ea * 16384 + pa] = m * 2;
    const int pb = atomicAdd(p.cnt + eb, 1); p.lists[eb * 16384 + pb] = m * 2 + 1;
    p.routew[m * 2] = w1; p.routew[m * 2 + 1] = w2;
  }
}
DI void ln2_final(const Params& p, int m, int lane) {
  float* row = p.out + (size_t)m * 1024;
  float4 v[4];
  float s = 0.f;
#pragma unroll
  for (int i = 0; i < 4; i++) {
    const int k = i * 256 + lane * 4;
    const float4 xv = *(const float4*)(row + k);
    const uint2 a = *(const uint2*)(p.part + (size_t)(2 * m) * 1024 + k), b = *(const uint2*)(p.part + (size_t)(2 * m + 1) * 1024 + k);
    v[i].x = ALPHA * xv.x + lo2f(a.x) + lo2f(b.x); v[i].y = ALPHA * xv.y + hi2f(a.x) + hi2f(b.x);
    v[i].z = ALPHA * xv.z + lo2f(a.y) + lo2f(b.y); v[i].w = ALPHA * xv.w + hi2f(a.y) + hi2f(b.y);
    s += v[i].x + v[i].y + v[i].z + v[i].w;
  }
  const float mu = wsum(s) * (1.f / 1024.f);
  float q = 0.f;
#pragma unroll
  for (int i = 0; i < 4; i++) { const float a = v[i].x - mu, b = v[i].y - mu, c = v[i].z - mu, d = v[i].w - mu; q += a * a + b * b + c * c + d * d; }
  const float rs = rsqrtf(wsum(q) * (1.f / 1024.f) + 1e-5f);
#pragma unroll
  for (int i = 0; i < 4; i++) {
    const int k = i * 256 + lane * 4;
    const float4 g = *(const float4*)(p.ln2_g + k), bb = *(const float4*)(p.ln2_b + k);
    float4 o; o.x = (v[i].x - mu) * rs * g.x + bb.x; o.y = (v[i].y - mu) * rs * g.y + bb.y; o.z = (v[i].z - mu) * rs * g.z + bb.z; o.w = (v[i].w - mu) * rs * g.w + bb.w;
    *(float4*)(row + k) = o;
  }
}

struct MoeMap { int e, mi, cnt, hoff; };
DI bool moe_map(const Params& p, int mtile, MoeMap& mm) {
  int acc = 0;
  for (int e = 0; e < NEXP; e++) {
    const int c = p.cnt[e], nt = (c + 127) >> 7;
    if (mtile < acc + nt) { mm.e = e; mm.mi = mtile - acc; mm.cnt = c; mm.hoff = acc * 128; return true; }
    acc += nt;
  }
  return false;
}
DI int moe_total(const Params& p) { int acc = 0; for (int e = 0; e < NEXP; e++) acc += (p.cnt[e] + 127) >> 7; return acc; }
DI void moe_up_tile(const Params& p, const MoeMap& mm, int nt_, char* smem) {
  const int* lst = p.lists + mm.e * 16384 + mm.mi * 128; const int nrow = mm.cnt - mm.mi * 128;
  const bf16_t* Bt = p.EgT + ((size_t)mm.e * 1024 + nt_ * 128) * 1024;
  const bf16_t* X = p.x1b;
  f32x4 acc[4][4]; zero_acc(acc);
  gemm128<true>(acc, [=](int r) { const int tk = r < nrow ? (lst[r] >> 1) : 0; return X + (size_t)tk * 1024; }, [=](int r) { return Bt + (size_t)r * 1024; }, 1024, smem);
  const int lane = threadIdx.x & 63, wave = threadIdx.x >> 6, wr = wave >> 1, wc = wave & 1, fr = lane & 15, fq = lane >> 4;
#pragma unroll
  for (int mt = 0; mt < 4; mt++) {
    const int r = wr * 64 + mt * 16 + fr;
    if (r < nrow) {
      const float w = p.routew[lst[r]];
#pragma unroll
      for (int np = 0; np < 2; np++) {
        const f32x4 g = acc[mt][np * 2], u = acc[mt][np * 2 + 1];
        float hv[4];
#pragma unroll
        for (int i = 0; i < 4; i++) hv[i] = g[i] * sigmoidf_(g[i]) * u[i] * w;
        const int f = nt_ * 64 + wc * 32 + np * 16 + fq * 4;
        uint2 o; o.x = pack2(hv[0], hv[1]); o.y = pack2(hv[2], hv[3]);
        *(uint2*)(p.Hh + (size_t)(mm.hoff + mm.mi * 128 + r) * 512 + f) = o;
      }
    }
  }
}
DI void moe_down_tile(const Params& p, const MoeMap& mm, int nt_, char* smem) {
  const int* lst = p.lists + mm.e * 16384 + mm.mi * 128; const int nrow = mm.cnt - mm.mi * 128;
  const bf16_t* A = p.Hh + (size_t)(mm.hoff + mm.mi * 128) * 512;
  const bf16_t* Bt = p.EdT + ((size_t)mm.e * 1024 + nt_ * 128) * 512;
  f32x4 acc[4][4]; zero_acc(acc);
  gemm128<true>(acc, [=](int r) { return A + (size_t)r * 512; }, [=](int r) { return Bt + (size_t)r * 512; }, 512, smem);
  epilogue<true>(acc, [&](int r, int c, f32x4 v) {
    if (r < nrow) {
      const int ts = lst[r];
      uint2 o; o.x = pack2(v[0], v[1]); o.y = pack2(v[2], v[3]);
      *(uint2*)(p.part + (size_t)ts * 1024 + nt_ * 128 + c) = o;
    }
  });
}

constexpr int NPHASE = 12;
#if FUSED
#define PHFN DI
#else
#define PHFN DI
#endif
#define PH_PRE const int bid = blockIdx.x, nb = gridDim.x, tid = opq(threadIdx.x), lane = tid & 63, wave = tid >> 6; \
  const int gw = bid * 4 + wave, nw = nb * 4; char* wsm = smem + wave * 8192; (void)bid; (void)nb; (void)lane; (void)gw; (void)nw; (void)wsm;
PHFN void ph0(const Params& p, char* smem) { phase0(p, smem); }
PHFN void ph1(const Params& p, char* smem) { phase1(p, smem); }
PHFN void ph2(const Params& p, char* smem) { PH_PRE
  for (int t = bid; t < 192; t += nb) { if (t < 128) ret_scan_unit(p, t); else compress1_tile(p, t - 128, smem); }
}
PHFN void ph3(const Params& p, char* smem) { compress2(p); }
PHFN void ph4(const Params& p, char* smem) { PH_PRE
  for (int it = gw; it < 8 * T; it += nw) naive_cmp(p, it, wsm, lane);
  for (int u = bid; u < 1024; u += nb) ret_out_unit(p, u, smem);
}
PHFN void ph5(const Params& p, char* smem) { PH_PRE
  for (int u = bid; u < 512; u += nb) attn_unit(p, (u & ~63) | ((u & 256) ? (u & 63) : 63 - (u & 63)), smem);
}
PHFN void ph6(const Params& p, char* smem) { PH_PRE for (int t = bid; t < 1024; t += nb) upproj_tile(p, t, smem); }
PHFN void ph7(const Params& p, char* smem) { PH_PRE for (int t = bid; t < 1024; t += nb) wout_tile(p, t, smem); expert_cvt(p, smem); }
PHFN void ph8(const Params& p, char* smem) { PH_PRE for (int m = gw; m < M; m += nw) ln1_router(p, m, lane); }
PHFN void ph9(const Params& p, char* smem) { PH_PRE const int tot = moe_total(p);
  for (int t = bid; t < tot * 8; t += nb) { MoeMap mm; if (moe_map(p, t >> 3, mm)) moe_up_tile(p, mm, t & 7, smem); } }
PHFN void ph10(const Params& p, char* smem) { PH_PRE const int tot = moe_total(p);
  for (int t = bid; t < tot * 8; t += nb) { MoeMap mm; if (moe_map(p, t >> 3, mm)) moe_down_tile(p, mm, t & 7, smem); } }
PHFN void ph11(const Params& p, char* smem) { PH_PRE for (int m = gw; m < M; m += nw) ln2_final(p, m, lane); }
DI void run_phase(const Params& p, const int ph, char* smem) {
  switch (ph) {
    case 0: ph0(p, smem); break; case 1: ph1(p, smem); break; case 2: ph2(p, smem); break; case 3: ph3(p, smem); break;
    case 4: ph4(p, smem); break; case 5: ph5(p, smem); break; case 6: ph6(p, smem); break; case 7: ph7(p, smem); break;
    case 8: ph8(p, smem); break; case 9: ph9(p, smem); break; case 10: ph10(p, smem); break; case 11: ph11(p, smem); break;
  }
}

template <int PH>
__global__ void __launch_bounds__(256, 2) phase_kernel(Params p) {
  __shared__ __attribute__((aligned(16))) char smem[65536];
  run_phase(p, PH, smem);
}
#if FUSED
__global__ void __launch_bounds__(256, 2) mega_kernel(Params p_arg) {
  __shared__ __attribute__((aligned(16))) char smem[65536 + 16];
  const Params& p = *(const Params*)__builtin_amdgcn_kernarg_segment_ptr();
  volatile LAS unsigned* st = (volatile LAS unsigned*)(smem + 65536);
  if (threadIdx.x == 0) { st[0] = 0u; st[1] = 0u; }
  __syncthreads();
  const XcdBarrier xb = xcd_barrier_post(p.bar, st);
#define GSYNC() xcd_barrier(xb)
  ph0(p, smem); GSYNC(); ph1(p, smem); GSYNC(); ph2(p, smem); GSYNC(); ph3(p, smem); GSYNC();
  ph4(p, smem); GSYNC(); ph5(p, smem); GSYNC(); ph6(p, smem); GSYNC(); ph7(p, smem); GSYNC();
  ph8(p, smem); GSYNC(); ph9(p, smem); GSYNC(); ph10(p, smem); GSYNC(); ph11(p, smem);
}
#endif

extern "C" void kernel_launch(void* const* d_in, const int* in_sizes, int n_in, void* d_out, int out_size,
                              void* d_ws, size_t ws_size, hipStream_t stream) {
  Params p{};
  const float** ins = (const float**)&p;
  for (int i = 0; i < 28; i++) ins[i] = (const float*)d_in[i];
  p.out = (float*)d_out;
  char* ws = (char*)d_ws; size_t off = 0;
  auto alloc = [&](size_t bytes) { char* r = ws + off; off += (bytes + 255) & ~(size_t)255; return r; };
  const size_t MiB = 1 << 20;
  char* regionP = ws;
  p.Qn = (bf16_t*)alloc(16 * MiB);
  p.CK = (bf16_t*)alloc(4 * MiB); p.CV = (bf16_t*)alloc(4 * MiB); p.SK = (bf16_t*)alloc(4 * MiB); p.SVt = (bf16_t*)alloc(4 * MiB);
  p.WK = (bf16_t*)alloc(4 * MiB); p.WVt = (bf16_t*)alloc(4 * MiB);
  p.NG = (float*)alloc((size_t)M * 24 * 4);
  p.RQ = (bf16_t*)alloc(16 * MiB); p.RK = (bf16_t*)alloc(16 * MiB); p.RKzT = (bf16_t*)alloc(16 * MiB);
  p.RVt = (bf16_t*)alloc(32 * MiB); p.RG = (bf16_t*)alloc(32 * MiB); p.MG = (bf16_t*)alloc(64 * MiB);
  p.oattn = (bf16_t*)alloc(16 * MiB); p.WinT = p.oattn;
  p.oret = (bf16_t*)alloc(32 * MiB);
  p.WaT = (bf16_t*)alloc(1 * MiB); p.WrT = (bf16_t*)alloc(2 * MiB); p.WoT = (bf16_t*)alloc(2 * MiB);
  p.W1kT = (bf16_t*)alloc(1 * MiB); p.W1vT = (bf16_t*)alloc(1 * MiB);
  p.ropeN = (float*)alloc((size_t)T * 32 * 8); p.ropeR = (float*)alloc((size_t)T * 64 * 8); p.posb = (float*)alloc(512 * 4);
  p.H1 = (bf16_t*)alloc(2 * MiB); p.kcmp = (bf16_t*)alloc(8 * 256 * 64 * 2); p.vcmpT = (bf16_t*)alloc(8 * 64 * 256 * 2);
  p.selmask = (unsigned long long*)alloc((size_t)8 * T * 8);
  p.cnt = (int*)alloc(256); p.lists = (int*)alloc((size_t)NEXP * 16384 * 4); p.routew = (float*)alloc((size_t)M * 2 * 4);
  p.merged = (bf16_t*)(regionP); p.x1b = (bf16_t*)(regionP + 32 * MiB);
  p.EgT = (bf16_t*)(regionP + 64 * MiB); p.EdT = (bf16_t*)(regionP + 128 * MiB);
  p.Hh = (bf16_t*)(regionP + 160 * MiB); p.part = (bf16_t*)(regionP + 196 * MiB);
  p.bar = (unsigned*)alloc(XCD_BAR_WORDS * 4);
  p.xb = (bf16_t*)d_out; p.Rt = (bf16_t*)d_out;
  if (off > ws_size) { fprintf(stderr, "workspace too small: need %zu have %zu\n", off, ws_size); return; }
#if FUSED
  static int grid_blocks = 0;
  if (!grid_blocks) {
    int dev = 0, cus = 0, per_cu = 0;
    (void)hipGetDevice(&dev);
    (void)hipDeviceGetAttribute(&cus, hipDeviceAttributeMultiprocessorCount, dev);
    (void)hipOccupancyMaxActiveBlocksPerMultiprocessor(&per_cu, mega_kernel, 256, 0);
    if (per_cu > 2) per_cu = 2;
    grid_blocks = cus * per_cu;
  }
  (void)hipMemsetAsync(p.bar, 0, XCD_BAR_WORDS * 4, stream);
  void* args[] = {&p};
  hipError_t e = hipLaunchCooperativeKernel((void*)mega_kernel, dim3(grid_blocks), dim3(256), args, 0, stream);
  if (e != hipSuccess) fprintf(stderr, "coop launch failed: %s\n", hipGetErrorString(e));
#else
#define LAUNCH_PH(N) phase_kernel<N><<<512, 256, 0, stream>>>(p)
  LAUNCH_PH(0); LAUNCH_PH(1); LAUNCH_PH(2); LAUNCH_PH(3); LAUNCH_PH(4); LAUNCH_PH(5);
  LAUNCH_PH(6); LAUNCH_PH(7); LAUNCH_PH(8); LAUNCH_PH(9); LAUNCH_PH(10); LAUNCH_PH(11);
#endif
}
```

```cpp
#include <hip/hip_runtime.h>
#include <hip/hip_cooperative_groups.h>
#include <cstdio>
#include <cstdint>
namespace cg = cooperative_groups;

#ifndef FUSED
#define FUSED 1
#endif
#ifndef PROBE_DOUBLE
#define PROBE_DOUBLE 0
#endif
#ifndef PROBE_ROUTER
#define PROBE_ROUTER 0
#endif
#ifndef PROBE_PHASE
#define PROBE_PHASE -1
#endif

#define DI __device__ __forceinline__
typedef unsigned short bf16_t;
typedef short bf16x8 __attribute__((ext_vector_type(8)));
typedef float f32x4 __attribute__((ext_vector_type(4)));

constexpr int Bn = 4, T = 4096, D = 1024, M = Bn * T;
constexpr int NINP = 6528;
constexpr int NEXP = 32, DFF = 512;
constexpr int HROWS = 36864;
constexpr float ALPHA = 1.189207115002721f;

struct Params {
  const float *x, *w_in, *cmp_pos_k, *cmp_k_w1, *cmp_k_b1, *cmp_k_w2, *cmp_k_b2;
  const float *cmp_pos_v, *cmp_v_w1, *cmp_v_b1, *cmp_v_w2, *cmp_v_b2;
  const float *gn_g, *gn_b, *w_up_attn, *w_up_ret, *w_out, *ln1_g, *ln1_b;
  const float *rg_w, *rg_b, *ri_w, *ri_b, *e_wg, *e_wu, *e_wd, *ln2_g, *ln2_b;
  float* out;
  bf16_t *Qn, *CK, *CV, *SK, *SVt, *WK, *WVt; float* NG;
  bf16_t *RQ, *RK, *RKzT, *RVt, *RG, *MG;
  bf16_t *WinT  , *oattn, *oret;
  bf16_t *WaT, *WrT, *WoT, *W1kT, *W1vT;
  float *ropeN, *ropeR, *posb, *posp;
  bf16_t *H1, *kcmp, *vcmpT;
  unsigned long long* selmask;
  int* cnt; int* lists; float* routew;
  bf16_t *merged, *x1b, *EgT  , *EdT  , *Hh, *part;
  bf16_t *xb, *Rt, *Ut;
  unsigned* bar;
  unsigned* qctr;
};

DI float bf2f(bf16_t v) { return __uint_as_float(((unsigned)v) << 16); }
typedef __bf16 bf16x2_t __attribute__((ext_vector_type(2)));
DI bf16_t f2bf(float f) { return __builtin_bit_cast(bf16_t, (__bf16)f); }
DI unsigned pack2(float a, float b) { bf16x2_t v = {(__bf16)a, (__bf16)b}; return __builtin_bit_cast(unsigned, v); }
typedef float f32x16 __attribute__((ext_vector_type(16)));
#define MFMA32(a, b, c) __builtin_amdgcn_mfma_f32_32x32x16_bf16((a), (b), (c), 0, 0, 0)
DI float lo2f(unsigned u) { return __uint_as_float(u << 16); }
DI float hi2f(unsigned u) { return __uint_as_float(u & 0xffff0000u); }
DI float wsum(float v) {
  v += __int_as_float(__builtin_amdgcn_update_dpp(0, __float_as_int(v), 0x111, 0xf, 0xf, false));
  v += __int_as_float(__builtin_amdgcn_update_dpp(0, __float_as_int(v), 0x112, 0xf, 0xf, false));
  v += __int_as_float(__builtin_amdgcn_update_dpp(0, __float_as_int(v), 0x114, 0xf, 0xf, false));
  v += __int_as_float(__builtin_amdgcn_update_dpp(0, __float_as_int(v), 0x118, 0xf, 0xf, false));
  v += __int_as_float(__builtin_amdgcn_update_dpp(0, __float_as_int(v), 0x142, 0xa, 0xf, false));
  v += __int_as_float(__builtin_amdgcn_update_dpp(0, __float_as_int(v), 0x143, 0xc, 0xf, false));
  return __int_as_float(__builtin_amdgcn_readlane(__float_as_int(v), 63));
}
DI float wmax(float v) { for (int o = 32; o > 0; o >>= 1) v = fmaxf(v, __shfl_xor(v, o)); return v; }
DI float sigmoidf_(float x) { return 1.f / (1.f + __expf(-x)); }
#define WSYNC() asm volatile("s_waitcnt lgkmcnt(0)" ::: "memory")
DI size_t frag_off(int row, int k, int K) { return ((size_t)(((row >> 5) * (K >> 4) + (k >> 4)) * 2 + ((k >> 3) & 1))) * 256 + (row & 31) * 8 + (k & 7); }
DI int perm23(int r) { return (r & 0x13) | ((r & 4) << 1) | ((r & 8) >> 1); }
DI int opq(int x) { asm volatile("" : "+v"(x)); return x; }


#define XB_TMO      128
#define XB_XCNT(j)  (256  + 64 * (j))
#define XB_XSUB(j)  (1280 + 64 * (j))
#define XB_XGEN(j)  (2304 + 64 * (j))
#define XB_TOP      3328
#define XB_TOPGEN   3392
#define XCD_BAR_WORDS 3456
#define XB_SPIN_CAP (1u << 20)
#define LAS __attribute__((address_space(3)))
DI unsigned xb_ld(unsigned* p) { return __hip_atomic_load(p, __ATOMIC_RELAXED, __HIP_MEMORY_SCOPE_AGENT); }
DI unsigned xb_add(unsigned* p, unsigned v) { return __hip_atomic_fetch_add(p, v, __ATOMIC_RELAXED, __HIP_MEMORY_SCOPE_AGENT); }
DI unsigned xb_xcc_id() { return (unsigned)__builtin_amdgcn_s_getreg((3 << 11) | 20) & 0xFu; }
#define XB_SPIN(cond, bar) do { unsigned _sp = 0; while (cond) { __builtin_amdgcn_s_sleep(1); \
    if ((++_sp & 255u) == 0u) { if (xb_ld(&(bar)[XB_TMO])) break; if (_sp > XB_SPIN_CAP) { atomicAdd(&(bar)[XB_TMO], 1u); break; } } } } while (0)
struct XcdBarrier { unsigned* bar; unsigned x; volatile LAS unsigned* st; };
DI XcdBarrier xcd_barrier_post(unsigned* bar, volatile LAS unsigned* st) {
  XcdBarrier b; b.bar = bar; b.x = xb_xcc_id(); b.st = st;
  if (threadIdx.x == 0) (void)xb_add(&bar[XB_XCNT(b.x)], 1u);
  return b;
}
DI void xcd_barrier_complete(unsigned* bar, unsigned x, unsigned& nloc, unsigned& nx) {
  const unsigned G = gridDim.x * gridDim.y * gridDim.z;
  unsigned sum, cnt, mine, sp = 0u;
  for (;;) {
    sum = 0u; cnt = 0u; mine = 0u;
#pragma unroll
    for (unsigned j = 0; j < 16; ++j) { const unsigned c = xb_ld(&bar[XB_XCNT(j)]); sum += c; cnt += (c > 0u) ? 1u : 0u; mine = (j == x) ? c : mine; }
    if (sum == G) break;
    __builtin_amdgcn_s_sleep(1);
    if ((++sp & 255u) == 0u) { if (xb_ld(&bar[XB_TMO])) break; if (sp > XB_SPIN_CAP) { atomicAdd(&bar[XB_TMO], 1u); break; } }
  }
  nloc = mine > 0u ? mine : 1u; nx = cnt > 0u ? cnt : 1u;
}
DI void xcd_barrier(const XcdBarrier& b) {
  asm volatile("s_waitcnt vmcnt(0)" ::: "memory");
  __syncthreads();
  if (threadIdx.x == 0) {
    unsigned* bar = b.bar;
    __builtin_amdgcn_s_waitcnt(0);
    unsigned nloc = b.st[0], nx = b.st[1];
    if (nloc == 0u) { xcd_barrier_complete(bar, b.x, nloc, nx); b.st[0] = nloc; b.st[1] = nx; }
    const unsigned old = xb_add(&bar[XB_XSUB(b.x)], 1u);
    const unsigned gen = old / nloc;
    if (old + 1u == (gen + 1u) * nloc) {
      __builtin_amdgcn_fence(__ATOMIC_RELEASE, "agent");
      asm volatile("s_waitcnt vmcnt(0)" ::: "memory");
      const unsigned og = xb_add(&bar[XB_TOP], 1u);
      const unsigned tg = og / nx;
      if (og + 1u == (tg + 1u) * nx) xb_add(&bar[XB_TOPGEN], 1u);
      else XB_SPIN(xb_ld(&bar[XB_TOPGEN]) == tg, bar);
      __builtin_amdgcn_fence(__ATOMIC_ACQUIRE, "agent");
      xb_add(&bar[XB_XGEN(b.x)], 1u);
      asm volatile("s_waitcnt vmcnt(0)" ::: "memory");
    } else {
      XB_SPIN(xb_ld(&bar[XB_XGEN(b.x)]) == gen, bar);
      __builtin_amdgcn_fence(__ATOMIC_ACQUIRE, "agent");
      asm volatile("s_waitcnt vmcnt(0)" ::: "memory");
    }
  }
  __syncthreads();
}

DI void glds16_asm(const void* gsrc, unsigned lds_dst) {
  unsigned keep;
  asm volatile("s_mov_b32 %0, m0\n\ts_mov_b32 m0, %2\n\ts_nop 0\n\tglobal_load_lds_dwordx4 %1, off\n\ts_mov_b32 m0, %0" : "=&s"(keep) : "v"(gsrc), "s"(lds_dst) : "memory");
}
template <bool SWAP, class AR, class BR>
DI void gemm128(f32x4 (&acc)[4][4], AR arow, BR brow, int K, char* smem) {
  const int tid = opq(threadIdx.x), lane = tid & 63, wave = tid >> 6, wr = wave >> 1, wc = wave & 1;
  const int prow = lane >> 3, pch = ((lane & 7) ^ prow) << 3;
  const bf16_t* ap[4]; const bf16_t* bp[4];
#pragma unroll
  for (int i = 0; i < 4; i++) { ap[i] = arow((wave * 4 + i) * 8 + prow) + pch; bp[i] = brow((wave * 4 + i) * 8 + prow) + pch; }
  const unsigned ldsb = (unsigned)(size_t)(LAS char*)smem;
  const unsigned lpiece = __builtin_amdgcn_readfirstlane(wave * 4096);
  char* As = smem; char* Bs = smem + 32768;
  const int nk = K >> 6;
  const int fr = lane & 15, fq = lane >> 4;
  const int aoff0 = (wr * 64 + fr) * 128, boff0 = (wc * 64 + fr) * 128;
  auto gload = [&](int t, int buf) {
#pragma unroll
    for (int i = 0; i < 4; i++) {
      glds16_asm(ap[i] + t * 64, ldsb + buf * 16384 + lpiece + i * 1024);
      glds16_asm(bp[i] + t * 64, ldsb + 32768 + buf * 16384 + lpiece + i * 1024);
    }
  };
  auto gcomp = [&](int buf) {
    const char* Ac = As + buf * 16384; const char* Bc = Bs + buf * 16384;
#pragma unroll
    for (int ks = 0; ks < 2; ks++) {
      const int chs = ((ks * 4 + fq) ^ (fr & 7)) << 4;
      bf16x8 a[4], b[4];
#pragma unroll
      for (int mt = 0; mt < 4; mt++) a[mt] = *(const bf16x8*)(Ac + aoff0 + mt * 2048 + chs);
#pragma unroll
      for (int nt = 0; nt < 4; nt++) b[nt] = *(const bf16x8*)(Bc + boff0 + nt * 2048 + chs);
      __builtin_amdgcn_s_setprio(1);
#pragma unroll
      for (int mt = 0; mt < 4; mt++)
#pragma unroll
        for (int nt = 0; nt < 4; nt++)
          acc[mt][nt] = SWAP ? __builtin_amdgcn_mfma_f32_16x16x32_bf16(b[nt], a[mt], acc[mt][nt], 0, 0, 0)
                             : __builtin_amdgcn_mfma_f32_16x16x32_bf16(a[mt], b[nt], acc[mt][nt], 0, 0, 0);
      __builtin_amdgcn_s_setprio(0);
    }
  };
  asm volatile("s_waitcnt vmcnt(0)" ::: "memory");
  gload(0, 0);
  asm volatile("s_waitcnt vmcnt(0)" ::: "memory");
  __builtin_amdgcn_s_barrier();
#pragma unroll 1
  for (int kt = 0; kt < nk; kt++) {
    const int cur = kt & 1;
    if (kt + 1 < nk) gload(kt + 1, cur ^ 1);
    gcomp(cur);
    asm volatile("s_waitcnt vmcnt(0)" ::: "memory");
    __builtin_amdgcn_s_barrier();
  }
}
template <bool SWAP, class AR, class BC>
DI void gemm128f(f32x4 (&acc)[4][4], AR arow, BC bcol, int ldb, int K, char* smem) {
  const int tid = opq(threadIdx.x), lane = tid & 63, wave = tid >> 6, wr = wave >> 1, wc = wave & 1;
  const int srow = tid >> 3, sch = tid & 7;
  const int bn = tid & 127, bh = tid >> 7;
  const bf16_t* ap[4];
#pragma unroll
  for (int i = 0; i < 4; i++) ap[i] = arow(srow + 32 * i) + sch * 8;
  const float* bq = bcol(bn) + (size_t)(bh * 32) * ldb;
  const int woff = srow * 128 + ((sch ^ (srow & 7)) << 4);
  char* As = smem; char* Bs = smem + 32768;
  uint4 ra[4]; float rb[4][8];
  auto bload = [&](int kt) {
    const float* q = bq + (size_t)kt * 64 * ldb;
#pragma unroll
    for (int i = 0; i < 4; i++)
#pragma unroll
      for (int j = 0; j < 8; j++) rb[i][j] = q[(size_t)(i * 8 + j) * ldb];
  };
  auto bwrite = [&](char* Bd) {
#pragma unroll
    for (int i = 0; i < 4; i++) {
      uint4 u; u.x = pack2(rb[i][0], rb[i][1]); u.y = pack2(rb[i][2], rb[i][3]); u.z = pack2(rb[i][4], rb[i][5]); u.w = pack2(rb[i][6], rb[i][7]);
      *(uint4*)(Bd + bn * 128 + ((((bh * 4 + i)) ^ (bn & 7)) << 4)) = u;
    }
  };
#pragma unroll
  for (int i = 0; i < 4; i++) ra[i] = *(const uint4*)(ap[i]);
  bload(0);
#pragma unroll
  for (int i = 0; i < 4; i++) *(uint4*)(As + woff + i * 4096) = ra[i];
  bwrite(Bs);
  __syncthreads();
  const int nk = K >> 6;
  const int fr = lane & 15, fq = lane >> 4;
  const int aoff0 = (wr * 64 + fr) * 128, boff0 = (wc * 64 + fr) * 128;
  for (int kt = 0; kt < nk; kt++) {
    const int cur = kt & 1;
    if (kt + 1 < nk) {
#pragma unroll
      for (int i = 0; i < 4; i++) ra[i] = *(const uint4*)(ap[i] + (kt + 1) * 64);
      bload(kt + 1);
    }
    const char* Ac = As + cur * 16384; const char* Bc = Bs + cur * 16384;
#pragma unroll
    for (int ks = 0; ks < 2; ks++) {
      const int chs = ((ks * 4 + fq) ^ (fr & 7)) << 4;
      bf16x8 a[4], b[4];
#pragma unroll
      for (int mt = 0; mt < 4; mt++) a[mt] = *(const bf16x8*)(Ac + aoff0 + mt * 2048 + chs);
#pragma unroll
      for (int nt = 0; nt < 4; nt++) b[nt] = *(const bf16x8*)(Bc + boff0 + nt * 2048 + chs);
#pragma unroll
      for (int mt = 0; mt < 4; mt++)
#pragma unroll
        for (int nt = 0; nt < 4; nt++)
          acc[mt][nt] = SWAP ? __builtin_amdgcn_mfma_f32_16x16x32_bf16(b[nt], a[mt], acc[mt][nt], 0, 0, 0)
                             : __builtin_amdgcn_mfma_f32_16x16x32_bf16(a[mt], b[nt], acc[mt][nt], 0, 0, 0);
    }
    if (kt + 1 < nk) {
      char* An = As + (cur ^ 1) * 16384;
#pragma unroll
      for (int i = 0; i < 4; i++) *(uint4*)(An + woff + i * 4096) = ra[i];
      bwrite(Bs + (cur ^ 1) * 16384);
    }
    __syncthreads();
  }
}
DI void zero_acc(f32x4 (&acc)[4][4]) {
#pragma unroll
  for (int i = 0; i < 4; i++)
#pragma unroll
    for (int j = 0; j < 4; j++) acc[i][j] = (f32x4){0.f, 0.f, 0.f, 0.f};
}
template <bool SWAP, class F>
DI void epilogue(const f32x4 (&acc)[4][4], F f) {
  const int lane = opq(threadIdx.x) & 63, wave = opq(threadIdx.x) >> 6, wr = wave >> 1, wc = wave & 1, fr = lane & 15, fq = lane >> 4;
#pragma unroll
  for (int mt = 0; mt < 4; mt++)
#pragma unroll
    for (int nt = 0; nt < 4; nt++) {
      if (SWAP) f(wr * 64 + mt * 16 + fr, wc * 64 + nt * 16 + fq * 4, acc[mt][nt]);
      else f(wr * 64 + mt * 16 + fq * 4, wc * 64 + nt * 16 + fr, acc[mt][nt]);
    }
}

template <class CP>
DI void tcvt_tile(CP colptr, int ldsrc, bf16_t* dst, int K, int kt, int jt, float* tile) {
  const int tx = opq(threadIdx.x) & 63, ty = opq(threadIdx.x) >> 6;
  const float* sp = colptr(jt * 64 + tx);
  for (int i = ty; i < 64; i += 4) tile[i * 65 + tx] = sp ? sp[(size_t)(kt * 64 + i) * ldsrc] : 0.f;
  __syncthreads();
  for (int i = ty * 2 + (tx >> 5); i < 64; i += 8) {
    const int kk = (tx & 31) * 2;
    *(unsigned*)(dst + (size_t)(jt * 64 + i) * K + kt * 64 + kk) = pack2(tile[kk * 65 + i], tile[(kk + 1) * 65 + i]);
  }
  __syncthreads();
}
template <class CP>
DI void tcvt_all(CP colptr, int ldsrc, bf16_t* dst, int K, int N, float* tile, int bid, int nb) {
  const int nkt = K / 64, njt = N / 64;
  for (int t = bid; t < nkt * njt; t += nb) tcvt_tile(colptr, ldsrc, dst, K, t / njt, t % njt, tile);
}

template <class CP>
DI void tcvt_tile128(CP colptr, int ldsrc, bf16_t* dst, int K, int kt, int jt, float* tile  ) {
  const int tid = opq(threadIdx.x), tx = tid & 127, ty = tid >> 7;
  const float* sp0 = colptr(jt * 128 + tx);
  const float* sp = sp0 + (size_t)(kt * 64 + ty) * ldsrc;
  float v[32];
  if (sp0) {
#pragma unroll
    for (int i = 0; i < 32; i++) v[i] = sp[(size_t)(2 * i) * ldsrc];
  } else {
#pragma unroll
    for (int i = 0; i < 32; i++) v[i] = 0.f;
  }
#pragma unroll
  for (int i = 0; i < 32; i++) tile[(ty + 2 * i) * 129 + tx] = v[i];
  __syncthreads();
  const int pp = (tid & 31) * 2, j0 = tid >> 5;
#pragma unroll
  for (int i = 0; i < 16; i++) {
    const int j = j0 + 8 * i;
    *(unsigned*)(dst + (size_t)(jt * 128 + j) * K + kt * 64 + pp) = pack2(tile[pp * 129 + j], tile[(pp + 1) * 129 + j]);
  }
  __syncthreads();
}
DI int perm_half(int p, int d) { return (p & 1) ? (d / 2 + (p >> 1)) : (p >> 1); }
DI int inproj_col(int j) {
  if (j < 512) return (j & ~63) + perm_half(j & 63, 64);
  if (j < 1280) { const int grp = (j - 512) >> 7;
    if (grp == 2 || grp == 4) return (j & ~63) + perm_half(j & 63, 64);
    return j; }
  if (j < 1792) { const int q = j - 1280; return 1304 + (q & ~127) + perm_half(q & 127, 128); }
  if (j < 2304) { const int q = j - 1792; return 1816 + (q & ~127) + perm_half(q & 127, 128); }
  if (j < 3328) return 2328 + (j - 2304);
  if (j < 4352) return 3352 + (j - 3328);
  if (j < 6400) return 4376 + (j - 4352);
  const int q = j - 6400; return q < 24 ? 1280 + q : -1;
}

DI void phase0(const Params& p, char* smem) {
  const int bid = blockIdx.x, nb = gridDim.x, tid = opq(threadIdx.x);
  const size_t gtid = (size_t)bid * 256 + tid, gsz = (size_t)nb * 256;
  for (size_t i = gtid; i < (size_t)M * D / 4; i += gsz) {
    const float4 v = ((const float4*)p.x)[i];
    uint2 o; o.x = pack2(v.x, v.y); o.y = pack2(v.z, v.w);
    ((uint2*)p.xb)[i] = o;
  }
  float* tile = (float*)smem;
  for (int tt = bid; tt < 1264; tt += nb) {
    if (tt < 816) { const float* w = p.w_in; tcvt_tile128([=](int j) -> const float* { const int c = inproj_col(j); return c >= 0 ? w + c : nullptr; }, 6424, p.WinT, 1024, tt / 51, tt % 51, tile); }
    else if (tt < 880) { const int q = tt - 816; const float* w = p.w_up_attn; tcvt_tile128([=](int j) -> const float* { return w + j; }, 1024, p.WaT, 512, q >> 3, q & 7, tile); }
    else if (tt < 1008) { const int q = tt - 880; const float* w = p.w_up_ret; tcvt_tile128([=](int j) -> const float* { return w + j; }, 1024, p.WrT, 1024, q >> 3, q & 7, tile); }
    else if (tt < 1136) { const int q = tt - 1008; const float* w = p.w_out; tcvt_tile128([=](int j) -> const float* { return w + j; }, 1024, p.WoT, 1024, q >> 3, q & 7, tile); }
    else if (tt < 1200) { const int q = tt - 1136; const float* w = p.cmp_k_w1; tcvt_tile128([=](int j) -> const float* { return w + j; }, 256, p.W1kT, 2048, q >> 1, q & 1, tile); }
    else { const int q = tt - 1200; const float* w = p.cmp_v_w1; tcvt_tile128([=](int j) -> const float* { return w + j; }, 256, p.W1vT, 2048, q >> 1, q & 1, tile); }
  }
  for (size_t i = gtid; i < (size_t)T * 96; i += gsz) {
    const int t = (int)(i / 96), r = (int)(i % 96);
    float invf; float* dst;
    if (r < 32) { invf = (float)exp2(-(double)r * (2.0 / 64.0) * 13.287712379549449); dst = p.ropeN + ((size_t)t * 32 + r) * 2; }
    else { const int q = r - 32; invf = (float)exp2(-(double)q * (2.0 / 128.0) * 13.287712379549449); dst = p.ropeR + ((size_t)t * 64 + q) * 2; }
    const double ang = (double)((float)t * invf);
    const double kk = rint(ang * 0.15915494309189535);
    const float red = (float)(ang - kk * 6.283185307179586);
    dst[0] = cosf(red); dst[1] = sinf(red);
  }
  for (size_t i = gtid; i < 32 * 512; i += gsz) {
    const int qp = (int)(i >> 9), kv = (int)((i >> 8) & 1), j = (int)(i & 255);
    const float* pos = kv ? p.cmp_pos_v : p.cmp_pos_k; const float* w1 = kv ? p.cmp_v_w1 : p.cmp_k_w1;
    float s0 = 0.f;
#pragma unroll 8
    for (int q = qp * 64; q < qp * 64 + 64; q++) s0 += pos[q] * w1[(size_t)q * 256 + j];
    p.posp[i] = s0;
  }
  if (gtid < 512) p.cnt[gtid] = 0;
}

DI void inproj_tile(const Params& p, int mt_, int nt_, char* smem) {
  const int m0 = mt_ * 128;
  const bf16_t* A = p.xb + (size_t)m0 * D; const bf16_t* Bt = p.WinT + (size_t)nt_ * 128 * D;
  f32x4 acc[4][4]; zero_acc(acc);
  auto ar = [=](int r) { return A + (size_t)r * D; };
  auto br = [=](int r) { return Bt + (size_t)r * D; };
  const bool transposed = (nt_ == 7 || nt_ == 9 || (nt_ >= 18 && nt_ < 26));
  if (transposed) {
    gemm128<false>(acc, ar, br, D, smem);
    epilogue<false>(acc, [&](int r, int c, f32x4 v) {
      const int m = m0 + r, b = m >> 12, t = m & 4095;
      uint2 o; o.x = pack2(v[0], v[1]); o.y = pack2(v[2], v[3]);
      if (nt_ < 18) { bf16_t* dst = (nt_ == 7) ? p.SVt : p.WVt; const int g = c >> 6, d = c & 63;
        *(uint2*)(dst + ((size_t)((b * 2 + g) * 64 + d)) * T + t) = o; }
      else { const int h = (nt_ - 18) >> 1, e = ((nt_ - 18) & 1) * 128 + c;
        *(uint2*)(p.RVt + (size_t)(b * 4 + h) * 256 * T + frag_off(e, t, T)) = o; }
    });
    return;
  }
  gemm128<true>(acc, ar, br, D, smem);
  epilogue<true>(acc, [&](int r, int c, f32x4 v) {
    const int m = m0 + r, b = m >> 12, t = m & 4095;
    if (nt_ < 4 || nt_ == 6 || nt_ == 8) {
      const int pp = c & 63;
      const float4 cs = *(const float4*)(p.ropeN + ((size_t)t * 32 + (pp >> 1)) * 2);
      const float sc = nt_ < 4 ? 0.18033688011112042f : 1.f;
      const float a0 = (v[0] * cs.x - v[1] * cs.y) * sc, a1 = (v[0] * cs.y + v[1] * cs.x) * sc;
      const float a2 = (v[2] * cs.z - v[3] * cs.w) * sc, a3 = (v[2] * cs.w + v[3] * cs.z) * sc;
      uint2 o; o.x = pack2(a0, a1); o.y = pack2(a2, a3);
      if (nt_ < 4) { const int head = nt_ * 2 + (c >> 6); *(uint2*)(p.Qn + ((size_t)(b * 8 + head) * T + t) * 64 + pp) = o; }
      else { bf16_t* dst = nt_ == 6 ? p.SK : p.WK; const int g = c >> 6; *(uint2*)(dst + ((size_t)(b * 2 + g) * T + t) * 64 + pp) = o; }
    } else if (nt_ == 4 || nt_ == 5) {
      bf16_t* dst = nt_ == 4 ? p.CK : p.CV; const int g = c >> 6, pp = c & 63;
      uint2 o; o.x = pack2(v[0], v[1]); o.y = pack2(v[2], v[3]);
      *(uint2*)(dst + ((size_t)(b * 2 + g) * T + t) * 64 + pp) = o;
    } else if (nt_ >= 10 && nt_ < 18) {
      const bool isk = nt_ >= 14; const int h = (nt_ - 10) & 3;
      const float4 cs = *(const float4*)(p.ropeR + ((size_t)t * 64 + (c >> 1)) * 2);
      const float sc = isk ? 0.08838834764831845f : 1.f;
      const float a0 = (v[0] * cs.x - v[1] * cs.y) * sc, a1 = (v[0] * cs.y + v[1] * cs.x) * sc;
      const float a2 = (v[2] * cs.z - v[3] * cs.w) * sc, a3 = (v[2] * cs.w + v[3] * cs.z) * sc;
      uint2 o; o.x = pack2(a0, a1); o.y = pack2(a2, a3);
      *(uint2*)((isk ? p.RK : p.RQ) + (size_t)(b * 4 + h) * T * 128 + frag_off(t, c, 128)) = o;
      if (isk) {
        const float lg = log2f(1.f - exp2f(-5.f - (float)h));
        const float z = exp2f((float)(127 - (t & 127)) * lg);
        bf16_t* dst = p.RKzT + (size_t)(b * 4 + h) * 128 * T + frag_off(c, t, T);
        dst[0] = f2bf(a0 * z); dst[8] = f2bf(a1 * z); dst[16] = f2bf(a2 * z); dst[24] = f2bf(a3 * z);
      }
    } else if (nt_ >= 26 && nt_ < 34) {
      uint2 o; o.x = pack2(v[0], v[1]); o.y = pack2(v[2], v[3]);
      *(uint2*)(p.RG + (size_t)m * 1024 + (nt_ - 26) * 128 + c) = o;
    } else if (nt_ >= 34 && nt_ < 50) {
      uint2 o; o.x = pack2(v[0], v[1]); o.y = pack2(v[2], v[3]);
      *(uint2*)(p.MG + (size_t)m * 2048 + (nt_ - 34) * 128 + c) = o;
    } else if (nt_ == 50) {
      if (c < 24) { float4 o; o.x = sigmoidf_(v[0]); o.y = sigmoidf_(v[1]); o.z = sigmoidf_(v[2]); o.w = sigmoidf_(v[3]);
        *(float4*)(p.NG + (size_t)m * 24 + c) = o; }
    }
  });
}
DI void phase1(const Params& p, char* smem) {
  if (blockIdx.x < 2) {
    const int i = blockIdx.x * 256 + opq(threadIdx.x), kv = i >> 8, j = i & 255;
    float s0 = (kv ? p.cmp_v_b1 : p.cmp_k_b1)[j];
    for (int qp = 0; qp < 32; qp++) s0 += p.posp[qp * 512 + i];
    p.posb[i] = s0;
  }
  const int xcd = blockIdx.x & 7, lb = blockIdx.x >> 3, nlb = gridDim.x >> 3;
  for (int li = lb; li < 16 * 51; li += nlb) {
    const int mi = li & 7, rest = li >> 3, nt_ = rest % 51, half = rest / 51;
    inproj_tile(p, xcd * 16 + half * 8 + mi, nt_, smem);
  }
}


DI void attn_unit(const Params& p, int unit, char* smem) {
  const int tid = opq(threadIdx.x), lane = tid & 63, w = tid >> 6, r = lane & 31, h2 = lane >> 5;
  const int bg = unit >> 6, jq = unit & 63, b = bg >> 1, g = bg & 1, hh = g * 4 + w, t0 = jq * 64;
  bf16x8 qf[2][4];
#pragma unroll
  for (int qt = 0; qt < 2; qt++)
#pragma unroll
    for (int ks = 0; ks < 4; ks++)
      qf[qt][ks] = *(const bf16x8*)(p.Qn + ((size_t)(b * 8 + hh) * T + t0 + qt * 32 + r) * 64 + ks * 16 + h2 * 8);
  unsigned long long* sell = (unsigned long long*)(smem + 49152) + tid * 2;
#pragma unroll
  for (int qt = 0; qt < 2; qt++) sell[qt] = p.selmask[(size_t)bg * T + t0 + qt * 32 + r];
  const int wlo = jq > 8 ? jq - 8 : 0, nwin = jq - wlo + 1, nsteps = nwin + jq + 1;
  char* Kl = smem; char* Vl = smem + 24576;
  const unsigned ldsK = (unsigned)(size_t)(LAS char*)smem;
  const int grow = lane >> 3;
  auto gload = [&](int i, int buf) {
    const int br = i < nwin ? 2 : 1, j = i < nwin ? wlo + i : i - nwin;
    const bf16_t* Kp = (br == 1 ? p.SK : p.WK) + ((size_t)bg * T + j * 64) * 64;
    const bf16_t* Vp = (br == 1 ? p.SVt : p.WVt) + (size_t)bg * 64 * T + j * 64;
#pragma unroll
    for (int pc = 0; pc < 2; pc++) {
      const int row = (w * 2 + pc) * 8 + grow;
      const int gch = (lane & 7) ^ ((row >> 1) & 7);
      const unsigned loff = __builtin_amdgcn_readfirstlane(buf * 8192 + (w * 2 + pc) * 1024);
      glds16_asm(Kp + row * 64 + gch * 8, ldsK + loff);
      glds16_asm(Vp + (size_t)row * T + gch * 8, ldsK + 24576 + loff);
    }
  };
  const int pr = perm23(r);
  float mrow[2], lrow[2]; f32x16 O[2][2];
  auto reset = [&]() {
#pragma unroll
    for (int qt = 0; qt < 2; qt++) { mrow[qt] = -INFINITY; lrow[qt] = 0.f;
#pragma unroll
      for (int dt = 0; dt < 2; dt++)
#pragma unroll
        for (int i = 0; i < 16; i++) O[dt][qt][i] = 0.f; }
  };
  auto flush = [&](int br) {
#pragma unroll
    for (int qt = 0; qt < 2; qt++) {
      const int m = b * T + t0 + qt * 32 + r;
      const float gate = p.NG[(size_t)m * 24 + hh * 3 + br];
      const float sc = lrow[qt] > 0.f ? gate / lrow[qt] : 0.f;
#pragma unroll
      for (int dt = 0; dt < 2; dt++)
#pragma unroll
        for (int q4 = 0; q4 < 4; q4++) {
          bf16_t* dst = p.oattn + (size_t)m * 512 + hh * 64 + dt * 32 + q4 * 8 + h2 * 4;
          const uint2 old = *(const uint2*)dst;
          uint2 o; o.x = pack2(lo2f(old.x) + sc * O[dt][qt][q4 * 4], hi2f(old.x) + sc * O[dt][qt][q4 * 4 + 1]);
          o.y = pack2(lo2f(old.y) + sc * O[dt][qt][q4 * 4 + 2], hi2f(old.y) + sc * O[dt][qt][q4 * 4 + 3]);
          *(uint2*)dst = o;
        }
    }
  };
  reset();
#pragma unroll
  for (int qt = 0; qt < 2; qt++)
#pragma unroll
    for (int ks = 0; ks < 4; ks++) asm volatile("" :: "v"(qf[qt][ks]));
  gload(0, 0);
  if (nsteps > 1) { gload(1, 1); asm volatile("s_waitcnt vmcnt(4)" ::: "memory"); } else asm volatile("s_waitcnt vmcnt(0)" ::: "memory");
  __builtin_amdgcn_s_barrier();
  int cur = 0;
#pragma unroll 1
  for (int i = 0; i < nsteps; i++) {
    const int br = i < nwin ? 2 : 1, j = i < nwin ? wlo + i : i - nwin;
    if (i == nwin) { flush(2); reset(); }
    if (i + 2 < nsteps) gload(i + 2, cur == 0 ? 2 : cur - 1);
    const char* Kc = Kl + cur * 8192; const char* Vc = Vl + cur * 8192;
    const int mmode = (br == 2) ? ((j == jq || j + 8 == jq) ? 2 : 0) : (j == jq ? 2 : 1);
#pragma unroll
    for (int qt = 0; qt < 2; qt++) {
      const float msafe0 = (mrow[qt] == -INFINITY) ? 0.f : mrow[qt];
      float cinit = -msafe0;
      if (mmode == 1) cinit = ((sell[qt] >> j) & 1ull) ? cinit : -INFINITY;
      f32x16 S[2];
#pragma unroll
      for (int kt2 = 0; kt2 < 2; kt2++) {
#pragma unroll
        for (int ii = 0; ii < 16; ii++) S[kt2][ii] = cinit;
#pragma unroll
        for (int ks = 0; ks < 4; ks++) {
          const bf16x8 a = *(const bf16x8*)(Kc + (kt2 * 32 + pr) * 128 + (((ks * 2 + h2) ^ ((pr >> 1) & 7)) << 4));
          S[kt2] = MFMA32(a, qf[qt][ks], S[kt2]);
        }
      }
      const int t = t0 + qt * 32 + r;
      if (mmode == 2) {
        const bool selb = (br == 2) || ((sell[qt] >> j) & 1ull);
        const int khi = t, klo = (br == 2) ? t - 511 : 0;
#pragma unroll
        for (int kt2 = 0; kt2 < 2; kt2++)
#pragma unroll
          for (int ii = 0; ii < 16; ii++) {
            const int key = j * 64 + kt2 * 32 + (ii & 7) + 16 * (ii >> 3) + 8 * h2;
            S[kt2][ii] = (selb && key <= khi && key >= klo) ? S[kt2][ii] : -INFINITY;
          }
      }
      float mx = -INFINITY;
#pragma unroll
      for (int kt2 = 0; kt2 < 2; kt2++)
#pragma unroll
        for (int ii = 0; ii < 16; ii++) mx = fmaxf(mx, S[kt2][ii]);
      mx = fmaxf(mx, __shfl_xor(mx, 32));
      if (__any(mx > 6.f)) {
        const float dl = fmaxf(mx, 0.f);
        const float alpha = __builtin_amdgcn_exp2f(-dl);
        lrow[qt] *= alpha; mrow[qt] = msafe0 + dl;
#pragma unroll
        for (int dt = 0; dt < 2; dt++)
#pragma unroll
          for (int ii = 0; ii < 16; ii++) O[dt][qt][ii] *= alpha;
#pragma unroll
        for (int kt2 = 0; kt2 < 2; kt2++)
#pragma unroll
          for (int ii = 0; ii < 16; ii++) S[kt2][ii] -= dl;
      }
      float rs = 0.f;
#pragma unroll
      for (int kt2 = 0; kt2 < 2; kt2++)
#pragma unroll
        for (int ii = 0; ii < 16; ii++) { const float pv = __builtin_amdgcn_exp2f(S[kt2][ii]); S[kt2][ii] = pv; rs += pv; }
      rs += __shfl_xor(rs, 32);
      lrow[qt] += rs;
#pragma unroll
      for (int kt2 = 0; kt2 < 2; kt2++)
#pragma unroll
        for (int s2 = 0; s2 < 2; s2++) {
          uint4 u;
          u.x = pack2(S[kt2][8 * s2 + 0], S[kt2][8 * s2 + 1]); u.y = pack2(S[kt2][8 * s2 + 2], S[kt2][8 * s2 + 3]);
          u.z = pack2(S[kt2][8 * s2 + 4], S[kt2][8 * s2 + 5]); u.w = pack2(S[kt2][8 * s2 + 6], S[kt2][8 * s2 + 7]);
          const bf16x8 pfr = __builtin_bit_cast(bf16x8, u);
#pragma unroll
          for (int dt = 0; dt < 2; dt++) {
            const int d = dt * 32 + r;
            const bf16x8 vf = *(const bf16x8*)(Vc + d * 128 + (((kt2 * 4 + s2 * 2 + h2) ^ ((d >> 1) & 7)) << 4));
            O[dt][qt] = MFMA32(vf, pfr, O[dt][qt]);
          }
        }
      __builtin_amdgcn_sched_barrier(0);
    }
    if (i + 2 < nsteps) asm volatile("s_waitcnt vmcnt(4)" ::: "memory"); else asm volatile("s_waitcnt vmcnt(0)" ::: "memory");
    __builtin_amdgcn_s_barrier();
    cur = cur == 2 ? 0 : cur + 1;
  }
  flush(1);
  __syncthreads();
}

DI void cmp_unit(const Params& p, int unit, char* smem) {
  const int tid = opq(threadIdx.x), lane = tid & 63, w = tid >> 6, r = lane & 31, h2 = lane >> 5;
  const int bg = unit >> 7, q32 = unit & 127, b = bg >> 1, g = bg & 1, hh = g * 4 + w;
  const int pr = perm23(r);
  const bf16_t* Kg = p.kcmp + (size_t)bg * 256 * 64;
  const bf16_t* Vg = p.vcmpT + (size_t)bg * 64 * 256;
  const int tb = q32 * 32, t = tb + r;
  const int nvalid = t >= 31 ? ((t - 31) >> 4) + 1 : 0;
  const int nvmax = (tb >> 4) + 1;
  const int nkt = (nvmax + 31) >> 5;
  char* Kl = smem; char* Vl = smem + 32768; float* impw = (float*)smem;
  const unsigned ldsb = (unsigned)(size_t)(LAS char*)smem;
  __syncthreads();
  for (int pc = w; pc < 4 * nkt; pc += 4) {
    const int row = pc * 8 + (lane >> 3);
    glds16_asm(Kg + row * 64 + (((lane & 7) ^ ((row >> 1) & 7)) << 3), ldsb + __builtin_amdgcn_readfirstlane(pc * 1024));
  }
#pragma unroll
  for (int i = 0; i < 8; i++) {
    const int pc = w * 8 + i, d = pc * 2 + h2;
    glds16_asm(Vg + d * 256 + (((lane & 31) ^ (d & 15)) << 3), ldsb + 32768 + __builtin_amdgcn_readfirstlane(pc * 1024));
  }
  bf16x8 qf[4];
#pragma unroll
  for (int ks = 0; ks < 4; ks++) qf[ks] = *(const bf16x8*)(p.Qn + ((size_t)(b * 8 + hh) * T + t) * 64 + ks * 16 + h2 * 8);
  asm volatile("s_waitcnt vmcnt(0)" ::: "memory");
  __syncthreads();
  float mx = -1e30f;
#pragma unroll 1
  for (int kt = 0; kt < nkt; kt++) {
    f32x16 S;
#pragma unroll
    for (int i = 0; i < 16; i++) S[i] = 0.f;
    const int row = kt * 32 + pr;
#pragma unroll
    for (int ks = 0; ks < 4; ks++) { const bf16x8 kf = *(const bf16x8*)(Kl + row * 128 + (((ks * 2 + h2) ^ ((row >> 1) & 7)) << 4)); S = MFMA32(kf, qf[ks], S); }
#pragma unroll
    for (int i = 0; i < 16; i++) { const int key = kt * 32 + (i & 7) + 16 * (i >> 3) + 8 * h2; mx = fmaxf(mx, key < nvalid ? S[i] : -1e30f); }
  }
  mx = fmaxf(mx, __shfl_xor(mx, 32));
  float sum = 0.f;
  float impo[32];
#pragma unroll
  for (int i = 0; i < 32; i++) impo[i] = 0.f;
  f32x16 O[2];
#pragma unroll
  for (int dt = 0; dt < 2; dt++)
#pragma unroll
    for (int i = 0; i < 16; i++) O[dt][i] = 0.f;
  float carry = 0.f;
#pragma unroll
  for (int kt = 0; kt < 8; kt++) {
    if (kt < nkt) {
      f32x16 S;
#pragma unroll
      for (int i = 0; i < 16; i++) S[i] = 0.f;
      const int row = kt * 32 + pr;
#pragma unroll
      for (int ks = 0; ks < 4; ks++) { const bf16x8 kf = *(const bf16x8*)(Kl + row * 128 + (((ks * 2 + h2) ^ ((row >> 1) & 7)) << 4)); S = MFMA32(kf, qf[ks], S); }
#pragma unroll
      for (int i = 0; i < 16; i++) {
        const int key = kt * 32 + (i & 7) + 16 * (i >> 3) + 8 * h2;
        const float e = key < nvalid ? __builtin_amdgcn_exp2f(S[i] - mx) : 0.f;
        S[i] = e; sum += e;
      }
      {
        const float x1 = __shfl_xor(S[7], 32), x3 = __shfl_xor(S[15], 32);
#pragma unroll
        for (int q4 = 0; q4 < 4; q4++) {
          const float mainv = 2.f * (S[q4 * 4] + S[q4 * 4 + 1] + S[q4 * 4 + 2]) + S[q4 * 4 + 3];
          const float prev = (q4 == 0) ? (h2 ? x1 : carry) : (q4 == 1) ? S[3] : (q4 == 2) ? (h2 ? x3 : x1) : S[11];
          impo[kt * 4 + q4] = mainv + prev;
        }
        carry = x3;
      }
#pragma unroll
      for (int s2 = 0; s2 < 2; s2++) {
        uint4 u;
        u.x = pack2(S[8 * s2 + 0], S[8 * s2 + 1]); u.y = pack2(S[8 * s2 + 2], S[8 * s2 + 3]);
        u.z = pack2(S[8 * s2 + 4], S[8 * s2 + 5]); u.w = pack2(S[8 * s2 + 6], S[8 * s2 + 7]);
        const bf16x8 pfr = __builtin_bit_cast(bf16x8, u);
#pragma unroll
        for (int dt = 0; dt < 2; dt++) {
          const int d = dt * 32 + r;
          const bf16x8 vf = *(const bf16x8*)(Vl + d * 512 + (((kt * 4 + s2 * 2 + h2) ^ (d & 15)) << 4));
          O[dt] = MFMA32(vf, pfr, O[dt]);
        }
      }
    }
  }
  sum += __shfl_xor(sum, 32);
  const float inv = sum > 0.f ? 1.f / sum : 0.f;
  {
    const size_t m = (size_t)b * T + t;
    const float sc = inv * p.NG[m * 24 + hh * 3 + 0];
#pragma unroll
    for (int dt = 0; dt < 2; dt++)
#pragma unroll
      for (int q4 = 0; q4 < 4; q4++) {
        uint2 o; o.x = pack2(sc * O[dt][q4 * 4], sc * O[dt][q4 * 4 + 1]); o.y = pack2(sc * O[dt][q4 * 4 + 2], sc * O[dt][q4 * 4 + 3]);
        *(uint2*)(p.oattn + m * 512 + hh * 64 + dt * 32 + q4 * 8 + h2 * 4) = o;
      }
  }
  __syncthreads();
#pragma unroll
  for (int kt = 0; kt < 8; kt++)
#pragma unroll
    for (int q4 = 0; q4 < 4; q4++)
      impw[(w * 32 + r) * 65 + 8 * kt + 4 * (q4 >> 1) + 2 * h2 + (q4 & 1)] = impo[kt * 4 + q4] * inv;
  __syncthreads();
#pragma unroll 1
  for (int k8 = 0; k8 < 8; k8++) {
    const int rr = w * 8 + k8, tt = tb + rr, blk = tt >> 6;
    const float imp = ((impw[rr * 65 + lane] + impw[(32 + rr) * 65 + lane]) + impw[(64 + rr) * 65 + lane]) + impw[(96 + rr) * 65 + lane];
    const float score = (lane == 0 || lane == blk || lane == blk - 1) ? 1e9f : (lane <= blk ? imp : -1e9f);
    int rank = 0;
#pragma unroll
    for (int i = 0; i < 64; i++) { const float si = __int_as_float(__builtin_amdgcn_readlane(__float_as_int(score), i)); rank += (si > score || (si == score && i < lane)) ? 1 : 0; }
    const unsigned long long selm = __ballot(rank < 16);
    if (lane == 0) p.selmask[(size_t)bg * T + tt] = selm;
  }
}

DI float gelu_tanh(float x) { const float u = 0.7978845608028654f * (x + 0.044715f * x * x * x); return 0.5f * x * (1.f + tanhf(u)); }
DI void compress1_tile(const Params& p, int task, char* smem) {
  const int ks = task & 3, tile = task >> 2;
  const int ntl = tile & 1, mtile = tile >> 1, half = mtile & 1, bg = (mtile >> 1) & 7, kv = mtile >> 4;
  const bf16_t* src = (kv ? p.CV : p.CK) + (size_t)bg * T * 64 + (size_t)half * 128 * 1024 + ks * 512;
  const bf16_t* Bt = (kv ? p.W1vT : p.W1kT) + (size_t)ntl * 128 * 2048 + ks * 512;
  f32x4 acc[4][4]; zero_acc(acc);
  gemm128<true>(acc, [=](int r) { return src + (size_t)r * 1024; }, [=](int r) { return Bt + (size_t)r * 2048; }, 512, smem);
  float* H1p = (float*)p.oattn + (size_t)ks * 4096 * 256;
  epilogue<true>(acc, [&](int r, int c, f32x4 v) {
    const int n = half * 128 + r;
    if (n < 255) { float4 o; o.x = v[0]; o.y = v[1]; o.z = v[2]; o.w = v[3];
      *(float4*)(H1p + ((size_t)((kv * 8 + bg) * 256 + n)) * 256 + ntl * 128 + c) = o; }
  });
}
DI void compress2(const Params& p, char* smem) {
  float* hl = (float*)smem;
  const int tid = opq(threadIdx.x);
  const float* H1p = (const float*)p.oattn;
  for (int rb = blockIdx.x; rb < 512; rb += gridDim.x) {
    const int row0 = rb * 8, kv = row0 >> 11;
    __syncthreads();
#pragma unroll
    for (int q = 0; q < 8; q++) {
      const size_t idx = (size_t)(row0 + q) * 256 + tid;
      hl[q * 256 + tid] = gelu_tanh(H1p[idx] + H1p[idx + (size_t)4096 * 256] + H1p[idx + (size_t)2 * 4096 * 256] + H1p[idx + (size_t)3 * 4096 * 256] + p.posb[kv * 256 + tid]);
    }
    __syncthreads();
    const int q = tid >> 5, ii = tid & 31, row = row0 + q, n = row & 255, bg = (row >> 8) & 7;
    float a0 = 0.f, a1 = 0.f;
    if (n < 255) {
      const float* w2 = kv ? p.cmp_v_w2 : p.cmp_k_w2; const float* b2 = kv ? p.cmp_v_b2 : p.cmp_k_b2;
      a0 = b2[ii]; a1 = b2[ii + 32];
#pragma unroll 8
      for (int j = 0; j < 256; j++) { const float hv = hl[q * 256 + j]; a0 += hv * w2[j * 64 + ii]; a1 += hv * w2[j * 64 + ii + 32]; }
    }
    if (kv == 0) {
      float r0 = 0.f, r1 = 0.f;
      if (n < 255) { const int pos = 16 * n + 31; const float c = p.ropeN[((size_t)pos * 32 + ii) * 2], s = p.ropeN[((size_t)pos * 32 + ii) * 2 + 1];
        r0 = a0 * c - a1 * s; r1 = a0 * s + a1 * c; }
      *(unsigned*)(p.kcmp + ((size_t)(bg * 256 + n)) * 64 + 2 * ii) = pack2(r0, r1);
    } else {
      p.vcmpT[((size_t)(bg * 64 + ii)) * 256 + n] = f2bf(a0);
      p.vcmpT[((size_t)(bg * 64 + ii + 32)) * 256 + n] = f2bf(a1);
    }
  }
}


DI void ret_u_unit(const Params& p, int unit) {
  const int tid = opq(threadIdx.x), lane = tid & 63, w = tid >> 6, r = lane & 31, h2 = lane >> 5;
  const int bh = unit >> 5, n = unit & 31;
  const bf16_t* kz = p.RKzT + (size_t)bh * 128 * T + ((size_t)((w * 256 + n * 8) * 2 + h2)) * 256 + r * 8;
  const bf16_t* vt = p.RVt + (size_t)bh * 256 * T + ((size_t)((n * 8) * 2 + h2)) * 256 + r * 8;
  bf16_t* ut = p.Ut + ((size_t)bh * 32 + n) * 32768 + (size_t)(w * 2) * 512 + r * 8 + 4 * h2;
  bf16x8 a[8], b0[8], b1[8];
#pragma unroll
  for (int ks = 0; ks < 8; ks++) a[ks] = *(const bf16x8*)(kz + ks * 512);
#pragma unroll
  for (int ks = 0; ks < 8; ks++) b0[ks] = *(const bf16x8*)(vt + ks * 512);
#pragma unroll
  for (int dvs = 0; dvs < 8; dvs += 2) {
#pragma unroll
    for (int ks = 0; ks < 8; ks++) b1[ks] = *(const bf16x8*)(vt + (size_t)(dvs + 1) * 32 * T + ks * 512);
    {
      f32x16 R;
#pragma unroll
      for (int i = 0; i < 16; i++) R[i] = 0.f;
#pragma unroll
      for (int ks = 0; ks < 8; ks++) R = MFMA32(a[ks], b0[ks], R);
#pragma unroll
      for (int q4 = 0; q4 < 4; q4++) { uint2 o; o.x = pack2(R[q4 * 4], R[q4 * 4 + 1]); o.y = pack2(R[q4 * 4 + 2], R[q4 * 4 + 3]);
        *(uint2*)(ut + (size_t)dvs * 4096 + (q4 >> 1) * 512 + (q4 & 1) * 256) = o; }
    }
    if (dvs + 2 < 8) {
#pragma unroll
      for (int ks = 0; ks < 8; ks++) b0[ks] = *(const bf16x8*)(vt + (size_t)(dvs + 2) * 32 * T + ks * 512);
    }
    {
      f32x16 R;
#pragma unroll
      for (int i = 0; i < 16; i++) R[i] = 0.f;
#pragma unroll
      for (int ks = 0; ks < 8; ks++) R = MFMA32(a[ks], b1[ks], R);
#pragma unroll
      for (int q4 = 0; q4 < 4; q4++) { uint2 o; o.x = pack2(R[q4 * 4], R[q4 * 4 + 1]); o.y = pack2(R[q4 * 4 + 2], R[q4 * 4 + 3]);
        *(uint2*)(ut + (size_t)(dvs + 1) * 4096 + (q4 >> 1) * 512 + (q4 & 1) * 256) = o; }
    }
  }
}
DI void ret_scan_elem(const Params& p) {
  const size_t gtid = (size_t)blockIdx.x * 256 + opq(threadIdx.x), gsz = (size_t)gridDim.x * 256;
  for (size_t i = gtid; i < (size_t)16 * 256 * 32; i += gsz) {
    const int bh = (int)(i >> 13), h = bh & 3;
    const size_t off = (size_t)(i & 8191) * 4;
    const float cd = exp2f(128.f * log2f(1.f - exp2f(-5.f - (float)h)));
    const bf16_t* up = p.Ut + (size_t)bh * 32 * 32768 + off;
    bf16_t* rp = p.Rt + (size_t)bh * 32 * 32768 + off;
    uint2 u[31];
#pragma unroll
    for (int n = 0; n < 31; n++) u[n] = *(const uint2*)(up + (size_t)n * 32768);
    float r0 = 0.f, r1 = 0.f, r2 = 0.f, r3 = 0.f;
    { uint2 z; z.x = 0u; z.y = 0u; *(uint2*)rp = z; }
#pragma unroll
    for (int n = 0; n < 31; n++) {
      r0 = r0 * cd + lo2f(u[n].x); r1 = r1 * cd + hi2f(u[n].x); r2 = r2 * cd + lo2f(u[n].y); r3 = r3 * cd + hi2f(u[n].y);
      uint2 o; o.x = pack2(r0, r1); o.y = pack2(r2, r3);
      *(uint2*)(rp + (size_t)(n + 1) * 32768) = o;
    }
  }
}

DI void ret_out_unit(const Params& p, int unit, char* smem) {
  const int tid = opq(threadIdx.x), lane = tid & 63, w = tid >> 6, r = lane & 31, h2 = lane >> 5, tq = w >> 1, dh = w & 1;
  const int th = unit & 1, n = (unit >> 1) & 31, bh = unit >> 6, b = bh >> 2, h = bh & 3;
  const int qt = th * 2 + tq, c = qt * 32 + r;
  const float lg = log2f(1.f - exp2f(-5.f - (float)h));
  const bf16_t* qp = p.RQ + (size_t)bh * T * 128 + ((size_t)(((n * 4 + qt) * 8) * 2 + h2)) * 256 + r * 8;
  f32x16 O[4];
  {
    const bf16_t* rp = p.Rt + ((size_t)bh * 32 + n) * 32768 + ((size_t)((dh * 4 * 8) * 2 + h2)) * 256 + r * 8;
#pragma unroll
    for (int dvt = 0; dvt < 4; dvt++)
#pragma unroll
      for (int i = 0; i < 16; i++) O[dvt][i] = 0.f;
#pragma unroll
    for (int ks = 0; ks < 8; ks++) {
      const bf16x8 qk = *(const bf16x8*)(qp + ks * 512);
#pragma unroll
      for (int dvt = 0; dvt < 4; dvt++) {
        const bf16x8 rf = *(const bf16x8*)(rp + (size_t)dvt * 4096 + ks * 512);
        O[dvt] = MFMA32(rf, qk, O[dvt]);
      }
    }
    const float xi = exp2f((float)(c + 1) * lg);
#pragma unroll
    for (int dvt = 0; dvt < 4; dvt++)
#pragma unroll
      for (int i = 0; i < 16; i++) O[dvt][i] *= xi;
  }
#pragma unroll 1
  for (int kt = 0; kt <= qt; kt++) {
    f32x16 S;
#pragma unroll
    for (int i = 0; i < 16; i++) S[i] = 0.f;
    const bf16_t* kp = p.RK + (size_t)bh * T * 128 + ((size_t)(((n * 4 + kt) * 8) * 2 + h2)) * 256 + perm23(r) * 8;
#pragma unroll
    for (int ks = 0; ks < 8; ks++) { const bf16x8 kf = *(const bf16x8*)(kp + ks * 512); const bf16x8 qk = *(const bf16x8*)(qp + ks * 512); S = MFMA32(kf, qk, S); }
    bf16x8 pf[2];
#pragma unroll
    for (int s2 = 0; s2 < 2; s2++) {
      float v[8];
#pragma unroll
      for (int jj = 0; jj < 8; jj++) {
        const int i = 8 * s2 + jj;
        const int mkey = kt * 32 + (i & 7) + 16 * (i >> 3) + 8 * h2;
        v[jj] = (mkey <= c) ? S[i] * exp2f((float)(c - mkey) * lg) : 0.f;
      }
      uint4 u; u.x = pack2(v[0], v[1]); u.y = pack2(v[2], v[3]); u.z = pack2(v[4], v[5]); u.w = pack2(v[6], v[7]);
      pf[s2] = __builtin_bit_cast(bf16x8, u);
    }
    const bf16_t* vp = p.RVt + (size_t)bh * 256 * T + ((size_t)(((dh * 4) * 256 + n * 8 + kt * 2) * 2 + h2)) * 256 + r * 8;
#pragma unroll
    for (int dvt = 0; dvt < 4; dvt++)
#pragma unroll
      for (int s2 = 0; s2 < 2; s2++) {
        const bf16x8 vf = *(const bf16x8*)(vp + (size_t)dvt * 32 * T + s2 * 512);
        O[dvt] = MFMA32(vf, pf[s2], O[dvt]);
      }
  }
  float s1 = 0.f, s2s = 0.f;
#pragma unroll
  for (int dvt = 0; dvt < 4; dvt++)
#pragma unroll
    for (int i = 0; i < 16; i++) { s1 += O[dvt][i]; s2s += O[dvt][i] * O[dvt][i]; }
  s1 += __shfl_xor(s1, 32); s2s += __shfl_xor(s2s, 32);
  float* red = (float*)smem;
  __syncthreads();
  if (h2 == 0) { red[(w * 32 + r) * 2] = s1; red[(w * 32 + r) * 2 + 1] = s2s; }
  __syncthreads();
  s1 += red[((w ^ 1) * 32 + r) * 2]; s2s += red[((w ^ 1) * 32 + r) * 2 + 1];
  const float mu = s1 * (1.f / 256.f);
  const float var = fmaxf(s2s * (1.f / 256.f) - mu * mu, 0.f);
  const float rs = rsqrtf(var + 1e-5f);
  const size_t m = (size_t)b * T + n * 128 + c;
#pragma unroll
  for (int dvt = 0; dvt < 4; dvt++)
#pragma unroll
    for (int q4 = 0; q4 < 4; q4++) {
      const int col = h * 256 + dh * 128 + dvt * 32 + q4 * 8 + 4 * h2;
      const float4 gg = *(const float4*)(p.gn_g + col), bb = *(const float4*)(p.gn_b + col);
      const uint2 rg = *(const uint2*)(p.RG + m * 1024 + col);
      const float g0 = lo2f(rg.x), g1 = hi2f(rg.x), g2 = lo2f(rg.y), g3 = hi2f(rg.y);
      const float y0 = ((O[dvt][q4 * 4] - mu) * rs * gg.x + bb.x) * g0 * sigmoidf_(g0);
      const float y1 = ((O[dvt][q4 * 4 + 1] - mu) * rs * gg.y + bb.y) * g1 * sigmoidf_(g1);
      const float y2 = ((O[dvt][q4 * 4 + 2] - mu) * rs * gg.z + bb.z) * g2 * sigmoidf_(g2);
      const float y3 = ((O[dvt][q4 * 4 + 3] - mu) * rs * gg.w + bb.w) * g3 * sigmoidf_(g3);
      uint2 o; o.x = pack2(y0, y1); o.y = pack2(y2, y3);
      *(uint2*)(p.oret + m * 1024 + col) = o;
    }
}

DI void upproj_tile(const Params& p, int tile, char* smem) {
  const int nt_ = tile & 7, mt_ = tile >> 3, m0 = mt_ * 128, n0 = nt_ * 128;
  const int lane = opq(threadIdx.x) & 63, wave = opq(threadIdx.x) >> 6, wr = wave >> 1, wc = wave & 1, fr = lane & 15, fq = lane >> 4;
  f32x4 acc[4][4]; uint2 res[4][4];
  zero_acc(acc);
  { const bf16_t* A = p.oattn + (size_t)m0 * 512; const bf16_t* Bt = p.WaT + (size_t)n0 * 512;
    gemm128<true>(acc, [=](int r) { return A + (size_t)r * 512; }, [=](int r) { return Bt + (size_t)r * 512; }, 512, smem); }
#pragma unroll
  for (int mt = 0; mt < 4; mt++)
#pragma unroll
    for (int nt = 0; nt < 4; nt++) {
      const size_t m = m0 + wr * 64 + mt * 16 + fr; const int cc = n0 + wc * 64 + nt * 16 + fq * 4;
      const uint2 gv = *(const uint2*)(p.MG + m * 2048 + cc);
      res[mt][nt].x = pack2(sigmoidf_(lo2f(gv.x)) * acc[mt][nt][0], sigmoidf_(hi2f(gv.x)) * acc[mt][nt][1]);
      res[mt][nt].y = pack2(sigmoidf_(lo2f(gv.y)) * acc[mt][nt][2], sigmoidf_(hi2f(gv.y)) * acc[mt][nt][3]);
    }
  zero_acc(acc);
  { const bf16_t* A = p.oret + (size_t)m0 * 1024; const bf16_t* Bt = p.WrT + (size_t)n0 * 1024;
    gemm128<true>(acc, [=](int r) { return A + (size_t)r * 1024; }, [=](int r) { return Bt + (size_t)r * 1024; }, 1024, smem); }
#pragma unroll
  for (int mt = 0; mt < 4; mt++)
#pragma unroll
    for (int nt = 0; nt < 4; nt++) {
      const size_t m = m0 + wr * 64 + mt * 16 + fr; const int cc = n0 + wc * 64 + nt * 16 + fq * 4;
      const uint2 gv = *(const uint2*)(p.MG + m * 2048 + 1024 + cc);
      uint2 o; o.x = pack2(lo2f(res[mt][nt].x) + sigmoidf_(lo2f(gv.x)) * acc[mt][nt][0], hi2f(res[mt][nt].x) + sigmoidf_(hi2f(gv.x)) * acc[mt][nt][1]);
      o.y = pack2(lo2f(res[mt][nt].y) + sigmoidf_(lo2f(gv.y)) * acc[mt][nt][2], hi2f(res[mt][nt].y) + sigmoidf_(hi2f(gv.y)) * acc[mt][nt][3]);
      *(uint2*)(p.merged + m * 1024 + cc) = o;
    }
}
DI void wout_tile(const Params& p, int tile, char* smem) {
  const int nt_ = tile & 7, mt_ = tile >> 3, m0 = mt_ * 128, n0 = nt_ * 128;
  f32x4 acc[4][4]; zero_acc(acc);
  const bf16_t* A = p.merged + (size_t)m0 * 1024; const bf16_t* Bt = p.WoT + (size_t)n0 * 1024;
  gemm128<true>(acc, [=](int r) { return A + (size_t)r * 1024; }, [=](int r) { return Bt + (size_t)r * 1024; }, 1024, smem);
  epilogue<true>(acc, [&](int r, int c, f32x4 v) {
    const size_t idx = (size_t)(m0 + r) * 1024 + n0 + c;
    const float4 xv = *(const float4*)(p.x + idx);
    float4 o; o.x = ALPHA * xv.x + v[0]; o.y = ALPHA * xv.y + v[1]; o.z = ALPHA * xv.z + v[2]; o.w = ALPHA * xv.w + v[3];
    *(float4*)(p.out + idx) = o;
  });
}
DI void expert_cvt_tile(const Params& p, int ct, float* tile) {
  const int e = ct / 192, rr = ct % 192;
  const float* wg = p.e_wg + (size_t)e * 1024 * 512; const float* wu = p.e_wu + (size_t)e * 1024 * 512; const float* wd = p.e_wd + (size_t)e * 512 * 1024;
  if (rr < 128)
    tcvt_tile128([=](int j) -> const float* { const int f = (j >> 7) * 64 + ((j >> 5) & 3) * 16 + (j & 15); return (((j >> 4) & 1) ? wu : wg) + f; },
                 512, p.EgT + (size_t)e * 1024 * 1024, 1024, rr >> 3, rr & 7, tile);
  else { const int q = rr - 128;
    tcvt_tile128([=](int j) -> const float* { return wd + j; }, 1024, p.EdT + (size_t)e * 1024 * 512, 512, q >> 3, q & 7, tile); }
}
DI void phase7(const Params& p, char* smem) {
  const int bid = blockIdx.x, nb = gridDim.x;
  if (bid & 1) for (int c = bid; c < 6144; c += nb) expert_cvt_tile(p, c, (float*)smem);
  for (int t = bid; t < 1024; t += nb) wout_tile(p, t, smem);
  if (!(bid & 1)) for (int c = bid; c < 6144; c += nb) expert_cvt_tile(p, c, (float*)smem);
}

DI void ln1_router(const Params& p, int m, int lane, float* xl  ) {
  float* row = p.out + (size_t)m * 1024;
  float4 v[4];
#pragma unroll
  for (int i = 0; i < 4; i++) v[i] = *(const float4*)(row + i * 256 + lane * 4);
  float s = 0.f;
#pragma unroll
  for (int i = 0; i < 4; i++) s += v[i].x + v[i].y + v[i].z + v[i].w;
  const float mu = wsum(s) * (1.f / 1024.f);
  float q = 0.f;
#pragma unroll
  for (int i = 0; i < 4; i++) { const float a = v[i].x - mu, b = v[i].y - mu, c = v[i].z - mu, d = v[i].w - mu; q += a * a + b * b + c * c + d * d; }
  const float rs = rsqrtf(wsum(q) * (1.f / 1024.f) + 1e-5f);
#pragma unroll
  for (int i = 0; i < 4; i++) {
    const int k = i * 256 + lane * 4;
    const float4 g = *(const float4*)(p.ln1_g + k), bb = *(const float4*)(p.ln1_b + k);
    v[i].x = (v[i].x - mu) * rs * g.x + bb.x; v[i].y = (v[i].y - mu) * rs * g.y + bb.y;
    v[i].z = (v[i].z - mu) * rs * g.z + bb.z; v[i].w = (v[i].w - mu) * rs * g.w + bb.w;
    *(float4*)(row + k) = v[i];
    uint2 o; o.x = pack2(v[i].x, v[i].y); o.y = pack2(v[i].z, v[i].w);
    *(uint2*)(p.x1b + (size_t)m * 1024 + k) = o;
    *(float4*)(xl + k) = v[i];
  }
  WSYNC();
  float gl[4] = {0.f, 0.f, 0.f, 0.f};
#pragma unroll 4
  for (int c = 0; c < 16; c++) {
    const int k = c * 64 + lane;
    const float xk = xl[k];
    const float4 w = *(const float4*)(p.rg_w + (size_t)k * 4);
    gl[0] += xk * w.x; gl[1] += xk * w.y; gl[2] += xk * w.z; gl[3] += xk * w.w;
  }
#pragma unroll
  for (int j = 0; j < 4; j++) gl[j] = wsum(gl[j]) + p.rg_b[j];
  int gi = 0; float gm = gl[0];
#pragma unroll
  for (int j = 1; j < 4; j++) if (gl[j] > gm) { gm = gl[j]; gi = j; }
  float gs = 0.f;
#pragma unroll
  for (int j = 0; j < 4; j++) gs += __expf(gl[j] - gm);
  const float gprob = 1.f / gs;
  const float* riw = p.ri_w + (size_t)gi * 1024 * 8 + (lane & 1) * 4;
  float tq[4] = {0.f, 0.f, 0.f, 0.f};
#pragma unroll 4
  for (int c = 0; c < 32; c++) {
    const int k = c * 32 + (lane >> 1);
    const float xk = xl[k];
    const float4 w = *(const float4*)(riw + (size_t)k * 8);
    tq[0] += xk * w.x; tq[1] += xk * w.y; tq[2] += xk * w.z; tq[3] += xk * w.w;
  }
  float il[8];
#pragma unroll
  for (int j = 0; j < 4; j++) { il[j] = wsum((lane & 1) ? 0.f : tq[j]) + p.ri_b[gi * 8 + j]; il[4 + j] = wsum((lane & 1) ? tq[j] : 0.f) + p.ri_b[gi * 8 + 4 + j]; }
  int e1 = 0; float l1 = il[0];
#pragma unroll
  for (int j = 1; j < 8; j++) if (il[j] > l1) { l1 = il[j]; e1 = j; }
  int e2 = -1; float l2 = -3e38f;
#pragma unroll
  for (int j = 0; j < 8; j++) if (j != e1 && il[j] > l2) { l2 = il[j]; e2 = j; }
  const float ex = __expf(l2 - l1);
  const float w1 = gprob / (1.f + ex), w2 = gprob * ex / (1.f + ex);
  if (lane == 0) {
    const int ea = gi * 8 + e1, eb = gi * 8 + e2;
    const int grp = blockIdx.x & 15;
    const int pa = atomicAdd(p.cnt + grp * 32 + ea, 1); p.lists[(ea * 16 + grp) * 2048 + pa] = m * 2;
    const int pb = atomicAdd(p.cnt + grp * 32 + eb, 1); p.lists[(eb * 16 + grp) * 2048 + pb] = m * 2 + 1;
    p.routew[m * 2] = w1; p.routew[m * 2 + 1] = w2;
  }
  WSYNC();
}
DI void ln2_final(const Params& p, int m, int lane) {
  float* row = p.out + (size_t)m * 1024;
  float4 v[4];
  float s = 0.f;
#pragma unroll
  for (int i = 0; i < 4; i++) {
    const int k = i * 256 + lane * 4;
    const float4 xv = *(const float4*)(row + k);
    const uint2 a = *(const uint2*)(p.part + (size_t)(2 * m) * 1024 + k), b = *(const uint2*)(p.part + (size_t)(2 * m + 1) * 1024 + k);
    v[i].x = ALPHA * xv.x + lo2f(a.x) + lo2f(b.x); v[i].y = ALPHA * xv.y + hi2f(a.x) + hi2f(b.x);
    v[i].z = ALPHA * xv.z + lo2f(a.y) + lo2f(b.y); v[i].w = ALPHA * xv.w + hi2f(a.y) + hi2f(b.y);
    s += v[i].x + v[i].y + v[i].z + v[i].w;
  }
  const float mu = wsum(s) * (1.f / 1024.f);
  float q = 0.f;
#pragma unroll
  for (int i = 0; i < 4; i++) { const float a = v[i].x - mu, b = v[i].y - mu, c = v[i].z - mu, d = v[i].w - mu; q += a * a + b * b + c * c + d * d; }
  const float rs = rsqrtf(wsum(q) * (1.f / 1024.f) + 1e-5f);
#pragma unroll
  for (int i = 0; i < 4; i++) {
    const int k = i * 256 + lane * 4;
    const float4 g = *(const float4*)(p.ln2_g + k), bb = *(const float4*)(p.ln2_b + k);
    float4 o; o.x = (v[i].x - mu) * rs * g.x + bb.x; o.y = (v[i].y - mu) * rs * g.y + bb.y; o.z = (v[i].z - mu) * rs * g.z + bb.z; o.w = (v[i].w - mu) * rs * g.w + bb.w;
    *(float4*)(row + k) = o;
  }
}

struct MoeMap { int e, mi, cnt, hoff; };
#define MOE_TAB(smem) ((int*)((smem) + 65552))
DI void moe_tables(const Params& p, char* smem) {
  int* tab = MOE_TAB(smem); int* pre = tab; int* tpre = tab + 32 * 17;
  const int tid = opq(threadIdx.x);
  __syncthreads();
  if (tid < 32) { int acc = 0; for (int g = 0; g < 16; g++) { pre[tid * 17 + g] = acc; acc += p.cnt[g * 32 + tid]; } pre[tid * 17 + 16] = acc; }
  __syncthreads();
  if (tid == 0) { int acc = 0; for (int e = 0; e < NEXP; e++) { tpre[e] = acc; acc += (pre[e * 17 + 16] + 127) >> 7; } tpre[32] = acc; }
  __syncthreads();
}
DI bool moe_map(char* smem, int mtile, MoeMap& mm) {
  const int* tab = MOE_TAB(smem); const int* pre = tab; const int* tpre = tab + 32 * 17;
  if (mtile >= tpre[32]) return false;
  int e = 0;
  while (tpre[e + 1] <= mtile) e++;
  mm.e = e; mm.mi = mtile - tpre[e]; mm.cnt = pre[e * 17 + 16]; mm.hoff = tpre[e] * 128;
  return true;
}
DI int moe_total(char* smem) { return MOE_TAB(smem)[32 * 17 + 32]; }
DI const int* moe_rows(const Params& p, const MoeMap& mm, char* smem) {
  int* tab = MOE_TAB(smem); const int* pre = tab + mm.e * 17; int* rowent = tab + 32 * 17 + 40;
  const int tid = opq(threadIdx.x);
  __syncthreads();
  if (tid < 128) {
    const int ri = mm.mi * 128 + tid; int ent = -1;
    if (ri < mm.cnt) { int g = 0; while (pre[g + 1] <= ri) g++; ent = p.lists[(mm.e * 16 + g) * 2048 + ri - pre[g]]; }
    rowent[tid] = ent;
  }
  __syncthreads();
  return rowent;
}
DI void moe_up_tile(const Params& p, const MoeMap& mm, int nt_, char* smem) {
  const int* lst = moe_rows(p, mm, smem); const int nrow = mm.cnt - mm.mi * 128;
  const bf16_t* Bt = p.EgT + ((size_t)mm.e * 1024 + nt_ * 128) * 1024;
  const bf16_t* X = p.x1b;
  f32x4 acc[4][4]; zero_acc(acc);
  gemm128<true>(acc, [=](int r) { const int tk = r < nrow ? (lst[r] >> 1) : 0; return X + (size_t)tk * 1024; }, [=](int r) { return Bt + (size_t)r * 1024; }, 1024, smem);
  const int lane = opq(threadIdx.x) & 63, wave = opq(threadIdx.x) >> 6, wr = wave >> 1, wc = wave & 1, fr = lane & 15, fq = lane >> 4;
#pragma unroll
  for (int mt = 0; mt < 4; mt++) {
    const int r = wr * 64 + mt * 16 + fr;
    if (r < nrow) {
      const float w = p.routew[lst[r]];
#pragma unroll
      for (int np = 0; np < 2; np++) {
        const f32x4 g = acc[mt][np * 2], u = acc[mt][np * 2 + 1];
        float hv[4];
#pragma unroll
        for (int i = 0; i < 4; i++) hv[i] = g[i] * sigmoidf_(g[i]) * u[i] * w;
        const int f = nt_ * 64 + wc * 32 + np * 16 + fq * 4;
        uint2 o; o.x = pack2(hv[0], hv[1]); o.y = pack2(hv[2], hv[3]);
        *(uint2*)(p.Hh + (size_t)(mm.hoff + mm.mi * 128 + r) * 512 + f) = o;
      }
    }
  }
}
DI void moe_down_tile(const Params& p, const MoeMap& mm, int nt_, char* smem) {
  const int* lst = moe_rows(p, mm, smem); const int nrow = mm.cnt - mm.mi * 128;
  const bf16_t* A = p.Hh + (size_t)(mm.hoff + mm.mi * 128) * 512;
  const bf16_t* Bt = p.EdT + ((size_t)mm.e * 1024 + nt_ * 128) * 512;
  f32x4 acc[4][4]; zero_acc(acc);
  gemm128<true>(acc, [=](int r) { return A + (size_t)r * 512; }, [=](int r) { return Bt + (size_t)r * 512; }, 512, smem);
  epilogue<true>(acc, [&](int r, int c, f32x4 v) {
    if (r < nrow) {
      const int ts = lst[r];
      uint2 o; o.x = pack2(v[0], v[1]); o.y = pack2(v[2], v[3]);
      *(uint2*)(p.part + (size_t)ts * 1024 + nt_ * 128 + c) = o;
    }
  });
}

constexpr int NPHASE = 12;
#if FUSED
#define PHFN DI
#else
#define PHFN DI
#endif
#define PH_PRE const int bid = blockIdx.x, nb = gridDim.x, tid = opq(threadIdx.x), lane = tid & 63, wave = tid >> 6; \
  const int gw = bid * 4 + wave, nw = nb * 4; char* wsm = smem + wave * 8192; (void)bid; (void)nb; (void)lane; (void)gw; (void)nw; (void)wsm;
PHFN void ph0(const Params& p, char* smem) { phase0(p, smem); }
PHFN void ph1(const Params& p, char* smem) { phase1(p, smem); }
PHFN void ph2(const Params& p, char* smem) { PH_PRE
  for (int t = bid; t < 256 + 512; t += nb) { if (t < 256) compress1_tile(p, t, smem); else if (((t - 256) & 31) != 31) ret_u_unit(p, t - 256); }
}
PHFN void ph3(const Params& p, char* smem) { compress2(p, smem); ret_scan_elem(p); }
PHFN void ph4(const Params& p, char* smem) { PH_PRE
  for (int u = bid; u < 1024; u += nb) cmp_unit(p, u, smem);
}
PHFN void ph5(const Params& p, char* smem) { PH_PRE
  for (int u = bid; u < 512; u += nb) { const int k = u >> 3; attn_unit(p, ((u & 7) << 6) | (k < 32 ? 63 - k : k - 32), smem); }
  {
    int* sh = (int*)(smem + 65552 + 3072);
    for (;;) {
      __syncthreads();
      if (tid == 0) sh[0] = (int)xb_add(&p.qctr[0], 1u);
      __syncthreads();
      const int u = sh[0];
      if (u >= 1024) break;
      ret_out_unit(p, u, smem);
    }
  }
}
PHFN void ph6(const Params& p, char* smem) { PH_PRE for (int t = bid; t < 1024; t += nb) upproj_tile(p, t, smem); }
PHFN void ph7(const Params& p, char* smem) { phase7(p, smem); }
PHFN void ph8(const Params& p, char* smem) { PH_PRE for (int m = gw; m < M; m += nw) ln1_router(p, m, lane, (float*)wsm); }
PHFN void ph9(const Params& p, char* smem) { PH_PRE moe_tables(p, smem); const int tot = moe_total(smem);
  for (int t = bid; t < tot * 8; t += nb) { MoeMap mm; if (moe_map(smem, t >> 3, mm)) moe_up_tile(p, mm, t & 7, smem); } }
PHFN void ph10(const Params& p, char* smem) { PH_PRE moe_tables(p, smem); const int tot = moe_total(smem);
  for (int t = bid; t < tot * 8; t += nb) { MoeMap mm; if (moe_map(smem, t >> 3, mm)) moe_down_tile(p, mm, t & 7, smem); } }
PHFN void ph11(const Params& p, char* smem) { PH_PRE for (int m = gw; m < M; m += nw) ln2_final(p, m, lane); }
DI void run_phase(const Params& p, const int ph, char* smem) {
  switch (ph) {
    case 0: ph0(p, smem); break; case 1: ph1(p, smem); break; case 2: ph2(p, smem); break; case 3: ph3(p, smem); break;
    case 4: ph4(p, smem); break; case 5: ph5(p, smem); break; case 6: ph6(p, smem); break; case 7: ph7(p, smem); break;
    case 8: ph8(p, smem); break; case 9: ph9(p, smem); break; case 10: ph10(p, smem); break; case 11: ph11(p, smem); break;
  }
}

template <int PH>
__global__ void __launch_bounds__(256, 2) phase_kernel(Params p) {
  __shared__ __attribute__((aligned(16))) char smem[65536 + 16 + 4096];
  run_phase(p, PH, smem);
}
#if FUSED
__global__ void __launch_bounds__(256, 2) mega_kernel(Params p_arg) {
  __shared__ __attribute__((aligned(16))) char smem[65536 + 16 + 4096];
  const Params& p = *(const Params*)__builtin_amdgcn_kernarg_segment_ptr();
  volatile LAS unsigned* st = (volatile LAS unsigned*)(smem + 65536);
  if (threadIdx.x == 0) { st[0] = 0u; st[1] = 0u; }
  __syncthreads();
  const XcdBarrier xb = xcd_barrier_post(p.bar, st);
#define GSYNC() xcd_barrier(xb)
  unsigned long long tk_ = 0; (void)tk_;
#define RUNPH(N) { unsigned long long t0_ = 0; if (PROBE_PHASE == N) t0_ = __builtin_amdgcn_s_memrealtime(); ph##N(p, smem); if (PROBE_DOUBLE & (1 << N)) { GSYNC(); ph##N(p, smem); } \
    if (PROBE_PHASE == N) { GSYNC(); tk_ = __builtin_amdgcn_s_memrealtime() - t0_; } }
  RUNPH(0); GSYNC(); RUNPH(1); GSYNC(); RUNPH(2); GSYNC(); RUNPH(3); GSYNC();
  RUNPH(4); GSYNC(); RUNPH(5); GSYNC(); RUNPH(6); GSYNC(); RUNPH(7); GSYNC();
  RUNPH(8); GSYNC(); RUNPH(9); GSYNC(); RUNPH(10); GSYNC(); RUNPH(11);
  if (PROBE_PHASE >= 0 && blockIdx.x == 0) { const unsigned long long t1_ = __builtin_amdgcn_s_memrealtime(); while (__builtin_amdgcn_s_memrealtime() - t1_ < 3ull * tk_) __builtin_amdgcn_s_sleep(8); }
}
#endif

extern "C" void kernel_launch(void* const* d_in, const int* in_sizes, int n_in, void* d_out, int out_size,
                              void* d_ws, size_t ws_size, hipStream_t stream) {
  Params p{};
  const float** ins = (const float**)&p;
  for (int i = 0; i < 28; i++) ins[i] = (const float*)d_in[i];
  p.out = (float*)d_out;
  char* ws = (char*)d_ws; size_t off = 0;
  auto alloc = [&](size_t bytes) { char* r = ws + off; off += (bytes + 255) & ~(size_t)255; return r; };
  const size_t MiB = 1 << 20;
  char* regionP = ws;
  p.Qn = (bf16_t*)alloc(16 * MiB);
  p.CK = (bf16_t*)alloc(4 * MiB); p.CV = (bf16_t*)alloc(4 * MiB); p.SK = (bf16_t*)alloc(4 * MiB); p.SVt = (bf16_t*)alloc(4 * MiB);
  p.WK = (bf16_t*)alloc(4 * MiB); p.WVt = (bf16_t*)alloc(4 * MiB);
  p.NG = (float*)alloc((size_t)M * 24 * 4);
  p.RQ = (bf16_t*)alloc(16 * MiB); p.RK = (bf16_t*)alloc(16 * MiB); p.RKzT = (bf16_t*)alloc(16 * MiB);
  p.RVt = (bf16_t*)alloc(32 * MiB); p.RG = (bf16_t*)alloc(32 * MiB); p.MG = (bf16_t*)alloc(64 * MiB);
  p.oattn = (bf16_t*)alloc(16 * MiB); p.WinT = p.oattn;
  p.oret = (bf16_t*)alloc(32 * MiB);
  p.WaT = (bf16_t*)alloc(1 * MiB); p.WrT = (bf16_t*)alloc(2 * MiB); p.WoT = (bf16_t*)alloc(2 * MiB);
  p.W1kT = (bf16_t*)alloc(1 * MiB); p.W1vT = (bf16_t*)alloc(1 * MiB);
  p.ropeN = (float*)alloc((size_t)T * 32 * 8); p.ropeR = (float*)alloc((size_t)T * 64 * 8); p.posb = (float*)alloc(512 * 4); p.posp = (float*)alloc(32 * 512 * 4);
  p.H1 = (bf16_t*)alloc(2 * MiB); p.kcmp = (bf16_t*)alloc(8 * 256 * 64 * 2); p.vcmpT = (bf16_t*)alloc(8 * 64 * 256 * 2);
  p.selmask = (unsigned long long*)alloc((size_t)8 * T * 8);
  p.cnt = (int*)alloc(512 * 4); p.lists = (int*)alloc((size_t)NEXP * 16 * 2048 * 4); p.routew = (float*)alloc((size_t)M * 2 * 4);
  p.merged = (bf16_t*)(regionP); p.x1b = (bf16_t*)(regionP + 32 * MiB);
  p.EgT = (bf16_t*)(regionP + 64 * MiB); p.EdT = (bf16_t*)(regionP + 128 * MiB);
  p.Hh = (bf16_t*)(regionP + 160 * MiB); p.part = (bf16_t*)(regionP + 196 * MiB);
  p.bar = (unsigned*)alloc((XCD_BAR_WORDS + 64) * 4); p.qctr = p.bar + XCD_BAR_WORDS;
  p.xb = (bf16_t*)d_out; p.Rt = (bf16_t*)d_out; p.Ut = (bf16_t*)d_out + (size_t)16 * 1024 * 1024;
  if (off > ws_size) { fprintf(stderr, "workspace too small: need %zu have %zu\n", off, ws_size); return; }
#if FUSED
  static int grid_blocks = 0;
  if (!grid_blocks) {
    int dev = 0, cus = 0, per_cu = 0;
    (void)hipGetDevice(&dev);
    (void)hipDeviceGetAttribute(&cus, hipDeviceAttributeMultiprocessorCount, dev);
    (void)hipOccupancyMaxActiveBlocksPerMultiprocessor(&per_cu, mega_kernel, 256, 0);
    if (per_cu > 2) per_cu = 2;
    grid_blocks = cus * per_cu;
  }
  (void)hipMemsetAsync(p.bar, 0, (XCD_BAR_WORDS + 64) * 4, stream);
  void* args[] = {&p};
  hipError_t e = hipLaunchCooperativeKernel((void*)mega_kernel, dim3(grid_blocks), dim3(256), args, 0, stream);
  if (e != hipSuccess) fprintf(stderr, "coop launch failed: %s\n", hipGetErrorString(e));
#else
(void)hipMemsetAsync(p.bar, 0, (XCD_BAR_WORDS + 64) * 4, stream);
#define LAUNCH_PH(N) phase_kernel<N><<<512, 256, 0, stream>>>(p)
  LAUNCH_PH(0); LAUNCH_PH(1); LAUNCH_PH(2); LAUNCH_PH(3); LAUNCH_PH(4); LAUNCH_PH(5);
  LAUNCH_PH(6); LAUNCH_PH(7); LAUNCH_PH(8); LAUNCH_PH(9); LAUNCH_PH(10); LAUNCH_PH(11);
#endif
}
```

```cpp
#include <hip/hip_runtime.h>
#include <hip/hip_cooperative_groups.h>
#include <cstdio>
#include <cstdint>
namespace cg = cooperative_groups;

#ifndef FUSED
#define FUSED 1
#endif
#ifndef PROBE_DOUBLE
#define PROBE_DOUBLE 0
#endif
#ifndef PROBE_ROUTER
#define PROBE_ROUTER 0
#endif
#ifndef PROBE_PHASE
#define PROBE_PHASE -1
#endif

#define DI __device__ __forceinline__
typedef unsigned short bf16_t;
typedef short bf16x8 __attribute__((ext_vector_type(8)));
typedef float f32x4 __attribute__((ext_vector_type(4)));

constexpr int Bn = 4, T = 4096, D = 1024, M = Bn * T;
constexpr int NINP = 6528;
constexpr int NEXP = 32, DFF = 512;
constexpr int HROWS = 36864;
constexpr float ALPHA = 1.189207115002721f;

struct Params {
  const float *x, *w_in, *cmp_pos_k, *cmp_k_w1, *cmp_k_b1, *cmp_k_w2, *cmp_k_b2;
  const float *cmp_pos_v, *cmp_v_w1, *cmp_v_b1, *cmp_v_w2, *cmp_v_b2;
  const float *gn_g, *gn_b, *w_up_attn, *w_up_ret, *w_out, *ln1_g, *ln1_b;
  const float *rg_w, *rg_b, *ri_w, *ri_b, *e_wg, *e_wu, *e_wd, *ln2_g, *ln2_b;
  float* out;
  bf16_t *Qn, *CK, *CV, *SK, *SVt, *WK, *WVt; float* NG;
  bf16_t *RQ, *RK, *RKzT, *RVt, *RG, *MG;
  bf16_t *WinT  , *oattn, *oret;
  bf16_t *WaT, *WrT, *WoT, *W1kT, *W1vT;
  float *ropeN, *ropeR, *posb, *posp;
  bf16_t *H1, *kcmp, *vcmpT;
  unsigned long long* selmask;
  int* cnt; int* lists; float* routew;
  bf16_t *merged, *x1b, *EgT  , *EdT  , *Hh, *part;
  bf16_t *xb, *Rt, *Ut;
  unsigned* bar;
  unsigned* qctr;
};

DI float bf2f(bf16_t v) { return __uint_as_float(((unsigned)v) << 16); }
typedef __bf16 bf16x2_t __attribute__((ext_vector_type(2)));
DI bf16_t f2bf(float f) { return __builtin_bit_cast(bf16_t, (__bf16)f); }
DI unsigned pack2(float a, float b) { bf16x2_t v = {(__bf16)a, (__bf16)b}; return __builtin_bit_cast(unsigned, v); }
typedef float f32x16 __attribute__((ext_vector_type(16)));
#define MFMA32(a, b, c) __builtin_amdgcn_mfma_f32_32x32x16_bf16((a), (b), (c), 0, 0, 0)
DI float lo2f(unsigned u) { return __uint_as_float(u << 16); }
DI float hi2f(unsigned u) { return __uint_as_float(u & 0xffff0000u); }
DI float wsum(float v) {
  v += __int_as_float(__builtin_amdgcn_update_dpp(0, __float_as_int(v), 0x111, 0xf, 0xf, false));
  v += __int_as_float(__builtin_amdgcn_update_dpp(0, __float_as_int(v), 0x112, 0xf, 0xf, false));
  v += __int_as_float(__builtin_amdgcn_update_dpp(0, __float_as_int(v), 0x114, 0xf, 0xf, false));
  v += __int_as_float(__builtin_amdgcn_update_dpp(0, __float_as_int(v), 0x118, 0xf, 0xf, false));
  v += __int_as_float(__builtin_amdgcn_update_dpp(0, __float_as_int(v), 0x142, 0xa, 0xf, false));
  v += __int_as_float(__builtin_amdgcn_update_dpp(0, __float_as_int(v), 0x143, 0xc, 0xf, false));
  return __int_as_float(__builtin_amdgcn_readlane(__float_as_int(v), 63));
}
DI float wmax(float v) { for (int o = 32; o > 0; o >>= 1) v = fmaxf(v, __shfl_xor(v, o)); return v; }
DI float sigmoidf_(float x) { return 1.f / (1.f + __expf(-x)); }
#define WSYNC() asm volatile("s_waitcnt lgkmcnt(0)" ::: "memory")
DI size_t frag_off(int row, int k, int K) { return ((size_t)(((row >> 5) * (K >> 4) + (k >> 4)) * 2 + ((k >> 3) & 1))) * 256 + (row & 31) * 8 + (k & 7); }
DI int perm23(int r) { return (r & 0x13) | ((r & 4) << 1) | ((r & 8) >> 1); }
DI int opq(int x) { asm volatile("" : "+v"(x)); return x; }


#define XB_TMO      128
#define XB_XCNT(j)  (256  + 64 * (j))
#define XB_XSUB(j)  (1280 + 64 * (j))
#define XB_XGEN(j)  (2304 + 64 * (j))
#define XB_TOP      3328
#define XB_TOPGEN   3392
#define XCD_BAR_WORDS 3456
#define XB_SPIN_CAP (1u << 20)
#define LAS __attribute__((address_space(3)))
DI unsigned xb_ld(unsigned* p) { return __hip_atomic_load(p, __ATOMIC_RELAXED, __HIP_MEMORY_SCOPE_AGENT); }
DI unsigned xb_add(unsigned* p, unsigned v) { return __hip_atomic_fetch_add(p, v, __ATOMIC_RELAXED, __HIP_MEMORY_SCOPE_AGENT); }
DI unsigned xb_xcc_id() { return (unsigned)__builtin_amdgcn_s_getreg((3 << 11) | 20) & 0xFu; }
#define XB_SPIN(cond, bar) do { unsigned _sp = 0; while (cond) { __builtin_amdgcn_s_sleep(1); \
    if ((++_sp & 255u) == 0u) { if (xb_ld(&(bar)[XB_TMO])) break; if (_sp > XB_SPIN_CAP) { atomicAdd(&(bar)[XB_TMO], 1u); break; } } } } while (0)
struct XcdBarrier { unsigned* bar; unsigned x; volatile LAS unsigned* st; };
DI XcdBarrier xcd_barrier_post(unsigned* bar, volatile LAS unsigned* st) {
  XcdBarrier b; b.bar = bar; b.x = xb_xcc_id(); b.st = st;
  if (threadIdx.x == 0) (void)xb_add(&bar[XB_XCNT(b.x)], 1u);
  return b;
}
DI void xcd_barrier_complete(unsigned* bar, unsigned x, unsigned& nloc, unsigned& nx) {
  const unsigned G = gridDim.x * gridDim.y * gridDim.z;
  unsigned sum, cnt, mine, sp = 0u;
  for (;;) {
    sum = 0u; cnt = 0u; mine = 0u;
#pragma unroll
    for (unsigned j = 0; j < 16; ++j) { const unsigned c = xb_ld(&bar[XB_XCNT(j)]); sum += c; cnt += (c > 0u) ? 1u : 0u; mine = (j == x) ? c : mine; }
    if (sum == G) break;
    __builtin_amdgcn_s_sleep(1);
    if ((++sp & 255u) == 0u) { if (xb_ld(&bar[XB_TMO])) break; if (sp > XB_SPIN_CAP) { atomicAdd(&bar[XB_TMO], 1u); break; } }
  }
  nloc = mine > 0u ? mine : 1u; nx = cnt > 0u ? cnt : 1u;
}
DI void xcd_barrier(const XcdBarrier& b) {
  asm volatile("s_waitcnt vmcnt(0)" ::: "memory");
  __syncthreads();
  if (threadIdx.x == 0) {
    unsigned* bar = b.bar;
    __builtin_amdgcn_s_waitcnt(0);
    unsigned nloc = b.st[0], nx = b.st[1];
    if (nloc == 0u) { xcd_barrier_complete(bar, b.x, nloc, nx); b.st[0] = nloc; b.st[1] = nx; }
    const unsigned old = xb_add(&bar[XB_XSUB(b.x)], 1u);
    const unsigned gen = old / nloc;
    if (old + 1u == (gen + 1u) * nloc) {
      __builtin_amdgcn_fence(__ATOMIC_RELEASE, "agent");
      asm volatile("s_waitcnt vmcnt(0)" ::: "memory");
      const unsigned og = xb_add(&bar[XB_TOP], 1u);
      const unsigned tg = og / nx;
      if (og + 1u == (tg + 1u) * nx) xb_add(&bar[XB_TOPGEN], 1u);
      else XB_SPIN(xb_ld(&bar[XB_TOPGEN]) == tg, bar);
      __builtin_amdgcn_fence(__ATOMIC_ACQUIRE, "agent");
      xb_add(&bar[XB_XGEN(b.x)], 1u);
      asm volatile("s_waitcnt vmcnt(0)" ::: "memory");
    } else {
      XB_SPIN(xb_ld(&bar[XB_XGEN(b.x)]) == gen, bar);
      __builtin_amdgcn_fence(__ATOMIC_ACQUIRE, "agent");
      asm volatile("s_waitcnt vmcnt(0)" ::: "memory");
    }
  }
  __syncthreads();
}

DI void glds16_asm(const void* gsrc, unsigned lds_dst) {
  unsigned keep;
  asm volatile("s_mov_b32 %0, m0\n\ts_mov_b32 m0, %2\n\ts_nop 0\n\tglobal_load_lds_dwordx4 %1, off\n\ts_mov_b32 m0, %0" : "=&s"(keep) : "v"(gsrc), "s"(lds_dst) : "memory");
}
template <bool SWAP, class AR, class BR>
DI void gemm128(f32x4 (&acc)[4][4], AR arow, BR brow, int K, char* smem) {
  const int tid = opq(threadIdx.x), lane = tid & 63, wave = tid >> 6, wr = wave >> 1, wc = wave & 1;
  const int prow = lane >> 3, pch = ((lane & 7) ^ prow) << 3;
  const bf16_t* ap[4]; const bf16_t* bp[4];
#pragma unroll
  for (int i = 0; i < 4; i++) { ap[i] = arow((wave * 4 + i) * 8 + prow) + pch; bp[i] = brow((wave * 4 + i) * 8 + prow) + pch; }
  const unsigned ldsb = (unsigned)(size_t)(LAS char*)smem;
  const unsigned lpiece = __builtin_amdgcn_readfirstlane(wave * 4096);
  char* As = smem; char* Bs = smem + 32768;
  const int nk = K >> 6;
  const int fr = lane & 15, fq = lane >> 4;
  const int aoff0 = (wr * 64 + fr) * 128, boff0 = (wc * 64 + fr) * 128;
  auto gload = [&](int t, int buf) {
#pragma unroll
    for (int i = 0; i < 4; i++) {
      glds16_asm(ap[i] + t * 64, ldsb + buf * 16384 + lpiece + i * 1024);
      glds16_asm(bp[i] + t * 64, ldsb + 32768 + buf * 16384 + lpiece + i * 1024);
    }
  };
  auto gcomp = [&](int buf) {
    const char* Ac = As + buf * 16384; const char* Bc = Bs + buf * 16384;
#pragma unroll
    for (int ks = 0; ks < 2; ks++) {
      const int chs = ((ks * 4 + fq) ^ (fr & 7)) << 4;
      bf16x8 a[4], b[4];
#pragma unroll
      for (int mt = 0; mt < 4; mt++) a[mt] = *(const bf16x8*)(Ac + aoff0 + mt * 2048 + chs);
#pragma unroll
      for (int nt = 0; nt < 4; nt++) b[nt] = *(const bf16x8*)(Bc + boff0 + nt * 2048 + chs);
      __builtin_amdgcn_s_setprio(1);
#pragma unroll
      for (int mt = 0; mt < 4; mt++)
#pragma unroll
        for (int nt = 0; nt < 4; nt++)
          acc[mt][nt] = SWAP ? __builtin_amdgcn_mfma_f32_16x16x32_bf16(b[nt], a[mt], acc[mt][nt], 0, 0, 0)
                             : __builtin_amdgcn_mfma_f32_16x16x32_bf16(a[mt], b[nt], acc[mt][nt], 0, 0, 0);
      __builtin_amdgcn_s_setprio(0);
    }
  };
  asm volatile("s_waitcnt vmcnt(0)" ::: "memory");
  gload(0, 0);
  asm volatile("s_waitcnt vmcnt(0)" ::: "memory");
  __builtin_amdgcn_s_barrier();
#pragma unroll 1
  for (int kt = 0; kt < nk; kt++) {
    const int cur = kt & 1;
    if (kt + 1 < nk) gload(kt + 1, cur ^ 1);
    gcomp(cur);
    asm volatile("s_waitcnt vmcnt(0)" ::: "memory");
    __builtin_amdgcn_s_barrier();
  }
}
template <bool SWAP, class AR, class BC>
DI void gemm128f(f32x4 (&acc)[4][4], AR arow, BC bcol, int ldb, int K, char* smem) {
  const int tid = opq(threadIdx.x), lane = tid & 63, wave = tid >> 6, wr = wave >> 1, wc = wave & 1;
  const int srow = tid >> 3, sch = tid & 7;
  const int bn = tid & 127, bh = tid >> 7;
  const bf16_t* ap[4];
#pragma unroll
  for (int i = 0; i < 4; i++) ap[i] = arow(srow + 32 * i) + sch * 8;
  const float* bq = bcol(bn) + (size_t)(bh * 32) * ldb;
  const int woff = srow * 128 + ((sch ^ (srow & 7)) << 4);
  char* As = smem; char* Bs = smem + 32768;
  uint4 ra[4]; float rb[4][8];
  auto bload = [&](int kt) {
    const float* q = bq + (size_t)kt * 64 * ldb;
#pragma unroll
    for (int i = 0; i < 4; i++)
#pragma unroll
      for (int j = 0; j < 8; j++) rb[i][j] = q[(size_t)(i * 8 + j) * ldb];
  };
  auto bwrite = [&](char* Bd) {
#pragma unroll
    for (int i = 0; i < 4; i++) {
      uint4 u; u.x = pack2(rb[i][0], rb[i][1]); u.y = pack2(rb[i][2], rb[i][3]); u.z = pack2(rb[i][4], rb[i][5]); u.w = pack2(rb[i][6], rb[i][7]);
      *(uint4*)(Bd + bn * 128 + ((((bh * 4 + i)) ^ (bn & 7)) << 4)) = u;
    }
  };
#pragma unroll
  for (int i = 0; i < 4; i++) ra[i] = *(const uint4*)(ap[i]);
  bload(0);
#pragma unroll
  for (int i = 0; i < 4; i++) *(uint4*)(As + woff + i * 4096) = ra[i];
  bwrite(Bs);
  __syncthreads();
  const int nk = K >> 6;
  const int fr = lane & 15, fq = lane >> 4;
  const int aoff0 = (wr * 64 + fr) * 128, boff0 = (wc * 64 + fr) * 128;
  for (int kt = 0; kt < nk; kt++) {
    const int cur = kt & 1;
    if (kt + 1 < nk) {
#pragma unroll
      for (int i = 0; i < 4; i++) ra[i] = *(const uint4*)(ap[i] + (kt + 1) * 64);
      bload(kt + 1);
    }
    const char* Ac = As + cur * 16384; const char* Bc = Bs + cur * 16384;
#pragma unroll
    for (int ks = 0; ks < 2; ks++) {
      const int chs = ((ks * 4 + fq) ^ (fr & 7)) << 4;
      bf16x8 a[4], b[4];
#pragma unroll
      for (int mt = 0; mt < 4; mt++) a[mt] = *(const bf16x8*)(Ac + aoff0 + mt * 2048 + chs);
#pragma unroll
      for (int nt = 0; nt < 4; nt++) b[nt] = *(const bf16x8*)(Bc + boff0 + nt * 2048 + chs);
#pragma unroll
      for (int mt = 0; mt < 4; mt++)
#pragma unroll
        for (int nt = 0; nt < 4; nt++)
          acc[mt][nt] = SWAP ? __builtin_amdgcn_mfma_f32_16x16x32_bf16(b[nt], a[mt], acc[mt][nt], 0, 0, 0)
                             : __builtin_amdgcn_mfma_f32_16x16x32_bf16(a[mt], b[nt], acc[mt][nt], 0, 0, 0);
    }
    if (kt + 1 < nk) {
      char* An = As + (cur ^ 1) * 16384;
#pragma unroll
      for (int i = 0; i < 4; i++) *(uint4*)(An + woff + i * 4096) = ra[i];
      bwrite(Bs + (cur ^ 1) * 16384);
    }
    __syncthreads();
  }
}
DI void zero_acc(f32x4 (&acc)[4][4]) {
#pragma unroll
  for (int i = 0; i < 4; i++)
#pragma unroll
    for (int j = 0; j < 4; j++) acc[i][j] = (f32x4){0.f, 0.f, 0.f, 0.f};
}
template <bool SWAP, class F>
DI void epilogue(const f32x4 (&acc)[4][4], F f) {
  const int lane = opq(threadIdx.x) & 63, wave = opq(threadIdx.x) >> 6, wr = wave >> 1, wc = wave & 1, fr = lane & 15, fq = lane >> 4;
#pragma unroll
  for (int mt = 0; mt < 4; mt++)
#pragma unroll
    for (int nt = 0; nt < 4; nt++) {
      if (SWAP) f(wr * 64 + mt * 16 + fr, wc * 64 + nt * 16 + fq * 4, acc[mt][nt]);
      else f(wr * 64 + mt * 16 + fq * 4, wc * 64 + nt * 16 + fr, acc[mt][nt]);
    }
}

template <class CP>
DI void tcvt_tile(CP colptr, int ldsrc, bf16_t* dst, int K, int kt, int jt, float* tile) {
  const int tx = opq(threadIdx.x) & 63, ty = opq(threadIdx.x) >> 6;
  const float* sp = colptr(jt * 64 + tx);
  for (int i = ty; i < 64; i += 4) tile[i * 65 + tx] = sp ? sp[(size_t)(kt * 64 + i) * ldsrc] : 0.f;
  __syncthreads();
  for (int i = ty * 2 + (tx >> 5); i < 64; i += 8) {
    const int kk = (tx & 31) * 2;
    *(unsigned*)(dst + (size_t)(jt * 64 + i) * K + kt * 64 + kk) = pack2(tile[kk * 65 + i], tile[(kk + 1) * 65 + i]);
  }
  __syncthreads();
}
template <class CP>
DI void tcvt_all(CP colptr, int ldsrc, bf16_t* dst, int K, int N, float* tile, int bid, int nb) {
  const int nkt = K / 64, njt = N / 64;
  for (int t = bid; t < nkt * njt; t += nb) tcvt_tile(colptr, ldsrc, dst, K, t / njt, t % njt, tile);
}

template <class CP>
DI void tcvt_tile128(CP colptr, int ldsrc, bf16_t* dst, int K, int kt, int jt, float* tile  ) {
  const int tid = opq(threadIdx.x), tx = tid & 127, ty = tid >> 7;
  const float* sp0 = colptr(jt * 128 + tx);
  const float* sp = sp0 + (size_t)(kt * 64 + ty) * ldsrc;
  float v[32];
  if (sp0) {
#pragma unroll
    for (int i = 0; i < 32; i++) v[i] = sp[(size_t)(2 * i) * ldsrc];
  } else {
#pragma unroll
    for (int i = 0; i < 32; i++) v[i] = 0.f;
  }
#pragma unroll
  for (int i = 0; i < 32; i++) tile[(ty + 2 * i) * 129 + tx] = v[i];
  __syncthreads();
  const int pp = (tid & 31) * 2, j0 = tid >> 5;
#pragma unroll
  for (int i = 0; i < 16; i++) {
    const int j = j0 + 8 * i;
    *(unsigned*)(dst + (size_t)(jt * 128 + j) * K + kt * 64 + pp) = pack2(tile[pp * 129 + j], tile[(pp + 1) * 129 + j]);
  }
  __syncthreads();
}
DI int perm_half(int p, int d) { return (p & 1) ? (d / 2 + (p >> 1)) : (p >> 1); }
DI int inproj_col(int j) {
  if (j < 512) return (j & ~63) + perm_half(j & 63, 64);
  if (j < 1280) { const int grp = (j - 512) >> 7;
    if (grp == 2 || grp == 4) return (j & ~63) + perm_half(j & 63, 64);
    return j; }
  if (j < 1792) { const int q = j - 1280; return 1304 + (q & ~127) + perm_half(q & 127, 128); }
  if (j < 2304) { const int q = j - 1792; return 1816 + (q & ~127) + perm_half(q & 127, 128); }
  if (j < 3328) return 2328 + (j - 2304);
  if (j < 4352) return 3352 + (j - 3328);
  if (j < 6400) return 4376 + (j - 4352);
  const int q = j - 6400; return q < 24 ? 1280 + q : -1;
}

DI void phase0(const Params& p, char* smem) {
  const int bid = blockIdx.x, nb = gridDim.x, tid = opq(threadIdx.x);
  const size_t gtid = (size_t)bid * 256 + tid, gsz = (size_t)nb * 256;
  for (size_t i = gtid; i < (size_t)M * D / 4; i += gsz) {
    const float4 v = ((const float4*)p.x)[i];
    uint2 o; o.x = pack2(v.x, v.y); o.y = pack2(v.z, v.w);
    ((uint2*)p.xb)[i] = o;
  }
  float* tile = (float*)smem;
  for (int tt = bid; tt < 1264; tt += nb) {
    if (tt < 816) { const float* w = p.w_in; tcvt_tile128([=](int j) -> const float* { const int c = inproj_col(j); return c >= 0 ? w + c : nullptr; }, 6424, p.WinT, 1024, tt / 51, tt % 51, tile); }
    else if (tt < 880) { const int q = tt - 816; const float* w = p.w_up_attn; tcvt_tile128([=](int j) -> const float* { return w + j; }, 1024, p.WaT, 512, q >> 3, q & 7, tile); }
    else if (tt < 1008) { const int q = tt - 880; const float* w = p.w_up_ret; tcvt_tile128([=](int j) -> const float* { return w + j; }, 1024, p.WrT, 1024, q >> 3, q & 7, tile); }
    else if (tt < 1136) { const int q = tt - 1008; const float* w = p.w_out; tcvt_tile128([=](int j) -> const float* { return w + j; }, 1024, p.WoT, 1024, q >> 3, q & 7, tile); }
    else if (tt < 1200) { const int q = tt - 1136; const float* w = p.cmp_k_w1; tcvt_tile128([=](int j) -> const float* { return w + j; }, 256, p.W1kT, 2048, q >> 1, q & 1, tile); }
    else { const int q = tt - 1200; const float* w = p.cmp_v_w1; tcvt_tile128([=](int j) -> const float* { return w + j; }, 256, p.W1vT, 2048, q >> 1, q & 1, tile); }
  }
  for (size_t i = gtid; i < (size_t)T * 96; i += gsz) {
    const int t = (int)(i / 96), r = (int)(i % 96);
    float invf; float* dst;
    if (r < 32) { invf = (float)exp2(-(double)r * (2.0 / 64.0) * 13.287712379549449); dst = p.ropeN + ((size_t)t * 32 + r) * 2; }
    else { const int q = r - 32; invf = (float)exp2(-(double)q * (2.0 / 128.0) * 13.287712379549449); dst = p.ropeR + ((size_t)t * 64 + q) * 2; }
    const double ang = (double)((float)t * invf);
    const double kk = rint(ang * 0.15915494309189535);
    const float red = (float)(ang - kk * 6.283185307179586);
    dst[0] = cosf(red); dst[1] = sinf(red);
  }
  for (size_t i = gtid; i < 32 * 512; i += gsz) {
    const int qp = (int)(i >> 9), kv = (int)((i >> 8) & 1), j = (int)(i & 255);
    const float* pos = kv ? p.cmp_pos_v : p.cmp_pos_k; const float* w1 = kv ? p.cmp_v_w1 : p.cmp_k_w1;
    float s0 = 0.f;
#pragma unroll 8
    for (int q = qp * 64; q < qp * 64 + 64; q++) s0 += pos[q] * w1[(size_t)q * 256 + j];
    p.posp[i] = s0;
  }
  if (gtid < 512) p.cnt[gtid] = 0;
}

template <bool TRANS, class PROC, class DST>
DI void epilogue_lds(const f32x4 (&acc)[4][4], PROC proc, DST dst, char* smem) {
  const int tid = opq(threadIdx.x), lane = tid & 63, wave = tid >> 6, wr = wave >> 1, wc = wave & 1, fr = lane & 15, fq = lane >> 4;
#pragma unroll
  for (int mt = 0; mt < 4; mt++)
#pragma unroll
    for (int nt = 0; nt < 4; nt++) {
      const int r = wr * 64 + mt * 16 + (TRANS ? fq * 4 : fr), c = wc * 64 + nt * 16 + (TRANS ? fr : fq * 4);
      const uint2 o = proc(r, c, acc[mt][nt]);
      *(uint2*)(smem + (TRANS ? c * 272 + r * 2 : r * 272 + c * 2)) = o;
    }
  __syncthreads();
#pragma unroll
  for (int k = 0; k < 8; k++) {
    const int id = tid + 256 * k, i = id >> 4, j8 = (id & 15) * 8;
    *(uint4*)dst(i, j8) = *(const uint4*)(smem + i * 272 + j8 * 2);
  }
  __syncthreads();
}
DI void inproj_tile(const Params& p, int mt_, int nt_, char* smem) {
  const int m0 = mt_ * 128, b = m0 >> 12, t0 = m0 & 4095;
  const bf16_t* A = p.xb + (size_t)m0 * D; const bf16_t* Bt = p.WinT + (size_t)nt_ * 128 * D;
  f32x4 acc[4][4]; zero_acc(acc);
  auto ar = [=](int r) { return A + (size_t)r * D; };
  auto br = [=](int r) { return Bt + (size_t)r * D; };
  auto plain = [](int, int, f32x4 v) { uint2 o; o.x = pack2(v[0], v[1]); o.y = pack2(v[2], v[3]); return o; };
  const bool transposed = (nt_ == 7 || nt_ == 9 || (nt_ >= 18 && nt_ < 26));
  if (transposed) {
    gemm128<false>(acc, ar, br, D, smem);
    if (nt_ < 18) { bf16_t* base = ((nt_ == 7) ? p.SVt : p.WVt) + (size_t)b * 2 * 64 * T + t0;
      epilogue_lds<true>(acc, plain, [=](int c, int r8) { return base + (size_t)c * T + r8; }, smem); }
    else { const int h = (nt_ - 18) >> 1, e0 = ((nt_ - 18) & 1) * 128; bf16_t* base = p.RVt + (size_t)(b * 4 + h) * 256 * T;
      epilogue_lds<true>(acc, plain, [=](int c, int r8) { return base + frag_off(e0 + c, t0 + r8, T); }, smem); }
    return;
  }
  gemm128<true>(acc, ar, br, D, smem);
  if (nt_ < 4 || nt_ == 6 || nt_ == 8) {
    const float sc = nt_ < 4 ? 0.18033688011112042f : 1.f;
    bf16_t* base = (nt_ < 4) ? p.Qn + ((size_t)(b * 8 + nt_ * 2) * T + t0) * 64 : ((nt_ == 6) ? p.SK : p.WK) + ((size_t)(b * 2) * T + t0) * 64;
    epilogue_lds<false>(acc, [=](int r, int c, f32x4 v) {
      const float4 cs = *(const float4*)(p.ropeN + ((size_t)(t0 + r) * 32 + ((c & 63) >> 1)) * 2);
      uint2 o; o.x = pack2((v[0] * cs.x - v[1] * cs.y) * sc, (v[0] * cs.y + v[1] * cs.x) * sc); o.y = pack2((v[2] * cs.z - v[3] * cs.w) * sc, (v[2] * cs.w + v[3] * cs.z) * sc);
      return o; }, [=](int r, int c8) { return base + ((size_t)(c8 >> 6) * T + r) * 64 + (c8 & 63); }, smem);
  } else if (nt_ == 4 || nt_ == 5) {
    bf16_t* base = (nt_ == 4 ? p.CK : p.CV) + ((size_t)(b * 2) * T + t0) * 64;
    epilogue_lds<false>(acc, plain, [=](int r, int c8) { return base + ((size_t)(c8 >> 6) * T + r) * 64 + (c8 & 63); }, smem);
  } else if (nt_ >= 10 && nt_ < 18) {
    const bool isk = nt_ >= 14; const int h = (nt_ - 10) & 3;
    const float sc = isk ? 0.08838834764831845f : 1.f;
    bf16_t* base = (isk ? p.RK : p.RQ) + (size_t)(b * 4 + h) * T * 128;
    auto roped = [=](int r, int c, f32x4 v, float z) {
      const float4 cs = *(const float4*)(p.ropeR + ((size_t)(t0 + r) * 64 + (c >> 1)) * 2);
      const float s2 = sc * z;
      uint2 o; o.x = pack2((v[0] * cs.x - v[1] * cs.y) * s2, (v[0] * cs.y + v[1] * cs.x) * s2); o.y = pack2((v[2] * cs.z - v[3] * cs.w) * s2, (v[2] * cs.w + v[3] * cs.z) * s2);
      return o; };
    epilogue_lds<false>(acc, [=](int r, int c, f32x4 v) { return roped(r, c, v, 1.f); }, [=](int r, int c8) { return base + frag_off(t0 + r, c8, 128); }, smem);
    if (isk) {
      const float lg = log2f(1.f - exp2f(-5.f - (float)h));
      bf16_t* bz = p.RKzT + (size_t)(b * 4 + h) * 128 * T;
      const int tid = opq(threadIdx.x), lane = tid & 63, wave = tid >> 6, wr = wave >> 1, wc = wave & 1, fr = lane & 15, fq = lane >> 4;
#pragma unroll
      for (int mt = 0; mt < 4; mt++)
#pragma unroll
        for (int nt = 0; nt < 4; nt++) {
          const int r = wr * 64 + mt * 16 + fr, c = wc * 64 + nt * 16 + fq * 4;
          const uint2 o = roped(r, c, acc[mt][nt], exp2f((float)(127 - ((t0 + r) & 127)) * lg));
          bf16_t* q = (bf16_t*)(smem + c * 272 + r * 2);
          q[0] = (bf16_t)(o.x & 0xffffu); q[136] = (bf16_t)(o.x >> 16); q[272] = (bf16_t)(o.y & 0xffffu); q[408] = (bf16_t)(o.y >> 16);
        }
      __syncthreads();
#pragma unroll
      for (int k = 0; k < 8; k++) {
        const int id = tid + 256 * k, i = id >> 4, j8 = (id & 15) * 8;
        *(uint4*)(bz + frag_off(i, t0 + j8, T)) = *(const uint4*)(smem + i * 272 + j8 * 2);
      }
      __syncthreads();
    }
  } else if (nt_ >= 26 && nt_ < 34) {
    bf16_t* base = p.RG + (size_t)m0 * 1024 + (nt_ - 26) * 128;
    epilogue_lds<false>(acc, plain, [=](int r, int c8) { return base + (size_t)r * 1024 + c8; }, smem);
  } else if (nt_ >= 34 && nt_ < 50) {
    bf16_t* base = p.MG + (size_t)m0 * 2048 + (nt_ - 34) * 128;
    epilogue_lds<false>(acc, plain, [=](int r, int c8) { return base + (size_t)r * 2048 + c8; }, smem);
  } else {
    epilogue<true>(acc, [&](int r, int c, f32x4 v) {
      if (c < 24) { float4 o; o.x = sigmoidf_(v[0]); o.y = sigmoidf_(v[1]); o.z = sigmoidf_(v[2]); o.w = sigmoidf_(v[3]);
        *(float4*)(p.NG + (size_t)(m0 + r) * 24 + c) = o; }
    });
  }
}
DI void phase1(const Params& p, char* smem) {
  if (blockIdx.x < 2) {
    const int i = blockIdx.x * 256 + opq(threadIdx.x), kv = i >> 8, j = i & 255;
    float s0 = (kv ? p.cmp_v_b1 : p.cmp_k_b1)[j];
    for (int qp = 0; qp < 32; qp++) s0 += p.posp[qp * 512 + i];
    p.posb[i] = s0;
  }
  const int xcd = blockIdx.x & 7, lb = blockIdx.x >> 3, nlb = gridDim.x >> 3;
  for (int li = lb; li < 16 * 51; li += nlb) {
    const int mi = li & 7, rest = li >> 3, nt_ = rest % 51, half = rest / 51;
    inproj_tile(p, xcd * 16 + half * 8 + mi, nt_, smem);
  }
}


DI void attn_unit(const Params& p, int unit, char* smem) {
  const int tid = opq(threadIdx.x), lane = tid & 63, w = tid >> 6, r = lane & 31, h2 = lane >> 5;
  const int bg = unit >> 6, jq = unit & 63, b = bg >> 1, g = bg & 1, hh = g * 4 + w, t0 = jq * 64;
  bf16x8 qf[2][4];
#pragma unroll
  for (int qt = 0; qt < 2; qt++)
#pragma unroll
    for (int ks = 0; ks < 4; ks++)
      qf[qt][ks] = *(const bf16x8*)(p.Qn + ((size_t)(b * 8 + hh) * T + t0 + qt * 32 + r) * 64 + ks * 16 + h2 * 8);
  unsigned long long* sell = (unsigned long long*)(smem + 49152) + tid * 2;
#pragma unroll
  for (int qt = 0; qt < 2; qt++) sell[qt] = p.selmask[(size_t)bg * T + t0 + qt * 32 + r];
  const int wlo = jq > 8 ? jq - 8 : 0, nwin = jq - wlo + 1, nsteps = nwin + jq + 1;
  char* Kl = smem; char* Vl = smem + 24576;
  const unsigned ldsK = (unsigned)(size_t)(LAS char*)smem;
  const int grow = lane >> 3;
  auto gload = [&](int i, int buf) {
    const int br = i < nwin ? 2 : 1, j = i < nwin ? wlo + i : i - nwin;
    const bf16_t* Kp = (br == 1 ? p.SK : p.WK) + ((size_t)bg * T + j * 64) * 64;
    const bf16_t* Vp = (br == 1 ? p.SVt : p.WVt) + (size_t)bg * 64 * T + j * 64;
#pragma unroll
    for (int pc = 0; pc < 2; pc++) {
      const int row = (w * 2 + pc) * 8 + grow;
      const int gch = (lane & 7) ^ ((row >> 1) & 7);
      const unsigned loff = __builtin_amdgcn_readfirstlane(buf * 8192 + (w * 2 + pc) * 1024);
      glds16_asm(Kp + row * 64 + gch * 8, ldsK + loff);
      glds16_asm(Vp + (size_t)row * T + gch * 8, ldsK + 24576 + loff);
    }
  };
  const int pr = perm23(r);
  float mrow[2], lrow[2]; f32x16 O[2][2];
  auto reset = [&]() {
#pragma unroll
    for (int qt = 0; qt < 2; qt++) { mrow[qt] = -INFINITY; lrow[qt] = 0.f;
#pragma unroll
      for (int dt = 0; dt < 2; dt++)
#pragma unroll
        for (int i = 0; i < 16; i++) O[dt][qt][i] = 0.f; }
  };
  auto flush = [&](int br) {
#pragma unroll
    for (int qt = 0; qt < 2; qt++) {
      const int m = b * T + t0 + qt * 32 + r;
      const float gate = p.NG[(size_t)m * 24 + hh * 3 + br];
      const float sc = lrow[qt] > 0.f ? gate / lrow[qt] : 0.f;
#pragma unroll
      for (int dt = 0; dt < 2; dt++)
#pragma unroll
        for (int q4 = 0; q4 < 4; q4++) {
          bf16_t* dst = p.oattn + (size_t)m * 512 + hh * 64 + dt * 32 + q4 * 8 + h2 * 4;
          const uint2 old = *(const uint2*)dst;
          uint2 o; o.x = pack2(lo2f(old.x) + sc * O[dt][qt][q4 * 4], hi2f(old.x) + sc * O[dt][qt][q4 * 4 + 1]);
          o.y = pack2(lo2f(old.y) + sc * O[dt][qt][q4 * 4 + 2], hi2f(old.y) + sc * O[dt][qt][q4 * 4 + 3]);
          *(uint2*)dst = o;
        }
    }
  };
  reset();
#pragma unroll
  for (int qt = 0; qt < 2; qt++)
#pragma unroll
    for (int ks = 0; ks < 4; ks++) asm volatile("" :: "v"(qf[qt][ks]));
  gload(0, 0);
  if (nsteps > 1) { gload(1, 1); asm volatile("s_waitcnt vmcnt(4)" ::: "memory"); } else asm volatile("s_waitcnt vmcnt(0)" ::: "memory");
  __builtin_amdgcn_s_barrier();
  int cur = 0;
#pragma unroll 1
  for (int i = 0; i < nsteps; i++) {
    const int br = i < nwin ? 2 : 1, j = i < nwin ? wlo + i : i - nwin;
    if (i == nwin) { flush(2); reset(); }
    if (i + 2 < nsteps) gload(i + 2, cur == 0 ? 2 : cur - 1);
    const char* Kc = Kl + cur * 8192; const char* Vc = Vl + cur * 8192;
    const int mmode = (br == 2) ? ((j == jq || j + 8 == jq) ? 2 : 0) : (j == jq ? 2 : 1);
#pragma unroll
    for (int qt = 0; qt < 2; qt++) {
      const float msafe0 = (mrow[qt] == -INFINITY) ? 0.f : mrow[qt];
      float cinit = -msafe0;
      if (mmode == 1) cinit = ((sell[qt] >> j) & 1ull) ? cinit : -INFINITY;
      f32x16 S[2];
#pragma unroll
      for (int kt2 = 0; kt2 < 2; kt2++) {
#pragma unroll
        for (int ii = 0; ii < 16; ii++) S[kt2][ii] = cinit;
#pragma unroll
        for (int ks = 0; ks < 4; ks++) {
          const bf16x8 a = *(const bf16x8*)(Kc + (kt2 * 32 + pr) * 128 + (((ks * 2 + h2) ^ ((pr >> 1) & 7)) << 4));
          S[kt2] = MFMA32(a, qf[qt][ks], S[kt2]);
        }
      }
      const int t = t0 + qt * 32 + r;
      if (mmode == 2) {
        const bool selb = (br == 2) || ((sell[qt] >> j) & 1ull);
        const int khi = t, klo = (br == 2) ? t - 511 : 0;
#pragma unroll
        for (int kt2 = 0; kt2 < 2; kt2++)
#pragma unroll
          for (int ii = 0; ii < 16; ii++) {
            const int key = j * 64 + kt2 * 32 + (ii & 7) + 16 * (ii >> 3) + 8 * h2;
            S[kt2][ii] = (selb && key <= khi && key >= klo) ? S[kt2][ii] : -INFINITY;
          }
      }
      float mx = -INFINITY;
#pragma unroll
      for (int kt2 = 0; kt2 < 2; kt2++)
#pragma unroll
        for (int ii = 0; ii < 16; ii++) mx = fmaxf(mx, S[kt2][ii]);
      mx = fmaxf(mx, __shfl_xor(mx, 32));
      if (__any(mx > 6.f)) {
        const float dl = fmaxf(mx, 0.f);
        const float alpha = __builtin_amdgcn_exp2f(-dl);
        lrow[qt] *= alpha; mrow[qt] = msafe0 + dl;
#pragma unroll
        for (int dt = 0; dt < 2; dt++)
#pragma unroll
          for (int ii = 0; ii < 16; ii++) O[dt][qt][ii] *= alpha;
#pragma unroll
        for (int kt2 = 0; kt2 < 2; kt2++)
#pragma unroll
          for (int ii = 0; ii < 16; ii++) S[kt2][ii] -= dl;
      }
      float rs = 0.f;
#pragma unroll
      for (int kt2 = 0; kt2 < 2; kt2++)
#pragma unroll
        for (int ii = 0; ii < 16; ii++) { const float pv = __builtin_amdgcn_exp2f(S[kt2][ii]); S[kt2][ii] = pv; rs += pv; }
      rs += __shfl_xor(rs, 32);
      lrow[qt] += rs;
#pragma unroll
      for (int kt2 = 0; kt2 < 2; kt2++)
#pragma unroll
        for (int s2 = 0; s2 < 2; s2++) {
          uint4 u;
          u.x = pack2(S[kt2][8 * s2 + 0], S[kt2][8 * s2 + 1]); u.y = pack2(S[kt2][8 * s2 + 2], S[kt2][8 * s2 + 3]);
          u.z = pack2(S[kt2][8 * s2 + 4], S[kt2][8 * s2 + 5]); u.w = pack2(S[kt2][8 * s2 + 6], S[kt2][8 * s2 + 7]);
          const bf16x8 pfr = __builtin_bit_cast(bf16x8, u);
#pragma unroll
          for (int dt = 0; dt < 2; dt++) {
            const int d = dt * 32 + r;
            const bf16x8 vf = *(const bf16x8*)(Vc + d * 128 + (((kt2 * 4 + s2 * 2 + h2) ^ ((d >> 1) & 7)) << 4));
            O[dt][qt] = MFMA32(vf, pfr, O[dt][qt]);
          }
        }
      __builtin_amdgcn_sched_barrier(0);
    }
    if (i + 2 < nsteps) asm volatile("s_waitcnt vmcnt(4)" ::: "memory"); else asm volatile("s_waitcnt vmcnt(0)" ::: "memory");
    __builtin_amdgcn_s_barrier();
    cur = cur == 2 ? 0 : cur + 1;
  }
  flush(1);
  __syncthreads();
}

DI void cmp_unit(const Params& p, int unit, char* smem) {
  const int tid = opq(threadIdx.x), lane = tid & 63, w = tid >> 6, r = lane & 31, h2 = lane >> 5;
  const int bg = unit >> 7, q32 = unit & 127, b = bg >> 1, g = bg & 1, hh = g * 4 + w;
  const int pr = perm23(r);
  const bf16_t* Kg = p.kcmp + (size_t)bg * 256 * 64;
  const bf16_t* Vg = p.vcmpT + (size_t)bg * 64 * 256;
  const int tb = q32 * 32, t = tb + r;
  const int nvalid = t >= 31 ? ((t - 31) >> 4) + 1 : 0;
  const int nvmax = (tb >> 4) + 1;
  const int nkt = (nvmax + 31) >> 5;
  char* Kl = smem; char* Vl = smem + 32768; float* impw = (float*)smem;
  const unsigned ldsb = (unsigned)(size_t)(LAS char*)smem;
  __syncthreads();
  for (int pc = w; pc < 4 * nkt; pc += 4) {
    const int row = pc * 8 + (lane >> 3);
    glds16_asm(Kg + row * 64 + (((lane & 7) ^ ((row >> 1) & 7)) << 3), ldsb + __builtin_amdgcn_readfirstlane(pc * 1024));
  }
#pragma unroll
  for (int i = 0; i < 8; i++) {
    const int pc = w * 8 + i, d = pc * 2 + h2;
    glds16_asm(Vg + d * 256 + (((lane & 31) ^ (d & 15)) << 3), ldsb + 32768 + __builtin_amdgcn_readfirstlane(pc * 1024));
  }
  bf16x8 qf[4];
#pragma unroll
  for (int ks = 0; ks < 4; ks++) qf[ks] = *(const bf16x8*)(p.Qn + ((size_t)(b * 8 + hh) * T + t) * 64 + ks * 16 + h2 * 8);
  asm volatile("s_waitcnt vmcnt(0)" ::: "memory");
  __syncthreads();
  float mx = -1e30f;
#pragma unroll 1
  for (int kt = 0; kt < nkt; kt++) {
    f32x16 S;
#pragma unroll
    for (int i = 0; i < 16; i++) S[i] = 0.f;
    const int row = kt * 32 + pr;
#pragma unroll
    for (int ks = 0; ks < 4; ks++) { const bf16x8 kf = *(const bf16x8*)(Kl + row * 128 + (((ks * 2 + h2) ^ ((row >> 1) & 7)) << 4)); S = MFMA32(kf, qf[ks], S); }
#pragma unroll
    for (int i = 0; i < 16; i++) { const int key = kt * 32 + (i & 7) + 16 * (i >> 3) + 8 * h2; mx = fmaxf(mx, key < nvalid ? S[i] : -1e30f); }
  }
  mx = fmaxf(mx, __shfl_xor(mx, 32));
  float sum = 0.f;
  float impo[32];
#pragma unroll
  for (int i = 0; i < 32; i++) impo[i] = 0.f;
  f32x16 O[2];
#pragma unroll
  for (int dt = 0; dt < 2; dt++)
#pragma unroll
    for (int i = 0; i < 16; i++) O[dt][i] = 0.f;
  float carry = 0.f;
#pragma unroll
  for (int kt = 0; kt < 8; kt++) {
    if (kt < nkt) {
      f32x16 S;
#pragma unroll
      for (int i = 0; i < 16; i++) S[i] = 0.f;
      const int row = kt * 32 + pr;
#pragma unroll
      for (int ks = 0; ks < 4; ks++) { const bf16x8 kf = *(const bf16x8*)(Kl + row * 128 + (((ks * 2 + h2) ^ ((row >> 1) & 7)) << 4)); S = MFMA32(kf, qf[ks], S); }
#pragma unroll
      for (int i = 0; i < 16; i++) {
        const int key = kt * 32 + (i & 7) + 16 * (i >> 3) + 8 * h2;
        const float e = key < nvalid ? __builtin_amdgcn_exp2f(S[i] - mx) : 0.f;
        S[i] = e; sum += e;
      }
      {
        const float x1 = __shfl_xor(S[7], 32), x3 = __shfl_xor(S[15], 32);
#pragma unroll
        for (int q4 = 0; q4 < 4; q4++) {
          const float mainv = 2.f * (S[q4 * 4] + S[q4 * 4 + 1] + S[q4 * 4 + 2]) + S[q4 * 4 + 3];
          const float prev = (q4 == 0) ? (h2 ? x1 : carry) : (q4 == 1) ? S[3] : (q4 == 2) ? (h2 ? x3 : x1) : S[11];
          impo[kt * 4 + q4] = mainv + prev;
        }
        carry = x3;
      }
#pragma unroll
      for (int s2 = 0; s2 < 2; s2++) {
        uint4 u;
        u.x = pack2(S[8 * s2 + 0], S[8 * s2 + 1]); u.y = pack2(S[8 * s2 + 2], S[8 * s2 + 3]);
        u.z = pack2(S[8 * s2 + 4], S[8 * s2 + 5]); u.w = pack2(S[8 * s2 + 6], S[8 * s2 + 7]);
        const bf16x8 pfr = __builtin_bit_cast(bf16x8, u);
#pragma unroll
        for (int dt = 0; dt < 2; dt++) {
          const int d = dt * 32 + r;
          const bf16x8 vf = *(const bf16x8*)(Vl + d * 512 + (((kt * 4 + s2 * 2 + h2) ^ (d & 15)) << 4));
          O[dt] = MFMA32(vf, pfr, O[dt]);
        }
      }
    }
  }
  sum += __shfl_xor(sum, 32);
  const float inv = sum > 0.f ? 1.f / sum : 0.f;
  {
    const size_t m = (size_t)b * T + t;
    const float sc = inv * p.NG[m * 24 + hh * 3 + 0];
#pragma unroll
    for (int dt = 0; dt < 2; dt++)
#pragma unroll
      for (int q4 = 0; q4 < 4; q4++) {
        uint2 o; o.x = pack2(sc * O[dt][q4 * 4], sc * O[dt][q4 * 4 + 1]); o.y = pack2(sc * O[dt][q4 * 4 + 2], sc * O[dt][q4 * 4 + 3]);
        *(uint2*)(p.oattn + m * 512 + hh * 64 + dt * 32 + q4 * 8 + h2 * 4) = o;
      }
  }
  __syncthreads();
#pragma unroll
  for (int kt = 0; kt < 8; kt++)
#pragma unroll
    for (int q4 = 0; q4 < 4; q4++)
      impw[(w * 32 + r) * 65 + 8 * kt + 4 * (q4 >> 1) + 2 * h2 + (q4 & 1)] = impo[kt * 4 + q4] * inv;
  __syncthreads();
#pragma unroll 1
  for (int k8 = 0; k8 < 8; k8++) {
    const int rr = w * 8 + k8, tt = tb + rr, blk = tt >> 6;
    const float imp = ((impw[rr * 65 + lane] + impw[(32 + rr) * 65 + lane]) + impw[(64 + rr) * 65 + lane]) + impw[(96 + rr) * 65 + lane];
    const float score = (lane == 0 || lane == blk || lane == blk - 1) ? 1e9f : (lane <= blk ? imp : -1e9f);
    int rank = 0;
#pragma unroll
    for (int i = 0; i < 64; i++) { const float si = __int_as_float(__builtin_amdgcn_readlane(__float_as_int(score), i)); rank += (si > score || (si == score && i < lane)) ? 1 : 0; }
    const unsigned long long selm = __ballot(rank < 16);
    if (lane == 0) p.selmask[(size_t)bg * T + tt] = selm;
  }
}

DI float gelu_tanh(float x) { const float u = 0.7978845608028654f * (x + 0.044715f * x * x * x); return 0.5f * x * (1.f + tanhf(u)); }
DI void compress1_tile(const Params& p, int task, char* smem) {
  const int ks = task & 3, tile = task >> 2;
  const int ntl = tile & 1, mtile = tile >> 1, half = mtile & 1, bg = (mtile >> 1) & 7, kv = mtile >> 4;
  const bf16_t* src = (kv ? p.CV : p.CK) + (size_t)bg * T * 64 + (size_t)half * 128 * 1024 + ks * 512;
  const bf16_t* Bt = (kv ? p.W1vT : p.W1kT) + (size_t)ntl * 128 * 2048 + ks * 512;
  f32x4 acc[4][4]; zero_acc(acc);
  gemm128<true>(acc, [=](int r) { return src + (size_t)r * 1024; }, [=](int r) { return Bt + (size_t)r * 2048; }, 512, smem);
  float* H1p = (float*)p.oattn + (size_t)ks * 4096 * 256;
  epilogue<true>(acc, [&](int r, int c, f32x4 v) {
    const int n = half * 128 + r;
    if (n < 255) { float4 o; o.x = v[0]; o.y = v[1]; o.z = v[2]; o.w = v[3];
      *(float4*)(H1p + ((size_t)((kv * 8 + bg) * 256 + n)) * 256 + ntl * 128 + c) = o; }
  });
}
DI void compress2(const Params& p, char* smem) {
  float* hl = (float*)smem;
  const int tid = opq(threadIdx.x);
  const float* H1p = (const float*)p.oattn;
  for (int rb = blockIdx.x; rb < 512; rb += gridDim.x) {
    const int row0 = rb * 8, kv = row0 >> 11;
    __syncthreads();
#pragma unroll
    for (int q = 0; q < 8; q++) {
      const size_t idx = (size_t)(row0 + q) * 256 + tid;
      hl[q * 256 + tid] = gelu_tanh(H1p[idx] + H1p[idx + (size_t)4096 * 256] + H1p[idx + (size_t)2 * 4096 * 256] + H1p[idx + (size_t)3 * 4096 * 256] + p.posb[kv * 256 + tid]);
    }
    __syncthreads();
    const int q = tid >> 5, ii = tid & 31, row = row0 + q, n = row & 255, bg = (row >> 8) & 7;
    float a0 = 0.f, a1 = 0.f;
    if (n < 255) {
      const float* w2 = kv ? p.cmp_v_w2 : p.cmp_k_w2; const float* b2 = kv ? p.cmp_v_b2 : p.cmp_k_b2;
      a0 = b2[ii]; a1 = b2[ii + 32];
#pragma unroll 8
      for (int j = 0; j < 256; j++) { const float hv = hl[q * 256 + j]; a0 += hv * w2[j * 64 + ii]; a1 += hv * w2[j * 64 + ii + 32]; }
    }
    if (kv == 0) {
      float r0 = 0.f, r1 = 0.f;
      if (n < 255) { const int pos = 16 * n + 31; const float c = p.ropeN[((size_t)pos * 32 + ii) * 2], s = p.ropeN[((size_t)pos * 32 + ii) * 2 + 1];
        r0 = a0 * c - a1 * s; r1 = a0 * s + a1 * c; }
      *(unsigned*)(p.kcmp + ((size_t)(bg * 256 + n)) * 64 + 2 * ii) = pack2(r0, r1);
    } else {
      p.vcmpT[((size_t)(bg * 64 + ii)) * 256 + n] = f2bf(a0);
      p.vcmpT[((size_t)(bg * 64 + ii + 32)) * 256 + n] = f2bf(a1);
    }
  }
}


DI void ret_u_unit(const Params& p, int unit) {
  const int tid = opq(threadIdx.x), lane = tid & 63, w = tid >> 6, r = lane & 31, h2 = lane >> 5;
  const int bh = unit >> 5, n = unit & 31;
  const bf16_t* kz = p.RKzT + (size_t)bh * 128 * T + ((size_t)((w * 256 + n * 8) * 2 + h2)) * 256 + r * 8;
  const bf16_t* vt = p.RVt + (size_t)bh * 256 * T + ((size_t)((n * 8) * 2 + h2)) * 256 + r * 8;
  bf16_t* ut = p.Ut + ((size_t)bh * 32 + n) * 32768 + (size_t)(w * 2) * 512 + r * 8 + 4 * h2;
  bf16x8 a[8], b0[8], b1[8];
#pragma unroll
  for (int ks = 0; ks < 8; ks++) a[ks] = *(const bf16x8*)(kz + ks * 512);
#pragma unroll
  for (int ks = 0; ks < 8; ks++) b0[ks] = *(const bf16x8*)(vt + ks * 512);
#pragma unroll
  for (int dvs = 0; dvs < 8; dvs += 2) {
#pragma unroll
    for (int ks = 0; ks < 8; ks++) b1[ks] = *(const bf16x8*)(vt + (size_t)(dvs + 1) * 32 * T + ks * 512);
    {
      f32x16 R;
#pragma unroll
      for (int i = 0; i < 16; i++) R[i] = 0.f;
#pragma unroll
      for (int ks = 0; ks < 8; ks++) R = MFMA32(a[ks], b0[ks], R);
#pragma unroll
      for (int q4 = 0; q4 < 4; q4++) { uint2 o; o.x = pack2(R[q4 * 4], R[q4 * 4 + 1]); o.y = pack2(R[q4 * 4 + 2], R[q4 * 4 + 3]);
        *(uint2*)(ut + (size_t)dvs * 4096 + (q4 >> 1) * 512 + (q4 & 1) * 256) = o; }
    }
    if (dvs + 2 < 8) {
#pragma unroll
      for (int ks = 0; ks < 8; ks++) b0[ks] = *(const bf16x8*)(vt + (size_t)(dvs + 2) * 32 * T + ks * 512);
    }
    {
      f32x16 R;
#pragma unroll
      for (int i = 0; i < 16; i++) R[i] = 0.f;
#pragma unroll
      for (int ks = 0; ks < 8; ks++) R = MFMA32(a[ks], b1[ks], R);
#pragma unroll
      for (int q4 = 0; q4 < 4; q4++) { uint2 o; o.x = pack2(R[q4 * 4], R[q4 * 4 + 1]); o.y = pack2(R[q4 * 4 + 2], R[q4 * 4 + 3]);
        *(uint2*)(ut + (size_t)(dvs + 1) * 4096 + (q4 >> 1) * 512 + (q4 & 1) * 256) = o; }
    }
  }
}
DI void ret_scan_elem(const Params& p) {
  const size_t gtid = (size_t)blockIdx.x * 256 + opq(threadIdx.x), gsz = (size_t)gridDim.x * 256;
  for (size_t i = gtid; i < (size_t)16 * 256 * 32; i += gsz) {
    const int bh = (int)(i >> 13), h = bh & 3;
    const size_t off = (size_t)(i & 8191) * 4;
    const float cd = exp2f(128.f * log2f(1.f - exp2f(-5.f - (float)h)));
    const bf16_t* up = p.Ut + (size_t)bh * 32 * 32768 + off;
    bf16_t* rp = p.Rt + (size_t)bh * 32 * 32768 + off;
    uint2 u[31];
#pragma unroll
    for (int n = 0; n < 31; n++) u[n] = *(const uint2*)(up + (size_t)n * 32768);
    float r0 = 0.f, r1 = 0.f, r2 = 0.f, r3 = 0.f;
    { uint2 z; z.x = 0u; z.y = 0u; *(uint2*)rp = z; }
#pragma unroll
    for (int n = 0; n < 31; n++) {
      r0 = r0 * cd + lo2f(u[n].x); r1 = r1 * cd + hi2f(u[n].x); r2 = r2 * cd + lo2f(u[n].y); r3 = r3 * cd + hi2f(u[n].y);
      uint2 o; o.x = pack2(r0, r1); o.y = pack2(r2, r3);
      *(uint2*)(rp + (size_t)(n + 1) * 32768) = o;
    }
  }
}

DI void ret_out_unit(const Params& p, int unit, char* smem) {
  const int tid = opq(threadIdx.x), lane = tid & 63, w = tid >> 6, r = lane & 31, h2 = lane >> 5, tq = w >> 1, dh = w & 1;
  const int th = unit & 1, n = (unit >> 1) & 31, bh = unit >> 6, b = bh >> 2, h = bh & 3;
  const int qt = th * 2 + tq, c = qt * 32 + r;
  const float lg = log2f(1.f - exp2f(-5.f - (float)h));
  const bf16_t* qp = p.RQ + (size_t)bh * T * 128 + ((size_t)(((n * 4 + qt) * 8) * 2 + h2)) * 256 + r * 8;
  f32x16 O[4];
  {
    const bf16_t* rp = p.Rt + ((size_t)bh * 32 + n) * 32768 + ((size_t)((dh * 4 * 8) * 2 + h2)) * 256 + r * 8;
#pragma unroll
    for (int dvt = 0; dvt < 4; dvt++)
#pragma unroll
      for (int i = 0; i < 16; i++) O[dvt][i] = 0.f;
#pragma unroll
    for (int ks = 0; ks < 8; ks++) {
      const bf16x8 qk = *(const bf16x8*)(qp + ks * 512);
#pragma unroll
      for (int dvt = 0; dvt < 4; dvt++) {
        const bf16x8 rf = *(const bf16x8*)(rp + (size_t)dvt * 4096 + ks * 512);
        O[dvt] = MFMA32(rf, qk, O[dvt]);
      }
    }
    const float xi = exp2f((float)(c + 1) * lg);
#pragma unroll
    for (int dvt = 0; dvt < 4; dvt++)
#pragma unroll
      for (int i = 0; i < 16; i++) O[dvt][i] *= xi;
  }
#pragma unroll 1
  for (int kt = 0; kt <= qt; kt++) {
    f32x16 S;
#pragma unroll
    for (int i = 0; i < 16; i++) S[i] = 0.f;
    const bf16_t* kp = p.RK + (size_t)bh * T * 128 + ((size_t)(((n * 4 + kt) * 8) * 2 + h2)) * 256 + perm23(r) * 8;
#pragma unroll
    for (int ks = 0; ks < 8; ks++) { const bf16x8 kf = *(const bf16x8*)(kp + ks * 512); const bf16x8 qk = *(const bf16x8*)(qp + ks * 512); S = MFMA32(kf, qk, S); }
    bf16x8 pf[2];
#pragma unroll
    for (int s2 = 0; s2 < 2; s2++) {
      float v[8];
#pragma unroll
      for (int jj = 0; jj < 8; jj++) {
        const int i = 8 * s2 + jj;
        const int mkey = kt * 32 + (i & 7) + 16 * (i >> 3) + 8 * h2;
        v[jj] = (mkey <= c) ? S[i] * exp2f((float)(c - mkey) * lg) : 0.f;
      }
      uint4 u; u.x = pack2(v[0], v[1]); u.y = pack2(v[2], v[3]); u.z = pack2(v[4], v[5]); u.w = pack2(v[6], v[7]);
      pf[s2] = __builtin_bit_cast(bf16x8, u);
    }
    const bf16_t* vp = p.RVt + (size_t)bh * 256 * T + ((size_t)(((dh * 4) * 256 + n * 8 + kt * 2) * 2 + h2)) * 256 + r * 8;
#pragma unroll
    for (int dvt = 0; dvt < 4; dvt++)
#pragma unroll
      for (int s2 = 0; s2 < 2; s2++) {
        const bf16x8 vf = *(const bf16x8*)(vp + (size_t)dvt * 32 * T + s2 * 512);
        O[dvt] = MFMA32(vf, pf[s2], O[dvt]);
      }
  }
  float s1 = 0.f, s2s = 0.f;
#pragma unroll
  for (int dvt = 0; dvt < 4; dvt++)
#pragma unroll
    for (int i = 0; i < 16; i++) { s1 += O[dvt][i]; s2s += O[dvt][i] * O[dvt][i]; }
  s1 += __shfl_xor(s1, 32); s2s += __shfl_xor(s2s, 32);
  float* red = (float*)smem;
  __syncthreads();
  if (h2 == 0) { red[(w * 32 + r) * 2] = s1; red[(w * 32 + r) * 2 + 1] = s2s; }
  __syncthreads();
  s1 += red[((w ^ 1) * 32 + r) * 2]; s2s += red[((w ^ 1) * 32 + r) * 2 + 1];
  const float mu = s1 * (1.f / 256.f);
  const float var = fmaxf(s2s * (1.f / 256.f) - mu * mu, 0.f);
  const float rs = rsqrtf(var + 1e-5f);
  const size_t m = (size_t)b * T + n * 128 + c;
#pragma unroll
  for (int dvt = 0; dvt < 4; dvt++)
#pragma unroll
    for (int q4 = 0; q4 < 4; q4++) {
      const int col = h * 256 + dh * 128 + dvt * 32 + q4 * 8 + 4 * h2;
      const float4 gg = *(const float4*)(p.gn_g + col), bb = *(const float4*)(p.gn_b + col);
      const uint2 rg = *(const uint2*)(p.RG + m * 1024 + col);
      const float g0 = lo2f(rg.x), g1 = hi2f(rg.x), g2 = lo2f(rg.y), g3 = hi2f(rg.y);
      const float y0 = ((O[dvt][q4 * 4] - mu) * rs * gg.x + bb.x) * g0 * sigmoidf_(g0);
      const float y1 = ((O[dvt][q4 * 4 + 1] - mu) * rs * gg.y + bb.y) * g1 * sigmoidf_(g1);
      const float y2 = ((O[dvt][q4 * 4 + 2] - mu) * rs * gg.z + bb.z) * g2 * sigmoidf_(g2);
      const float y3 = ((O[dvt][q4 * 4 + 3] - mu) * rs * gg.w + bb.w) * g3 * sigmoidf_(g3);
      uint2 o; o.x = pack2(y0, y1); o.y = pack2(y2, y3);
      *(uint2*)(p.oret + m * 1024 + col) = o;
    }
}

DI void upproj_tile(const Params& p, int tile, char* smem) {
  const int nt_ = tile & 7, mt_ = tile >> 3, m0 = mt_ * 128, n0 = nt_ * 128;
  const int lane = opq(threadIdx.x) & 63, wave = opq(threadIdx.x) >> 6, wr = wave >> 1, wc = wave & 1, fr = lane & 15, fq = lane >> 4;
  f32x4 acc[4][4]; uint2 res[4][4];
  zero_acc(acc);
  { const bf16_t* A = p.oattn + (size_t)m0 * 512; const bf16_t* Bt = p.WaT + (size_t)n0 * 512;
    gemm128<true>(acc, [=](int r) { return A + (size_t)r * 512; }, [=](int r) { return Bt + (size_t)r * 512; }, 512, smem); }
#pragma unroll
  for (int mt = 0; mt < 4; mt++)
#pragma unroll
    for (int nt = 0; nt < 4; nt++) {
      const size_t m = m0 + wr * 64 + mt * 16 + fr; const int cc = n0 + wc * 64 + nt * 16 + fq * 4;
      const uint2 gv = *(const uint2*)(p.MG + m * 2048 + cc);
      res[mt][nt].x = pack2(sigmoidf_(lo2f(gv.x)) * acc[mt][nt][0], sigmoidf_(hi2f(gv.x)) * acc[mt][nt][1]);
      res[mt][nt].y = pack2(sigmoidf_(lo2f(gv.y)) * acc[mt][nt][2], sigmoidf_(hi2f(gv.y)) * acc[mt][nt][3]);
    }
  zero_acc(acc);
  { const bf16_t* A = p.oret + (size_t)m0 * 1024; const bf16_t* Bt = p.WrT + (size_t)n0 * 1024;
    gemm128<true>(acc, [=](int r) { return A + (size_t)r * 1024; }, [=](int r) { return Bt + (size_t)r * 1024; }, 1024, smem); }
#pragma unroll
  for (int mt = 0; mt < 4; mt++)
#pragma unroll
    for (int nt = 0; nt < 4; nt++) {
      const size_t m = m0 + wr * 64 + mt * 16 + fr; const int cc = n0 + wc * 64 + nt * 16 + fq * 4;
      const uint2 gv = *(const uint2*)(p.MG + m * 2048 + 1024 + cc);
      uint2 o; o.x = pack2(lo2f(res[mt][nt].x) + sigmoidf_(lo2f(gv.x)) * acc[mt][nt][0], hi2f(res[mt][nt].x) + sigmoidf_(hi2f(gv.x)) * acc[mt][nt][1]);
      o.y = pack2(lo2f(res[mt][nt].y) + sigmoidf_(lo2f(gv.y)) * acc[mt][nt][2], hi2f(res[mt][nt].y) + sigmoidf_(hi2f(gv.y)) * acc[mt][nt][3]);
      *(uint2*)(p.merged + m * 1024 + cc) = o;
    }
}
DI void wout_tile(const Params& p, int tile, char* smem) {
  const int nt_ = tile & 7, mt_ = tile >> 3, m0 = mt_ * 128, n0 = nt_ * 128;
  f32x4 acc[4][4]; zero_acc(acc);
  const bf16_t* A = p.merged + (size_t)m0 * 1024; const bf16_t* Bt = p.WoT + (size_t)n0 * 1024;
  gemm128<true>(acc, [=](int r) { return A + (size_t)r * 1024; }, [=](int r) { return Bt + (size_t)r * 1024; }, 1024, smem);
  epilogue<true>(acc, [&](int r, int c, f32x4 v) {
    const size_t idx = (size_t)(m0 + r) * 1024 + n0 + c;
    const float4 xv = *(const float4*)(p.x + idx);
    float4 o; o.x = ALPHA * xv.x + v[0]; o.y = ALPHA * xv.y + v[1]; o.z = ALPHA * xv.z + v[2]; o.w = ALPHA * xv.w + v[3];
    *(float4*)(p.out + idx) = o;
  });
}
DI void expert_cvt_tile(const Params& p, int ct, float* tile) {
  const int e = ct / 192, rr = ct % 192;
  const float* wg = p.e_wg + (size_t)e * 1024 * 512; const float* wu = p.e_wu + (size_t)e * 1024 * 512; const float* wd = p.e_wd + (size_t)e * 512 * 1024;
  if (rr < 128)
    tcvt_tile128([=](int j) -> const float* { const int f = (j >> 7) * 64 + ((j >> 5) & 3) * 16 + (j & 15); return (((j >> 4) & 1) ? wu : wg) + f; },
                 512, p.EgT + (size_t)e * 1024 * 1024, 1024, rr >> 3, rr & 7, tile);
  else { const int q = rr - 128;
    tcvt_tile128([=](int j) -> const float* { return wd + j; }, 1024, p.EdT + (size_t)e * 1024 * 512, 512, q >> 3, q & 7, tile); }
}
DI void phase7(const Params& p, char* smem) {
  const int bid = blockIdx.x, nb = gridDim.x;
  if (bid & 1) for (int c = bid; c < 6144; c += nb) expert_cvt_tile(p, c, (float*)smem);
  for (int t = bid; t < 1024; t += nb) wout_tile(p, t, smem);
  if (!(bid & 1)) for (int c = bid; c < 6144; c += nb) expert_cvt_tile(p, c, (float*)smem);
}

DI void ln1_router(const Params& p, int m, int lane, float* xl  ) {
  float* row = p.out + (size_t)m * 1024;
  float4 v[4];
#pragma unroll
  for (int i = 0; i < 4; i++) v[i] = *(const float4*)(row + i * 256 + lane * 4);
  float s = 0.f;
#pragma unroll
  for (int i = 0; i < 4; i++) s += v[i].x + v[i].y + v[i].z + v[i].w;
  const float mu = wsum(s) * (1.f / 1024.f);
  float q = 0.f;
#pragma unroll
  for (int i = 0; i < 4; i++) { const float a = v[i].x - mu, b = v[i].y - mu, c = v[i].z - mu, d = v[i].w - mu; q += a * a + b * b + c * c + d * d; }
  const float rs = rsqrtf(wsum(q) * (1.f / 1024.f) + 1e-5f);
#pragma unroll
  for (int i = 0; i < 4; i++) {
    const int k = i * 256 + lane * 4;
    const float4 g = *(const float4*)(p.ln1_g + k), bb = *(const float4*)(p.ln1_b + k);
    v[i].x = (v[i].x - mu) * rs * g.x + bb.x; v[i].y = (v[i].y - mu) * rs * g.y + bb.y;
    v[i].z = (v[i].z - mu) * rs * g.z + bb.z; v[i].w = (v[i].w - mu) * rs * g.w + bb.w;
    *(float4*)(row + k) = v[i];
    uint2 o; o.x = pack2(v[i].x, v[i].y); o.y = pack2(v[i].z, v[i].w);
    *(uint2*)(p.x1b + (size_t)m * 1024 + k) = o;
    *(float4*)(xl + k) = v[i];
  }
  WSYNC();
  float gl[4] = {0.f, 0.f, 0.f, 0.f};
#pragma unroll 4
  for (int c = 0; c < 16; c++) {
    const int k = c * 64 + lane;
    const float xk = xl[k];
    const float4 w = *(const float4*)(p.rg_w + (size_t)k * 4);
    gl[0] += xk * w.x; gl[1] += xk * w.y; gl[2] += xk * w.z; gl[3] += xk * w.w;
  }
#pragma unroll
  for (int j = 0; j < 4; j++) gl[j] = wsum(gl[j]) + p.rg_b[j];
  int gi = 0; float gm = gl[0];
#pragma unroll
  for (int j = 1; j < 4; j++) if (gl[j] > gm) { gm = gl[j]; gi = j; }
  float gs = 0.f;
#pragma unroll
  for (int j = 0; j < 4; j++) gs += __expf(gl[j] - gm);
  const float gprob = 1.f / gs;
  const float* riw = p.ri_w + (size_t)gi * 1024 * 8 + (lane & 1) * 4;
  float tq[4] = {0.f, 0.f, 0.f, 0.f};
#pragma unroll 4
  for (int c = 0; c < 32; c++) {
    const int k = c * 32 + (lane >> 1);
    const float xk = xl[k];
    const float4 w = *(const float4*)(riw + (size_t)k * 8);
    tq[0] += xk * w.x; tq[1] += xk * w.y; tq[2] += xk * w.z; tq[3] += xk * w.w;
  }
  float il[8];
#pragma unroll
  for (int j = 0; j < 4; j++) { il[j] = wsum((lane & 1) ? 0.f : tq[j]) + p.ri_b[gi * 8 + j]; il[4 + j] = wsum((lane & 1) ? tq[j] : 0.f) + p.ri_b[gi * 8 + 4 + j]; }
  int e1 = 0; float l1 = il[0];
#pragma unroll
  for (int j = 1; j < 8; j++) if (il[j] > l1) { l1 = il[j]; e1 = j; }
  int e2 = -1; float l2 = -3e38f;
#pragma unroll
  for (int j = 0; j < 8; j++) if (j != e1 && il[j] > l2) { l2 = il[j]; e2 = j; }
  const float ex = __expf(l2 - l1);
  const float w1 = gprob / (1.f + ex), w2 = gprob * ex / (1.f + ex);
  if (lane == 0) {
    const int ea = gi * 8 + e1, eb = gi * 8 + e2;
    const int grp = blockIdx.x & 15;
    const int pa = atomicAdd(p.cnt + grp * 32 + ea, 1); p.lists[(ea * 16 + grp) * 2048 + pa] = m * 2;
    const int pb = atomicAdd(p.cnt + grp * 32 + eb, 1); p.lists[(eb * 16 + grp) * 2048 + pb] = m * 2 + 1;
    p.routew[m * 2] = w1; p.routew[m * 2 + 1] = w2;
  }
  WSYNC();
}
DI void ln2_final(const Params& p, int m, int lane) {
  float* row = p.out + (size_t)m * 1024;
  float4 v[4];
  float s = 0.f;
#pragma unroll
  for (int i = 0; i < 4; i++) {
    const int k = i * 256 + lane * 4;
    const float4 xv = *(const float4*)(row + k);
    const uint2 a = *(const uint2*)(p.part + (size_t)(2 * m) * 1024 + k), b = *(const uint2*)(p.part + (size_t)(2 * m + 1) * 1024 + k);
    v[i].x = ALPHA * xv.x + lo2f(a.x) + lo2f(b.x); v[i].y = ALPHA * xv.y + hi2f(a.x) + hi2f(b.x);
    v[i].z = ALPHA * xv.z + lo2f(a.y) + lo2f(b.y); v[i].w = ALPHA * xv.w + hi2f(a.y) + hi2f(b.y);
    s += v[i].x + v[i].y + v[i].z + v[i].w;
  }
  const float mu = wsum(s) * (1.f / 1024.f);
  float q = 0.f;
#pragma unroll
  for (int i = 0; i < 4; i++) { const float a = v[i].x - mu, b = v[i].y - mu, c = v[i].z - mu, d = v[i].w - mu; q += a * a + b * b + c * c + d * d; }
  const float rs = rsqrtf(wsum(q) * (1.f / 1024.f) + 1e-5f);
#pragma unroll
  for (int i = 0; i < 4; i++) {
    const int k = i * 256 + lane * 4;
    const float4 g = *(const float4*)(p.ln2_g + k), bb = *(const float4*)(p.ln2_b + k);
    float4 o; o.x = (v[i].x - mu) * rs * g.x + bb.x; o.y = (v[i].y - mu) * rs * g.y + bb.y; o.z = (v[i].z - mu) * rs * g.z + bb.z; o.w = (v[i].w - mu) * rs * g.w + bb.w;
    *(float4*)(row + k) = o;
  }
}

struct MoeMap { int e, mi, cnt, hoff; };
#define MOE_TAB(smem) ((int*)((smem) + 65552))
DI void moe_tables(const Params& p, char* smem) {
  int* tab = MOE_TAB(smem); int* pre = tab; int* tpre = tab + 32 * 17;
  const int tid = opq(threadIdx.x);
  __syncthreads();
  if (tid < 32) { int acc = 0; for (int g = 0; g < 16; g++) { pre[tid * 17 + g] = acc; acc += p.cnt[g * 32 + tid]; } pre[tid * 17 + 16] = acc; }
  __syncthreads();
  if (tid == 0) { int acc = 0; for (int e = 0; e < NEXP; e++) { tpre[e] = acc; acc += (pre[e * 17 + 16] + 127) >> 7; } tpre[32] = acc; }
  __syncthreads();
}
DI bool moe_map(char* smem, int mtile, MoeMap& mm) {
  const int* tab = MOE_TAB(smem); const int* pre = tab; const int* tpre = tab + 32 * 17;
  if (mtile >= tpre[32]) return false;
  int e = 0;
  while (tpre[e + 1] <= mtile) e++;
  mm.e = e; mm.mi = mtile - tpre[e]; mm.cnt = pre[e * 17 + 16]; mm.hoff = tpre[e] * 128;
  return true;
}
DI int moe_total(char* smem) { return MOE_TAB(smem)[32 * 17 + 32]; }
DI const int* moe_rows(const Params& p, const MoeMap& mm, char* smem) {
  int* tab = MOE_TAB(smem); const int* pre = tab + mm.e * 17; int* rowent = tab + 32 * 17 + 40;
  const int tid = opq(threadIdx.x);
  __syncthreads();
  if (tid < 128) {
    const int ri = mm.mi * 128 + tid; int ent = -1;
    if (ri < mm.cnt) { int g = 0; while (pre[g + 1] <= ri) g++; ent = p.lists[(mm.e * 16 + g) * 2048 + ri - pre[g]]; }
    rowent[tid] = ent;
  }
  __syncthreads();
  return rowent;
}
DI void moe_up_tile(const Params& p, const MoeMap& mm, int nt_, char* smem) {
  const int* lst = moe_rows(p, mm, smem); const int nrow = mm.cnt - mm.mi * 128;
  const bf16_t* Bt = p.EgT + ((size_t)mm.e * 1024 + nt_ * 128) * 1024;
  const bf16_t* X = p.x1b;
  f32x4 acc[4][4]; zero_acc(acc);
  gemm128<true>(acc, [=](int r) { const int tk = r < nrow ? (lst[r] >> 1) : 0; return X + (size_t)tk * 1024; }, [=](int r) { return Bt + (size_t)r * 1024; }, 1024, smem);
  const int lane = opq(threadIdx.x) & 63, wave = opq(threadIdx.x) >> 6, wr = wave >> 1, wc = wave & 1, fr = lane & 15, fq = lane >> 4;
#pragma unroll
  for (int mt = 0; mt < 4; mt++) {
    const int r = wr * 64 + mt * 16 + fr;
    if (r < nrow) {
      const float w = p.routew[lst[r]];
#pragma unroll
      for (int np = 0; np < 2; np++) {
        const f32x4 g = acc[mt][np * 2], u = acc[mt][np * 2 + 1];
        float hv[4];
#pragma unroll
        for (int i = 0; i < 4; i++) hv[i] = g[i] * sigmoidf_(g[i]) * u[i] * w;
        const int f = nt_ * 64 + wc * 32 + np * 16 + fq * 4;
        uint2 o; o.x = pack2(hv[0], hv[1]); o.y = pack2(hv[2], hv[3]);
        *(uint2*)(p.Hh + (size_t)(mm.hoff + mm.mi * 128 + r) * 512 + f) = o;
      }
    }
  }
}
DI void moe_down_tile(const Params& p, const MoeMap& mm, int nt_, char* smem) {
  const int* lst = moe_rows(p, mm, smem); const int nrow = mm.cnt - mm.mi * 128;
  const bf16_t* A = p.Hh + (size_t)(mm.hoff + mm.mi * 128) * 512;
  const bf16_t* Bt = p.EdT + ((size_t)mm.e * 1024 + nt_ * 128) * 512;
  f32x4 acc[4][4]; zero_acc(acc);
  gemm128<true>(acc, [=](int r) { return A + (size_t)r * 512; }, [=](int r) { return Bt + (size_t)r * 512; }, 512, smem);
  epilogue<true>(acc, [&](int r, int c, f32x4 v) {
    if (r < nrow) {
      const int ts = lst[r];
      uint2 o; o.x = pack2(v[0], v[1]); o.y = pack2(v[2], v[3]);
      *(uint2*)(p.part + (size_t)ts * 1024 + nt_ * 128 + c) = o;
    }
  });
}

constexpr int NPHASE = 12;
#if FUSED
#define PHFN DI
#else
#define PHFN DI
#endif
#define PH_PRE const int bid = blockIdx.x, nb = gridDim.x, tid = opq(threadIdx.x), lane = tid & 63, wave = tid >> 6; \
  const int gw = bid * 4 + wave, nw = nb * 4; char* wsm = smem + wave * 8192; (void)bid; (void)nb; (void)lane; (void)gw; (void)nw; (void)wsm;
PHFN void ph0(const Params& p, char* smem) { phase0(p, smem); }
PHFN void ph1(const Params& p, char* smem) { phase1(p, smem); }
PHFN void ph2(const Params& p, char* smem) { PH_PRE
  for (int t = bid; t < 256 + 512; t += nb) { if (t < 256) compress1_tile(p, t, smem); else if (((t - 256) & 31) != 31) ret_u_unit(p, t - 256); }
}
PHFN void ph3(const Params& p, char* smem) { compress2(p, smem); ret_scan_elem(p); }
PHFN void ph4(const Params& p, char* smem) { PH_PRE
  for (int u = bid; u < 1024; u += nb) cmp_unit(p, u, smem);
}
PHFN void ph5(const Params& p, char* smem) { PH_PRE
  for (int u = bid; u < 512; u += nb) { const int k = u >> 3; attn_unit(p, ((u & 7) << 6) | (k < 32 ? 63 - k : k - 32), smem); }
  {
    int* sh = (int*)(smem + 65552 + 3072);
    for (;;) {
      __syncthreads();
      if (tid == 0) sh[0] = (int)xb_add(&p.qctr[0], 1u);
      __syncthreads();
      const int u = sh[0];
      if (u >= 1024) break;
      ret_out_unit(p, u, smem);
    }
  }
}
PHFN void ph6(const Params& p, char* smem) { PH_PRE for (int t = bid; t < 1024; t += nb) upproj_tile(p, t, smem); }
PHFN void ph7(const Params& p, char* smem) { phase7(p, smem); }
PHFN void ph8(const Params& p, char* smem) { PH_PRE for (int m = gw; m < M; m += nw) ln1_router(p, m, lane, (float*)wsm); }
PHFN void ph9(const Params& p, char* smem) { PH_PRE moe_tables(p, smem); const int tot = moe_total(smem);
  for (int t = bid; t < tot * 8; t += nb) { MoeMap mm; if (moe_map(smem, t >> 3, mm)) moe_up_tile(p, mm, t & 7, smem); } }
PHFN void ph10(const Params& p, char* smem) { PH_PRE moe_tables(p, smem); const int tot = moe_total(smem);
  for (int t = bid; t < tot * 8; t += nb) { MoeMap mm; if (moe_map(smem, t >> 3, mm)) moe_down_tile(p, mm, t & 7, smem); } }
PHFN void ph11(const Params& p, char* smem) { PH_PRE for (int m = gw; m < M; m += nw) ln2_final(p, m, lane); }
DI void run_phase(const Params& p, const int ph, char* smem) {
  switch (ph) {
    case 0: ph0(p, smem); break; case 1: ph1(p, smem); break; case 2: ph2(p, smem); break; case 3: ph3(p, smem); break;
    case 4: ph4(p, smem); break; case 5: ph5(p, smem); break; case 6: ph6(p, smem); break; case 7: ph7(p, smem); break;
    case 8: ph8(p, smem); break; case 9: ph9(p, smem); break; case 10: ph10(p, smem); break; case 11: ph11(p, smem); break;
  }
}

template <int PH>
__global__ void __launch_bounds__(256, 2) phase_kernel(Params p) {
  __shared__ __attribute__((aligned(16))) char smem[65536 + 16 + 4096];
  run_phase(p, PH, smem);
}
#if FUSED
__global__ void __launch_bounds__(256, 2) mega_kernel(Params p_arg) {
  __shared__ __attribute__((aligned(16))) char smem[65536 + 16 + 4096];
  const Params& p = *(const Params*)__builtin_amdgcn_kernarg_segment_ptr();
  volatile LAS unsigned* st = (volatile LAS unsigned*)(smem + 65536);
  if (threadIdx.x == 0) { st[0] = 0u; st[1] = 0u; }
  __syncthreads();
  const XcdBarrier xb = xcd_barrier_post(p.bar, st);
#define GSYNC() xcd_barrier(xb)
  unsigned long long tk_ = 0; (void)tk_;
#define RUNPH(N) { unsigned long long t0_ = 0; if (PROBE_PHASE == N) t0_ = __builtin_amdgcn_s_memrealtime(); ph##N(p, smem); if (PROBE_DOUBLE & (1 << N)) { GSYNC(); ph##N(p, smem); } \
    if (PROBE_PHASE == N) { GSYNC(); tk_ = __builtin_amdgcn_s_memrealtime() - t0_; } }
  RUNPH(0); GSYNC(); RUNPH(1); GSYNC(); RUNPH(2); GSYNC(); RUNPH(3); GSYNC();
  RUNPH(4); GSYNC(); RUNPH(5); GSYNC(); RUNPH(6); GSYNC(); RUNPH(7); GSYNC();
  RUNPH(8); GSYNC(); RUNPH(9); GSYNC(); RUNPH(10); GSYNC(); RUNPH(11);
  if (PROBE_PHASE >= 0 && blockIdx.x == 0) { const unsigned long long t1_ = __builtin_amdgcn_s_memrealtime(); while (__builtin_amdgcn_s_memrealtime() - t1_ < 3ull * tk_) __builtin_amdgcn_s_sleep(8); }
}
#endif

extern "C" void kernel_launch(void* const* d_in, const int* in_sizes, int n_in, void* d_out, int out_size,
                              void* d_ws, size_t ws_size, hipStream_t stream) {
  Params p{};
  const float** ins = (const float**)&p;
  for (int i = 0; i < 28; i++) ins[i] = (const float*)d_in[i];
  p.out = (float*)d_out;
  char* ws = (char*)d_ws; size_t off = 0;
  auto alloc = [&](size_t bytes) { char* r = ws + off; off += (bytes + 255) & ~(size_t)255; return r; };
  const size_t MiB = 1 << 20;
  char* regionP = ws;
  p.Qn = (bf16_t*)alloc(16 * MiB);
  p.CK = (bf16_t*)alloc(4 * MiB); p.CV = (bf16_t*)alloc(4 * MiB); p.SK = (bf16_t*)alloc(4 * MiB); p.SVt = (bf16_t*)alloc(4 * MiB);
  p.WK = (bf16_t*)alloc(4 * MiB); p.WVt = (bf16_t*)alloc(4 * MiB);
  p.NG = (float*)alloc((size_t)M * 24 * 4);
  p.RQ = (bf16_t*)alloc(16 * MiB); p.RK = (bf16_t*)alloc(16 * MiB); p.RKzT = (bf16_t*)alloc(16 * MiB);
  p.RVt = (bf16_t*)alloc(32 * MiB); p.RG = (bf16_t*)alloc(32 * MiB); p.MG = (bf16_t*)alloc(64 * MiB);
  p.oattn = (bf16_t*)alloc(16 * MiB); p.WinT = p.oattn;
  p.oret = (bf16_t*)alloc(32 * MiB);
  p.WaT = (bf16_t*)alloc(1 * MiB); p.WrT = (bf16_t*)alloc(2 * MiB); p.WoT = (bf16_t*)alloc(2 * MiB);
  p.W1kT = (bf16_t*)alloc(1 * MiB); p.W1vT = (bf16_t*)alloc(1 * MiB);
  p.ropeN = (float*)alloc((size_t)T * 32 * 8); p.ropeR = (float*)alloc((size_t)T * 64 * 8); p.posb = (float*)alloc(512 * 4); p.posp = (float*)alloc(32 * 512 * 4);
  p.H1 = (bf16_t*)alloc(2 * MiB); p.kcmp = (bf16_t*)alloc(8 * 256 * 64 * 2); p.vcmpT = (bf16_t*)alloc(8 * 64 * 256 * 2);
  p.selmask = (unsigned long long*)alloc((size_t)8 * T * 8);
  p.cnt = (int*)alloc(512 * 4); p.lists = (int*)alloc((size_t)NEXP * 16 * 2048 * 4); p.routew = (float*)alloc((size_t)M * 2 * 4);
  p.merged = (bf16_t*)(regionP); p.x1b = (bf16_t*)(regionP + 32 * MiB);
  p.EgT = (bf16_t*)(regionP + 64 * MiB); p.EdT = (bf16_t*)(regionP + 128 * MiB);
  p.Hh = (bf16_t*)(regionP + 160 * MiB); p.part = (bf16_t*)(regionP + 196 * MiB);
  p.bar = (unsigned*)alloc((XCD_BAR_WORDS + 64) * 4); p.qctr = p.bar + XCD_BAR_WORDS;
  p.xb = (bf16_t*)d_out; p.Rt = (bf16_t*)d_out; p.Ut = (bf16_t*)d_out + (size_t)16 * 1024 * 1024;
  if (off > ws_size) { fprintf(stderr, "workspace too small: need %zu have %zu\n", off, ws_size); return; }
#if FUSED
  static int grid_blocks = 0;
  if (!grid_blocks) {
    int dev = 0, cus = 0, per_cu = 0;
    (void)hipGetDevice(&dev);
    (void)hipDeviceGetAttribute(&cus, hipDeviceAttributeMultiprocessorCount, dev);
    (void)hipOccupancyMaxActiveBlocksPerMultiprocessor(&per_cu, mega_kernel, 256, 0);
    if (per_cu > 2) per_cu = 2;
    grid_blocks = cus * per_cu;
  }
  (void)hipMemsetAsync(p.bar, 0, (XCD_BAR_WORDS + 64) * 4, stream);
  void* args[] = {&p};
  hipError_t e = hipLaunchCooperativeKernel((void*)mega_kernel, dim3(grid_blocks), dim3(256), args, 0, stream);
  if (e != hipSuccess) fprintf(stderr, "coop launch failed: %s\n", hipGetErrorString(e));
#else
(void)hipMemsetAsync(p.bar, 0, (XCD_BAR_WORDS + 64) * 4, stream);
#define LAUNCH_PH(N) phase_kernel<N><<<512, 256, 0, stream>>>(p)
  LAUNCH_PH(0); LAUNCH_PH(1); LAUNCH_PH(2); LAUNCH_PH(3); LAUNCH_PH(4); LAUNCH_PH(5);
  LAUNCH_PH(6); LAUNCH_PH(7); LAUNCH_PH(8); LAUNCH_PH(9); LAUNCH_PH(10); LAUNCH_PH(11);
#endif
}
```

```cpp
#include <hip/hip_runtime.h>
#include <hip/hip_cooperative_groups.h>
#include <cstdio>
#include <cstdint>
namespace cg = cooperative_groups;

#ifndef FUSED
#define FUSED 1
#endif
#ifndef PROBE_DOUBLE
#define PROBE_DOUBLE 0
#endif
#ifndef PROBE_ROUTER
#define PROBE_ROUTER 0
#endif
#ifndef PROBE_PHASE
#define PROBE_PHASE -1
#endif

#define DI __device__ __forceinline__
typedef unsigned short bf16_t;
typedef short bf16x8 __attribute__((ext_vector_type(8)));
typedef float f32x4 __attribute__((ext_vector_type(4)));

constexpr int Bn = 4, T = 4096, D = 1024, M = Bn * T;
constexpr int NINP = 6528;
constexpr int NEXP = 32, DFF = 512;
constexpr int HROWS = 36864;
constexpr float ALPHA = 1.189207115002721f;

struct Params {
  const float *x, *w_in, *cmp_pos_k, *cmp_k_w1, *cmp_k_b1, *cmp_k_w2, *cmp_k_b2;
  const float *cmp_pos_v, *cmp_v_w1, *cmp_v_b1, *cmp_v_w2, *cmp_v_b2;
  const float *gn_g, *gn_b, *w_up_attn, *w_up_ret, *w_out, *ln1_g, *ln1_b;
  const float *rg_w, *rg_b, *ri_w, *ri_b, *e_wg, *e_wu, *e_wd, *ln2_g, *ln2_b;
  float* out;
  bf16_t *Qn, *CK, *CV, *SK, *SVt, *WK, *WVt; float* NG;
  bf16_t *RQ, *RK, *RKzT, *RVt, *RG, *MG;
  bf16_t *WinT  , *oattn, *oret;
  bf16_t *WaT, *WrT, *WoT, *W1kT, *W1vT;
  float *ropeN, *ropeR, *posb, *posp;
  bf16_t *H1, *kcmp, *vcmpT;
  unsigned long long* selmask;
  int* cnt; int* lists; float* routew;
  bf16_t *merged, *x1b, *EgT  , *EdT  , *Hh, *part;
  bf16_t *xb, *Rt, *Ut;
  unsigned* bar;
  unsigned* qctr;
};

DI float bf2f(bf16_t v) { return __uint_as_float(((unsigned)v) << 16); }
typedef __bf16 bf16x2_t __attribute__((ext_vector_type(2)));
DI bf16_t f2bf(float f) { return __builtin_bit_cast(bf16_t, (__bf16)f); }
DI unsigned pack2(float a, float b) { bf16x2_t v = {(__bf16)a, (__bf16)b}; return __builtin_bit_cast(unsigned, v); }
typedef float f32x16 __attribute__((ext_vector_type(16)));
#define MFMA32(a, b, c) __builtin_amdgcn_mfma_f32_32x32x16_bf16((a), (b), (c), 0, 0, 0)
DI float lo2f(unsigned u) { return __uint_as_float(u << 16); }
DI float hi2f(unsigned u) { return __uint_as_float(u & 0xffff0000u); }
DI float wsum(float v) {
  v += __int_as_float(__builtin_amdgcn_update_dpp(0, __float_as_int(v), 0x111, 0xf, 0xf, false));
  v += __int_as_float(__builtin_amdgcn_update_dpp(0, __float_as_int(v), 0x112, 0xf, 0xf, false));
  v += __int_as_float(__builtin_amdgcn_update_dpp(0, __float_as_int(v), 0x114, 0xf, 0xf, false));
  v += __int_as_float(__builtin_amdgcn_update_dpp(0, __float_as_int(v), 0x118, 0xf, 0xf, false));
  v += __int_as_float(__builtin_amdgcn_update_dpp(0, __float_as_int(v), 0x142, 0xa, 0xf, false));
  v += __int_as_float(__builtin_amdgcn_update_dpp(0, __float_as_int(v), 0x143, 0xc, 0xf, false));
  return __int_as_float(__builtin_amdgcn_readlane(__float_as_int(v), 63));
}
DI float wmax(float v) { for (int o = 32; o > 0; o >>= 1) v = fmaxf(v, __shfl_xor(v, o)); return v; }
DI float sigmoidf_(float x) { return 1.f / (1.f + __expf(-x)); }
#define WSYNC() asm volatile("s_waitcnt lgkmcnt(0)" ::: "memory")
DI size_t frag_off(int row, int k, int K) { return ((size_t)(((row >> 5) * (K >> 4) + (k >> 4)) * 2 + ((k >> 3) & 1))) * 256 + (row & 31) * 8 + (k & 7); }
DI int perm23(int r) { return (r & 0x13) | ((r & 4) << 1) | ((r & 8) >> 1); }
DI int opq(int x) { asm volatile("" : "+v"(x)); return x; }


#define XB_TMO      128
#define XB_XCNT(j)  (256  + 64 * (j))
#define XB_XSUB(j)  (1280 + 64 * (j))
#define XB_XGEN(j)  (2304 + 64 * (j))
#define XB_TOP      3328
#define XB_TOPGEN   3392
#define XCD_BAR_WORDS 3456
#define XB_SPIN_CAP (1u << 20)
#define LAS __attribute__((address_space(3)))
DI unsigned xb_ld(unsigned* p) { return __hip_atomic_load(p, __ATOMIC_RELAXED, __HIP_MEMORY_SCOPE_AGENT); }
DI unsigned xb_add(unsigned* p, unsigned v) { return __hip_atomic_fetch_add(p, v, __ATOMIC_RELAXED, __HIP_MEMORY_SCOPE_AGENT); }
DI unsigned xb_xcc_id() { return (unsigned)__builtin_amdgcn_s_getreg((3 << 11) | 20) & 0xFu; }
#define XB_SPIN(cond, bar) do { unsigned _sp = 0; while (cond) { __builtin_amdgcn_s_sleep(1); \
    if ((++_sp & 255u) == 0u) { if (xb_ld(&(bar)[XB_TMO])) break; if (_sp > XB_SPIN_CAP) { atomicAdd(&(bar)[XB_TMO], 1u); break; } } } } while (0)
struct XcdBarrier { unsigned* bar; unsigned x; volatile LAS unsigned* st; };
DI XcdBarrier xcd_barrier_post(unsigned* bar, volatile LAS unsigned* st) {
  XcdBarrier b; b.bar = bar; b.x = xb_xcc_id(); b.st = st;
  if (threadIdx.x == 0) (void)xb_add(&bar[XB_XCNT(b.x)], 1u);
  return b;
}
DI void xcd_barrier_complete(unsigned* bar, unsigned x, unsigned& nloc, unsigned& nx) {
  const unsigned G = gridDim.x * gridDim.y * gridDim.z;
  unsigned sum, cnt, mine, sp = 0u;
  for (;;) {
    sum = 0u; cnt = 0u; mine = 0u;
#pragma unroll
    for (unsigned j = 0; j < 16; ++j) { const unsigned c = xb_ld(&bar[XB_XCNT(j)]); sum += c; cnt += (c > 0u) ? 1u : 0u; mine = (j == x) ? c : mine; }
    if (sum == G) break;
    __builtin_amdgcn_s_sleep(1);
    if ((++sp & 255u) == 0u) { if (xb_ld(&bar[XB_TMO])) break; if (sp > XB_SPIN_CAP) { atomicAdd(&bar[XB_TMO], 1u); break; } }
  }
  nloc = mine > 0u ? mine : 1u; nx = cnt > 0u ? cnt : 1u;
}
DI void xcd_barrier(const XcdBarrier& b) {
  asm volatile("s_waitcnt vmcnt(0)" ::: "memory");
  __syncthreads();
  if (threadIdx.x == 0) {
    unsigned* bar = b.bar;
    __builtin_amdgcn_s_waitcnt(0);
    unsigned nloc = b.st[0], nx = b.st[1];
    if (nloc == 0u) { xcd_barrier_complete(bar, b.x, nloc, nx); b.st[0] = nloc; b.st[1] = nx; }
    const unsigned old = xb_add(&bar[XB_XSUB(b.x)], 1u);
    const unsigned gen = old / nloc;
    if (old + 1u == (gen + 1u) * nloc) {
      __builtin_amdgcn_fence(__ATOMIC_RELEASE, "agent");
      asm volatile("s_waitcnt vmcnt(0)" ::: "memory");
      const unsigned og = xb_add(&bar[XB_TOP], 1u);
      const unsigned tg = og / nx;
      if (og + 1u == (tg + 1u) * nx) xb_add(&bar[XB_TOPGEN], 1u);
      else XB_SPIN(xb_ld(&bar[XB_TOPGEN]) == tg, bar);
      __builtin_amdgcn_fence(__ATOMIC_ACQUIRE, "agent");
      xb_add(&bar[XB_XGEN(b.x)], 1u);
      asm volatile("s_waitcnt vmcnt(0)" ::: "memory");
    } else {
      XB_SPIN(xb_ld(&bar[XB_XGEN(b.x)]) == gen, bar);
      __builtin_amdgcn_fence(__ATOMIC_ACQUIRE, "agent");
      asm volatile("s_waitcnt vmcnt(0)" ::: "memory");
    }
  }
  __syncthreads();
}

DI void glds16_asm(const void* gsrc, unsigned lds_dst) {
  unsigned keep;
  asm volatile("s_mov_b32 %0, m0\n\ts_mov_b32 m0, %2\n\ts_nop 0\n\tglobal_load_lds_dwordx4 %1, off\n\ts_mov_b32 m0, %0" : "=&s"(keep) : "v"(gsrc), "s"(lds_dst) : "memory");
}
template <bool SWAP, class AR, class BR>
DI void gemm128(f32x4 (&acc)[4][4], AR arow, BR brow, int K, char* smem) {
  const int tid = opq(threadIdx.x), lane = tid & 63, wave = tid >> 6, wr = wave >> 1, wc = wave & 1;
  const int prow = lane >> 3, pch = ((lane & 7) ^ prow) << 3;
  const bf16_t* ap[4]; const bf16_t* bp[4];
#pragma unroll
  for (int i = 0; i < 4; i++) { ap[i] = arow((wave * 4 + i) * 8 + prow) + pch; bp[i] = brow((wave * 4 + i) * 8 + prow) + pch; }
  const unsigned ldsb = (unsigned)(size_t)(LAS char*)smem;
  const unsigned lpiece = __builtin_amdgcn_readfirstlane(wave * 4096);
  char* As = smem; char* Bs = smem + 32768;
  const int nk = K >> 6;
  const int fr = lane & 15, fq = lane >> 4;
  const int aoff0 = (wr * 64 + fr) * 128, boff0 = (wc * 64 + fr) * 128;
  auto gload = [&](int t, int buf) {
#pragma unroll
    for (int i = 0; i < 4; i++) {
      glds16_asm(ap[i] + t * 64, ldsb + buf * 16384 + lpiece + i * 1024);
      glds16_asm(bp[i] + t * 64, ldsb + 32768 + buf * 16384 + lpiece + i * 1024);
    }
  };
  auto gcomp = [&](int buf) {
    const char* Ac = As + buf * 16384; const char* Bc = Bs + buf * 16384;
#pragma unroll
    for (int ks = 0; ks < 2; ks++) {
      const int chs = ((ks * 4 + fq) ^ (fr & 7)) << 4;
      bf16x8 a[4], b[4];
#pragma unroll
      for (int mt = 0; mt < 4; mt++) a[mt] = *(const bf16x8*)(Ac + aoff0 + mt * 2048 + chs);
#pragma unroll
      for (int nt = 0; nt < 4; nt++) b[nt] = *(const bf16x8*)(Bc + boff0 + nt * 2048 + chs);
      __builtin_amdgcn_s_setprio(1);
#pragma unroll
      for (int mt = 0; mt < 4; mt++)
#pragma unroll
        for (int nt = 0; nt < 4; nt++)
          acc[mt][nt] = SWAP ? __builtin_amdgcn_mfma_f32_16x16x32_bf16(b[nt], a[mt], acc[mt][nt], 0, 0, 0)
                             : __builtin_amdgcn_mfma_f32_16x16x32_bf16(a[mt], b[nt], acc[mt][nt], 0, 0, 0);
      __builtin_amdgcn_s_setprio(0);
    }
  };
  asm volatile("s_waitcnt vmcnt(0)" ::: "memory");
  gload(0, 0);
  asm volatile("s_waitcnt vmcnt(0)" ::: "memory");
  __builtin_amdgcn_s_barrier();
#pragma unroll 1
  for (int kt = 0; kt < nk; kt++) {
    const int cur = kt & 1;
    if (kt + 1 < nk) gload(kt + 1, cur ^ 1);
    gcomp(cur);
    asm volatile("s_waitcnt vmcnt(0)" ::: "memory");
    __builtin_amdgcn_s_barrier();
  }
}
template <bool SWAP, class AR, class BC>
DI void gemm128f(f32x4 (&acc)[4][4], AR arow, BC bcol, int ldb, int K, char* smem) {
  const int tid = opq(threadIdx.x), lane = tid & 63, wave = tid >> 6, wr = wave >> 1, wc = wave & 1;
  const int srow = tid >> 3, sch = tid & 7;
  const int bn = tid & 127, bh = tid >> 7;
  const bf16_t* ap[4];
#pragma unroll
  for (int i = 0; i < 4; i++) ap[i] = arow(srow + 32 * i) + sch * 8;
  const float* bq = bcol(bn) + (size_t)(bh * 32) * ldb;
  const int woff = srow * 128 + ((sch ^ (srow & 7)) << 4);
  char* As = smem; char* Bs = smem + 32768;
  uint4 ra[4]; float rb[4][8];
  auto bload = [&](int kt) {
    const float* q = bq + (size_t)kt * 64 * ldb;
#pragma unroll
    for (int i = 0; i < 4; i++)
#pragma unroll
      for (int j = 0; j < 8; j++) rb[i][j] = q[(size_t)(i * 8 + j) * ldb];
  };
  auto bwrite = [&](char* Bd) {
#pragma unroll
    for (int i = 0; i < 4; i++) {
      uint4 u; u.x = pack2(rb[i][0], rb[i][1]); u.y = pack2(rb[i][2], rb[i][3]); u.z = pack2(rb[i][4], rb[i][5]); u.w = pack2(rb[i][6], rb[i][7]);
      *(uint4*)(Bd + bn * 128 + ((((bh * 4 + i)) ^ (bn & 7)) << 4)) = u;
    }
  };
#pragma unroll
  for (int i = 0; i < 4; i++) ra[i] = *(const uint4*)(ap[i]);
  bload(0);
#pragma unroll
  for (int i = 0; i < 4; i++) *(uint4*)(As + woff + i * 4096) = ra[i];
  bwrite(Bs);
  __syncthreads();
  const int nk = K >> 6;
  const int fr = lane & 15, fq = lane >> 4;
  const int aoff0 = (wr * 64 + fr) * 128, boff0 = (wc * 64 + fr) * 128;
  for (int kt = 0; kt < nk; kt++) {
    const int cur = kt & 1;
    if (kt + 1 < nk) {
#pragma unroll
      for (int i = 0; i < 4; i++) ra[i] = *(const uint4*)(ap[i] + (kt + 1) * 64);
      bload(kt + 1);
    }
    const char* Ac = As + cur * 16384; const char* Bc = Bs + cur * 16384;
#pragma unroll
    for (int ks = 0; ks < 2; ks++) {
      const int chs = ((ks * 4 + fq) ^ (fr & 7)) << 4;
      bf16x8 a[4], b[4];
#pragma unroll
      for (int mt = 0; mt < 4; mt++) a[mt] = *(const bf16x8*)(Ac + aoff0 + mt * 2048 + chs);
#pragma unroll
      for (int nt = 0; nt < 4; nt++) b[nt] = *(const bf16x8*)(Bc + boff0 + nt * 2048 + chs);
#pragma unroll
      for (int mt = 0; mt < 4; mt++)
#pragma unroll
        for (int nt = 0; nt < 4; nt++)
          acc[mt][nt] = SWAP ? __builtin_amdgcn_mfma_f32_16x16x32_bf16(b[nt], a[mt], acc[mt][nt], 0, 0, 0)
                             : __builtin_amdgcn_mfma_f32_16x16x32_bf16(a[mt], b[nt], acc[mt][nt], 0, 0, 0);
    }
    if (kt + 1 < nk) {
      char* An = As + (cur ^ 1) * 16384;
#pragma unroll
      for (int i = 0; i < 4; i++) *(uint4*)(An + woff + i * 4096) = ra[i];
      bwrite(Bs + (cur ^ 1) * 16384);
    }
    __syncthreads();
  }
}
DI void zero_acc(f32x4 (&acc)[4][4]) {
#pragma unroll
  for (int i = 0; i < 4; i++)
#pragma unroll
    for (int j = 0; j < 4; j++) acc[i][j] = (f32x4){0.f, 0.f, 0.f, 0.f};
}
template <bool SWAP, class F>
DI void epilogue(const f32x4 (&acc)[4][4], F f) {
  const int lane = opq(threadIdx.x) & 63, wave = opq(threadIdx.x) >> 6, wr = wave >> 1, wc = wave & 1, fr = lane & 15, fq = lane >> 4;
#pragma unroll
  for (int mt = 0; mt < 4; mt++)
#pragma unroll
    for (int nt = 0; nt < 4; nt++) {
      if (SWAP) f(wr * 64 + mt * 16 + fr, wc * 64 + nt * 16 + fq * 4, acc[mt][nt]);
      else f(wr * 64 + mt * 16 + fq * 4, wc * 64 + nt * 16 + fr, acc[mt][nt]);
    }
}

template <class CP>
DI void tcvt_tile(CP colptr, int ldsrc, bf16_t* dst, int K, int kt, int jt, float* tile) {
  const int tx = opq(threadIdx.x) & 63, ty = opq(threadIdx.x) >> 6;
  const float* sp = colptr(jt * 64 + tx);
  for (int i = ty; i < 64; i += 4) tile[i * 65 + tx] = sp ? sp[(size_t)(kt * 64 + i) * ldsrc] : 0.f;
  __syncthreads();
  for (int i = ty * 2 + (tx >> 5); i < 64; i += 8) {
    const int kk = (tx & 31) * 2;
    *(unsigned*)(dst + (size_t)(jt * 64 + i) * K + kt * 64 + kk) = pack2(tile[kk * 65 + i], tile[(kk + 1) * 65 + i]);
  }
  __syncthreads();
}
template <class CP>
DI void tcvt_all(CP colptr, int ldsrc, bf16_t* dst, int K, int N, float* tile, int bid, int nb) {
  const int nkt = K / 64, njt = N / 64;
  for (int t = bid; t < nkt * njt; t += nb) tcvt_tile(colptr, ldsrc, dst, K, t / njt, t % njt, tile);
}

template <class CP>
DI void tcvt_tile128(CP colptr, int ldsrc, bf16_t* dst, int K, int kt, int jt, float* tile  ) {
  const int tid = opq(threadIdx.x), tx = tid & 127, ty = tid >> 7;
  const float* sp0 = colptr(jt * 128 + tx);
  const float* sp = sp0 + (size_t)(kt * 64 + ty) * ldsrc;
  float v[32];
  if (sp0) {
#pragma unroll
    for (int i = 0; i < 32; i++) v[i] = sp[(size_t)(2 * i) * ldsrc];
  } else {
#pragma unroll
    for (int i = 0; i < 32; i++) v[i] = 0.f;
  }
#pragma unroll
  for (int i = 0; i < 32; i++) tile[(ty + 2 * i) * 129 + tx] = v[i];
  __syncthreads();
  const int pp = (tid & 31) * 2, j0 = tid >> 5;
#pragma unroll
  for (int i = 0; i < 16; i++) {
    const int j = j0 + 8 * i;
    *(unsigned*)(dst + (size_t)(jt * 128 + j) * K + kt * 64 + pp) = pack2(tile[pp * 129 + j], tile[(pp + 1) * 129 + j]);
  }
  __syncthreads();
}
DI int perm_half(int p, int d) { return (p & 1) ? (d / 2 + (p >> 1)) : (p >> 1); }
DI int inproj_col(int j) {
  if (j < 512) return (j & ~63) + perm_half(j & 63, 64);
  if (j < 1280) { const int grp = (j - 512) >> 7;
    if (grp == 2 || grp == 4) return (j & ~63) + perm_half(j & 63, 64);
    return j; }
  if (j < 1792) { const int q = j - 1280; return 1304 + (q & ~127) + perm_half(q & 127, 128); }
  if (j < 2304) { const int q = j - 1792; return 1816 + (q & ~127) + perm_half(q & 127, 128); }
  if (j < 3328) return 2328 + (j - 2304);
  if (j < 4352) return 3352 + (j - 3328);
  if (j < 6400) return 4376 + (j - 4352);
  const int q = j - 6400; return q < 24 ? 1280 + q : -1;
}

DI void phase0(const Params& p, char* smem) {
  const int bid = blockIdx.x, nb = gridDim.x, tid = opq(threadIdx.x);
  const size_t gtid = (size_t)bid * 256 + tid, gsz = (size_t)nb * 256;
  for (size_t i = gtid; i < (size_t)M * D / 4; i += gsz) {
    const float4 v = ((const float4*)p.x)[i];
    uint2 o; o.x = pack2(v.x, v.y); o.y = pack2(v.z, v.w);
    ((uint2*)p.xb)[i] = o;
  }
  float* tile = (float*)smem;
  for (int tt = bid; tt < 1264; tt += nb) {
    if (tt < 816) { const float* w = p.w_in; tcvt_tile128([=](int j) -> const float* { const int c = inproj_col(j); return c >= 0 ? w + c : nullptr; }, 6424, p.WinT, 1024, tt / 51, tt % 51, tile); }
    else if (tt < 880) { const int q = tt - 816; const float* w = p.w_up_attn; tcvt_tile128([=](int j) -> const float* { return w + j; }, 1024, p.WaT, 512, q >> 3, q & 7, tile); }
    else if (tt < 1008) { const int q = tt - 880; const float* w = p.w_up_ret; tcvt_tile128([=](int j) -> const float* { return w + j; }, 1024, p.WrT, 1024, q >> 3, q & 7, tile); }
    else if (tt < 1136) { const int q = tt - 1008; const float* w = p.w_out; tcvt_tile128([=](int j) -> const float* { return w + j; }, 1024, p.WoT, 1024, q >> 3, q & 7, tile); }
    else if (tt < 1200) { const int q = tt - 1136; const float* w = p.cmp_k_w1; tcvt_tile128([=](int j) -> const float* { return w + j; }, 256, p.W1kT, 2048, q >> 1, q & 1, tile); }
    else { const int q = tt - 1200; const float* w = p.cmp_v_w1; tcvt_tile128([=](int j) -> const float* { return w + j; }, 256, p.W1vT, 2048, q >> 1, q & 1, tile); }
  }
  for (size_t i = gtid; i < (size_t)T * 96; i += gsz) {
    const int t = (int)(i / 96), r = (int)(i % 96);
    float invf; float* dst;
    if (r < 32) { invf = (float)exp2(-(double)r * (2.0 / 64.0) * 13.287712379549449); dst = p.ropeN + ((size_t)t * 32 + r) * 2; }
    else { const int q = r - 32; invf = (float)exp2(-(double)q * (2.0 / 128.0) * 13.287712379549449); dst = p.ropeR + ((size_t)t * 64 + q) * 2; }
    const double ang = (double)((float)t * invf);
    const double kk = rint(ang * 0.15915494309189535);
    const float red = (float)(ang - kk * 6.283185307179586);
    dst[0] = cosf(red); dst[1] = sinf(red);
  }
  for (size_t i = gtid; i < 32 * 512; i += gsz) {
    const int qp = (int)(i >> 9), kv = (int)((i >> 8) & 1), j = (int)(i & 255);
    const float* pos = kv ? p.cmp_pos_v : p.cmp_pos_k; const float* w1 = kv ? p.cmp_v_w1 : p.cmp_k_w1;
    float s0 = 0.f;
#pragma unroll 8
    for (int q = qp * 64; q < qp * 64 + 64; q++) s0 += pos[q] * w1[(size_t)q * 256 + j];
    p.posp[i] = s0;
  }
  if (gtid < 512) p.cnt[gtid] = 0;
}

template <bool TRANS, class PROC, class DST>
DI void epilogue_lds(const f32x4 (&acc)[4][4], PROC proc, DST dst, char* smem) {
  const int tid = opq(threadIdx.x), lane = tid & 63, wave = tid >> 6, wr = wave >> 1, wc = wave & 1, fr = lane & 15, fq = lane >> 4;
#pragma unroll
  for (int mt = 0; mt < 4; mt++)
#pragma unroll
    for (int nt = 0; nt < 4; nt++) {
      const int r = wr * 64 + mt * 16 + (TRANS ? fq * 4 : fr), c = wc * 64 + nt * 16 + (TRANS ? fr : fq * 4);
      const uint2 o = proc(r, c, acc[mt][nt]);
      *(uint2*)(smem + (TRANS ? c * 272 + r * 2 : r * 272 + c * 2)) = o;
    }
  __syncthreads();
#pragma unroll
  for (int k = 0; k < 8; k++) {
    const int id = tid + 256 * k, i = id >> 4, j8 = (id & 15) * 8;
    *(uint4*)dst(i, j8) = *(const uint4*)(smem + i * 272 + j8 * 2);
  }
  __syncthreads();
}
DI void inproj_tile(const Params& p, int mt_, int nt_, char* smem) {
  const int m0 = mt_ * 128, b = m0 >> 12, t0 = m0 & 4095;
  const bf16_t* A = p.xb + (size_t)m0 * D; const bf16_t* Bt = p.WinT + (size_t)nt_ * 128 * D;
  f32x4 acc[4][4]; zero_acc(acc);
  auto ar = [=](int r) { return A + (size_t)r * D; };
  auto br = [=](int r) { return Bt + (size_t)r * D; };
  auto plain = [](int, int, f32x4 v) { uint2 o; o.x = pack2(v[0], v[1]); o.y = pack2(v[2], v[3]); return o; };
  const bool transposed = (nt_ == 7 || nt_ == 9 || (nt_ >= 18 && nt_ < 26));
  if (transposed) {
    gemm128<false>(acc, ar, br, D, smem);
    if (nt_ < 18) { bf16_t* base = ((nt_ == 7) ? p.SVt : p.WVt) + (size_t)b * 2 * 64 * T + t0;
      epilogue_lds<true>(acc, plain, [=](int c, int r8) { return base + (size_t)c * T + r8; }, smem); }
    else { const int h = (nt_ - 18) >> 1, e0 = ((nt_ - 18) & 1) * 128; bf16_t* base = p.RVt + (size_t)(b * 4 + h) * 256 * T;
      epilogue_lds<true>(acc, plain, [=](int c, int r8) { return base + frag_off(e0 + c, t0 + r8, T); }, smem); }
    return;
  }
  gemm128<true>(acc, ar, br, D, smem);
  if (nt_ < 4 || nt_ == 6 || nt_ == 8) {
    const float sc = nt_ < 4 ? 0.18033688011112042f : 1.f;
    bf16_t* base = (nt_ < 4) ? p.Qn + ((size_t)(b * 8 + nt_ * 2) * T + t0) * 64 : ((nt_ == 6) ? p.SK : p.WK) + ((size_t)(b * 2) * T + t0) * 64;
    epilogue_lds<false>(acc, [=](int r, int c, f32x4 v) {
      const float4 cs = *(const float4*)(p.ropeN + ((size_t)(t0 + r) * 32 + ((c & 63) >> 1)) * 2);
      uint2 o; o.x = pack2((v[0] * cs.x - v[1] * cs.y) * sc, (v[0] * cs.y + v[1] * cs.x) * sc); o.y = pack2((v[2] * cs.z - v[3] * cs.w) * sc, (v[2] * cs.w + v[3] * cs.z) * sc);
      return o; }, [=](int r, int c8) { return base + ((size_t)(c8 >> 6) * T + r) * 64 + (c8 & 63); }, smem);
  } else if (nt_ == 4 || nt_ == 5) {
    bf16_t* base = (nt_ == 4 ? p.CK : p.CV) + ((size_t)(b * 2) * T + t0) * 64;
    epilogue_lds<false>(acc, plain, [=](int r, int c8) { return base + ((size_t)(c8 >> 6) * T + r) * 64 + (c8 & 63); }, smem);
  } else if (nt_ >= 10 && nt_ < 18) {
    const bool isk = nt_ >= 14; const int h = (nt_ - 10) & 3;
    const float sc = isk ? 0.08838834764831845f : 1.f;
    bf16_t* base = (isk ? p.RK : p.RQ) + (size_t)(b * 4 + h) * T * 128;
    auto roped = [=](int r, int c, f32x4 v, float z) {
      const float4 cs = *(const float4*)(p.ropeR + ((size_t)(t0 + r) * 64 + (c >> 1)) * 2);
      const float s2 = sc * z;
      uint2 o; o.x = pack2((v[0] * cs.x - v[1] * cs.y) * s2, (v[0] * cs.y + v[1] * cs.x) * s2); o.y = pack2((v[2] * cs.z - v[3] * cs.w) * s2, (v[2] * cs.w + v[3] * cs.z) * s2);
      return o; };
    epilogue_lds<false>(acc, [=](int r, int c, f32x4 v) { return roped(r, c, v, 1.f); }, [=](int r, int c8) { return base + frag_off(t0 + r, c8, 128); }, smem);
    if (isk) {
      const float lg = log2f(1.f - exp2f(-5.f - (float)h));
      bf16_t* bz = p.RKzT + (size_t)(b * 4 + h) * 128 * T;
      const int tid = opq(threadIdx.x), lane = tid & 63, wave = tid >> 6, wr = wave >> 1, wc = wave & 1, fr = lane & 15, fq = lane >> 4;
#pragma unroll
      for (int mt = 0; mt < 4; mt++)
#pragma unroll
        for (int nt = 0; nt < 4; nt++) {
          const int r = wr * 64 + mt * 16 + fr, c = wc * 64 + nt * 16 + fq * 4;
          const uint2 o = roped(r, c, acc[mt][nt], exp2f((float)(127 - ((t0 + r) & 127)) * lg));
          bf16_t* q = (bf16_t*)(smem + c * 272 + r * 2);
          q[0] = (bf16_t)(o.x & 0xffffu); q[136] = (bf16_t)(o.x >> 16); q[272] = (bf16_t)(o.y & 0xffffu); q[408] = (bf16_t)(o.y >> 16);
        }
      __syncthreads();
#pragma unroll
      for (int k = 0; k < 8; k++) {
        const int id = tid + 256 * k, i = id >> 4, j8 = (id & 15) * 8;
        *(uint4*)(bz + frag_off(i, t0 + j8, T)) = *(const uint4*)(smem + i * 272 + j8 * 2);
      }
      __syncthreads();
    }
  } else if (nt_ >= 26 && nt_ < 34) {
    bf16_t* base = p.RG + (size_t)m0 * 1024 + (nt_ - 26) * 128;
    epilogue_lds<false>(acc, plain, [=](int r, int c8) { return base + (size_t)r * 1024 + c8; }, smem);
  } else if (nt_ >= 34 && nt_ < 50) {
    bf16_t* base = p.MG + (size_t)m0 * 2048 + (nt_ - 34) * 128;
    epilogue_lds<false>(acc, plain, [=](int r, int c8) { return base + (size_t)r * 2048 + c8; }, smem);
  } else {
    epilogue<true>(acc, [&](int r, int c, f32x4 v) {
      if (c < 24) { float4 o; o.x = sigmoidf_(v[0]); o.y = sigmoidf_(v[1]); o.z = sigmoidf_(v[2]); o.w = sigmoidf_(v[3]);
        *(float4*)(p.NG + (size_t)(m0 + r) * 24 + c) = o; }
    });
  }
}
DI void phase1(const Params& p, char* smem) {
  if (blockIdx.x < 2) {
    const int i = blockIdx.x * 256 + opq(threadIdx.x), kv = i >> 8, j = i & 255;
    float s0 = (kv ? p.cmp_v_b1 : p.cmp_k_b1)[j];
    for (int qp = 0; qp < 32; qp++) s0 += p.posp[qp * 512 + i];
    p.posb[i] = s0;
  }
  const int xcd = blockIdx.x & 7, lb = blockIdx.x >> 3, nlb = gridDim.x >> 3;
  for (int li = lb; li < 16 * 51; li += nlb) {
    const int mi = li & 7, rest = li >> 3, nt_ = rest % 51, half = rest / 51;
    inproj_tile(p, xcd * 16 + half * 8 + mi, nt_, smem);
  }
}


DI void attn_unit(const Params& p, int unit, char* smem) {
  const int tid = opq(threadIdx.x), lane = tid & 63, w = tid >> 6, r = lane & 31, h2 = lane >> 5;
  const int bg = unit >> 6, jq = unit & 63, b = bg >> 1, g = bg & 1, hh = g * 4 + w, t0 = jq * 64;
  bf16x8 qf[2][4];
#pragma unroll
  for (int qt = 0; qt < 2; qt++)
#pragma unroll
    for (int ks = 0; ks < 4; ks++)
      qf[qt][ks] = *(const bf16x8*)(p.Qn + ((size_t)(b * 8 + hh) * T + t0 + qt * 32 + r) * 64 + ks * 16 + h2 * 8);
  unsigned long long* sell = (unsigned long long*)(smem + 49152) + tid * 2;
#pragma unroll
  for (int qt = 0; qt < 2; qt++) sell[qt] = p.selmask[(size_t)bg * T + t0 + qt * 32 + r];
  const int wlo = jq > 8 ? jq - 8 : 0, nwin = jq - wlo + 1, nsteps = nwin + jq + 1;
  char* Kl = smem; char* Vl = smem + 24576;
  const unsigned ldsK = (unsigned)(size_t)(LAS char*)smem;
  const int grow = lane >> 3;
  auto gload = [&](int i, int buf) {
    const int br = i < nwin ? 2 : 1, j = i < nwin ? wlo + i : i - nwin;
    const bf16_t* Kp = (br == 1 ? p.SK : p.WK) + ((size_t)bg * T + j * 64) * 64;
    const bf16_t* Vp = (br == 1 ? p.SVt : p.WVt) + (size_t)bg * 64 * T + j * 64;
#pragma unroll
    for (int pc = 0; pc < 2; pc++) {
      const int row = (w * 2 + pc) * 8 + grow;
      const int gch = (lane & 7) ^ ((row >> 1) & 7);
      const unsigned loff = __builtin_amdgcn_readfirstlane(buf * 8192 + (w * 2 + pc) * 1024);
      glds16_asm(Kp + row * 64 + gch * 8, ldsK + loff);
      glds16_asm(Vp + (size_t)row * T + gch * 8, ldsK + 24576 + loff);
    }
  };
  const int pr = perm23(r);
  float mrow[2], lrow[2]; f32x16 O[2][2];
  auto reset = [&]() {
#pragma unroll
    for (int qt = 0; qt < 2; qt++) { mrow[qt] = -INFINITY; lrow[qt] = 0.f;
#pragma unroll
      for (int dt = 0; dt < 2; dt++)
#pragma unroll
        for (int i = 0; i < 16; i++) O[dt][qt][i] = 0.f; }
  };
  auto flush = [&](int br) {
#pragma unroll
    for (int qt = 0; qt < 2; qt++) {
      const int m = b * T + t0 + qt * 32 + r;
      const float gate = p.NG[(size_t)m * 24 + hh * 3 + br];
      const float sc = lrow[qt] > 0.f ? gate / lrow[qt] : 0.f;
#pragma unroll
      for (int dt = 0; dt < 2; dt++)
#pragma unroll
        for (int q4 = 0; q4 < 4; q4++) {
          bf16_t* dst = p.oattn + (size_t)m * 512 + hh * 64 + dt * 32 + q4 * 8 + h2 * 4;
          const uint2 old = *(const uint2*)dst;
          uint2 o; o.x = pack2(lo2f(old.x) + sc * O[dt][qt][q4 * 4], hi2f(old.x) + sc * O[dt][qt][q4 * 4 + 1]);
          o.y = pack2(lo2f(old.y) + sc * O[dt][qt][q4 * 4 + 2], hi2f(old.y) + sc * O[dt][qt][q4 * 4 + 3]);
          *(uint2*)dst = o;
        }
    }
  };
  reset();
#pragma unroll
  for (int qt = 0; qt < 2; qt++)
#pragma unroll
    for (int ks = 0; ks < 4; ks++) asm volatile("" :: "v"(qf[qt][ks]));
  gload(0, 0);
  if (nsteps > 1) { gload(1, 1); asm volatile("s_waitcnt vmcnt(4)" ::: "memory"); } else asm volatile("s_waitcnt vmcnt(0)" ::: "memory");
  __builtin_amdgcn_s_barrier();
  int cur = 0;
#pragma unroll 1
  for (int i = 0; i < nsteps; i++) {
    const int br = i < nwin ? 2 : 1, j = i < nwin ? wlo + i : i - nwin;
    if (i == nwin) { flush(2); reset(); }
    if (i + 2 < nsteps) gload(i + 2, cur == 0 ? 2 : cur - 1);
    const char* Kc = Kl + cur * 8192; const char* Vc = Vl + cur * 8192;
    const int mmode = (br == 2) ? ((j == jq || j + 8 == jq) ? 2 : 0) : (j == jq ? 2 : 1);
#pragma unroll
    for (int qt = 0; qt < 2; qt++) {
      const float msafe0 = (mrow[qt] == -INFINITY) ? 0.f : mrow[qt];
      float cinit = -msafe0;
      if (mmode == 1) cinit = ((sell[qt] >> j) & 1ull) ? cinit : -INFINITY;
      f32x16 S[2];
#pragma unroll
      for (int kt2 = 0; kt2 < 2; kt2++) {
#pragma unroll
        for (int ii = 0; ii < 16; ii++) S[kt2][ii] = cinit;
#pragma unroll
        for (int ks = 0; ks < 4; ks++) {
          const bf16x8 a = *(const bf16x8*)(Kc + (kt2 * 32 + pr) * 128 + (((ks * 2 + h2) ^ ((pr >> 1) & 7)) << 4));
          S[kt2] = MFMA32(a, qf[qt][ks], S[kt2]);
        }
      }
      const int t = t0 + qt * 32 + r;
      if (mmode == 2) {
        const bool selb = (br == 2) || ((sell[qt] >> j) & 1ull);
        const int khi = t, klo = (br == 2) ? t - 511 : 0;
#pragma unroll
        for (int kt2 = 0; kt2 < 2; kt2++)
#pragma unroll
          for (int ii = 0; ii < 16; ii++) {
            const int key = j * 64 + kt2 * 32 + (ii & 7) + 16 * (ii >> 3) + 8 * h2;
            S[kt2][ii] = (selb && key <= khi && key >= klo) ? S[kt2][ii] : -INFINITY;
          }
      }
      float mx = -INFINITY;
#pragma unroll
      for (int kt2 = 0; kt2 < 2; kt2++)
#pragma unroll
        for (int ii = 0; ii < 16; ii++) mx = fmaxf(mx, S[kt2][ii]);
      mx = fmaxf(mx, __shfl_xor(mx, 32));
      if (__any(mx > 6.f)) {
        const float dl = fmaxf(mx, 0.f);
        const float alpha = __builtin_amdgcn_exp2f(-dl);
        lrow[qt] *= alpha; mrow[qt] = msafe0 + dl;
#pragma unroll
        for (int dt = 0; dt < 2; dt++)
#pragma unroll
          for (int ii = 0; ii < 16; ii++) O[dt][qt][ii] *= alpha;
#pragma unroll
        for (int kt2 = 0; kt2 < 2; kt2++)
#pragma unroll
          for (int ii = 0; ii < 16; ii++) S[kt2][ii] -= dl;
      }
      float rs = 0.f;
#pragma unroll
      for (int kt2 = 0; kt2 < 2; kt2++)
#pragma unroll
        for (int ii = 0; ii < 16; ii++) { const float pv = __builtin_amdgcn_exp2f(S[kt2][ii]); S[kt2][ii] = pv; rs += pv; }
      rs += __shfl_xor(rs, 32);
      lrow[qt] += rs;
#pragma unroll
      for (int kt2 = 0; kt2 < 2; kt2++)
#pragma unroll
        for (int s2 = 0; s2 < 2; s2++) {
          uint4 u;
          u.x = pack2(S[kt2][8 * s2 + 0], S[kt2][8 * s2 + 1]); u.y = pack2(S[kt2][8 * s2 + 2], S[kt2][8 * s2 + 3]);
          u.z = pack2(S[kt2][8 * s2 + 4], S[kt2][8 * s2 + 5]); u.w = pack2(S[kt2][8 * s2 + 6], S[kt2][8 * s2 + 7]);
          const bf16x8 pfr = __builtin_bit_cast(bf16x8, u);
#pragma unroll
          for (int dt = 0; dt < 2; dt++) {
            const int d = dt * 32 + r;
            const bf16x8 vf = *(const bf16x8*)(Vc + d * 128 + (((kt2 * 4 + s2 * 2 + h2) ^ ((d >> 1) & 7)) << 4));
            O[dt][qt] = MFMA32(vf, pfr, O[dt][qt]);
          }
        }
      __builtin_amdgcn_sched_barrier(0);
    }
    if (i + 2 < nsteps) asm volatile("s_waitcnt vmcnt(4)" ::: "memory"); else asm volatile("s_waitcnt vmcnt(0)" ::: "memory");
    __builtin_amdgcn_s_barrier();
    cur = cur == 2 ? 0 : cur + 1;
  }
  flush(1);
  __syncthreads();
}

DI void cmp_unit(const Params& p, int unit, char* smem) {
  const int tid = opq(threadIdx.x), lane = tid & 63, w = tid >> 6, r = lane & 31, h2 = lane >> 5;
  const int bg = unit >> 7, q32 = unit & 127, b = bg >> 1, g = bg & 1, hh = g * 4 + w;
  const int pr = perm23(r);
  const bf16_t* Kg = p.kcmp + (size_t)bg * 256 * 64;
  const bf16_t* Vg = p.vcmpT + (size_t)bg * 64 * 256;
  const int tb = q32 * 32, t = tb + r;
  const int nvalid = t >= 31 ? ((t - 31) >> 4) + 1 : 0;
  const int nvmax = (tb >> 4) + 1;
  const int nkt = (nvmax + 31) >> 5;
  char* Kl = smem; char* Vl = smem + 32768; float* impw = (float*)smem;
  const unsigned ldsb = (unsigned)(size_t)(LAS char*)smem;
  __syncthreads();
  for (int pc = w; pc < 4 * nkt; pc += 4) {
    const int row = pc * 8 + (lane >> 3);
    glds16_asm(Kg + row * 64 + (((lane & 7) ^ ((row >> 1) & 7)) << 3), ldsb + __builtin_amdgcn_readfirstlane(pc * 1024));
  }
#pragma unroll
  for (int i = 0; i < 8; i++) {
    const int pc = w * 8 + i, d = pc * 2 + h2;
    glds16_asm(Vg + d * 256 + (((lane & 31) ^ (d & 15)) << 3), ldsb + 32768 + __builtin_amdgcn_readfirstlane(pc * 1024));
  }
  bf16x8 qf[4];
#pragma unroll
  for (int ks = 0; ks < 4; ks++) qf[ks] = *(const bf16x8*)(p.Qn + ((size_t)(b * 8 + hh) * T + t) * 64 + ks * 16 + h2 * 8);
  asm volatile("s_waitcnt vmcnt(0)" ::: "memory");
  __syncthreads();
  float mx = -1e30f;
#pragma unroll 1
  for (int kt = 0; kt < nkt; kt++) {
    f32x16 S;
#pragma unroll
    for (int i = 0; i < 16; i++) S[i] = 0.f;
    const int row = kt * 32 + pr;
#pragma unroll
    for (int ks = 0; ks < 4; ks++) { const bf16x8 kf = *(const bf16x8*)(Kl + row * 128 + (((ks * 2 + h2) ^ ((row >> 1) & 7)) << 4)); S = MFMA32(kf, qf[ks], S); }
#pragma unroll
    for (int i = 0; i < 16; i++) { const int key = kt * 32 + (i & 7) + 16 * (i >> 3) + 8 * h2; mx = fmaxf(mx, key < nvalid ? S[i] : -1e30f); }
  }
  mx = fmaxf(mx, __shfl_xor(mx, 32));
  float sum = 0.f;
  float impo[32];
#pragma unroll
  for (int i = 0; i < 32; i++) impo[i] = 0.f;
  f32x16 O[2];
#pragma unroll
  for (int dt = 0; dt < 2; dt++)
#pragma unroll
    for (int i = 0; i < 16; i++) O[dt][i] = 0.f;
  float carry = 0.f;
#pragma unroll
  for (int kt = 0; kt < 8; kt++) {
    if (kt < nkt) {
      f32x16 S;
#pragma unroll
      for (int i = 0; i < 16; i++) S[i] = 0.f;
      const int row = kt * 32 + pr;
#pragma unroll
      for (int ks = 0; ks < 4; ks++) { const bf16x8 kf = *(const bf16x8*)(Kl + row * 128 + (((ks * 2 + h2) ^ ((row >> 1) & 7)) << 4)); S = MFMA32(kf, qf[ks], S); }
#pragma unroll
      for (int i = 0; i < 16; i++) {
        const int key = kt * 32 + (i & 7) + 16 * (i >> 3) + 8 * h2;
        const float e = key < nvalid ? __builtin_amdgcn_exp2f(S[i] - mx) : 0.f;
        S[i] = e; sum += e;
      }
      {
        const float x1 = __shfl_xor(S[7], 32), x3 = __shfl_xor(S[15], 32);
#pragma unroll
        for (int q4 = 0; q4 < 4; q4++) {
          const float mainv = 2.f * (S[q4 * 4] + S[q4 * 4 + 1] + S[q4 * 4 + 2]) + S[q4 * 4 + 3];
          const float prev = (q4 == 0) ? (h2 ? x1 : carry) : (q4 == 1) ? S[3] : (q4 == 2) ? (h2 ? x3 : x1) : S[11];
          impo[kt * 4 + q4] = mainv + prev;
        }
        carry = x3;
      }
#pragma unroll
      for (int s2 = 0; s2 < 2; s2++) {
        uint4 u;
        u.x = pack2(S[8 * s2 + 0], S[8 * s2 + 1]); u.y = pack2(S[8 * s2 + 2], S[8 * s2 + 3]);
        u.z = pack2(S[8 * s2 + 4], S[8 * s2 + 5]); u.w = pack2(S[8 * s2 + 6], S[8 * s2 + 7]);
        const bf16x8 pfr = __builtin_bit_cast(bf16x8, u);
#pragma unroll
        for (int dt = 0; dt < 2; dt++) {
          const int d = dt * 32 + r;
          const bf16x8 vf = *(const bf16x8*)(Vl + d * 512 + (((kt * 4 + s2 * 2 + h2) ^ (d & 15)) << 4));
          O[dt] = MFMA32(vf, pfr, O[dt]);
        }
      }
    }
  }
  sum += __shfl_xor(sum, 32);
  const float inv = sum > 0.f ? 1.f / sum : 0.f;
  {
    const size_t m = (size_t)b * T + t;
    const float sc = inv * p.NG[m * 24 + hh * 3 + 0];
#pragma unroll
    for (int dt = 0; dt < 2; dt++)
#pragma unroll
      for (int q4 = 0; q4 < 4; q4++) {
        uint2 o; o.x = pack2(sc * O[dt][q4 * 4], sc * O[dt][q4 * 4 + 1]); o.y = pack2(sc * O[dt][q4 * 4 + 2], sc * O[dt][q4 * 4 + 3]);
        *(uint2*)(p.oattn + m * 512 + hh * 64 + dt * 32 + q4 * 8 + h2 * 4) = o;
      }
  }
  __syncthreads();
#pragma unroll
  for (int kt = 0; kt < 8; kt++)
#pragma unroll
    for (int q4 = 0; q4 < 4; q4++)
      impw[(w * 32 + r) * 65 + 8 * kt + 4 * (q4 >> 1) + 2 * h2 + (q4 & 1)] = impo[kt * 4 + q4] * inv;
  __syncthreads();
#pragma unroll 1
  for (int k8 = 0; k8 < 8; k8++) {
    const int rr = w * 8 + k8, tt = tb + rr, blk = tt >> 6;
    const float imp = ((impw[rr * 65 + lane] + impw[(32 + rr) * 65 + lane]) + impw[(64 + rr) * 65 + lane]) + impw[(96 + rr) * 65 + lane];
    const float score = (lane == 0 || lane == blk || lane == blk - 1) ? 1e9f : (lane <= blk ? imp : -1e9f);
    int rank = 0;
#pragma unroll
    for (int i = 0; i < 64; i++) { const float si = __int_as_float(__builtin_amdgcn_readlane(__float_as_int(score), i)); rank += (si > score || (si == score && i < lane)) ? 1 : 0; }
    const unsigned long long selm = __ballot(rank < 16);
    if (lane == 0) p.selmask[(size_t)bg * T + tt] = selm;
  }
}

DI float gelu_tanh(float x) { const float u = 0.7978845608028654f * (x + 0.044715f * x * x * x); return 0.5f * x * (1.f + tanhf(u)); }
DI void compress1_tile(const Params& p, int task, char* smem) {
  const int ks = task & 3, tile = task >> 2;
  const int ntl = tile & 1, mtile = tile >> 1, half = mtile & 1, bg = (mtile >> 1) & 7, kv = mtile >> 4;
  const bf16_t* src = (kv ? p.CV : p.CK) + (size_t)bg * T * 64 + (size_t)half * 128 * 1024 + ks * 512;
  const bf16_t* Bt = (kv ? p.W1vT : p.W1kT) + (size_t)ntl * 128 * 2048 + ks * 512;
  f32x4 acc[4][4]; zero_acc(acc);
  gemm128<true>(acc, [=](int r) { return src + (size_t)r * 1024; }, [=](int r) { return Bt + (size_t)r * 2048; }, 512, smem);
  float* H1p = (float*)p.oattn + (size_t)ks * 4096 * 256;
  epilogue<true>(acc, [&](int r, int c, f32x4 v) {
    const int n = half * 128 + r;
    if (n < 255) { float4 o; o.x = v[0]; o.y = v[1]; o.z = v[2]; o.w = v[3];
      *(float4*)(H1p + ((size_t)((kv * 8 + bg) * 256 + n)) * 256 + ntl * 128 + c) = o; }
  });
}
DI void compress2(const Params& p, char* smem) {
  float* hl = (float*)smem;
  const int tid = opq(threadIdx.x);
  const float* H1p = (const float*)p.oattn;
  for (int rb = blockIdx.x; rb < 512; rb += gridDim.x) {
    const int row0 = rb * 8, kv = row0 >> 11;
    __syncthreads();
#pragma unroll
    for (int q = 0; q < 8; q++) {
      const size_t idx = (size_t)(row0 + q) * 256 + tid;
      hl[q * 256 + tid] = gelu_tanh(H1p[idx] + H1p[idx + (size_t)4096 * 256] + H1p[idx + (size_t)2 * 4096 * 256] + H1p[idx + (size_t)3 * 4096 * 256] + p.posb[kv * 256 + tid]);
    }
    __syncthreads();
    const int q = tid >> 5, ii = tid & 31, row = row0 + q, n = row & 255, bg = (row >> 8) & 7;
    float a0 = 0.f, a1 = 0.f;
    if (n < 255) {
      const float* w2 = kv ? p.cmp_v_w2 : p.cmp_k_w2; const float* b2 = kv ? p.cmp_v_b2 : p.cmp_k_b2;
      a0 = b2[ii]; a1 = b2[ii + 32];
#pragma unroll 8
      for (int j = 0; j < 256; j++) { const float hv = hl[q * 256 + j]; a0 += hv * w2[j * 64 + ii]; a1 += hv * w2[j * 64 + ii + 32]; }
    }
    if (kv == 0) {
      float r0 = 0.f, r1 = 0.f;
      if (n < 255) { const int pos = 16 * n + 31; const float c = p.ropeN[((size_t)pos * 32 + ii) * 2], s = p.ropeN[((size_t)pos * 32 + ii) * 2 + 1];
        r0 = a0 * c - a1 * s; r1 = a0 * s + a1 * c; }
      *(unsigned*)(p.kcmp + ((size_t)(bg * 256 + n)) * 64 + 2 * ii) = pack2(r0, r1);
    } else {
      p.vcmpT[((size_t)(bg * 64 + ii)) * 256 + n] = f2bf(a0);
      p.vcmpT[((size_t)(bg * 64 + ii + 32)) * 256 + n] = f2bf(a1);
    }
  }
}


DI void ret_u_unit(const Params& p, int unit) {
  const int tid = opq(threadIdx.x), lane = tid & 63, w = tid >> 6, r = lane & 31, h2 = lane >> 5;
  const int bh = unit >> 5, n = unit & 31;
  const bf16_t* kz = p.RKzT + (size_t)bh * 128 * T + ((size_t)((w * 256 + n * 8) * 2 + h2)) * 256 + r * 8;
  const bf16_t* vt = p.RVt + (size_t)bh * 256 * T + ((size_t)((n * 8) * 2 + h2)) * 256 + r * 8;
  bf16_t* ut = p.Ut + ((size_t)bh * 32 + n) * 32768 + (size_t)(w * 2) * 512 + r * 8 + 4 * h2;
  bf16x8 a[8], b0[8], b1[8];
#pragma unroll
  for (int ks = 0; ks < 8; ks++) a[ks] = *(const bf16x8*)(kz + ks * 512);
#pragma unroll
  for (int ks = 0; ks < 8; ks++) b0[ks] = *(const bf16x8*)(vt + ks * 512);
#pragma unroll
  for (int dvs = 0; dvs < 8; dvs += 2) {
#pragma unroll
    for (int ks = 0; ks < 8; ks++) b1[ks] = *(const bf16x8*)(vt + (size_t)(dvs + 1) * 32 * T + ks * 512);
    {
      f32x16 R;
#pragma unroll
      for (int i = 0; i < 16; i++) R[i] = 0.f;
#pragma unroll
      for (int ks = 0; ks < 8; ks++) R = MFMA32(a[ks], b0[ks], R);
#pragma unroll
      for (int q4 = 0; q4 < 4; q4++) { uint2 o; o.x = pack2(R[q4 * 4], R[q4 * 4 + 1]); o.y = pack2(R[q4 * 4 + 2], R[q4 * 4 + 3]);
        *(uint2*)(ut + (size_t)dvs * 4096 + (q4 >> 1) * 512 + (q4 & 1) * 256) = o; }
    }
    if (dvs + 2 < 8) {
#pragma unroll
      for (int ks = 0; ks < 8; ks++) b0[ks] = *(const bf16x8*)(vt + (size_t)(dvs + 2) * 32 * T + ks * 512);
    }
    {
      f32x16 R;
#pragma unroll
      for (int i = 0; i < 16; i++) R[i] = 0.f;
#pragma unroll
      for (int ks = 0; ks < 8; ks++) R = MFMA32(a[ks], b1[ks], R);
#pragma unroll
      for (int q4 = 0; q4 < 4; q4++) { uint2 o; o.x = pack2(R[q4 * 4], R[q4 * 4 + 1]); o.y = pack2(R[q4 * 4 + 2], R[q4 * 4 + 3]);
        *(uint2*)(ut + (size_t)(dvs + 1) * 4096 + (q4 >> 1) * 512 + (q4 & 1) * 256) = o; }
    }
  }
}
DI void ret_scan_elem(const Params& p) {
  const size_t gtid = (size_t)blockIdx.x * 256 + opq(threadIdx.x), gsz = (size_t)gridDim.x * 256;
  for (size_t i = gtid; i < (size_t)16 * 256 * 32; i += gsz) {
    const int bh = (int)(i >> 13), h = bh & 3;
    const size_t off = (size_t)(i & 8191) * 4;
    const float cd = exp2f(128.f * log2f(1.f - exp2f(-5.f - (float)h)));
    const bf16_t* up = p.Ut + (size_t)bh * 32 * 32768 + off;
    bf16_t* rp = p.Rt + (size_t)bh * 32 * 32768 + off;
    uint2 u[31];
#pragma unroll
    for (int n = 0; n < 31; n++) u[n] = *(const uint2*)(up + (size_t)n * 32768);
    float r0 = 0.f, r1 = 0.f, r2 = 0.f, r3 = 0.f;
    { uint2 z; z.x = 0u; z.y = 0u; *(uint2*)rp = z; }
#pragma unroll
    for (int n = 0; n < 31; n++) {
      r0 = r0 * cd + lo2f(u[n].x); r1 = r1 * cd + hi2f(u[n].x); r2 = r2 * cd + lo2f(u[n].y); r3 = r3 * cd + hi2f(u[n].y);
      uint2 o; o.x = pack2(r0, r1); o.y = pack2(r2, r3);
      *(uint2*)(rp + (size_t)(n + 1) * 32768) = o;
    }
  }
}

DI void ret_out_unit(const Params& p, int unit, char* smem) {
  const int tid = opq(threadIdx.x), lane = tid & 63, w = tid >> 6, r = lane & 31, h2 = lane >> 5, tq = w >> 1, dh = w & 1;
  const int th = unit & 1, n = (unit >> 1) & 31, bh = unit >> 6, b = bh >> 2, h = bh & 3;
  const int qt = th * 2 + tq, c = qt * 32 + r;
  const float lg = log2f(1.f - exp2f(-5.f - (float)h));
  const bf16_t* qp = p.RQ + (size_t)bh * T * 128 + ((size_t)(((n * 4 + qt) * 8) * 2 + h2)) * 256 + r * 8;
  f32x16 O[4];
  {
    const bf16_t* rp = p.Rt + ((size_t)bh * 32 + n) * 32768 + ((size_t)((dh * 4 * 8) * 2 + h2)) * 256 + r * 8;
#pragma unroll
    for (int dvt = 0; dvt < 4; dvt++)
#pragma unroll
      for (int i = 0; i < 16; i++) O[dvt][i] = 0.f;
#pragma unroll
    for (int ks = 0; ks < 8; ks++) {
      const bf16x8 qk = *(const bf16x8*)(qp + ks * 512);
#pragma unroll
      for (int dvt = 0; dvt < 4; dvt++) {
        const bf16x8 rf = *(const bf16x8*)(rp + (size_t)dvt * 4096 + ks * 512);
        O[dvt] = MFMA32(rf, qk, O[dvt]);
      }
    }
    const float xi = exp2f((float)(c + 1) * lg);
#pragma unroll
    for (int dvt = 0; dvt < 4; dvt++)
#pragma unroll
      for (int i = 0; i < 16; i++) O[dvt][i] *= xi;
  }
#pragma unroll 1
  for (int kt = 0; kt <= qt; kt++) {
    f32x16 S;
#pragma unroll
    for (int i = 0; i < 16; i++) S[i] = 0.f;
    const bf16_t* kp = p.RK + (size_t)bh * T * 128 + ((size_t)(((n * 4 + kt) * 8) * 2 + h2)) * 256 + perm23(r) * 8;
#pragma unroll
    for (int ks = 0; ks < 8; ks++) { const bf16x8 kf = *(const bf16x8*)(kp + ks * 512); const bf16x8 qk = *(const bf16x8*)(qp + ks * 512); S = MFMA32(kf, qk, S); }
    bf16x8 pf[2];
#pragma unroll
    for (int s2 = 0; s2 < 2; s2++) {
      float v[8];
#pragma unroll
      for (int jj = 0; jj < 8; jj++) {
        const int i = 8 * s2 + jj;
        const int mkey = kt * 32 + (i & 7) + 16 * (i >> 3) + 8 * h2;
        v[jj] = (mkey <= c) ? S[i] * exp2f((float)(c - mkey) * lg) : 0.f;
      }
      uint4 u; u.x = pack2(v[0], v[1]); u.y = pack2(v[2], v[3]); u.z = pack2(v[4], v[5]); u.w = pack2(v[6], v[7]);
      pf[s2] = __builtin_bit_cast(bf16x8, u);
    }
    const bf16_t* vp = p.RVt + (size_t)bh * 256 * T + ((size_t)(((dh * 4) * 256 + n * 8 + kt * 2) * 2 + h2)) * 256 + r * 8;
#pragma unroll
    for (int dvt = 0; dvt < 4; dvt++)
#pragma unroll
      for (int s2 = 0; s2 < 2; s2++) {
        const bf16x8 vf = *(const bf16x8*)(vp + (size_t)dvt * 32 * T + s2 * 512);
        O[dvt] = MFMA32(vf, pf[s2], O[dvt]);
      }
  }
  float s1 = 0.f, s2s = 0.f;
#pragma unroll
  for (int dvt = 0; dvt < 4; dvt++)
#pragma unroll
    for (int i = 0; i < 16; i++) { s1 += O[dvt][i]; s2s += O[dvt][i] * O[dvt][i]; }
  s1 += __shfl_xor(s1, 32); s2s += __shfl_xor(s2s, 32);
  float* red = (float*)smem;
  __syncthreads();
  if (h2 == 0) { red[(w * 32 + r) * 2] = s1; red[(w * 32 + r) * 2 + 1] = s2s; }
  __syncthreads();
  s1 += red[((w ^ 1) * 32 + r) * 2]; s2s += red[((w ^ 1) * 32 + r) * 2 + 1];
  const float mu = s1 * (1.f / 256.f);
  const float var = fmaxf(s2s * (1.f / 256.f) - mu * mu, 0.f);
  const float rs = rsqrtf(var + 1e-5f);
  const size_t m = (size_t)b * T + n * 128 + c;
#pragma unroll
  for (int dvt = 0; dvt < 4; dvt++)
#pragma unroll
    for (int q4 = 0; q4 < 4; q4++) {
      const int col = h * 256 + dh * 128 + dvt * 32 + q4 * 8 + 4 * h2;
      const float4 gg = *(const float4*)(p.gn_g + col), bb = *(const float4*)(p.gn_b + col);
      const uint2 rg = *(const uint2*)(p.RG + m * 1024 + col);
      const float g0 = lo2f(rg.x), g1 = hi2f(rg.x), g2 = lo2f(rg.y), g3 = hi2f(rg.y);
      const float y0 = ((O[dvt][q4 * 4] - mu) * rs * gg.x + bb.x) * g0 * sigmoidf_(g0);
      const float y1 = ((O[dvt][q4 * 4 + 1] - mu) * rs * gg.y + bb.y) * g1 * sigmoidf_(g1);
      const float y2 = ((O[dvt][q4 * 4 + 2] - mu) * rs * gg.z + bb.z) * g2 * sigmoidf_(g2);
      const float y3 = ((O[dvt][q4 * 4 + 3] - mu) * rs * gg.w + bb.w) * g3 * sigmoidf_(g3);
      uint2 o; o.x = pack2(y0, y1); o.y = pack2(y2, y3);
      *(uint2*)(p.oret + m * 1024 + col) = o;
    }
}

DI void lds_tile_load(const bf16_t* src, size_t ld, char* smem) {
  const int tid = opq(threadIdx.x);
#pragma unroll
  for (int k = 0; k < 8; k++) { const int id = tid + 256 * k, i = id >> 4, j8 = (id & 15) * 8; *(uint4*)(smem + i * 272 + j8 * 2) = *(const uint4*)(src + (size_t)i * ld + j8); }
}
DI void lds_tile_store(bf16_t* dstp, size_t ld, char* smem) {
  const int tid = opq(threadIdx.x);
#pragma unroll
  for (int k = 0; k < 8; k++) { const int id = tid + 256 * k, i = id >> 4, j8 = (id & 15) * 8; *(uint4*)(dstp + (size_t)i * ld + j8) = *(const uint4*)(smem + i * 272 + j8 * 2); }
}
DI void upproj_tile(const Params& p, int tile, char* smem) {
  const int nt_ = tile & 7, mt_ = tile >> 3, m0 = mt_ * 128, n0 = nt_ * 128;
  const int lane = opq(threadIdx.x) & 63, wave = opq(threadIdx.x) >> 6, wr = wave >> 1, wc = wave & 1, fr = lane & 15, fq = lane >> 4;
  f32x4 acc[4][4]; uint2 res[4][4];
  zero_acc(acc);
  { const bf16_t* A = p.oattn + (size_t)m0 * 512; const bf16_t* Bt = p.WaT + (size_t)n0 * 512;
    gemm128<true>(acc, [=](int r) { return A + (size_t)r * 512; }, [=](int r) { return Bt + (size_t)r * 512; }, 512, smem); }
  lds_tile_load(p.MG + (size_t)m0 * 2048 + n0, 2048, smem);
  __syncthreads();
#pragma unroll
  for (int mt = 0; mt < 4; mt++)
#pragma unroll
    for (int nt = 0; nt < 4; nt++) {
      const int r = wr * 64 + mt * 16 + fr, c = wc * 64 + nt * 16 + fq * 4;
      const uint2 gv = *(const uint2*)(smem + r * 272 + c * 2);
      res[mt][nt].x = pack2(sigmoidf_(lo2f(gv.x)) * acc[mt][nt][0], sigmoidf_(hi2f(gv.x)) * acc[mt][nt][1]);
      res[mt][nt].y = pack2(sigmoidf_(lo2f(gv.y)) * acc[mt][nt][2], sigmoidf_(hi2f(gv.y)) * acc[mt][nt][3]);
    }
  __syncthreads();
  zero_acc(acc);
  { const bf16_t* A = p.oret + (size_t)m0 * 1024; const bf16_t* Bt = p.WrT + (size_t)n0 * 1024;
    gemm128<true>(acc, [=](int r) { return A + (size_t)r * 1024; }, [=](int r) { return Bt + (size_t)r * 1024; }, 1024, smem); }
  lds_tile_load(p.MG + (size_t)m0 * 2048 + 1024 + n0, 2048, smem);
  __syncthreads();
#pragma unroll
  for (int mt = 0; mt < 4; mt++)
#pragma unroll
    for (int nt = 0; nt < 4; nt++) {
      const int r = wr * 64 + mt * 16 + fr, c = wc * 64 + nt * 16 + fq * 4;
      uint2* q = (uint2*)(smem + r * 272 + c * 2);
      const uint2 gv = *q;
      uint2 o; o.x = pack2(lo2f(res[mt][nt].x) + sigmoidf_(lo2f(gv.x)) * acc[mt][nt][0], hi2f(res[mt][nt].x) + sigmoidf_(hi2f(gv.x)) * acc[mt][nt][1]);
      o.y = pack2(lo2f(res[mt][nt].y) + sigmoidf_(lo2f(gv.y)) * acc[mt][nt][2], hi2f(res[mt][nt].y) + sigmoidf_(hi2f(gv.y)) * acc[mt][nt][3]);
      *q = o;
    }
  __syncthreads();
  lds_tile_store(p.merged + (size_t)m0 * 1024 + n0, 1024, smem);
  __syncthreads();
}
DI void wout_tile(const Params& p, int tile, char* smem) {
  const int nt_ = tile & 7, mt_ = tile >> 3, m0 = mt_ * 128, n0 = nt_ * 128;
  const int tid = opq(threadIdx.x), lane = tid & 63, wave = tid >> 6, wr = wave >> 1, wc = wave & 1, fr = lane & 15, fq = lane >> 4;
  f32x4 acc[4][4]; zero_acc(acc);
  const bf16_t* A = p.merged + (size_t)m0 * 1024; const bf16_t* Bt = p.WoT + (size_t)n0 * 1024;
  gemm128<true>(acc, [=](int r) { return A + (size_t)r * 1024; }, [=](int r) { return Bt + (size_t)r * 1024; }, 1024, smem);
#pragma unroll
  for (int hcol = 0; hcol < 2; hcol++) {
    const size_t g0 = (size_t)m0 * 1024 + n0 + hcol * 64;
#pragma unroll
    for (int k = 0; k < 8; k++) { const int id = tid + 256 * k, i = id >> 4, j4 = (id & 15) * 4; *(float4*)(smem + i * 272 + j4 * 4) = *(const float4*)(p.x + g0 + (size_t)i * 1024 + j4); }
    __syncthreads();
    if (wc == hcol) {
#pragma unroll
      for (int mt = 0; mt < 4; mt++)
#pragma unroll
        for (int nt = 0; nt < 4; nt++) {
          float4* q = (float4*)(smem + (wr * 64 + mt * 16 + fr) * 272 + (nt * 16 + fq * 4) * 4);
          const float4 xv = *q;
          float4 o; o.x = ALPHA * xv.x + acc[mt][nt][0]; o.y = ALPHA * xv.y + acc[mt][nt][1]; o.z = ALPHA * xv.z + acc[mt][nt][2]; o.w = ALPHA * xv.w + acc[mt][nt][3];
          *q = o;
        }
    }
    __syncthreads();
#pragma unroll
    for (int k = 0; k < 8; k++) { const int id = tid + 256 * k, i = id >> 4, j4 = (id & 15) * 4; *(float4*)(p.out + g0 + (size_t)i * 1024 + j4) = *(const float4*)(smem + i * 272 + j4 * 4); }
    __syncthreads();
  }
}
DI void expert_cvt_tile(const Params& p, int ct, float* tile) {
  const int e = ct / 192, rr = ct % 192;
  const float* wg = p.e_wg + (size_t)e * 1024 * 512; const float* wu = p.e_wu + (size_t)e * 1024 * 512; const float* wd = p.e_wd + (size_t)e * 512 * 1024;
  if (rr < 128)
    tcvt_tile128([=](int j) -> const float* { const int f = (j >> 7) * 64 + ((j >> 5) & 3) * 16 + (j & 15); return (((j >> 4) & 1) ? wu : wg) + f; },
                 512, p.EgT + (size_t)e * 1024 * 1024, 1024, rr >> 3, rr & 7, tile);
  else { const int q = rr - 128;
    tcvt_tile128([=](int j) -> const float* { return wd + j; }, 1024, p.EdT + (size_t)e * 1024 * 512, 512, q >> 3, q & 7, tile); }
}
DI void phase7(const Params& p, char* smem) {
  const int bid = blockIdx.x, nb = gridDim.x;
  if (bid & 1) for (int c = bid; c < 6144; c += nb) expert_cvt_tile(p, c, (float*)smem);
  for (int t = bid; t < 1024; t += nb) wout_tile(p, t, smem);
  if (!(bid & 1)) for (int c = bid; c < 6144; c += nb) expert_cvt_tile(p, c, (float*)smem);
}

DI void ln1_router(const Params& p, int m, int lane, float* xl  ) {
  float* row = p.out + (size_t)m * 1024;
  float4 v[4];
#pragma unroll
  for (int i = 0; i < 4; i++) v[i] = *(const float4*)(row + i * 256 + lane * 4);
  float s = 0.f;
#pragma unroll
  for (int i = 0; i < 4; i++) s += v[i].x + v[i].y + v[i].z + v[i].w;
  const float mu = wsum(s) * (1.f / 1024.f);
  float q = 0.f;
#pragma unroll
  for (int i = 0; i < 4; i++) { const float a = v[i].x - mu, b = v[i].y - mu, c = v[i].z - mu, d = v[i].w - mu; q += a * a + b * b + c * c + d * d; }
  const float rs = rsqrtf(wsum(q) * (1.f / 1024.f) + 1e-5f);
#pragma unroll
  for (int i = 0; i < 4; i++) {
    const int k = i * 256 + lane * 4;
    const float4 g = *(const float4*)(p.ln1_g + k), bb = *(const float4*)(p.ln1_b + k);
    v[i].x = (v[i].x - mu) * rs * g.x + bb.x; v[i].y = (v[i].y - mu) * rs * g.y + bb.y;
    v[i].z = (v[i].z - mu) * rs * g.z + bb.z; v[i].w = (v[i].w - mu) * rs * g.w + bb.w;
    *(float4*)(row + k) = v[i];
    uint2 o; o.x = pack2(v[i].x, v[i].y); o.y = pack2(v[i].z, v[i].w);
    *(uint2*)(p.x1b + (size_t)m * 1024 + k) = o;
    *(float4*)(xl + k) = v[i];
  }
  WSYNC();
  float gl[4] = {0.f, 0.f, 0.f, 0.f};
#pragma unroll 4
  for (int c = 0; c < 16; c++) {
    const int k = c * 64 + lane;
    const float xk = xl[k];
    const float4 w = *(const float4*)(p.rg_w + (size_t)k * 4);
    gl[0] += xk * w.x; gl[1] += xk * w.y; gl[2] += xk * w.z; gl[3] += xk * w.w;
  }
#pragma unroll
  for (int j = 0; j < 4; j++) gl[j] = wsum(gl[j]) + p.rg_b[j];
  int gi = 0; float gm = gl[0];
#pragma unroll
  for (int j = 1; j < 4; j++) if (gl[j] > gm) { gm = gl[j]; gi = j; }
  float gs = 0.f;
#pragma unroll
  for (int j = 0; j < 4; j++) gs += __expf(gl[j] - gm);
  const float gprob = 1.f / gs;
  const float* riw = p.ri_w + (size_t)gi * 1024 * 8 + (lane & 1) * 4;
  float tq[4] = {0.f, 0.f, 0.f, 0.f};
#pragma unroll 4
  for (int c = 0; c < 32; c++) {
    const int k = c * 32 + (lane >> 1);
    const float xk = xl[k];
    const float4 w = *(const float4*)(riw + (size_t)k * 8);
    tq[0] += xk * w.x; tq[1] += xk * w.y; tq[2] += xk * w.z; tq[3] += xk * w.w;
  }
  float il[8];
#pragma unroll
  for (int j = 0; j < 4; j++) { il[j] = wsum((lane & 1) ? 0.f : tq[j]) + p.ri_b[gi * 8 + j]; il[4 + j] = wsum((lane & 1) ? tq[j] : 0.f) + p.ri_b[gi * 8 + 4 + j]; }
  int e1 = 0; float l1 = il[0];
#pragma unroll
  for (int j = 1; j < 8; j++) if (il[j] > l1) { l1 = il[j]; e1 = j; }
  int e2 = -1; float l2 = -3e38f;
#pragma unroll
  for (int j = 0; j < 8; j++) if (j != e1 && il[j] > l2) { l2 = il[j]; e2 = j; }
  const float ex = __expf(l2 - l1);
  const float w1 = gprob / (1.f + ex), w2 = gprob * ex / (1.f + ex);
  if (lane == 0) {
    const int ea = gi * 8 + e1, eb = gi * 8 + e2;
    const int grp = blockIdx.x & 15;
    const int pa = atomicAdd(p.cnt + grp * 32 + ea, 1); p.lists[(ea * 16 + grp) * 2048 + pa] = m * 2;
    const int pb = atomicAdd(p.cnt + grp * 32 + eb, 1); p.lists[(eb * 16 + grp) * 2048 + pb] = m * 2 + 1;
    p.routew[m * 2] = w1; p.routew[m * 2 + 1] = w2;
  }
  WSYNC();
}
DI void ln2_final(const Params& p, int m, int lane) {
  float* row = p.out + (size_t)m * 1024;
  float4 v[4];
  float s = 0.f;
#pragma unroll
  for (int i = 0; i < 4; i++) {
    const int k = i * 256 + lane * 4;
    const float4 xv = *(const float4*)(row + k);
    const uint2 a = *(const uint2*)(p.part + (size_t)(2 * m) * 1024 + k), b = *(const uint2*)(p.part + (size_t)(2 * m + 1) * 1024 + k);
    v[i].x = ALPHA * xv.x + lo2f(a.x) + lo2f(b.x); v[i].y = ALPHA * xv.y + hi2f(a.x) + hi2f(b.x);
    v[i].z = ALPHA * xv.z + lo2f(a.y) + lo2f(b.y); v[i].w = ALPHA * xv.w + hi2f(a.y) + hi2f(b.y);
    s += v[i].x + v[i].y + v[i].z + v[i].w;
  }
  const float mu = wsum(s) * (1.f / 1024.f);
  float q = 0.f;
#pragma unroll
  for (int i = 0; i < 4; i++) { const float a = v[i].x - mu, b = v[i].y - mu, c = v[i].z - mu, d = v[i].w - mu; q += a * a + b * b + c * c + d * d; }
  const float rs = rsqrtf(wsum(q) * (1.f / 1024.f) + 1e-5f);
#pragma unroll
  for (int i = 0; i < 4; i++) {
    const int k = i * 256 + lane * 4;
    const float4 g = *(const float4*)(p.ln2_g + k), bb = *(const float4*)(p.ln2_b + k);
    float4 o; o.x = (v[i].x - mu) * rs * g.x + bb.x; o.y = (v[i].y - mu) * rs * g.y + bb.y; o.z = (v[i].z - mu) * rs * g.z + bb.z; o.w = (v[i].w - mu) * rs * g.w + bb.w;
    *(float4*)(row + k) = o;
  }
}

struct MoeMap { int e, mi, cnt, hoff; };
#define MOE_TAB(smem) ((int*)((smem) + 65552))
DI void moe_tables(const Params& p, char* smem) {
  int* tab = MOE_TAB(smem); int* pre = tab; int* tpre = tab + 32 * 17;
  const int tid = opq(threadIdx.x);
  __syncthreads();
  if (tid < 32) { int acc = 0; for (int g = 0; g < 16; g++) { pre[tid * 17 + g] = acc; acc += p.cnt[g * 32 + tid]; } pre[tid * 17 + 16] = acc; }
  __syncthreads();
  if (tid == 0) { int acc = 0; for (int e = 0; e < NEXP; e++) { tpre[e] = acc; acc += (pre[e * 17 + 16] + 127) >> 7; } tpre[32] = acc; }
  __syncthreads();
}
DI bool moe_map(char* smem, int mtile, MoeMap& mm) {
  const int* tab = MOE_TAB(smem); const int* pre = tab; const int* tpre = tab + 32 * 17;
  if (mtile >= tpre[32]) return false;
  int e = 0;
  while (tpre[e + 1] <= mtile) e++;
  mm.e = e; mm.mi = mtile - tpre[e]; mm.cnt = pre[e * 17 + 16]; mm.hoff = tpre[e] * 128;
  return true;
}
DI int moe_total(char* smem) { return MOE_TAB(smem)[32 * 17 + 32]; }
DI const int* moe_rows(const Params& p, const MoeMap& mm, char* smem) {
  int* tab = MOE_TAB(smem); const int* pre = tab + mm.e * 17; int* rowent = tab + 32 * 17 + 40;
  const int tid = opq(threadIdx.x);
  __syncthreads();
  if (tid < 128) {
    const int ri = mm.mi * 128 + tid; int ent = -1;
    if (ri < mm.cnt) { int g = 0; while (pre[g + 1] <= ri) g++; ent = p.lists[(mm.e * 16 + g) * 2048 + ri - pre[g]]; }
    rowent[tid] = ent;
  }
  __syncthreads();
  return rowent;
}
DI void moe_up_tile(const Params& p, const MoeMap& mm, int nt_, char* smem) {
  const int* lst = moe_rows(p, mm, smem); const int nrow = mm.cnt - mm.mi * 128;
  const bf16_t* Bt = p.EgT + ((size_t)mm.e * 1024 + nt_ * 128) * 1024;
  const bf16_t* X = p.x1b;
  f32x4 acc[4][4]; zero_acc(acc);
  gemm128<true>(acc, [=](int r) { const int tk = r < nrow ? (lst[r] >> 1) : 0; return X + (size_t)tk * 1024; }, [=](int r) { return Bt + (size_t)r * 1024; }, 1024, smem);
  const int lane = opq(threadIdx.x) & 63, wave = opq(threadIdx.x) >> 6, wr = wave >> 1, wc = wave & 1, fr = lane & 15, fq = lane >> 4;
#pragma unroll
  for (int mt = 0; mt < 4; mt++) {
    const int r = wr * 64 + mt * 16 + fr;
    if (r < nrow) {
      const float w = p.routew[lst[r]];
#pragma unroll
      for (int np = 0; np < 2; np++) {
        const f32x4 g = acc[mt][np * 2], u = acc[mt][np * 2 + 1];
        float hv[4];
#pragma unroll
        for (int i = 0; i < 4; i++) hv[i] = g[i] * sigmoidf_(g[i]) * u[i] * w;
        const int f = nt_ * 64 + wc * 32 + np * 16 + fq * 4;
        uint2 o; o.x = pack2(hv[0], hv[1]); o.y = pack2(hv[2], hv[3]);
        *(uint2*)(p.Hh + (size_t)(mm.hoff + mm.mi * 128 + r) * 512 + f) = o;
      }
    }
  }
}
DI void moe_down_tile(const Params& p, const MoeMap& mm, int nt_, char* smem) {
  const int* lst = moe_rows(p, mm, smem); const int nrow = mm.cnt - mm.mi * 128;
  const bf16_t* A = p.Hh + (size_t)(mm.hoff + mm.mi * 128) * 512;
  const bf16_t* Bt = p.EdT + ((size_t)mm.e * 1024 + nt_ * 128) * 512;
  f32x4 acc[4][4]; zero_acc(acc);
  gemm128<true>(acc, [=](int r) { return A + (size_t)r * 512; }, [=](int r) { return Bt + (size_t)r * 512; }, 512, smem);
  epilogue<true>(acc, [&](int r, int c, f32x4 v) {
    if (r < nrow) {
      const int ts = lst[r];
      uint2 o; o.x = pack2(v[0], v[1]); o.y = pack2(v[2], v[3]);
      *(uint2*)(p.part + (size_t)ts * 1024 + nt_ * 128 + c) = o;
    }
  });
}

constexpr int NPHASE = 12;
#if FUSED
#define PHFN DI
#else
#define PHFN DI
#endif
#define PH_PRE const int bid = blockIdx.x, nb = gridDim.x, tid = opq(threadIdx.x), lane = tid & 63, wave = tid >> 6; \
  const int gw = bid * 4 + wave, nw = nb * 4; char* wsm = smem + wave * 8192; (void)bid; (void)nb; (void)lane; (void)gw; (void)nw; (void)wsm;
PHFN void ph0(const Params& p, char* smem) { phase0(p, smem); }
PHFN void ph1(const Params& p, char* smem) { phase1(p, smem); }
PHFN void ph2(const Params& p, char* smem) { PH_PRE
  for (int t = bid; t < 256 + 512; t += nb) { if (t < 256) compress1_tile(p, t, smem); else if (((t - 256) & 31) != 31) ret_u_unit(p, t - 256); }
}
PHFN void ph3(const Params& p, char* smem) { compress2(p, smem); ret_scan_elem(p); }
PHFN void ph4(const Params& p, char* smem) { PH_PRE
  for (int u = bid; u < 1024; u += nb) cmp_unit(p, u, smem);
}
PHFN void ph5(const Params& p, char* smem) { PH_PRE
  for (int u = bid; u < 512; u += nb) { const int k = u >> 3; attn_unit(p, ((u & 7) << 6) | (k < 32 ? 63 - k : k - 32), smem); }
  {
    int* sh = (int*)(smem + 65552 + 3072);
    for (;;) {
      __syncthreads();
      if (tid == 0) sh[0] = (int)xb_add(&p.qctr[0], 1u);
      __syncthreads();
      const int u = sh[0];
      if (u >= 1024) break;
      ret_out_unit(p, u, smem);
    }
  }
}
PHFN void ph6(const Params& p, char* smem) { PH_PRE for (int t = bid; t < 1024; t += nb) upproj_tile(p, t, smem); }
PHFN void ph7(const Params& p, char* smem) { phase7(p, smem); }
PHFN void ph8(const Params& p, char* smem) { PH_PRE for (int m = gw; m < M; m += nw) ln1_router(p, m, lane, (float*)wsm); }
PHFN void ph9(const Params& p, char* smem) { PH_PRE moe_tables(p, smem); const int tot = moe_total(smem);
  for (int t = bid; t < tot * 8; t += nb) { MoeMap mm; if (moe_map(smem, t >> 3, mm)) moe_up_tile(p, mm, t & 7, smem); } }
PHFN void ph10(const Params& p, char* smem) { PH_PRE moe_tables(p, smem); const int tot = moe_total(smem);
  for (int t = bid; t < tot * 8; t += nb) { MoeMap mm; if (moe_map(smem, t >> 3, mm)) moe_down_tile(p, mm, t & 7, smem); } }
PHFN void ph11(const Params& p, char* smem) { PH_PRE for (int m = gw; m < M; m += nw) ln2_final(p, m, lane); }
DI void run_phase(const Params& p, const int ph, char* smem) {
  switch (ph) {
    case 0: ph0(p, smem); break; case 1: ph1(p, smem); break; case 2: ph2(p, smem); break; case 3: ph3(p, smem); break;
    case 4: ph4(p, smem); break; case 5: ph5(p, smem); break; case 6: ph6(p, smem); break; case 7: ph7(p, smem); break;
    case 8: ph8(p, smem); break; case 9: ph9(p, smem); break; case 10: ph10(p, smem); break; case 11: ph11(p, smem); break;
  }
}

template <int PH>
__global__ void __launch_bounds__(256, 2) phase_kernel(Params p) {
  __shared__ __attribute__((aligned(16))) char smem[65536 + 16 + 4096];
  run_phase(p, PH, smem);
}
#if FUSED
__global__ void __launch_bounds__(256, 2) mega_kernel(Params p_arg) {
  __shared__ __attribute__((aligned(16))) char smem[65536 + 16 + 4096];
  const Params& p = *(const Params*)__builtin_amdgcn_kernarg_segment_ptr();
  volatile LAS unsigned* st = (volatile LAS unsigned*)(smem + 65536);
  if (threadIdx.x == 0) { st[0] = 0u; st[1] = 0u; }
  __syncthreads();
  const XcdBarrier xb = xcd_barrier_post(p.bar, st);
#define GSYNC() xcd_barrier(xb)
  unsigned long long tk_ = 0; (void)tk_;
#define RUNPH(N) { unsigned long long t0_ = 0; if (PROBE_PHASE == N) t0_ = __builtin_amdgcn_s_memrealtime(); ph##N(p, smem); if (PROBE_DOUBLE & (1 << N)) { GSYNC(); ph##N(p, smem); } \
    if (PROBE_PHASE == N) { GSYNC(); tk_ = __builtin_amdgcn_s_memrealtime() - t0_; } }
  RUNPH(0); GSYNC(); RUNPH(1); GSYNC(); RUNPH(2); GSYNC(); RUNPH(3); GSYNC();
  RUNPH(4); GSYNC(); RUNPH(5); GSYNC(); RUNPH(6); GSYNC(); RUNPH(7); GSYNC();
  RUNPH(8); GSYNC(); RUNPH(9); GSYNC(); RUNPH(10); GSYNC(); RUNPH(11);
  if (PROBE_PHASE >= 0 && blockIdx.x == 0) { const unsigned long long t1_ = __builtin_amdgcn_s_memrealtime(); while (__builtin_amdgcn_s_memrealtime() - t1_ < 3ull * tk_) __builtin_amdgcn_s_sleep(8); }
}
#endif

extern "C" void kernel_launch(void* const* d_in, const int* in_sizes, int n_in, void* d_out, int out_size,
                              void* d_ws, size_t ws_size, hipStream_t stream) {
  Params p{};
  const float** ins = (const float**)&p;
  for (int i = 0; i < 28; i++) ins[i] = (const float*)d_in[i];
  p.out = (float*)d_out;
  char* ws = (char*)d_ws; size_t off = 0;
  auto alloc = [&](size_t bytes) { char* r = ws + off; off += (bytes + 255) & ~(size_t)255; return r; };
  const size_t MiB = 1 << 20;
  char* regionP = ws;
  p.Qn = (bf16_t*)alloc(16 * MiB);
  p.CK = (bf16_t*)alloc(4 * MiB); p.CV = (bf16_t*)alloc(4 * MiB); p.SK = (bf16_t*)alloc(4 * MiB); p.SVt = (bf16_t*)alloc(4 * MiB);
  p.WK = (bf16_t*)alloc(4 * MiB); p.WVt = (bf16_t*)alloc(4 * MiB);
  p.NG = (float*)alloc((size_t)M * 24 * 4);
  p.RQ = (bf16_t*)alloc(16 * MiB); p.RK = (bf16_t*)alloc(16 * MiB); p.RKzT = (bf16_t*)alloc(16 * MiB);
  p.RVt = (bf16_t*)alloc(32 * MiB); p.RG = (bf16_t*)alloc(32 * MiB); p.MG = (bf16_t*)alloc(64 * MiB);
  p.oattn = (bf16_t*)alloc(16 * MiB); p.WinT = p.oattn;
  p.oret = (bf16_t*)alloc(32 * MiB);
  p.WaT = (bf16_t*)alloc(1 * MiB); p.WrT = (bf16_t*)alloc(2 * MiB); p.WoT = (bf16_t*)alloc(2 * MiB);
  p.W1kT = (bf16_t*)alloc(1 * MiB); p.W1vT = (bf16_t*)alloc(1 * MiB);
  p.ropeN = (float*)alloc((size_t)T * 32 * 8); p.ropeR = (float*)alloc((size_t)T * 64 * 8); p.posb = (float*)alloc(512 * 4); p.posp = (float*)alloc(32 * 512 * 4);
  p.H1 = (bf16_t*)alloc(2 * MiB); p.kcmp = (bf16_t*)alloc(8 * 256 * 64 * 2); p.vcmpT = (bf16_t*)alloc(8 * 64 * 256 * 2);
  p.selmask = (unsigned long long*)alloc((size_t)8 * T * 8);
  p.cnt = (int*)alloc(512 * 4); p.lists = (int*)alloc((size_t)NEXP * 16 * 2048 * 4); p.routew = (float*)alloc((size_t)M * 2 * 4);
  p.merged = (bf16_t*)(regionP); p.x1b = (bf16_t*)(regionP + 32 * MiB);
  p.EgT = (bf16_t*)(regionP + 64 * MiB); p.EdT = (bf16_t*)(regionP + 128 * MiB);
  p.Hh = (bf16_t*)(regionP + 160 * MiB); p.part = (bf16_t*)(regionP + 196 * MiB);
  p.bar = (unsigned*)alloc((XCD_BAR_WORDS + 64) * 4); p.qctr = p.bar + XCD_BAR_WORDS;
  p.xb = (bf16_t*)d_out; p.Rt = (bf16_t*)d_out; p.Ut = (bf16_t*)d_out + (size_t)16 * 1024 * 1024;
  if (off > ws_size) { fprintf(stderr, "workspace too small: need %zu have %zu\n", off, ws_size); return; }
#if FUSED
  static int grid_blocks = 0;
  if (!grid_blocks) {
    int dev = 0, cus = 0, per_cu = 0;
    (void)hipGetDevice(&dev);
    (void)hipDeviceGetAttribute(&cus, hipDeviceAttributeMultiprocessorCount, dev);
    (void)hipOccupancyMaxActiveBlocksPerMultiprocessor(&per_cu, mega_kernel, 256, 0);
    if (per_cu > 2) per_cu = 2;
    grid_blocks = cus * per_cu;
  }
  (void)hipMemsetAsync(p.bar, 0, (XCD_BAR_WORDS + 64) * 4, stream);
  void* args[] = {&p};
  hipError_t e = hipLaunchCooperativeKernel((void*)mega_kernel, dim3(grid_blocks), dim3(256), args, 0, stream);
  if (e != hipSuccess) fprintf(stderr, "coop launch failed: %s\n", hipGetErrorString(e));
#else
(void)hipMemsetAsync(p.bar, 0, (XCD_BAR_WORDS + 64) * 4, stream);
#define LAUNCH_PH(N) phase_kernel<N><<<512, 256, 0, stream>>>(p)
  LAUNCH_PH(0); LAUNCH_PH(1); LAUNCH_PH(2); LAUNCH_PH(3); LAUNCH_PH(4); LAUNCH_PH(5);
  LAUNCH_PH(6); LAUNCH_PH(7); LAUNCH_PH(8); LAUNCH_PH(9); LAUNCH_PH(10); LAUNCH_PH(11);
#endif
}
```

```cpp
#include <hip/hip_runtime.h>
#include <hip/hip_cooperative_groups.h>
#include <cstdio>
#include <cstdint>
namespace cg = cooperative_groups;

#ifndef FUSED
#define FUSED 1
#endif
#ifndef PROBE_DOUBLE
#define PROBE_DOUBLE 0
#endif
#ifndef PROBE_ROUTER
#define PROBE_ROUTER 0
#endif
#ifndef PROBE_PHASE
#define PROBE_PHASE -1
#endif

#define DI __device__ __forceinline__
typedef unsigned short bf16_t;
typedef short bf16x8 __attribute__((ext_vector_type(8)));
typedef float f32x4 __attribute__((ext_vector_type(4)));

constexpr int Bn = 4, T = 4096, D = 1024, M = Bn * T;
constexpr int NINP = 6528;
constexpr int NEXP = 32, DFF = 512;
constexpr int HROWS = 36864;
constexpr float ALPHA = 1.189207115002721f;

struct Params {
  const float *x, *w_in, *cmp_pos_k, *cmp_k_w1, *cmp_k_b1, *cmp_k_w2, *cmp_k_b2;
  const float *cmp_pos_v, *cmp_v_w1, *cmp_v_b1, *cmp_v_w2, *cmp_v_b2;
  const float *gn_g, *gn_b, *w_up_attn, *w_up_ret, *w_out, *ln1_g, *ln1_b;
  const float *rg_w, *rg_b, *ri_w, *ri_b, *e_wg, *e_wu, *e_wd, *ln2_g, *ln2_b;
  float* out;
  bf16_t *Qn, *CK, *CV, *SK, *SVt, *WK, *WVt; float* NG;
  bf16_t *RQ, *RK, *RKzT, *RVt, *RG, *MG;
  bf16_t *WinT  , *oattn, *oret;
  bf16_t *WaT, *WrT, *WoT, *W1kT, *W1vT;
  float *ropeN, *ropeR, *posb, *posp;
  bf16_t *H1, *kcmp, *vcmpT;
  unsigned long long* selmask;
  int* cnt; int* lists; float* routew;
  bf16_t *merged, *x1b, *EgT  , *EdT  , *Hh, *part;
  bf16_t *xb, *Rt, *Ut;
  unsigned* bar;
  unsigned* qctr;
};

DI float bf2f(bf16_t v) { return __uint_as_float(((unsigned)v) << 16); }
typedef __bf16 bf16x2_t __attribute__((ext_vector_type(2)));
DI bf16_t f2bf(float f) { return __builtin_bit_cast(bf16_t, (__bf16)f); }
DI unsigned pack2(float a, float b) { bf16x2_t v = {(__bf16)a, (__bf16)b}; return __builtin_bit_cast(unsigned, v); }
typedef float f32x16 __attribute__((ext_vector_type(16)));
#define MFMA32(a, b, c) __builtin_amdgcn_mfma_f32_32x32x16_bf16((a), (b), (c), 0, 0, 0)
DI float lo2f(unsigned u) { return __uint_as_float(u << 16); }
DI float hi2f(unsigned u) { return __uint_as_float(u & 0xffff0000u); }
DI float wsum(float v) {
  v += __int_as_float(__builtin_amdgcn_update_dpp(0, __float_as_int(v), 0x111, 0xf, 0xf, false));
  v += __int_as_float(__builtin_amdgcn_update_dpp(0, __float_as_int(v), 0x112, 0xf, 0xf, false));
  v += __int_as_float(__builtin_amdgcn_update_dpp(0, __float_as_int(v), 0x114, 0xf, 0xf, false));
  v += __int_as_float(__builtin_amdgcn_update_dpp(0, __float_as_int(v), 0x118, 0xf, 0xf, false));
  v += __int_as_float(__builtin_amdgcn_update_dpp(0, __float_as_int(v), 0x142, 0xa, 0xf, false));
  v += __int_as_float(__builtin_amdgcn_update_dpp(0, __float_as_int(v), 0x143, 0xc, 0xf, false));
  return __int_as_float(__builtin_amdgcn_readlane(__float_as_int(v), 63));
}
DI float wmax(float v) { for (int o = 32; o > 0; o >>= 1) v = fmaxf(v, __shfl_xor(v, o)); return v; }
DI float sigmoidf_(float x) { return 1.f / (1.f + __expf(-x)); }
#define WSYNC() asm volatile("s_waitcnt lgkmcnt(0)" ::: "memory")
DI size_t frag_off(int row, int k, int K) { return ((size_t)(((row >> 5) * (K >> 4) + (k >> 4)) * 2 + ((k >> 3) & 1))) * 256 + (row & 31) * 8 + (k & 7); }
DI float xh_max(float x) { const auto r_ = __builtin_amdgcn_permlane32_swap(__float_as_uint(x), __float_as_uint(x), false, false); return fmaxf(__uint_as_float(r_[0]), __uint_as_float(r_[1])); }
DI float xh_sum(float x) { const auto r_ = __builtin_amdgcn_permlane32_swap(__float_as_uint(x), __float_as_uint(x), false, false); return __uint_as_float(r_[0]) + __uint_as_float(r_[1]); }
DI int perm23(int r) { return (r & 0x13) | ((r & 4) << 1) | ((r & 8) >> 1); }
DI int opq(int x) { asm volatile("" : "+v"(x)); return x; }


#define XB_TMO      128
#define XB_XCNT(j)  (256  + 64 * (j))
#define XB_XSUB(j)  (1280 + 64 * (j))
#define XB_XGEN(j)  (2304 + 64 * (j))
#define XB_TOP      3328
#define XB_TOPGEN   3392
#define XCD_BAR_WORDS 3456
#define XB_SPIN_CAP (1u << 20)
#define LAS __attribute__((address_space(3)))
DI unsigned xb_ld(unsigned* p) { return __hip_atomic_load(p, __ATOMIC_RELAXED, __HIP_MEMORY_SCOPE_AGENT); }
DI unsigned xb_add(unsigned* p, unsigned v) { return __hip_atomic_fetch_add(p, v, __ATOMIC_RELAXED, __HIP_MEMORY_SCOPE_AGENT); }
DI unsigned xb_xcc_id() { return (unsigned)__builtin_amdgcn_s_getreg((3 << 11) | 20) & 0xFu; }
#define XB_SPIN(cond, bar) do { unsigned _sp = 0; while (cond) { __builtin_amdgcn_s_sleep(1); \
    if ((++_sp & 255u) == 0u) { if (xb_ld(&(bar)[XB_TMO])) break; if (_sp > XB_SPIN_CAP) { atomicAdd(&(bar)[XB_TMO], 1u); break; } } } } while (0)
struct XcdBarrier { unsigned* bar; unsigned x; volatile LAS unsigned* st; };
DI XcdBarrier xcd_barrier_post(unsigned* bar, volatile LAS unsigned* st) {
  XcdBarrier b; b.bar = bar; b.x = xb_xcc_id(); b.st = st;
  if (threadIdx.x == 0) (void)xb_add(&bar[XB_XCNT(b.x)], 1u);
  return b;
}
DI void xcd_barrier_complete(unsigned* bar, unsigned x, unsigned& nloc, unsigned& nx) {
  const unsigned G = gridDim.x * gridDim.y * gridDim.z;
  unsigned sum, cnt, mine, sp = 0u;
  for (;;) {
    sum = 0u; cnt = 0u; mine = 0u;
#pragma unroll
    for (unsigned j = 0; j < 16; ++j) { const unsigned c = xb_ld(&bar[XB_XCNT(j)]); sum += c; cnt += (c > 0u) ? 1u : 0u; mine = (j == x) ? c : mine; }
    if (sum == G) break;
    __builtin_amdgcn_s_sleep(1);
    if ((++sp & 255u) == 0u) { if (xb_ld(&bar[XB_TMO])) break; if (sp > XB_SPIN_CAP) { atomicAdd(&bar[XB_TMO], 1u); break; } }
  }
  nloc = mine > 0u ? mine : 1u; nx = cnt > 0u ? cnt : 1u;
}
DI void xcd_barrier(const XcdBarrier& b) {
  asm volatile("s_waitcnt vmcnt(0)" ::: "memory");
  __syncthreads();
  if (threadIdx.x == 0) {
    unsigned* bar = b.bar;
    __builtin_amdgcn_s_waitcnt(0);
    unsigned nloc = b.st[0], nx = b.st[1];
    if (nloc == 0u) { xcd_barrier_complete(bar, b.x, nloc, nx); b.st[0] = nloc; b.st[1] = nx; }
    const unsigned old = xb_add(&bar[XB_XSUB(b.x)], 1u);
    const unsigned gen = old / nloc;
    if (old + 1u == (gen + 1u) * nloc) {
      __builtin_amdgcn_fence(__ATOMIC_RELEASE, "agent");
      asm volatile("s_waitcnt vmcnt(0)" ::: "memory");
      const unsigned og = xb_add(&bar[XB_TOP], 1u);
      const unsigned tg = og / nx;
      if (og + 1u == (tg + 1u) * nx) xb_add(&bar[XB_TOPGEN], 1u);
      else XB_SPIN(xb_ld(&bar[XB_TOPGEN]) == tg, bar);
      __builtin_amdgcn_fence(__ATOMIC_ACQUIRE, "agent");
      xb_add(&bar[XB_XGEN(b.x)], 1u);
      asm volatile("s_waitcnt vmcnt(0)" ::: "memory");
    } else {
      XB_SPIN(xb_ld(&bar[XB_XGEN(b.x)]) == gen, bar);
      __builtin_amdgcn_fence(__ATOMIC_ACQUIRE, "agent");
      asm volatile("s_waitcnt vmcnt(0)" ::: "memory");
    }
  }
  __syncthreads();
}

DI void glds16_asm(const void* gsrc, unsigned lds_dst) {
  unsigned keep;
  asm volatile("s_mov_b32 %0, m0\n\ts_mov_b32 m0, %2\n\ts_nop 0\n\tglobal_load_lds_dwordx4 %1, off\n\ts_mov_b32 m0, %0" : "=&s"(keep) : "v"(gsrc), "s"(lds_dst) : "memory");
}
template <bool SWAP, class AR, class BR>
DI void gemm128(f32x4 (&acc)[4][4], AR arow, BR brow, int K, char* smem) {
  const int tid = opq(threadIdx.x), lane = tid & 63, wave = tid >> 6, wr = wave >> 1, wc = wave & 1;
  const int prow = lane >> 3, pch = ((lane & 7) ^ prow) << 3;
  const bf16_t* ap[4]; const bf16_t* bp[4];
#pragma unroll
  for (int i = 0; i < 4; i++) { ap[i] = arow((wave * 4 + i) * 8 + prow) + pch; bp[i] = brow((wave * 4 + i) * 8 + prow) + pch; }
  const unsigned ldsb = (unsigned)(size_t)(LAS char*)smem;
  const unsigned lpiece = __builtin_amdgcn_readfirstlane(wave * 4096);
  char* As = smem; char* Bs = smem + 32768;
  const int nk = K >> 6;
  const int fr = lane & 15, fq = lane >> 4;
  const int aoff0 = (wr * 64 + fr) * 128, boff0 = (wc * 64 + fr) * 128;
  auto gload = [&](int t, int buf) {
#pragma unroll
    for (int i = 0; i < 4; i++) {
      glds16_asm(ap[i] + t * 64, ldsb + buf * 16384 + lpiece + i * 1024);
      glds16_asm(bp[i] + t * 64, ldsb + 32768 + buf * 16384 + lpiece + i * 1024);
    }
  };
  auto gcomp = [&](int buf) {
    const char* Ac = As + buf * 16384; const char* Bc = Bs + buf * 16384;
#pragma unroll
    for (int ks = 0; ks < 2; ks++) {
      const int chs = ((ks * 4 + fq) ^ (fr & 7)) << 4;
      bf16x8 a[4], b[4];
#pragma unroll
      for (int mt = 0; mt < 4; mt++) a[mt] = *(const bf16x8*)(Ac + aoff0 + mt * 2048 + chs);
#pragma unroll
      for (int nt = 0; nt < 4; nt++) b[nt] = *(const bf16x8*)(Bc + boff0 + nt * 2048 + chs);
      __builtin_amdgcn_s_setprio(1);
#pragma unroll
      for (int mt = 0; mt < 4; mt++)
#pragma unroll
        for (int nt = 0; nt < 4; nt++)
          acc[mt][nt] = SWAP ? __builtin_amdgcn_mfma_f32_16x16x32_bf16(b[nt], a[mt], acc[mt][nt], 0, 0, 0)
                             : __builtin_amdgcn_mfma_f32_16x16x32_bf16(a[mt], b[nt], acc[mt][nt], 0, 0, 0);
      __builtin_amdgcn_s_setprio(0);
    }
  };
  asm volatile("s_waitcnt vmcnt(0)" ::: "memory");
  gload(0, 0);
  asm volatile("s_waitcnt vmcnt(0)" ::: "memory");
  __builtin_amdgcn_s_barrier();
#pragma unroll 1
  for (int kt = 0; kt < nk; kt++) {
    const int cur = kt & 1;
    if (kt + 1 < nk) gload(kt + 1, cur ^ 1);
    gcomp(cur);
    asm volatile("s_waitcnt vmcnt(0)" ::: "memory");
    __builtin_amdgcn_s_barrier();
  }
}
template <bool SWAP, class AR, class BC>
DI void gemm128f(f32x4 (&acc)[4][4], AR arow, BC bcol, int ldb, int K, char* smem) {
  const int tid = opq(threadIdx.x), lane = tid & 63, wave = tid >> 6, wr = wave >> 1, wc = wave & 1;
  const int srow = tid >> 3, sch = tid & 7;
  const int bn = tid & 127, bh = tid >> 7;
  const bf16_t* ap[4];
#pragma unroll
  for (int i = 0; i < 4; i++) ap[i] = arow(srow + 32 * i) + sch * 8;
  const float* bq = bcol(bn) + (size_t)(bh * 32) * ldb;
  const int woff = srow * 128 + ((sch ^ (srow & 7)) << 4);
  char* As = smem; char* Bs = smem + 32768;
  uint4 ra[4]; float rb[4][8];
  auto bload = [&](int kt) {
    const float* q = bq + (size_t)kt * 64 * ldb;
#pragma unroll
    for (int i = 0; i < 4; i++)
#pragma unroll
      for (int j = 0; j < 8; j++) rb[i][j] = q[(size_t)(i * 8 + j) * ldb];
  };
  auto bwrite = [&](char* Bd) {
#pragma unroll
    for (int i = 0; i < 4; i++) {
      uint4 u; u.x = pack2(rb[i][0], rb[i][1]); u.y = pack2(rb[i][2], rb[i][3]); u.z = pack2(rb[i][4], rb[i][5]); u.w = pack2(rb[i][6], rb[i][7]);
      *(uint4*)(Bd + bn * 128 + ((((bh * 4 + i)) ^ (bn & 7)) << 4)) = u;
    }
  };
#pragma unroll
  for (int i = 0; i < 4; i++) ra[i] = *(const uint4*)(ap[i]);
  bload(0);
#pragma unroll
  for (int i = 0; i < 4; i++) *(uint4*)(As + woff + i * 4096) = ra[i];
  bwrite(Bs);
  __syncthreads();
  const int nk = K >> 6;
  const int fr = lane & 15, fq = lane >> 4;
  const int aoff0 = (wr * 64 + fr) * 128, boff0 = (wc * 64 + fr) * 128;
  for (int kt = 0; kt < nk; kt++) {
    const int cur = kt & 1;
    if (kt + 1 < nk) {
#pragma unroll
      for (int i = 0; i < 4; i++) ra[i] = *(const uint4*)(ap[i] + (kt + 1) * 64);
      bload(kt + 1);
    }
    const char* Ac = As + cur * 16384; const char* Bc = Bs + cur * 16384;
#pragma unroll
    for (int ks = 0; ks < 2; ks++) {
      const int chs = ((ks * 4 + fq) ^ (fr & 7)) << 4;
      bf16x8 a[4], b[4];
#pragma unroll
      for (int mt = 0; mt < 4; mt++) a[mt] = *(const bf16x8*)(Ac + aoff0 + mt * 2048 + chs);
#pragma unroll
      for (int nt = 0; nt < 4; nt++) b[nt] = *(const bf16x8*)(Bc + boff0 + nt * 2048 + chs);
#pragma unroll
      for (int mt = 0; mt < 4; mt++)
#pragma unroll
        for (int nt = 0; nt < 4; nt++)
          acc[mt][nt] = SWAP ? __builtin_amdgcn_mfma_f32_16x16x32_bf16(b[nt], a[mt], acc[mt][nt], 0, 0, 0)
                             : __builtin_amdgcn_mfma_f32_16x16x32_bf16(a[mt], b[nt], acc[mt][nt], 0, 0, 0);
    }
    if (kt + 1 < nk) {
      char* An = As + (cur ^ 1) * 16384;
#pragma unroll
      for (int i = 0; i < 4; i++) *(uint4*)(An + woff + i * 4096) = ra[i];
      bwrite(Bs + (cur ^ 1) * 16384);
    }
    __syncthreads();
  }
}
DI void zero_acc(f32x4 (&acc)[4][4]) {
#pragma unroll
  for (int i = 0; i < 4; i++)
#pragma unroll
    for (int j = 0; j < 4; j++) acc[i][j] = (f32x4){0.f, 0.f, 0.f, 0.f};
}
template <bool SWAP, class F>
DI void epilogue(const f32x4 (&acc)[4][4], F f) {
  const int lane = opq(threadIdx.x) & 63, wave = opq(threadIdx.x) >> 6, wr = wave >> 1, wc = wave & 1, fr = lane & 15, fq = lane >> 4;
#pragma unroll
  for (int mt = 0; mt < 4; mt++)
#pragma unroll
    for (int nt = 0; nt < 4; nt++) {
      if (SWAP) f(wr * 64 + mt * 16 + fr, wc * 64 + nt * 16 + fq * 4, acc[mt][nt]);
      else f(wr * 64 + mt * 16 + fq * 4, wc * 64 + nt * 16 + fr, acc[mt][nt]);
    }
}

template <class CP>
DI void tcvt_tile(CP colptr, int ldsrc, bf16_t* dst, int K, int kt, int jt, float* tile) {
  const int tx = opq(threadIdx.x) & 63, ty = opq(threadIdx.x) >> 6;
  const float* sp = colptr(jt * 64 + tx);
  for (int i = ty; i < 64; i += 4) tile[i * 65 + tx] = sp ? sp[(size_t)(kt * 64 + i) * ldsrc] : 0.f;
  __syncthreads();
  for (int i = ty * 2 + (tx >> 5); i < 64; i += 8) {
    const int kk = (tx & 31) * 2;
    *(unsigned*)(dst + (size_t)(jt * 64 + i) * K + kt * 64 + kk) = pack2(tile[kk * 65 + i], tile[(kk + 1) * 65 + i]);
  }
  __syncthreads();
}
template <class CP>
DI void tcvt_all(CP colptr, int ldsrc, bf16_t* dst, int K, int N, float* tile, int bid, int nb) {
  const int nkt = K / 64, njt = N / 64;
  for (int t = bid; t < nkt * njt; t += nb) tcvt_tile(colptr, ldsrc, dst, K, t / njt, t % njt, tile);
}

template <class CP>
DI void tcvt_tile128(CP colptr, int ldsrc, bf16_t* dst, int K, int kt, int jt, float* tile  ) {
  const int tid = opq(threadIdx.x), tx = tid & 127, ty = tid >> 7;
  const float* sp0 = colptr(jt * 128 + tx);
  const float* sp = sp0 + (size_t)(kt * 64 + ty) * ldsrc;
  float v[32];
  if (sp0) {
#pragma unroll
    for (int i = 0; i < 32; i++) v[i] = sp[(size_t)(2 * i) * ldsrc];
  } else {
#pragma unroll
    for (int i = 0; i < 32; i++) v[i] = 0.f;
  }
#pragma unroll
  for (int i = 0; i < 32; i++) tile[(ty + 2 * i) * 129 + tx] = v[i];
  __syncthreads();
  const int pp = (tid & 31) * 2, j0 = tid >> 5;
#pragma unroll
  for (int i = 0; i < 16; i++) {
    const int j = j0 + 8 * i;
    *(unsigned*)(dst + (size_t)(jt * 128 + j) * K + kt * 64 + pp) = pack2(tile[pp * 129 + j], tile[(pp + 1) * 129 + j]);
  }
  __syncthreads();
}
DI int perm_half(int p, int d) { return (p & 1) ? (d / 2 + (p >> 1)) : (p >> 1); }
DI int inproj_col(int j) {
  if (j < 512) return (j & ~63) + perm_half(j & 63, 64);
  if (j < 1280) { const int grp = (j - 512) >> 7;
    if (grp == 2 || grp == 4) return (j & ~63) + perm_half(j & 63, 64);
    return j; }
  if (j < 1792) { const int q = j - 1280; return 1304 + (q & ~127) + perm_half(q & 127, 128); }
  if (j < 2304) { const int q = j - 1792; return 1816 + (q & ~127) + perm_half(q & 127, 128); }
  if (j < 3328) return 2328 + (j - 2304);
  if (j < 4352) return 3352 + (j - 3328);
  if (j < 6400) return 4376 + (j - 4352);
  const int q = j - 6400; return q < 24 ? 1280 + q : -1;
}

DI void phase0(const Params& p, char* smem) {
  const int bid = blockIdx.x, nb = gridDim.x, tid = opq(threadIdx.x);
  const size_t gtid = (size_t)bid * 256 + tid, gsz = (size_t)nb * 256;
  for (size_t i = gtid; i < (size_t)M * D / 4; i += gsz) {
    const float4 v = ((const float4*)p.x)[i];
    uint2 o; o.x = pack2(v.x, v.y); o.y = pack2(v.z, v.w);
    ((uint2*)p.xb)[i] = o;
  }
  float* tile = (float*)smem;
  for (int tt = bid; tt < 1264; tt += nb) {
    if (tt < 816) { const float* w = p.w_in; tcvt_tile128([=](int j) -> const float* { const int c = inproj_col(j); return c >= 0 ? w + c : nullptr; }, 6424, p.WinT, 1024, tt / 51, tt % 51, tile); }
    else if (tt < 880) { const int q = tt - 816; const float* w = p.w_up_attn; tcvt_tile128([=](int j) -> const float* { return w + j; }, 1024, p.WaT, 512, q >> 3, q & 7, tile); }
    else if (tt < 1008) { const int q = tt - 880; const float* w = p.w_up_ret; tcvt_tile128([=](int j) -> const float* { return w + j; }, 1024, p.WrT, 1024, q >> 3, q & 7, tile); }
    else if (tt < 1136) { const int q = tt - 1008; const float* w = p.w_out; tcvt_tile128([=](int j) -> const float* { return w + j; }, 1024, p.WoT, 1024, q >> 3, q & 7, tile); }
    else if (tt < 1200) { const int q = tt - 1136; const float* w = p.cmp_k_w1; tcvt_tile128([=](int j) -> const float* { return w + j; }, 256, p.W1kT, 2048, q >> 1, q & 1, tile); }
    else { const int q = tt - 1200; const float* w = p.cmp_v_w1; tcvt_tile128([=](int j) -> const float* { return w + j; }, 256, p.W1vT, 2048, q >> 1, q & 1, tile); }
  }
  for (size_t i = gtid; i < (size_t)T * 96; i += gsz) {
    const int t = (int)(i / 96), r = (int)(i % 96);
    float invf; float* dst;
    if (r < 32) { invf = (float)exp2(-(double)r * (2.0 / 64.0) * 13.287712379549449); dst = p.ropeN + ((size_t)t * 32 + r) * 2; }
    else { const int q = r - 32; invf = (float)exp2(-(double)q * (2.0 / 128.0) * 13.287712379549449); dst = p.ropeR + ((size_t)t * 64 + q) * 2; }
    const double ang = (double)((float)t * invf);
    const double kk = rint(ang * 0.15915494309189535);
    const float red = (float)(ang - kk * 6.283185307179586);
    dst[0] = cosf(red); dst[1] = sinf(red);
  }
  for (size_t i = gtid; i < 32 * 512; i += gsz) {
    const int qp = (int)(i >> 9), kv = (int)((i >> 8) & 1), j = (int)(i & 255);
    const float* pos = kv ? p.cmp_pos_v : p.cmp_pos_k; const float* w1 = kv ? p.cmp_v_w1 : p.cmp_k_w1;
    float s0 = 0.f;
#pragma unroll 8
    for (int q = qp * 64; q < qp * 64 + 64; q++) s0 += pos[q] * w1[(size_t)q * 256 + j];
    p.posp[i] = s0;
  }
  if (gtid < 512) p.cnt[gtid] = 0;
}

template <bool TRANS, class PROC, class DST>
DI void epilogue_lds(const f32x4 (&acc)[4][4], PROC proc, DST dst, char* smem) {
  const int tid = opq(threadIdx.x), lane = tid & 63, wave = tid >> 6, wr = wave >> 1, wc = wave & 1, fr = lane & 15, fq = lane >> 4;
#pragma unroll
  for (int mt = 0; mt < 4; mt++)
#pragma unroll
    for (int nt = 0; nt < 4; nt++) {
      const int r = wr * 64 + mt * 16 + (TRANS ? fq * 4 : fr), c = wc * 64 + nt * 16 + (TRANS ? fr : fq * 4);
      const uint2 o = proc(r, c, acc[mt][nt]);
      *(uint2*)(smem + (TRANS ? c * 272 + r * 2 : r * 272 + c * 2)) = o;
    }
  __syncthreads();
#pragma unroll
  for (int k = 0; k < 8; k++) {
    const int id = tid + 256 * k, i = id >> 4, j8 = (id & 15) * 8;
    *(uint4*)dst(i, j8) = *(const uint4*)(smem + i * 272 + j8 * 2);
  }
  __syncthreads();
}
DI void inproj_tile(const Params& p, int mt_, int nt_, char* smem) {
  const int m0 = mt_ * 128, b = m0 >> 12, t0 = m0 & 4095;
  const bf16_t* A = p.xb + (size_t)m0 * D; const bf16_t* Bt = p.WinT + (size_t)nt_ * 128 * D;
  f32x4 acc[4][4]; zero_acc(acc);
  auto ar = [=](int r) { return A + (size_t)r * D; };
  auto br = [=](int r) { return Bt + (size_t)r * D; };
  auto plain = [](int, int, f32x4 v) { uint2 o; o.x = pack2(v[0], v[1]); o.y = pack2(v[2], v[3]); return o; };
  const bool transposed = (nt_ == 7 || nt_ == 9 || (nt_ >= 18 && nt_ < 26));
  if (transposed) {
    gemm128<false>(acc, ar, br, D, smem);
    if (nt_ < 18) { bf16_t* base = ((nt_ == 7) ? p.SVt : p.WVt) + (size_t)b * 2 * 64 * T + t0;
      epilogue_lds<true>(acc, plain, [=](int c, int r8) { return base + (size_t)c * T + r8; }, smem); }
    else { const int h = (nt_ - 18) >> 1, e0 = ((nt_ - 18) & 1) * 128; bf16_t* base = p.RVt + (size_t)(b * 4 + h) * 256 * T;
      epilogue_lds<true>(acc, plain, [=](int c, int r8) { return base + frag_off(e0 + c, t0 + r8, T); }, smem); }
    return;
  }
  gemm128<true>(acc, ar, br, D, smem);
  if (nt_ < 4 || nt_ == 6 || nt_ == 8) {
    const float sc = nt_ < 4 ? 0.18033688011112042f : 1.f;
    bf16_t* base = (nt_ < 4) ? p.Qn + ((size_t)(b * 8 + nt_ * 2) * T + t0) * 64 : ((nt_ == 6) ? p.SK : p.WK) + ((size_t)(b * 2) * T + t0) * 64;
    epilogue_lds<false>(acc, [=](int r, int c, f32x4 v) {
      const float4 cs = *(const float4*)(p.ropeN + ((size_t)(t0 + r) * 32 + ((c & 63) >> 1)) * 2);
      uint2 o; o.x = pack2((v[0] * cs.x - v[1] * cs.y) * sc, (v[0] * cs.y + v[1] * cs.x) * sc); o.y = pack2((v[2] * cs.z - v[3] * cs.w) * sc, (v[2] * cs.w + v[3] * cs.z) * sc);
      return o; }, [=](int r, int c8) { return base + ((size_t)(c8 >> 6) * T + r) * 64 + (c8 & 63); }, smem);
  } else if (nt_ == 4 || nt_ == 5) {
    bf16_t* base = (nt_ == 4 ? p.CK : p.CV) + ((size_t)(b * 2) * T + t0) * 64;
    epilogue_lds<false>(acc, plain, [=](int r, int c8) { return base + ((size_t)(c8 >> 6) * T + r) * 64 + (c8 & 63); }, smem);
  } else if (nt_ >= 10 && nt_ < 18) {
    const bool isk = nt_ >= 14; const int h = (nt_ - 10) & 3;
    const float sc = isk ? 0.08838834764831845f : 1.f;
    bf16_t* base = (isk ? p.RK : p.RQ) + (size_t)(b * 4 + h) * T * 128;
    auto roped = [=](int r, int c, f32x4 v, float z) {
      const float4 cs = *(const float4*)(p.ropeR + ((size_t)(t0 + r) * 64 + (c >> 1)) * 2);
      const float s2 = sc * z;
      uint2 o; o.x = pack2((v[0] * cs.x - v[1] * cs.y) * s2, (v[0] * cs.y + v[1] * cs.x) * s2); o.y = pack2((v[2] * cs.z - v[3] * cs.w) * s2, (v[2] * cs.w + v[3] * cs.z) * s2);
      return o; };
    epilogue_lds<false>(acc, [=](int r, int c, f32x4 v) { return roped(r, c, v, 1.f); }, [=](int r, int c8) { return base + frag_off(t0 + r, c8, 128); }, smem);
    if (isk) {
      const float lg = log2f(1.f - exp2f(-5.f - (float)h));
      bf16_t* bz = p.RKzT + (size_t)(b * 4 + h) * 128 * T;
      const int tid = opq(threadIdx.x), lane = tid & 63, wave = tid >> 6, wr = wave >> 1, wc = wave & 1, fr = lane & 15, fq = lane >> 4;
#pragma unroll
      for (int mt = 0; mt < 4; mt++)
#pragma unroll
        for (int nt = 0; nt < 4; nt++) {
          const int r = wr * 64 + mt * 16 + fr, c = wc * 64 + nt * 16 + fq * 4;
          const uint2 o = roped(r, c, acc[mt][nt], exp2f((float)(127 - ((t0 + r) & 127)) * lg));
          bf16_t* q = (bf16_t*)(smem + c * 272 + r * 2);
          q[0] = (bf16_t)(o.x & 0xffffu); q[136] = (bf16_t)(o.x >> 16); q[272] = (bf16_t)(o.y & 0xffffu); q[408] = (bf16_t)(o.y >> 16);
        }
      __syncthreads();
#pragma unroll
      for (int k = 0; k < 8; k++) {
        const int id = tid + 256 * k, i = id >> 4, j8 = (id & 15) * 8;
        *(uint4*)(bz + frag_off(i, t0 + j8, T)) = *(const uint4*)(smem + i * 272 + j8 * 2);
      }
      __syncthreads();
    }
  } else if (nt_ >= 26 && nt_ < 34) {
    bf16_t* base = p.RG + (size_t)m0 * 1024 + (nt_ - 26) * 128;
    epilogue_lds<false>(acc, plain, [=](int r, int c8) { return base + (size_t)r * 1024 + c8; }, smem);
  } else if (nt_ >= 34 && nt_ < 50) {
    bf16_t* base = p.MG + (size_t)m0 * 2048 + (nt_ - 34) * 128;
    epilogue_lds<false>(acc, plain, [=](int r, int c8) { return base + (size_t)r * 2048 + c8; }, smem);
  } else {
    epilogue<true>(acc, [&](int r, int c, f32x4 v) {
      if (c < 24) { float4 o; o.x = sigmoidf_(v[0]); o.y = sigmoidf_(v[1]); o.z = sigmoidf_(v[2]); o.w = sigmoidf_(v[3]);
        *(float4*)(p.NG + (size_t)(m0 + r) * 24 + c) = o; }
    });
  }
}
DI void phase1(const Params& p, char* smem) {
  if (blockIdx.x < 2) {
    const int i = blockIdx.x * 256 + opq(threadIdx.x), kv = i >> 8, j = i & 255;
    float s0 = (kv ? p.cmp_v_b1 : p.cmp_k_b1)[j];
    for (int qp = 0; qp < 32; qp++) s0 += p.posp[qp * 512 + i];
    p.posb[i] = s0;
  }
  const int xcd = blockIdx.x & 7, lb = blockIdx.x >> 3, nlb = gridDim.x >> 3;
  for (int li = lb; li < 16 * 51; li += nlb) {
    const int mi = li & 7, rest = li >> 3, nt_ = rest % 51, half = rest / 51;
    inproj_tile(p, xcd * 16 + half * 8 + mi, nt_, smem);
  }
}


DI void attn_unit(const Params& p, int unit, char* smem) {
  const int tid = opq(threadIdx.x), lane = tid & 63, w = tid >> 6, r = lane & 31, h2 = lane >> 5;
  const int bg = unit >> 6, jq = unit & 63, b = bg >> 1, g = bg & 1, hh = g * 4 + w, t0 = jq * 64;
  bf16x8 qf[2][4];
#pragma unroll
  for (int qt = 0; qt < 2; qt++)
#pragma unroll
    for (int ks = 0; ks < 4; ks++)
      qf[qt][ks] = *(const bf16x8*)(p.Qn + ((size_t)(b * 8 + hh) * T + t0 + qt * 32 + r) * 64 + ks * 16 + h2 * 8);
  unsigned long long* sell = (unsigned long long*)(smem + 49152) + tid * 2;
#pragma unroll
  for (int qt = 0; qt < 2; qt++) sell[qt] = p.selmask[(size_t)bg * T + t0 + qt * 32 + r];
  const int wlo = jq > 8 ? jq - 8 : 0, nwin = jq - wlo + 1, nsteps = nwin + jq + 1;
  char* Kl = smem; char* Vl = smem + 24576;
  const unsigned ldsK = (unsigned)(size_t)(LAS char*)smem;
  const int grow = lane >> 3;
  auto gload = [&](int i, int buf) {
    const int br = i < nwin ? 2 : 1, j = i < nwin ? wlo + i : i - nwin;
    const bf16_t* Kp = (br == 1 ? p.SK : p.WK) + ((size_t)bg * T + j * 64) * 64;
    const bf16_t* Vp = (br == 1 ? p.SVt : p.WVt) + (size_t)bg * 64 * T + j * 64;
#pragma unroll
    for (int pc = 0; pc < 2; pc++) {
      const int row = (w * 2 + pc) * 8 + grow;
      const int gch = (lane & 7) ^ ((row >> 1) & 7);
      const unsigned loff = __builtin_amdgcn_readfirstlane(buf * 8192 + (w * 2 + pc) * 1024);
      glds16_asm(Kp + row * 64 + gch * 8, ldsK + loff);
      glds16_asm(Vp + (size_t)row * T + gch * 8, ldsK + 24576 + loff);
    }
  };
  const int pr = perm23(r);
  float lrow[2]; unsigned mbias[2]; f32x16 O[2][2];
  float* mrow = (float*)(smem + 53248) + tid * 2;
  uint4 ao4 = {h2 == 0 ? 0x3F803F80u : 0u, 0u, 0u, 0u};
  const bf16x8 aones = __builtin_bit_cast(bf16x8, ao4);
  uint4 bb4 = {0u, 0u, 0u, 0u};
  auto reset = [&]() {
#pragma unroll
    for (int qt = 0; qt < 2; qt++) { mrow[qt] = -INFINITY; lrow[qt] = 0.f; mbias[qt] = 0u;
#pragma unroll
      for (int dt = 0; dt < 2; dt++)
#pragma unroll
        for (int i = 0; i < 16; i++) O[dt][qt][i] = 0.f; }
  };
  auto flush = [&](int br) {
#pragma unroll
    for (int qt = 0; qt < 2; qt++) {
      const int m = opq(b * T + t0 + qt * 32 + r);
      const float gate = p.NG[(size_t)m * 24 + hh * 3 + br];
      const float sc = lrow[qt] > 0.f ? gate / lrow[qt] : 0.f;
#pragma unroll
      for (int dt = 0; dt < 2; dt++)
#pragma unroll
        for (int q4 = 0; q4 < 4; q4++) {
          bf16_t* dst = p.oattn + (size_t)m * 512 + hh * 64 + dt * 32 + q4 * 8 + h2 * 4;
          const uint2 old = *(const uint2*)dst;
          uint2 o; o.x = pack2(lo2f(old.x) + sc * O[dt][qt][q4 * 4], hi2f(old.x) + sc * O[dt][qt][q4 * 4 + 1]);
          o.y = pack2(lo2f(old.y) + sc * O[dt][qt][q4 * 4 + 2], hi2f(old.y) + sc * O[dt][qt][q4 * 4 + 3]);
          *(uint2*)dst = o;
        }
    }
  };
  reset();
#pragma unroll
  for (int qt = 0; qt < 2; qt++)
#pragma unroll
    for (int ks = 0; ks < 4; ks++) asm volatile("" :: "v"(qf[qt][ks]));
  gload(0, 0);
  if (nsteps > 1) { gload(1, 1); asm volatile("s_waitcnt vmcnt(4)" ::: "memory"); } else asm volatile("s_waitcnt vmcnt(0)" ::: "memory");
  __builtin_amdgcn_s_barrier();
  int cur = 0;
  const f32x16 zero16 = {0.f, 0.f, 0.f, 0.f, 0.f, 0.f, 0.f, 0.f, 0.f, 0.f, 0.f, 0.f, 0.f, 0.f, 0.f, 0.f};
#define QK_TILE(S, QT) { \
    _Pragma("unroll") for (int kt2 = 0; kt2 < 2; kt2++) { \
      S[kt2] = MFMA32(aones, bbias, zero16); \
      _Pragma("unroll") for (int ks = 0; ks < 4; ks++) { \
        const bf16x8 a_ = *(const bf16x8*)(Kc + (kt2 * 32 + pr) * 128 + (((ks * 2 + h2) ^ ((pr >> 1) & 7)) << 4)); \
        S[kt2] = MFMA32(a_, qf[QT][ks], S[kt2]); } } \
    if (mmode == 2) { \
      const bool selb = (br == 2) || ((sell[QT] >> j) & 1ull); \
      const int khi = t, klo = (br == 2) ? t - 511 : 0; \
      _Pragma("unroll") for (int kt2 = 0; kt2 < 2; kt2++) \
        _Pragma("unroll") for (int ii = 0; ii < 16; ii++) { \
          const int key = j * 64 + kt2 * 32 + (ii & 7) + 16 * (ii >> 3) + 8 * h2; \
          S[kt2][ii] = (selb && key <= khi && key >= klo) ? S[kt2][ii] : -INFINITY; } } }
#define EXP_TILE(S, rs) { rs = 0.f; \
    _Pragma("unroll") for (int kt2 = 0; kt2 < 2; kt2++) \
      _Pragma("unroll") for (int ii = 0; ii < 16; ii++) { const float pv_ = __builtin_amdgcn_exp2f(S[kt2][ii]); S[kt2][ii] = pv_; rs += pv_; } }
#pragma unroll 1
  for (int i = 0; i < nsteps; i++) {
    const int br = i < nwin ? 2 : 1, j = i < nwin ? wlo + i : i - nwin;
    if (i == nwin) { flush(2); reset(); }
    if (i + 2 < nsteps) gload(i + 2, cur == 0 ? 2 : cur - 1);
    const char* Kc = Kl + cur * 8192; const char* Vc = Vl + cur * 8192;
    const int mmode = (br == 2) ? ((j == jq || j + 8 == jq) ? 2 : 0) : (j == jq ? 2 : 1);
#pragma unroll
    for (int qt = 0; qt < 2; qt++) {
      unsigned w0 = mbias[qt];
      if (mmode == 1) w0 = ((sell[qt] >> j) & 1ull) ? w0 : 0x0000FF80u;
      bb4.x = h2 == 0 ? w0 : 0u;
      const bf16x8 bbias = __builtin_bit_cast(bf16x8, bb4);
      const int t = t0 + qt * 32 + r;
      f32x16 S[2];
      QK_TILE(S, qt);
      float rs;
      EXP_TILE(S, rs);
      if (__any(rs > 65536.f)) {
        QK_TILE(S, qt);
        float mx = -INFINITY;
#pragma unroll
        for (int kt2 = 0; kt2 < 2; kt2++)
#pragma unroll
          for (int ii = 0; ii < 16; ii++) mx = fmaxf(mx, S[kt2][ii]);
        mx = xh_max(mx);
        const float msafe0 = (mrow[qt] == -INFINITY) ? 0.f : mrow[qt];
        const float mn = msafe0 + fmaxf(mx, 0.f);
        const float mhi = bf2f(f2bf(mn)), mlo = bf2f(f2bf(mn - mhi)), mq = mhi + mlo;
        const float dl = mq - msafe0;
        const float alpha = __builtin_amdgcn_exp2f(-dl);
        lrow[qt] *= alpha; mrow[qt] = mq; mbias[qt] = pack2(-mhi, -mlo);
#pragma unroll
        for (int dt = 0; dt < 2; dt++)
#pragma unroll
          for (int ii = 0; ii < 16; ii++) O[dt][qt][ii] *= alpha;
#pragma unroll
        for (int kt2 = 0; kt2 < 2; kt2++)
#pragma unroll
          for (int ii = 0; ii < 16; ii++) S[kt2][ii] -= dl;
        EXP_TILE(S, rs);
      }
      lrow[qt] += xh_sum(rs);
#pragma unroll
      for (int kt2 = 0; kt2 < 2; kt2++)
#pragma unroll
        for (int s2 = 0; s2 < 2; s2++) {
          uint4 u;
          u.x = pack2(S[kt2][8 * s2 + 0], S[kt2][8 * s2 + 1]); u.y = pack2(S[kt2][8 * s2 + 2], S[kt2][8 * s2 + 3]);
          u.z = pack2(S[kt2][8 * s2 + 4], S[kt2][8 * s2 + 5]); u.w = pack2(S[kt2][8 * s2 + 6], S[kt2][8 * s2 + 7]);
          const bf16x8 pfr = __builtin_bit_cast(bf16x8, u);
#pragma unroll
          for (int dt = 0; dt < 2; dt++) {
            const int d = dt * 32 + r;
            const bf16x8 vf = *(const bf16x8*)(Vc + d * 128 + (((kt2 * 4 + s2 * 2 + h2) ^ ((d >> 1) & 7)) << 4));
            O[dt][qt] = MFMA32(vf, pfr, O[dt][qt]);
          }
        }
      __builtin_amdgcn_sched_barrier(0);
    }
    if (i + 2 < nsteps) asm volatile("s_waitcnt vmcnt(4)" ::: "memory"); else asm volatile("s_waitcnt vmcnt(0)" ::: "memory");
    __builtin_amdgcn_s_barrier();
    cur = cur == 2 ? 0 : cur + 1;
  }
#undef QK_TILE
#undef EXP_TILE
  flush(1);
  __syncthreads();
}

DI void cmp_unit(const Params& p, int unit, char* smem) {
  const int tid = opq(threadIdx.x), lane = tid & 63, w = tid >> 6, r = lane & 31, h2 = lane >> 5;
  const int bg = unit >> 7, q32 = unit & 127, b = bg >> 1, g = bg & 1, hh = g * 4 + w;
  const int pr = perm23(r);
  const bf16_t* Kg = p.kcmp + (size_t)bg * 256 * 64;
  const bf16_t* Vg = p.vcmpT + (size_t)bg * 64 * 256;
  const int tb = q32 * 32, t = tb + r;
  const int nvalid = t >= 31 ? ((t - 31) >> 4) + 1 : 0;
  const int nvmax = (tb >> 4) + 1;
  const int nkt = (nvmax + 31) >> 5;
  char* Kl = smem; char* Vl = smem + 32768; float* impw = (float*)smem;
  const unsigned ldsb = (unsigned)(size_t)(LAS char*)smem;
  __syncthreads();
  for (int pc = w; pc < 4 * nkt; pc += 4) {
    const int row = pc * 8 + (lane >> 3);
    glds16_asm(Kg + row * 64 + (((lane & 7) ^ ((row >> 1) & 7)) << 3), ldsb + __builtin_amdgcn_readfirstlane(pc * 1024));
  }
#pragma unroll
  for (int i = 0; i < 8; i++) {
    const int pc = w * 8 + i, d = pc * 2 + h2;
    glds16_asm(Vg + d * 256 + (((lane & 31) ^ (d & 15)) << 3), ldsb + 32768 + __builtin_amdgcn_readfirstlane(pc * 1024));
  }
  bf16x8 qf[4];
#pragma unroll
  for (int ks = 0; ks < 4; ks++) qf[ks] = *(const bf16x8*)(p.Qn + ((size_t)(b * 8 + hh) * T + t) * 64 + ks * 16 + h2 * 8);
  asm volatile("s_waitcnt vmcnt(0)" ::: "memory");
  __syncthreads();
  float mx = -1e30f;
#pragma unroll 1
  for (int kt = 0; kt < nkt; kt++) {
    f32x16 S;
#pragma unroll
    for (int i = 0; i < 16; i++) S[i] = 0.f;
    const int row = kt * 32 + pr;
#pragma unroll
    for (int ks = 0; ks < 4; ks++) { const bf16x8 kf = *(const bf16x8*)(Kl + row * 128 + (((ks * 2 + h2) ^ ((row >> 1) & 7)) << 4)); S = MFMA32(kf, qf[ks], S); }
#pragma unroll
    for (int i = 0; i < 16; i++) { const int key = kt * 32 + (i & 7) + 16 * (i >> 3) + 8 * h2; mx = fmaxf(mx, key < nvalid ? S[i] : -1e30f); }
  }
  mx = fmaxf(mx, __shfl_xor(mx, 32));
  float sum = 0.f;
  float impo[32];
#pragma unroll
  for (int i = 0; i < 32; i++) impo[i] = 0.f;
  f32x16 O[2];
#pragma unroll
  for (int dt = 0; dt < 2; dt++)
#pragma unroll
    for (int i = 0; i < 16; i++) O[dt][i] = 0.f;
  float carry = 0.f;
#pragma unroll
  for (int kt = 0; kt < 8; kt++) {
    if (kt < nkt) {
      f32x16 S;
#pragma unroll
      for (int i = 0; i < 16; i++) S[i] = 0.f;
      const int row = kt * 32 + pr;
#pragma unroll
      for (int ks = 0; ks < 4; ks++) { const bf16x8 kf = *(const bf16x8*)(Kl + row * 128 + (((ks * 2 + h2) ^ ((row >> 1) & 7)) << 4)); S = MFMA32(kf, qf[ks], S); }
#pragma unroll
      for (int i = 0; i < 16; i++) {
        const int key = kt * 32 + (i & 7) + 16 * (i >> 3) + 8 * h2;
        const float e = key < nvalid ? __builtin_amdgcn_exp2f(S[i] - mx) : 0.f;
        S[i] = e; sum += e;
      }
      {
        const float x1 = __shfl_xor(S[7], 32), x3 = __shfl_xor(S[15], 32);
#pragma unroll
        for (int q4 = 0; q4 < 4; q4++) {
          const float mainv = 2.f * (S[q4 * 4] + S[q4 * 4 + 1] + S[q4 * 4 + 2]) + S[q4 * 4 + 3];
          const float prev = (q4 == 0) ? (h2 ? x1 : carry) : (q4 == 1) ? S[3] : (q4 == 2) ? (h2 ? x3 : x1) : S[11];
          impo[kt * 4 + q4] = mainv + prev;
        }
        carry = x3;
      }
#pragma unroll
      for (int s2 = 0; s2 < 2; s2++) {
        uint4 u;
        u.x = pack2(S[8 * s2 + 0], S[8 * s2 + 1]); u.y = pack2(S[8 * s2 + 2], S[8 * s2 + 3]);
        u.z = pack2(S[8 * s2 + 4], S[8 * s2 + 5]); u.w = pack2(S[8 * s2 + 6], S[8 * s2 + 7]);
        const bf16x8 pfr = __builtin_bit_cast(bf16x8, u);
#pragma unroll
        for (int dt = 0; dt < 2; dt++) {
          const int d = dt * 32 + r;
          const bf16x8 vf = *(const bf16x8*)(Vl + d * 512 + (((kt * 4 + s2 * 2 + h2) ^ (d & 15)) << 4));
          O[dt] = MFMA32(vf, pfr, O[dt]);
        }
      }
    }
  }
  sum += __shfl_xor(sum, 32);
  const float inv = sum > 0.f ? 1.f / sum : 0.f;
  {
    const size_t m = (size_t)b * T + t;
    const float sc = inv * p.NG[m * 24 + hh * 3 + 0];
#pragma unroll
    for (int dt = 0; dt < 2; dt++)
#pragma unroll
      for (int q4 = 0; q4 < 4; q4++) {
        uint2 o; o.x = pack2(sc * O[dt][q4 * 4], sc * O[dt][q4 * 4 + 1]); o.y = pack2(sc * O[dt][q4 * 4 + 2], sc * O[dt][q4 * 4 + 3]);
        *(uint2*)(p.oattn + m * 512 + hh * 64 + dt * 32 + q4 * 8 + h2 * 4) = o;
      }
  }
  __syncthreads();
#pragma unroll
  for (int kt = 0; kt < 8; kt++)
#pragma unroll
    for (int q4 = 0; q4 < 4; q4++)
      impw[(w * 32 + r) * 65 + 8 * kt + 4 * (q4 >> 1) + 2 * h2 + (q4 & 1)] = impo[kt * 4 + q4] * inv;
  __syncthreads();
#pragma unroll 1
  for (int k8 = 0; k8 < 8; k8++) {
    const int rr = w * 8 + k8, tt = tb + rr, blk = tt >> 6;
    const float imp = ((impw[rr * 65 + lane] + impw[(32 + rr) * 65 + lane]) + impw[(64 + rr) * 65 + lane]) + impw[(96 + rr) * 65 + lane];
    const float score = (lane == 0 || lane == blk || lane == blk - 1) ? 1e9f : (lane <= blk ? imp : -1e9f);
    int rank = 0;
#pragma unroll
    for (int i = 0; i < 64; i++) { const float si = __int_as_float(__builtin_amdgcn_readlane(__float_as_int(score), i)); rank += (si > score || (si == score && i < lane)) ? 1 : 0; }
    const unsigned long long selm = __ballot(rank < 16);
    if (lane == 0) p.selmask[(size_t)bg * T + tt] = selm;
  }
}

DI float gelu_tanh(float x) { const float u = 0.7978845608028654f * (x + 0.044715f * x * x * x); return 0.5f * x * (1.f + tanhf(u)); }
DI void compress1_tile(const Params& p, int task, char* smem) {
  const int ks = task & 3, tile = task >> 2;
  const int ntl = tile & 1, mtile = tile >> 1, half = mtile & 1, bg = (mtile >> 1) & 7, kv = mtile >> 4;
  const bf16_t* src = (kv ? p.CV : p.CK) + (size_t)bg * T * 64 + (size_t)half * 128 * 1024 + ks * 512;
  const bf16_t* Bt = (kv ? p.W1vT : p.W1kT) + (size_t)ntl * 128 * 2048 + ks * 512;
  f32x4 acc[4][4]; zero_acc(acc);
  gemm128<true>(acc, [=](int r) { return src + (size_t)r * 1024; }, [=](int r) { return Bt + (size_t)r * 2048; }, 512, smem);
  float* H1p = (float*)p.oattn + (size_t)ks * 4096 * 256;
  epilogue<true>(acc, [&](int r, int c, f32x4 v) {
    const int n = half * 128 + r;
    if (n < 255) { float4 o; o.x = v[0]; o.y = v[1]; o.z = v[2]; o.w = v[3];
      *(float4*)(H1p + ((size_t)((kv * 8 + bg) * 256 + n)) * 256 + ntl * 128 + c) = o; }
  });
}
DI void compress2(const Params& p, char* smem) {
  float* hl = (float*)smem;
  const int tid = opq(threadIdx.x);
  const float* H1p = (const float*)p.oattn;
  for (int rb = blockIdx.x; rb < 512; rb += gridDim.x) {
    const int row0 = rb * 8, kv = row0 >> 11;
    __syncthreads();
#pragma unroll
    for (int q = 0; q < 8; q++) {
      const size_t idx = (size_t)(row0 + q) * 256 + tid;
      hl[q * 256 + tid] = gelu_tanh(H1p[idx] + H1p[idx + (size_t)4096 * 256] + H1p[idx + (size_t)2 * 4096 * 256] + H1p[idx + (size_t)3 * 4096 * 256] + p.posb[kv * 256 + tid]);
    }
    __syncthreads();
    const int q = tid >> 5, ii = tid & 31, row = row0 + q, n = row & 255, bg = (row >> 8) & 7;
    float a0 = 0.f, a1 = 0.f;
    if (n < 255) {
      const float* w2 = kv ? p.cmp_v_w2 : p.cmp_k_w2; const float* b2 = kv ? p.cmp_v_b2 : p.cmp_k_b2;
      a0 = b2[ii]; a1 = b2[ii + 32];
#pragma unroll 8
      for (int j = 0; j < 256; j++) { const float hv = hl[q * 256 + j]; a0 += hv * w2[j * 64 + ii]; a1 += hv * w2[j * 64 + ii + 32]; }
    }
    if (kv == 0) {
      float r0 = 0.f, r1 = 0.f;
      if (n < 255) { const int pos = 16 * n + 31; const float c = p.ropeN[((size_t)pos * 32 + ii) * 2], s = p.ropeN[((size_t)pos * 32 + ii) * 2 + 1];
        r0 = a0 * c - a1 * s; r1 = a0 * s + a1 * c; }
      *(unsigned*)(p.kcmp + ((size_t)(bg * 256 + n)) * 64 + 2 * ii) = pack2(r0, r1);
    } else {
      p.vcmpT[((size_t)(bg * 64 + ii)) * 256 + n] = f2bf(a0);
      p.vcmpT[((size_t)(bg * 64 + ii + 32)) * 256 + n] = f2bf(a1);
    }
  }
}


DI void ret_u_unit(const Params& p, int unit) {
  const int tid = opq(threadIdx.x), lane = tid & 63, w = tid >> 6, r = lane & 31, h2 = lane >> 5;
  const int bh = unit >> 5, n = unit & 31;
  const bf16_t* kz = p.RKzT + (size_t)bh * 128 * T + ((size_t)((w * 256 + n * 8) * 2 + h2)) * 256 + r * 8;
  const bf16_t* vt = p.RVt + (size_t)bh * 256 * T + ((size_t)((n * 8) * 2 + h2)) * 256 + r * 8;
  bf16_t* ut = p.Ut + ((size_t)bh * 32 + n) * 32768 + (size_t)(w * 2) * 512 + r * 8 + 4 * h2;
  bf16x8 a[8], b0[8], b1[8];
#pragma unroll
  for (int ks = 0; ks < 8; ks++) a[ks] = *(const bf16x8*)(kz + ks * 512);
#pragma unroll
  for (int ks = 0; ks < 8; ks++) b0[ks] = *(const bf16x8*)(vt + ks * 512);
#pragma unroll
  for (int dvs = 0; dvs < 8; dvs += 2) {
#pragma unroll
    for (int ks = 0; ks < 8; ks++) b1[ks] = *(const bf16x8*)(vt + (size_t)(dvs + 1) * 32 * T + ks * 512);
    {
      f32x16 R;
#pragma unroll
      for (int i = 0; i < 16; i++) R[i] = 0.f;
#pragma unroll
      for (int ks = 0; ks < 8; ks++) R = MFMA32(a[ks], b0[ks], R);
#pragma unroll
      for (int q4 = 0; q4 < 4; q4++) { uint2 o; o.x = pack2(R[q4 * 4], R[q4 * 4 + 1]); o.y = pack2(R[q4 * 4 + 2], R[q4 * 4 + 3]);
        *(uint2*)(ut + (size_t)dvs * 4096 + (q4 >> 1) * 512 + (q4 & 1) * 256) = o; }
    }
    if (dvs + 2 < 8) {
#pragma unroll
      for (int ks = 0; ks < 8; ks++) b0[ks] = *(const bf16x8*)(vt + (size_t)(dvs + 2) * 32 * T + ks * 512);
    }
    {
      f32x16 R;
#pragma unroll
      for (int i = 0; i < 16; i++) R[i] = 0.f;
#pragma unroll
      for (int ks = 0; ks < 8; ks++) R = MFMA32(a[ks], b1[ks], R);
#pragma unroll
      for (int q4 = 0; q4 < 4; q4++) { uint2 o; o.x = pack2(R[q4 * 4], R[q4 * 4 + 1]); o.y = pack2(R[q4 * 4 + 2], R[q4 * 4 + 3]);
        *(uint2*)(ut + (size_t)(dvs + 1) * 4096 + (q4 >> 1) * 512 + (q4 & 1) * 256) = o; }
    }
  }
}
DI void ret_scan_elem(const Params& p) {
  const size_t gtid = (size_t)blockIdx.x * 256 + opq(threadIdx.x), gsz = (size_t)gridDim.x * 256;
  for (size_t i = gtid; i < (size_t)16 * 256 * 32; i += gsz) {
    const int bh = (int)(i >> 13), h = bh & 3;
    const size_t off = (size_t)(i & 8191) * 4;
    const float cd = exp2f(128.f * log2f(1.f - exp2f(-5.f - (float)h)));
    const bf16_t* up = p.Ut + (size_t)bh * 32 * 32768 + off;
    bf16_t* rp = p.Rt + (size_t)bh * 32 * 32768 + off;
    uint2 u[31];
#pragma unroll
    for (int n = 0; n < 31; n++) u[n] = *(const uint2*)(up + (size_t)n * 32768);
    float r0 = 0.f, r1 = 0.f, r2 = 0.f, r3 = 0.f;
    { uint2 z; z.x = 0u; z.y = 0u; *(uint2*)rp = z; }
#pragma unroll
    for (int n = 0; n < 31; n++) {
      r0 = r0 * cd + lo2f(u[n].x); r1 = r1 * cd + hi2f(u[n].x); r2 = r2 * cd + lo2f(u[n].y); r3 = r3 * cd + hi2f(u[n].y);
      uint2 o; o.x = pack2(r0, r1); o.y = pack2(r2, r3);
      *(uint2*)(rp + (size_t)(n + 1) * 32768) = o;
    }
  }
}

DI void ret_out_unit(const Params& p, int unit, char* smem) {
  const int tid = opq(threadIdx.x), lane = tid & 63, w = tid >> 6, r = lane & 31, h2 = lane >> 5, tq = w >> 1, dh = w & 1;
  const int th = unit & 1, n = (unit >> 1) & 31, bh = unit >> 6, b = bh >> 2, h = bh & 3;
  const int qt = th * 2 + tq, c = qt * 32 + r;
  const float lg = log2f(1.f - exp2f(-5.f - (float)h));
  const bf16_t* qp = p.RQ + (size_t)bh * T * 128 + ((size_t)(((n * 4 + qt) * 8) * 2 + h2)) * 256 + r * 8;
  f32x16 O[4];
  {
    const bf16_t* rp = p.Rt + ((size_t)bh * 32 + n) * 32768 + ((size_t)((dh * 4 * 8) * 2 + h2)) * 256 + r * 8;
#pragma unroll
    for (int dvt = 0; dvt < 4; dvt++)
#pragma unroll
      for (int i = 0; i < 16; i++) O[dvt][i] = 0.f;
#pragma unroll
    for (int ks = 0; ks < 8; ks++) {
      const bf16x8 qk = *(const bf16x8*)(qp + ks * 512);
#pragma unroll
      for (int dvt = 0; dvt < 4; dvt++) {
        const bf16x8 rf = *(const bf16x8*)(rp + (size_t)dvt * 4096 + ks * 512);
        O[dvt] = MFMA32(rf, qk, O[dvt]);
      }
    }
    const float xi = exp2f((float)(c + 1) * lg);
#pragma unroll
    for (int dvt = 0; dvt < 4; dvt++)
#pragma unroll
      for (int i = 0; i < 16; i++) O[dvt][i] *= xi;
  }
#pragma unroll 1
  for (int kt = 0; kt <= qt; kt++) {
    f32x16 S;
#pragma unroll
    for (int i = 0; i < 16; i++) S[i] = 0.f;
    const bf16_t* kp = p.RK + (size_t)bh * T * 128 + ((size_t)(((n * 4 + kt) * 8) * 2 + h2)) * 256 + perm23(r) * 8;
#pragma unroll
    for (int ks = 0; ks < 8; ks++) { const bf16x8 kf = *(const bf16x8*)(kp + ks * 512); const bf16x8 qk = *(const bf16x8*)(qp + ks * 512); S = MFMA32(kf, qk, S); }
    bf16x8 pf[2];
#pragma unroll
    for (int s2 = 0; s2 < 2; s2++) {
      float v[8];
#pragma unroll
      for (int jj = 0; jj < 8; jj++) {
        const int i = 8 * s2 + jj;
        const int mkey = kt * 32 + (i & 7) + 16 * (i >> 3) + 8 * h2;
        v[jj] = (mkey <= c) ? S[i] * exp2f((float)(c - mkey) * lg) : 0.f;
      }
      uint4 u; u.x = pack2(v[0], v[1]); u.y = pack2(v[2], v[3]); u.z = pack2(v[4], v[5]); u.w = pack2(v[6], v[7]);
      pf[s2] = __builtin_bit_cast(bf16x8, u);
    }
    const bf16_t* vp = p.RVt + (size_t)bh * 256 * T + ((size_t)(((dh * 4) * 256 + n * 8 + kt * 2) * 2 + h2)) * 256 + r * 8;
#pragma unroll
    for (int dvt = 0; dvt < 4; dvt++)
#pragma unroll
      for (int s2 = 0; s2 < 2; s2++) {
        const bf16x8 vf = *(const bf16x8*)(vp + (size_t)dvt * 32 * T + s2 * 512);
        O[dvt] = MFMA32(vf, pf[s2], O[dvt]);
      }
  }
  float s1 = 0.f, s2s = 0.f;
#pragma unroll
  for (int dvt = 0; dvt < 4; dvt++)
#pragma unroll
    for (int i = 0; i < 16; i++) { s1 += O[dvt][i]; s2s += O[dvt][i] * O[dvt][i]; }
  s1 += __shfl_xor(s1, 32); s2s += __shfl_xor(s2s, 32);
  float* red = (float*)smem;
  __syncthreads();
  if (h2 == 0) { red[(w * 32 + r) * 2] = s1; red[(w * 32 + r) * 2 + 1] = s2s; }
  __syncthreads();
  s1 += red[((w ^ 1) * 32 + r) * 2]; s2s += red[((w ^ 1) * 32 + r) * 2 + 1];
  const float mu = s1 * (1.f / 256.f);
  const float var = fmaxf(s2s * (1.f / 256.f) - mu * mu, 0.f);
  const float rs = rsqrtf(var + 1e-5f);
  const size_t m = (size_t)b * T + n * 128 + c;
#pragma unroll
  for (int dvt = 0; dvt < 4; dvt++)
#pragma unroll
    for (int q4 = 0; q4 < 4; q4++) {
      const int col = h * 256 + dh * 128 + dvt * 32 + q4 * 8 + 4 * h2;
      const float4 gg = *(const float4*)(p.gn_g + col), bb = *(const float4*)(p.gn_b + col);
      const uint2 rg = *(const uint2*)(p.RG + m * 1024 + col);
      const float g0 = lo2f(rg.x), g1 = hi2f(rg.x), g2 = lo2f(rg.y), g3 = hi2f(rg.y);
      const float y0 = ((O[dvt][q4 * 4] - mu) * rs * gg.x + bb.x) * g0 * sigmoidf_(g0);
      const float y1 = ((O[dvt][q4 * 4 + 1] - mu) * rs * gg.y + bb.y) * g1 * sigmoidf_(g1);
      const float y2 = ((O[dvt][q4 * 4 + 2] - mu) * rs * gg.z + bb.z) * g2 * sigmoidf_(g2);
      const float y3 = ((O[dvt][q4 * 4 + 3] - mu) * rs * gg.w + bb.w) * g3 * sigmoidf_(g3);
      uint2 o; o.x = pack2(y0, y1); o.y = pack2(y2, y3);
      *(uint2*)(p.oret + m * 1024 + col) = o;
    }
}

DI void lds_tile_load(const bf16_t* src, size_t ld, char* smem) {
  const int tid = opq(threadIdx.x);
#pragma unroll
  for (int k = 0; k < 8; k++) { const int id = tid + 256 * k, i = id >> 4, j8 = (id & 15) * 8; *(uint4*)(smem + i * 272 + j8 * 2) = *(const uint4*)(src + (size_t)i * ld + j8); }
}
DI void lds_tile_store(bf16_t* dstp, size_t ld, char* smem) {
  const int tid = opq(threadIdx.x);
#pragma unroll
  for (int k = 0; k < 8; k++) { const int id = tid + 256 * k, i = id >> 4, j8 = (id & 15) * 8; *(uint4*)(dstp + (size_t)i * ld + j8) = *(const uint4*)(smem + i * 272 + j8 * 2); }
}
DI void upproj_tile(const Params& p, int tile, char* smem) {
  const int nt_ = tile & 7, mt_ = tile >> 3, m0 = mt_ * 128, n0 = nt_ * 128;
  const int lane = opq(threadIdx.x) & 63, wave = opq(threadIdx.x) >> 6, wr = wave >> 1, wc = wave & 1, fr = lane & 15, fq = lane >> 4;
  f32x4 acc[4][4]; uint2 res[4][4];
  zero_acc(acc);
  { const bf16_t* A = p.oattn + (size_t)m0 * 512; const bf16_t* Bt = p.WaT + (size_t)n0 * 512;
    gemm128<true>(acc, [=](int r) { return A + (size_t)r * 512; }, [=](int r) { return Bt + (size_t)r * 512; }, 512, smem); }
  lds_tile_load(p.MG + (size_t)m0 * 2048 + n0, 2048, smem);
  __syncthreads();
#pragma unroll
  for (int mt = 0; mt < 4; mt++)
#pragma unroll
    for (int nt = 0; nt < 4; nt++) {
      const int r = wr * 64 + mt * 16 + fr, c = wc * 64 + nt * 16 + fq * 4;
      const uint2 gv = *(const uint2*)(smem + r * 272 + c * 2);
      res[mt][nt].x = pack2(sigmoidf_(lo2f(gv.x)) * acc[mt][nt][0], sigmoidf_(hi2f(gv.x)) * acc[mt][nt][1]);
      res[mt][nt].y = pack2(sigmoidf_(lo2f(gv.y)) * acc[mt][nt][2], sigmoidf_(hi2f(gv.y)) * acc[mt][nt][3]);
    }
  __syncthreads();
  zero_acc(acc);
  { const bf16_t* A = p.oret + (size_t)m0 * 1024; const bf16_t* Bt = p.WrT + (size_t)n0 * 1024;
    gemm128<true>(acc, [=](int r) { return A + (size_t)r * 1024; }, [=](int r) { return Bt + (size_t)r * 1024; }, 1024, smem); }
  lds_tile_load(p.MG + (size_t)m0 * 2048 + 1024 + n0, 2048, smem);
  __syncthreads();
#pragma unroll
  for (int mt = 0; mt < 4; mt++)
#pragma unroll
    for (int nt = 0; nt < 4; nt++) {
      const int r = wr * 64 + mt * 16 + fr, c = wc * 64 + nt * 16 + fq * 4;
      uint2* q = (uint2*)(smem + r * 272 + c * 2);
      const uint2 gv = *q;
      uint2 o; o.x = pack2(lo2f(res[mt][nt].x) + sigmoidf_(lo2f(gv.x)) * acc[mt][nt][0], hi2f(res[mt][nt].x) + sigmoidf_(hi2f(gv.x)) * acc[mt][nt][1]);
      o.y = pack2(lo2f(res[mt][nt].y) + sigmoidf_(lo2f(gv.y)) * acc[mt][nt][2], hi2f(res[mt][nt].y) + sigmoidf_(hi2f(gv.y)) * acc[mt][nt][3]);
      *q = o;
    }
  __syncthreads();
  lds_tile_store(p.merged + (size_t)m0 * 1024 + n0, 1024, smem);
  __syncthreads();
}
DI void wout_tile(const Params& p, int tile, char* smem) {
  const int nt_ = tile & 7, mt_ = tile >> 3, m0 = mt_ * 128, n0 = nt_ * 128;
  const int tid = opq(threadIdx.x), lane = tid & 63, wave = tid >> 6, wr = wave >> 1, wc = wave & 1, fr = lane & 15, fq = lane >> 4;
  f32x4 acc[4][4]; zero_acc(acc);
  const bf16_t* A = p.merged + (size_t)m0 * 1024; const bf16_t* Bt = p.WoT + (size_t)n0 * 1024;
  gemm128<true>(acc, [=](int r) { return A + (size_t)r * 1024; }, [=](int r) { return Bt + (size_t)r * 1024; }, 1024, smem);
#pragma unroll
  for (int hcol = 0; hcol < 2; hcol++) {
    const size_t g0 = (size_t)m0 * 1024 + n0 + hcol * 64;
#pragma unroll
    for (int k = 0; k < 8; k++) { const int id = tid + 256 * k, i = id >> 4, j4 = (id & 15) * 4; *(float4*)(smem + i * 272 + j4 * 4) = *(const float4*)(p.x + g0 + (size_t)i * 1024 + j4); }
    __syncthreads();
    if (wc == hcol) {
#pragma unroll
      for (int mt = 0; mt < 4; mt++)
#pragma unroll
        for (int nt = 0; nt < 4; nt++) {
          float4* q = (float4*)(smem + (wr * 64 + mt * 16 + fr) * 272 + (nt * 16 + fq * 4) * 4);
          const float4 xv = *q;
          float4 o; o.x = ALPHA * xv.x + acc[mt][nt][0]; o.y = ALPHA * xv.y + acc[mt][nt][1]; o.z = ALPHA * xv.z + acc[mt][nt][2]; o.w = ALPHA * xv.w + acc[mt][nt][3];
          *q = o;
        }
    }
    __syncthreads();
#pragma unroll
    for (int k = 0; k < 8; k++) { const int id = tid + 256 * k, i = id >> 4, j4 = (id & 15) * 4; *(float4*)(p.out + g0 + (size_t)i * 1024 + j4) = *(const float4*)(smem + i * 272 + j4 * 4); }
    __syncthreads();
  }
}
DI void expert_cvt_tile(const Params& p, int ct, float* tile) {
  const int e = ct / 192, rr = ct % 192;
  const float* wg = p.e_wg + (size_t)e * 1024 * 512; const float* wu = p.e_wu + (size_t)e * 1024 * 512; const float* wd = p.e_wd + (size_t)e * 512 * 1024;
  if (rr < 128)
    tcvt_tile128([=](int j) -> const float* { const int f = (j >> 7) * 64 + ((j >> 5) & 3) * 16 + (j & 15); return (((j >> 4) & 1) ? wu : wg) + f; },
                 512, p.EgT + (size_t)e * 1024 * 1024, 1024, rr >> 3, rr & 7, tile);
  else { const int q = rr - 128;
    tcvt_tile128([=](int j) -> const float* { return wd + j; }, 1024, p.EdT + (size_t)e * 1024 * 512, 512, q >> 3, q & 7, tile); }
}
DI void phase7(const Params& p, char* smem) {
  const int bid = blockIdx.x, nb = gridDim.x;
  if (bid & 1) for (int c = bid; c < 6144; c += nb) expert_cvt_tile(p, c, (float*)smem);
  for (int t = bid; t < 1024; t += nb) wout_tile(p, t, smem);
  if (!(bid & 1)) for (int c = bid; c < 6144; c += nb) expert_cvt_tile(p, c, (float*)smem);
}

DI void ln1_router(const Params& p, int m, int lane, float* xl  ) {
  float* row = p.out + (size_t)m * 1024;
  float4 v[4];
#pragma unroll
  for (int i = 0; i < 4; i++) v[i] = *(const float4*)(row + i * 256 + lane * 4);
  float s = 0.f;
#pragma unroll
  for (int i = 0; i < 4; i++) s += v[i].x + v[i].y + v[i].z + v[i].w;
  const float mu = wsum(s) * (1.f / 1024.f);
  float q = 0.f;
#pragma unroll
  for (int i = 0; i < 4; i++) { const float a = v[i].x - mu, b = v[i].y - mu, c = v[i].z - mu, d = v[i].w - mu; q += a * a + b * b + c * c + d * d; }
  const float rs = rsqrtf(wsum(q) * (1.f / 1024.f) + 1e-5f);
#pragma unroll
  for (int i = 0; i < 4; i++) {
    const int k = i * 256 + lane * 4;
    const float4 g = *(const float4*)(p.ln1_g + k), bb = *(const float4*)(p.ln1_b + k);
    v[i].x = (v[i].x - mu) * rs * g.x + bb.x; v[i].y = (v[i].y - mu) * rs * g.y + bb.y;
    v[i].z = (v[i].z - mu) * rs * g.z + bb.z; v[i].w = (v[i].w - mu) * rs * g.w + bb.w;
    *(float4*)(row + k) = v[i];
    uint2 o; o.x = pack2(v[i].x, v[i].y); o.y = pack2(v[i].z, v[i].w);
    *(uint2*)(p.x1b + (size_t)m * 1024 + k) = o;
    *(float4*)(xl + k) = v[i];
  }
  WSYNC();
  float gl[4] = {0.f, 0.f, 0.f, 0.f};
#pragma unroll
  for (int c = 0; c < 16; c++) {
    const int k = c * 64 + lane;
    const float xk = xl[k];
    const float4 w = *(const float4*)(p.rg_w + (size_t)k * 4);
    gl[0] += xk * w.x; gl[1] += xk * w.y; gl[2] += xk * w.z; gl[3] += xk * w.w;
  }
#pragma unroll
  for (int j = 0; j < 4; j++) gl[j] = wsum(gl[j]) + p.rg_b[j];
  int gi = 0; float gm = gl[0];
#pragma unroll
  for (int j = 1; j < 4; j++) if (gl[j] > gm) { gm = gl[j]; gi = j; }
  float gs = 0.f;
#pragma unroll
  for (int j = 0; j < 4; j++) gs += __expf(gl[j] - gm);
  const float gprob = 1.f / gs;
  const float* riw = p.ri_w + (size_t)gi * 1024 * 8 + (lane & 1) * 4;
  float tq[4] = {0.f, 0.f, 0.f, 0.f};
#pragma unroll 16
  for (int c = 0; c < 32; c++) {
    const int k = c * 32 + (lane >> 1);
    const float xk = xl[k];
    const float4 w = *(const float4*)(riw + (size_t)k * 8);
    tq[0] += xk * w.x; tq[1] += xk * w.y; tq[2] += xk * w.z; tq[3] += xk * w.w;
  }
  float il[8];
#pragma unroll
  for (int j = 0; j < 4; j++) { il[j] = wsum((lane & 1) ? 0.f : tq[j]) + p.ri_b[gi * 8 + j]; il[4 + j] = wsum((lane & 1) ? tq[j] : 0.f) + p.ri_b[gi * 8 + 4 + j]; }
  int e1 = 0; float l1 = il[0];
#pragma unroll
  for (int j = 1; j < 8; j++) if (il[j] > l1) { l1 = il[j]; e1 = j; }
  int e2 = -1; float l2 = -3e38f;
#pragma unroll
  for (int j = 0; j < 8; j++) if (j != e1 && il[j] > l2) { l2 = il[j]; e2 = j; }
  const float ex = __expf(l2 - l1);
  const float w1 = gprob / (1.f + ex), w2 = gprob * ex / (1.f + ex);
  if (lane == 0) {
    const int ea = gi * 8 + e1, eb = gi * 8 + e2;
    const int grp = blockIdx.x & 15;
    const int pa = atomicAdd(p.cnt + grp * 32 + ea, 1); p.lists[(ea * 16 + grp) * 2048 + pa] = m * 2;
    const int pb = atomicAdd(p.cnt + grp * 32 + eb, 1); p.lists[(eb * 16 + grp) * 2048 + pb] = m * 2 + 1;
    p.routew[m * 2] = w1; p.routew[m * 2 + 1] = w2;
  }
  WSYNC();
}
DI void ln2_final(const Params& p, int m, int lane) {
  float* row = p.out + (size_t)m * 1024;
  float4 v[4];
  float s = 0.f;
#pragma unroll
  for (int i = 0; i < 4; i++) {
    const int k = i * 256 + lane * 4;
    const float4 xv = *(const float4*)(row + k);
    const uint2 a = *(const uint2*)(p.part + (size_t)(2 * m) * 1024 + k), b = *(const uint2*)(p.part + (size_t)(2 * m + 1) * 1024 + k);
    v[i].x = ALPHA * xv.x + lo2f(a.x) + lo2f(b.x); v[i].y = ALPHA * xv.y + hi2f(a.x) + hi2f(b.x);
    v[i].z = ALPHA * xv.z + lo2f(a.y) + lo2f(b.y); v[i].w = ALPHA * xv.w + hi2f(a.y) + hi2f(b.y);
    s += v[i].x + v[i].y + v[i].z + v[i].w;
  }
  const float mu = wsum(s) * (1.f / 1024.f);
  float q = 0.f;
#pragma unroll
  for (int i = 0; i < 4; i++) { const float a = v[i].x - mu, b = v[i].y - mu, c = v[i].z - mu, d = v[i].w - mu; q += a * a + b * b + c * c + d * d; }
  const float rs = rsqrtf(wsum(q) * (1.f / 1024.f) + 1e-5f);
#pragma unroll
  for (int i = 0; i < 4; i++) {
    const int k = i * 256 + lane * 4;
    const float4 g = *(const float4*)(p.ln2_g + k), bb = *(const float4*)(p.ln2_b + k);
    float4 o; o.x = (v[i].x - mu) * rs * g.x + bb.x; o.y = (v[i].y - mu) * rs * g.y + bb.y; o.z = (v[i].z - mu) * rs * g.z + bb.z; o.w = (v[i].w - mu) * rs * g.w + bb.w;
    *(float4*)(row + k) = o;
  }
}

struct MoeMap { int e, mi, cnt, hoff; };
#define MOE_TAB(smem) ((int*)((smem) + 65552))
DI void moe_tables(const Params& p, char* smem) {
  int* tab = MOE_TAB(smem); int* pre = tab; int* tpre = tab + 32 * 17;
  const int tid = opq(threadIdx.x);
  __syncthreads();
  if (tid < 32) { int acc = 0; for (int g = 0; g < 16; g++) { pre[tid * 17 + g] = acc; acc += p.cnt[g * 32 + tid]; } pre[tid * 17 + 16] = acc; }
  __syncthreads();
  if (tid == 0) { int acc = 0; for (int e = 0; e < NEXP; e++) { tpre[e] = acc; acc += (pre[e * 17 + 16] + 127) >> 7; } tpre[32] = acc; }
  __syncthreads();
}
DI bool moe_map(char* smem, int mtile, MoeMap& mm) {
  const int* tab = MOE_TAB(smem); const int* pre = tab; const int* tpre = tab + 32 * 17;
  if (mtile >= tpre[32]) return false;
  int e = 0;
  while (tpre[e + 1] <= mtile) e++;
  mm.e = e; mm.mi = mtile - tpre[e]; mm.cnt = pre[e * 17 + 16]; mm.hoff = tpre[e] * 128;
  return true;
}
DI int moe_total(char* smem) { return MOE_TAB(smem)[32 * 17 + 32]; }
DI const int* moe_rows(const Params& p, const MoeMap& mm, char* smem) {
  int* tab = MOE_TAB(smem); const int* pre = tab + mm.e * 17; int* rowent = tab + 32 * 17 + 40;
  const int tid = opq(threadIdx.x);
  __syncthreads();
  if (tid < 128) {
    const int ri = mm.mi * 128 + tid; int ent = -1;
    if (ri < mm.cnt) { int g = 0; while (pre[g + 1] <= ri) g++; ent = p.lists[(mm.e * 16 + g) * 2048 + ri - pre[g]]; }
    rowent[tid] = ent;
  }
  __syncthreads();
  return rowent;
}
DI void moe_up_tile(const Params& p, const MoeMap& mm, int nt_, char* smem) {
  const int* lst = moe_rows(p, mm, smem); const int nrow = mm.cnt - mm.mi * 128;
  const bf16_t* Bt = p.EgT + ((size_t)mm.e * 1024 + nt_ * 128) * 1024;
  const bf16_t* X = p.x1b;
  f32x4 acc[4][4]; zero_acc(acc);
  gemm128<true>(acc, [=](int r) { const int tk = r < nrow ? (lst[r] >> 1) : 0; return X + (size_t)tk * 1024; }, [=](int r) { return Bt + (size_t)r * 1024; }, 1024, smem);
  const int lane = opq(threadIdx.x) & 63, wave = opq(threadIdx.x) >> 6, wr = wave >> 1, wc = wave & 1, fr = lane & 15, fq = lane >> 4;
#pragma unroll
  for (int mt = 0; mt < 4; mt++) {
    const int r = wr * 64 + mt * 16 + fr;
    if (r < nrow) {
      const float w = p.routew[lst[r]];
#pragma unroll
      for (int np = 0; np < 2; np++) {
        const f32x4 g = acc[mt][np * 2], u = acc[mt][np * 2 + 1];
        float hv[4];
#pragma unroll
        for (int i = 0; i < 4; i++) hv[i] = g[i] * sigmoidf_(g[i]) * u[i] * w;
        const int f = nt_ * 64 + wc * 32 + np * 16 + fq * 4;
        uint2 o; o.x = pack2(hv[0], hv[1]); o.y = pack2(hv[2], hv[3]);
        *(uint2*)(p.Hh + (size_t)(mm.hoff + mm.mi * 128 + r) * 512 + f) = o;
      }
    }
  }
}
DI void moe_down_tile(const Params& p, const MoeMap& mm, int nt_, char* smem) {
  const int* lst = moe_rows(p, mm, smem); const int nrow = mm.cnt - mm.mi * 128;
  const bf16_t* A = p.Hh + (size_t)(mm.hoff + mm.mi * 128) * 512;
  const bf16_t* Bt = p.EdT + ((size_t)mm.e * 1024 + nt_ * 128) * 512;
  f32x4 acc[4][4]; zero_acc(acc);
  gemm128<true>(acc, [=](int r) { return A + (size_t)r * 512; }, [=](int r) { return Bt + (size_t)r * 512; }, 512, smem);
  epilogue<true>(acc, [&](int r, int c, f32x4 v) {
    if (r < nrow) {
      const int ts = lst[r];
      uint2 o; o.x = pack2(v[0], v[1]); o.y = pack2(v[2], v[3]);
      *(uint2*)(p.part + (size_t)ts * 1024 + nt_ * 128 + c) = o;
    }
  });
}

constexpr int NPHASE = 12;
#if FUSED
#define PHFN DI
#else
#define PHFN DI
#endif
#define PH_PRE const int bid = blockIdx.x, nb = gridDim.x, tid = opq(threadIdx.x), lane = tid & 63, wave = tid >> 6; \
  const int gw = bid * 4 + wave, nw = nb * 4; char* wsm = smem + wave * 8192; (void)bid; (void)nb; (void)lane; (void)gw; (void)nw; (void)wsm;
PHFN void ph0(const Params& p, char* smem) { phase0(p, smem); }
PHFN void ph1(const Params& p, char* smem) { phase1(p, smem); }
PHFN void ph2(const Params& p, char* smem) { PH_PRE
  for (int t = bid; t < 256 + 512; t += nb) { if (t < 256) compress1_tile(p, t, smem); else if (((t - 256) & 31) != 31) ret_u_unit(p, t - 256); }
}
PHFN void ph3(const Params& p, char* smem) { compress2(p, smem); ret_scan_elem(p); }
PHFN void ph4(const Params& p, char* smem) { PH_PRE
  for (int u = bid; u < 1024; u += nb) cmp_unit(p, u, smem);
}
PHFN void ph5(const Params& p, char* smem) { PH_PRE
  for (int u = bid; u < 512; u += nb) { const int k = u >> 3; attn_unit(p, ((u & 7) << 6) | (k < 32 ? 63 - k : k - 32), smem); }
  {
    int* sh = (int*)(smem + 65552 + 3072);
    for (;;) {
      __syncthreads();
      if (tid == 0) sh[0] = (int)xb_add(&p.qctr[0], 1u);
      __syncthreads();
      const int u = sh[0];
      if (u >= 1024) break;
      ret_out_unit(p, u, smem);
    }
  }
}
PHFN void ph6(const Params& p, char* smem) { PH_PRE for (int t = bid; t < 1024; t += nb) upproj_tile(p, t, smem); }
PHFN void ph7(const Params& p, char* smem) { phase7(p, smem); }
PHFN void ph8(const Params& p, char* smem) { PH_PRE for (int m = gw; m < M; m += nw) ln1_router(p, m, lane, (float*)wsm); }
PHFN void ph9(const Params& p, char* smem) { PH_PRE moe_tables(p, smem); const int tot = moe_total(smem);
  for (int t = bid; t < tot * 8; t += nb) { MoeMap mm; if (moe_map(smem, t >> 3, mm)) moe_up_tile(p, mm, t & 7, smem); } }
PHFN void ph10(const Params& p, char* smem) { PH_PRE moe_tables(p, smem); const int tot = moe_total(smem);
  for (int t = bid; t < tot * 8; t += nb) { MoeMap mm; if (moe_map(smem, t >> 3, mm)) moe_down_tile(p, mm, t & 7, smem); } }
PHFN void ph11(const Params& p, char* smem) { PH_PRE for (int m = gw; m < M; m += nw) ln2_final(p, m, lane); }
DI void run_phase(const Params& p, const int ph, char* smem) {
  switch (ph) {
    case 0: ph0(p, smem); break; case 1: ph1(p, smem); break; case 2: ph2(p, smem); break; case 3: ph3(p, smem); break;
    case 4: ph4(p, smem); break; case 5: ph5(p, smem); break; case 6: ph6(p, smem); break; case 7: ph7(p, smem); break;
    case 8: ph8(p, smem); break; case 9: ph9(p, smem); break; case 10: ph10(p, smem); break; case 11: ph11(p, smem); break;
  }
}

template <int PH>
__global__ void __launch_bounds__(256, 2) phase_kernel(Params p) {
  __shared__ __attribute__((aligned(16))) char smem[65536 + 16 + 4096];
  run_phase(p, PH, smem);
}
#if FUSED
__global__ void __launch_bounds__(256, 2) mega_kernel(Params p_arg) {
  __shared__ __attribute__((aligned(16))) char smem[65536 + 16 + 4096];
  const Params& p = *(const Params*)__builtin_amdgcn_kernarg_segment_ptr();
  volatile LAS unsigned* st = (volatile LAS unsigned*)(smem + 65536);
  if (threadIdx.x == 0) { st[0] = 0u; st[1] = 0u; }
  __syncthreads();
  const XcdBarrier xb = xcd_barrier_post(p.bar, st);
#define GSYNC() xcd_barrier(xb)
  unsigned long long tk_ = 0; (void)tk_;
#define RUNPH(N) { unsigned long long t0_ = 0; if (PROBE_PHASE == N) t0_ = __builtin_amdgcn_s_memrealtime(); ph##N(p, smem); if (PROBE_DOUBLE & (1 << N)) { GSYNC(); ph##N(p, smem); } \
    if (PROBE_PHASE == N) { GSYNC(); tk_ = __builtin_amdgcn_s_memrealtime() - t0_; } }
  RUNPH(0); GSYNC(); RUNPH(1); GSYNC(); RUNPH(2); GSYNC(); RUNPH(3); GSYNC();
  RUNPH(4); GSYNC(); RUNPH(5); GSYNC(); RUNPH(6); GSYNC(); RUNPH(7); GSYNC();
  RUNPH(8); GSYNC(); RUNPH(9); GSYNC(); RUNPH(10); GSYNC(); RUNPH(11);
  if (PROBE_PHASE >= 0 && blockIdx.x == 0) { const unsigned long long t1_ = __builtin_amdgcn_s_memrealtime(); while (__builtin_amdgcn_s_memrealtime() - t1_ < 3ull * tk_) __builtin_amdgcn_s_sleep(8); }
}
#endif

extern "C" void kernel_launch(void* const* d_in, const int* in_sizes, int n_in, void* d_out, int out_size,
                              void* d_ws, size_t ws_size, hipStream_t stream) {
  Params p{};
  const float** ins = (const float**)&p;
  for (int i = 0; i < 28; i++) ins[i] = (const float*)d_in[i];
  p.out = (float*)d_out;
  char* ws = (char*)d_ws; size_t off = 0;
  auto alloc = [&](size_t bytes) { char* r = ws + off; off += (bytes + 255) & ~(size_t)255; return r; };
  const size_t MiB = 1 << 20;
  char* regionP = ws;
  p.Qn = (bf16_t*)alloc(16 * MiB);
  p.CK = (bf16_t*)alloc(4 * MiB); p.CV = (bf16_t*)alloc(4 * MiB); p.SK = (bf16_t*)alloc(4 * MiB); p.SVt = (bf16_t*)alloc(4 * MiB);
  p.WK = (bf16_t*)alloc(4 * MiB); p.WVt = (bf16_t*)alloc(4 * MiB);
  p.NG = (float*)alloc((size_t)M * 24 * 4);
  p.RQ = (bf16_t*)alloc(16 * MiB); p.RK = (bf16_t*)alloc(16 * MiB); p.RKzT = (bf16_t*)alloc(16 * MiB);
  p.RVt = (bf16_t*)alloc(32 * MiB); p.RG = (bf16_t*)alloc(32 * MiB); p.MG = (bf16_t*)alloc(64 * MiB);
  p.oattn = (bf16_t*)alloc(16 * MiB); p.WinT = p.oattn;
  p.oret = (bf16_t*)alloc(32 * MiB);
  p.WaT = (bf16_t*)alloc(1 * MiB); p.WrT = (bf16_t*)alloc(2 * MiB); p.WoT = (bf16_t*)alloc(2 * MiB);
  p.W1kT = (bf16_t*)alloc(1 * MiB); p.W1vT = (bf16_t*)alloc(1 * MiB);
  p.ropeN = (float*)alloc((size_t)T * 32 * 8); p.ropeR = (float*)alloc((size_t)T * 64 * 8); p.posb = (float*)alloc(512 * 4); p.posp = (float*)alloc(32 * 512 * 4);
  p.H1 = (bf16_t*)alloc(2 * MiB); p.kcmp = (bf16_t*)alloc(8 * 256 * 64 * 2); p.vcmpT = (bf16_t*)alloc(8 * 64 * 256 * 2);
  p.selmask = (unsigned long long*)alloc((size_t)8 * T * 8);
  p.cnt = (int*)alloc(512 * 4); p.lists = (int*)alloc((size_t)NEXP * 16 * 2048 * 4); p.routew = (float*)alloc((size_t)M * 2 * 4);
  p.merged = (bf16_t*)(regionP); p.x1b = (bf16_t*)(regionP + 32 * MiB);
  p.EgT = (bf16_t*)(regionP + 64 * MiB); p.EdT = (bf16_t*)(regionP + 128 * MiB);
  p.Hh = (bf16_t*)(regionP + 160 * MiB); p.part = (bf16_t*)(regionP + 196 * MiB);
  p.bar = (unsigned*)alloc((XCD_BAR_WORDS + 64) * 4); p.qctr = p.bar + XCD_BAR_WORDS;
  p.xb = (bf16_t*)d_out; p.Rt = (bf16_t*)d_out; p.Ut = (bf16_t*)d_out + (size_t)16 * 1024 * 1024;
  if (off > ws_size) { fprintf(stderr, "workspace too small: need %zu have %zu\n", off, ws_size); return; }
#if FUSED
  static int grid_blocks = 0;
  if (!grid_blocks) {
    int dev = 0, cus = 0, per_cu = 0;
    (void)hipGetDevice(&dev);
    (void)hipDeviceGetAttribute(&cus, hipDeviceAttributeMultiprocessorCount, dev);
    (void)hipOccupancyMaxActiveBlocksPerMultiprocessor(&per_cu, mega_kernel, 256, 0);
    if (per_cu > 2) per_cu = 2;
    grid_blocks = cus * per_cu;
  }
  (void)hipMemsetAsync(p.bar, 0, (XCD_BAR_WORDS + 64) * 4, stream);
  void* args[] = {&p};
  hipError_t e = hipLaunchCooperativeKernel((void*)mega_kernel, dim3(grid_blocks), dim3(256), args, 0, stream);
  if (e != hipSuccess) fprintf(stderr, "coop launch failed: %s\n", hipGetErrorString(e));
#else
(void)hipMemsetAsync(p.bar, 0, (XCD_BAR_WORDS + 64) * 4, stream);
#define LAUNCH_PH(N) phase_kernel<N><<<512, 256, 0, stream>>>(p)
  LAUNCH_PH(0); LAUNCH_PH(1); LAUNCH_PH(2); LAUNCH_PH(3); LAUNCH_PH(4); LAUNCH_PH(5);
  LAUNCH_PH(6); LAUNCH_PH(7); LAUNCH_PH(8); LAUNCH_PH(9); LAUNCH_PH(10); LAUNCH_PH(11);
#endif
}
```

```cpp
#include <hip/hip_runtime.h>
#include <hip/hip_cooperative_groups.h>
#include <cstdio>
#include <cstdint>
namespace cg = cooperative_groups;

#ifndef FUSED
#define FUSED 1
#endif
#ifndef PROBE_DOUBLE
#define PROBE_DOUBLE 0
#endif
#ifndef PROBE_ROUTER
#define PROBE_ROUTER 0
#endif
#ifndef PROBE_PHASE
#define PROBE_PHASE -1
#endif

#define DI __device__ __forceinline__
typedef unsigned short bf16_t;
typedef short bf16x8 __attribute__((ext_vector_type(8)));
typedef float f32x4 __attribute__((ext_vector_type(4)));

constexpr int Bn = 4, T = 4096, D = 1024, M = Bn * T;
constexpr int NINP = 6528;
constexpr int NEXP = 32, DFF = 512;
constexpr int HROWS = 36864;
constexpr float ALPHA = 1.189207115002721f;

struct Params {
  const float *x, *w_in, *cmp_pos_k, *cmp_k_w1, *cmp_k_b1, *cmp_k_w2, *cmp_k_b2;
  const float *cmp_pos_v, *cmp_v_w1, *cmp_v_b1, *cmp_v_w2, *cmp_v_b2;
  const float *gn_g, *gn_b, *w_up_attn, *w_up_ret, *w_out, *ln1_g, *ln1_b;
  const float *rg_w, *rg_b, *ri_w, *ri_b, *e_wg, *e_wu, *e_wd, *ln2_g, *ln2_b;
  float* out;
  bf16_t *Qn, *CK, *CV, *SK, *SVt, *WK, *WVt; float* NG;
  bf16_t *RQ, *RK, *RKzT, *RVt, *RG, *MG;
  bf16_t *WinT  , *oattn, *oret;
  bf16_t *WaT, *WrT, *WoT, *W1kT, *W1vT;
  float *ropeN, *ropeR, *posb, *posp;
  bf16_t *H1, *kcmp, *vcmpT;
  unsigned long long* selmask;
  int* cnt; int* lists; float* routew;
  bf16_t *merged, *x1b, *EgT  , *EdT  , *Hh, *part;
  bf16_t *xb, *Rt, *Ut;
  unsigned* bar;
  unsigned* qctr;
};

DI float bf2f(bf16_t v) { return __uint_as_float(((unsigned)v) << 16); }
typedef __bf16 bf16x2_t __attribute__((ext_vector_type(2)));
DI bf16_t f2bf(float f) { return __builtin_bit_cast(bf16_t, (__bf16)f); }
DI unsigned pack2(float a, float b) { bf16x2_t v = {(__bf16)a, (__bf16)b}; return __builtin_bit_cast(unsigned, v); }
typedef float f32x16 __attribute__((ext_vector_type(16)));
#define MFMA32(a, b, c) __builtin_amdgcn_mfma_f32_32x32x16_bf16((a), (b), (c), 0, 0, 0)
DI float lo2f(unsigned u) { return __uint_as_float(u << 16); }
DI float hi2f(unsigned u) { return __uint_as_float(u & 0xffff0000u); }
DI float wsum(float v) {
  v += __int_as_float(__builtin_amdgcn_update_dpp(0, __float_as_int(v), 0x111, 0xf, 0xf, false));
  v += __int_as_float(__builtin_amdgcn_update_dpp(0, __float_as_int(v), 0x112, 0xf, 0xf, false));
  v += __int_as_float(__builtin_amdgcn_update_dpp(0, __float_as_int(v), 0x114, 0xf, 0xf, false));
  v += __int_as_float(__builtin_amdgcn_update_dpp(0, __float_as_int(v), 0x118, 0xf, 0xf, false));
  v += __int_as_float(__builtin_amdgcn_update_dpp(0, __float_as_int(v), 0x142, 0xa, 0xf, false));
  v += __int_as_float(__builtin_amdgcn_update_dpp(0, __float_as_int(v), 0x143, 0xc, 0xf, false));
  return __int_as_float(__builtin_amdgcn_readlane(__float_as_int(v), 63));
}
DI float wmax(float v) { for (int o = 32; o > 0; o >>= 1) v = fmaxf(v, __shfl_xor(v, o)); return v; }
DI float sigmoidf_(float x) { return 1.f / (1.f + __expf(-x)); }
#define WSYNC() asm volatile("s_waitcnt lgkmcnt(0)" ::: "memory")
DI size_t frag_off(int row, int k, int K) { return ((size_t)(((row >> 5) * (K >> 4) + (k >> 4)) * 2 + ((k >> 3) & 1))) * 256 + (row & 31) * 8 + (k & 7); }
DI float xh_max(float x) { const auto r_ = __builtin_amdgcn_permlane32_swap(__float_as_uint(x), __float_as_uint(x), false, false); return fmaxf(__uint_as_float(r_[0]), __uint_as_float(r_[1])); }
DI float xh_sum(float x) { const auto r_ = __builtin_amdgcn_permlane32_swap(__float_as_uint(x), __float_as_uint(x), false, false); return __uint_as_float(r_[0]) + __uint_as_float(r_[1]); }
DI int perm23(int r) { return (r & 0x13) | ((r & 4) << 1) | ((r & 8) >> 1); }
DI int opq(int x) { asm volatile("" : "+v"(x)); return x; }


#define XB_TMO      128
#define XB_XCNT(j)  (256  + 64 * (j))
#define XB_XSUB(j)  (1280 + 64 * (j))
#define XB_XGEN(j)  (2304 + 64 * (j))
#define XB_TOP      3328
#define XB_TOPGEN   3392
#define XCD_BAR_WORDS 3456
#define XB_SPIN_CAP (1u << 20)
#define LAS __attribute__((address_space(3)))
DI unsigned xb_ld(unsigned* p) { return __hip_atomic_load(p, __ATOMIC_RELAXED, __HIP_MEMORY_SCOPE_AGENT); }
DI unsigned xb_add(unsigned* p, unsigned v) { return __hip_atomic_fetch_add(p, v, __ATOMIC_RELAXED, __HIP_MEMORY_SCOPE_AGENT); }
DI unsigned xb_xcc_id() { return (unsigned)__builtin_amdgcn_s_getreg((3 << 11) | 20) & 0xFu; }
#define XB_SPIN(cond, bar) do { unsigned _sp = 0; while (cond) { __builtin_amdgcn_s_sleep(1); \
    if ((++_sp & 255u) == 0u) { if (xb_ld(&(bar)[XB_TMO])) break; if (_sp > XB_SPIN_CAP) { atomicAdd(&(bar)[XB_TMO], 1u); break; } } } } while (0)
struct XcdBarrier { unsigned* bar; unsigned x; volatile LAS unsigned* st; };
DI XcdBarrier xcd_barrier_post(unsigned* bar, volatile LAS unsigned* st) {
  XcdBarrier b; b.bar = bar; b.x = xb_xcc_id(); b.st = st;
  if (threadIdx.x == 0) (void)xb_add(&bar[XB_XCNT(b.x)], 1u);
  return b;
}
DI void xcd_barrier_complete(unsigned* bar, unsigned x, unsigned& nloc, unsigned& nx) {
  const unsigned G = gridDim.x * gridDim.y * gridDim.z;
  unsigned sum, cnt, mine, sp = 0u;
  for (;;) {
    sum = 0u; cnt = 0u; mine = 0u;
#pragma unroll
    for (unsigned j = 0; j < 16; ++j) { const unsigned c = xb_ld(&bar[XB_XCNT(j)]); sum += c; cnt += (c > 0u) ? 1u : 0u; mine = (j == x) ? c : mine; }
    if (sum == G) break;
    __builtin_amdgcn_s_sleep(1);
    if ((++sp & 255u) == 0u) { if (xb_ld(&bar[XB_TMO])) break; if (sp > XB_SPIN_CAP) { atomicAdd(&bar[XB_TMO], 1u); break; } }
  }
  nloc = mine > 0u ? mine : 1u; nx = cnt > 0u ? cnt : 1u;
}
DI void xcd_barrier(const XcdBarrier& b) {
  asm volatile("s_waitcnt vmcnt(0)" ::: "memory");
  __syncthreads();
  if (threadIdx.x == 0) {
    unsigned* bar = b.bar;
    __builtin_amdgcn_s_waitcnt(0);
    unsigned nloc = b.st[0], nx = b.st[1];
    if (nloc == 0u) { xcd_barrier_complete(bar, b.x, nloc, nx); b.st[0] = nloc; b.st[1] = nx; }
    const unsigned old = xb_add(&bar[XB_XSUB(b.x)], 1u);
    const unsigned gen = old / nloc;
    if (old + 1u == (gen + 1u) * nloc) {
      __builtin_amdgcn_fence(__ATOMIC_RELEASE, "agent");
      asm volatile("s_waitcnt vmcnt(0)" ::: "memory");
      const unsigned og = xb_add(&bar[XB_TOP], 1u);
      const unsigned tg = og / nx;
      if (og + 1u == (tg + 1u) * nx) xb_add(&bar[XB_TOPGEN], 1u);
      else XB_SPIN(xb_ld(&bar[XB_TOPGEN]) == tg, bar);
      __builtin_amdgcn_fence(__ATOMIC_ACQUIRE, "agent");
      xb_add(&bar[XB_XGEN(b.x)], 1u);
      asm volatile("s_waitcnt vmcnt(0)" ::: "memory");
    } else {
      XB_SPIN(xb_ld(&bar[XB_XGEN(b.x)]) == gen, bar);
      __builtin_amdgcn_fence(__ATOMIC_ACQUIRE, "agent");
      asm volatile("s_waitcnt vmcnt(0)" ::: "memory");
    }
  }
  __syncthreads();
}

DI void glds16_asm(const void* gsrc, unsigned lds_dst) {
  unsigned keep;
  asm volatile("s_mov_b32 %0, m0\n\ts_mov_b32 m0, %2\n\ts_nop 0\n\tglobal_load_lds_dwordx4 %1, off\n\ts_mov_b32 m0, %0" : "=&s"(keep) : "v"(gsrc), "s"(lds_dst) : "memory");
}
template <bool SWAP, class AR, class BR>
DI void gemm128(f32x4 (&acc)[4][4], AR arow, BR brow, int K, char* smem) {
  const int tid = opq(threadIdx.x), lane = tid & 63, wave = tid >> 6, wr = wave >> 1, wc = wave & 1;
  const int prow = lane >> 3, pch = ((lane & 7) ^ prow) << 3;
  const bf16_t* ap[4]; const bf16_t* bp[4];
#pragma unroll
  for (int i = 0; i < 4; i++) { ap[i] = arow((wave * 4 + i) * 8 + prow) + pch; bp[i] = brow((wave * 4 + i) * 8 + prow) + pch; }
  const unsigned ldsb = (unsigned)(size_t)(LAS char*)smem;
  const unsigned lpiece = __builtin_amdgcn_readfirstlane(wave * 4096);
  char* As = smem; char* Bs = smem + 32768;
  const int nk = K >> 6;
  const int fr = lane & 15, fq = lane >> 4;
  const int aoff0 = (wr * 64 + fr) * 128, boff0 = (wc * 64 + fr) * 128;
  auto gload = [&](int t, int buf) {
#pragma unroll
    for (int i = 0; i < 4; i++) {
      glds16_asm(ap[i] + t * 64, ldsb + buf * 16384 + lpiece + i * 1024);
      glds16_asm(bp[i] + t * 64, ldsb + 32768 + buf * 16384 + lpiece + i * 1024);
    }
  };
  auto gcomp = [&](int buf) {
    const char* Ac = As + buf * 16384; const char* Bc = Bs + buf * 16384;
#pragma unroll
    for (int ks = 0; ks < 2; ks++) {
      const int chs = ((ks * 4 + fq) ^ (fr & 7)) << 4;
      bf16x8 a[4], b[4];
#pragma unroll
      for (int mt = 0; mt < 4; mt++) a[mt] = *(const bf16x8*)(Ac + aoff0 + mt * 2048 + chs);
#pragma unroll
      for (int nt = 0; nt < 4; nt++) b[nt] = *(const bf16x8*)(Bc + boff0 + nt * 2048 + chs);
      __builtin_amdgcn_s_setprio(1);
#pragma unroll
      for (int mt = 0; mt < 4; mt++)
#pragma unroll
        for (int nt = 0; nt < 4; nt++)
          acc[mt][nt] = SWAP ? __builtin_amdgcn_mfma_f32_16x16x32_bf16(b[nt], a[mt], acc[mt][nt], 0, 0, 0)
                             : __builtin_amdgcn_mfma_f32_16x16x32_bf16(a[mt], b[nt], acc[mt][nt], 0, 0, 0);
      __builtin_amdgcn_s_setprio(0);
    }
  };
  asm volatile("s_waitcnt vmcnt(0)" ::: "memory");
  gload(0, 0);
  asm volatile("s_waitcnt vmcnt(0)" ::: "memory");
  __builtin_amdgcn_s_barrier();
#pragma unroll 1
  for (int kt = 0; kt < nk; kt++) {
    const int cur = kt & 1;
    if (kt + 1 < nk) gload(kt + 1, cur ^ 1);
    gcomp(cur);
    asm volatile("s_waitcnt vmcnt(0)" ::: "memory");
    __builtin_amdgcn_s_barrier();
  }
}
template <bool SWAP, class AR, class BC>
DI void gemm128f(f32x4 (&acc)[4][4], AR arow, BC bcol, int ldb, int K, char* smem) {
  const int tid = opq(threadIdx.x), lane = tid & 63, wave = tid >> 6, wr = wave >> 1, wc = wave & 1;
  const int srow = tid >> 3, sch = tid & 7;
  const int bn = tid & 127, bh = tid >> 7;
  const bf16_t* ap[4];
#pragma unroll
  for (int i = 0; i < 4; i++) ap[i] = arow(srow + 32 * i) + sch * 8;
  const float* bq = bcol(bn) + (size_t)(bh * 32) * ldb;
  const int woff = srow * 128 + ((sch ^ (srow & 7)) << 4);
  char* As = smem; char* Bs = smem + 32768;
  uint4 ra[4]; float rb[4][8];
  auto bload = [&](int kt) {
    const float* q = bq + (size_t)kt * 64 * ldb;
#pragma unroll
    for (int i = 0; i < 4; i++)
#pragma unroll
      for (int j = 0; j < 8; j++) rb[i][j] = q[(size_t)(i * 8 + j) * ldb];
  };
  auto bwrite = [&](char* Bd) {
#pragma unroll
    for (int i = 0; i < 4; i++) {
      uint4 u; u.x = pack2(rb[i][0], rb[i][1]); u.y = pack2(rb[i][2], rb[i][3]); u.z = pack2(rb[i][4], rb[i][5]); u.w = pack2(rb[i][6], rb[i][7]);
      *(uint4*)(Bd + bn * 128 + ((((bh * 4 + i)) ^ (bn & 7)) << 4)) = u;
    }
  };
#pragma unroll
  for (int i = 0; i < 4; i++) ra[i] = *(const uint4*)(ap[i]);
  bload(0);
#pragma unroll
  for (int i = 0; i < 4; i++) *(uint4*)(As + woff + i * 4096) = ra[i];
  bwrite(Bs);
  __syncthreads();
  const int nk = K >> 6;
  const int fr = lane & 15, fq = lane >> 4;
  const int aoff0 = (wr * 64 + fr) * 128, boff0 = (wc * 64 + fr) * 128;
  for (int kt = 0; kt < nk; kt++) {
    const int cur = kt & 1;
    if (kt + 1 < nk) {
#pragma unroll
      for (int i = 0; i < 4; i++) ra[i] = *(const uint4*)(ap[i] + (kt + 1) * 64);
      bload(kt + 1);
    }
    const char* Ac = As + cur * 16384; const char* Bc = Bs + cur * 16384;
#pragma unroll
    for (int ks = 0; ks < 2; ks++) {
      const int chs = ((ks * 4 + fq) ^ (fr & 7)) << 4;
      bf16x8 a[4], b[4];
#pragma unroll
      for (int mt = 0; mt < 4; mt++) a[mt] = *(const bf16x8*)(Ac + aoff0 + mt * 2048 + chs);
#pragma unroll
      for (int nt = 0; nt < 4; nt++) b[nt] = *(const bf16x8*)(Bc + boff0 + nt * 2048 + chs);
#pragma unroll
      for (int mt = 0; mt < 4; mt++)
#pragma unroll
        for (int nt = 0; nt < 4; nt++)
          acc[mt][nt] = SWAP ? __builtin_amdgcn_mfma_f32_16x16x32_bf16(b[nt], a[mt], acc[mt][nt], 0, 0, 0)
                             : __builtin_amdgcn_mfma_f32_16x16x32_bf16(a[mt], b[nt], acc[mt][nt], 0, 0, 0);
    }
    if (kt + 1 < nk) {
      char* An = As + (cur ^ 1) * 16384;
#pragma unroll
      for (int i = 0; i < 4; i++) *(uint4*)(An + woff + i * 4096) = ra[i];
      bwrite(Bs + (cur ^ 1) * 16384);
    }
    __syncthreads();
  }
}
DI void zero_acc(f32x4 (&acc)[4][4]) {
#pragma unroll
  for (int i = 0; i < 4; i++)
#pragma unroll
    for (int j = 0; j < 4; j++) acc[i][j] = (f32x4){0.f, 0.f, 0.f, 0.f};
}
template <bool SWAP, class F>
DI void epilogue(const f32x4 (&acc)[4][4], F f) {
  const int lane = opq(threadIdx.x) & 63, wave = opq(threadIdx.x) >> 6, wr = wave >> 1, wc = wave & 1, fr = lane & 15, fq = lane >> 4;
#pragma unroll
  for (int mt = 0; mt < 4; mt++)
#pragma unroll
    for (int nt = 0; nt < 4; nt++) {
      if (SWAP) f(wr * 64 + mt * 16 + fr, wc * 64 + nt * 16 + fq * 4, acc[mt][nt]);
      else f(wr * 64 + mt * 16 + fq * 4, wc * 64 + nt * 16 + fr, acc[mt][nt]);
    }
}

template <class CP>
DI void tcvt_tile(CP colptr, int ldsrc, bf16_t* dst, int K, int kt, int jt, float* tile) {
  const int tx = opq(threadIdx.x) & 63, ty = opq(threadIdx.x) >> 6;
  const float* sp = colptr(jt * 64 + tx);
  for (int i = ty; i < 64; i += 4) tile[i * 65 + tx] = sp ? sp[(size_t)(kt * 64 + i) * ldsrc] : 0.f;
  __syncthreads();
  for (int i = ty * 2 + (tx >> 5); i < 64; i += 8) {
    const int kk = (tx & 31) * 2;
    *(unsigned*)(dst + (size_t)(jt * 64 + i) * K + kt * 64 + kk) = pack2(tile[kk * 65 + i], tile[(kk + 1) * 65 + i]);
  }
  __syncthreads();
}
template <class CP>
DI void tcvt_all(CP colptr, int ldsrc, bf16_t* dst, int K, int N, float* tile, int bid, int nb) {
  const int nkt = K / 64, njt = N / 64;
  for (int t = bid; t < nkt * njt; t += nb) tcvt_tile(colptr, ldsrc, dst, K, t / njt, t % njt, tile);
}

template <class CP>
DI void tcvt_tile128(CP colptr, int ldsrc, bf16_t* dst, int K, int kt, int jt, float* tile  ) {
  const int tid = opq(threadIdx.x), tx = tid & 127, ty = tid >> 7;
  const float* sp0 = colptr(jt * 128 + tx);
  const float* sp = sp0 + (size_t)(kt * 64 + ty) * ldsrc;
  float v[32];
  if (sp0) {
#pragma unroll
    for (int i = 0; i < 32; i++) v[i] = sp[(size_t)(2 * i) * ldsrc];
  } else {
#pragma unroll
    for (int i = 0; i < 32; i++) v[i] = 0.f;
  }
#pragma unroll
  for (int i = 0; i < 32; i++) tile[(ty + 2 * i) * 129 + tx] = v[i];
  __syncthreads();
  const int pp = (tid & 31) * 2, j0 = tid >> 5;
#pragma unroll
  for (int i = 0; i < 16; i++) {
    const int j = j0 + 8 * i;
    *(unsigned*)(dst + (size_t)(jt * 128 + j) * K + kt * 64 + pp) = pack2(tile[pp * 129 + j], tile[(pp + 1) * 129 + j]);
  }
  __syncthreads();
}
DI int perm_half(int p, int d) { return (p & 1) ? (d / 2 + (p >> 1)) : (p >> 1); }
DI int inproj_col(int j) {
  if (j < 512) return (j & ~63) + perm_half(j & 63, 64);
  if (j < 1280) { const int grp = (j - 512) >> 7;
    if (grp == 2 || grp == 4) return (j & ~63) + perm_half(j & 63, 64);
    return j; }
  if (j < 1792) { const int q = j - 1280; return 1304 + (q & ~127) + perm_half(q & 127, 128); }
  if (j < 2304) { const int q = j - 1792; return 1816 + (q & ~127) + perm_half(q & 127, 128); }
  if (j < 3328) return 2328 + (j - 2304);
  if (j < 4352) return 3352 + (j - 3328);
  if (j < 6400) return 4376 + (j - 4352);
  const int q = j - 6400; return q < 24 ? 1280 + q : -1;
}

DI void phase0(const Params& p, char* smem) {
  const int bid = blockIdx.x, nb = gridDim.x, tid = opq(threadIdx.x);
  const size_t gtid = (size_t)bid * 256 + tid, gsz = (size_t)nb * 256;
  for (size_t i = gtid; i < (size_t)M * D / 4; i += gsz) {
    const float4 v = ((const float4*)p.x)[i];
    uint2 o; o.x = pack2(v.x, v.y); o.y = pack2(v.z, v.w);
    ((uint2*)p.xb)[i] = o;
  }
  float* tile = (float*)smem;
  for (int tt = bid; tt < 1264; tt += nb) {
    if (tt < 816) { const float* w = p.w_in; tcvt_tile128([=](int j) -> const float* { const int c = inproj_col(j); return c >= 0 ? w + c : nullptr; }, 6424, p.WinT, 1024, tt / 51, tt % 51, tile); }
    else if (tt < 880) { const int q = tt - 816; const float* w = p.w_up_attn; tcvt_tile128([=](int j) -> const float* { return w + j; }, 1024, p.WaT, 512, q >> 3, q & 7, tile); }
    else if (tt < 1008) { const int q = tt - 880; const float* w = p.w_up_ret; tcvt_tile128([=](int j) -> const float* { return w + j; }, 1024, p.WrT, 1024, q >> 3, q & 7, tile); }
    else if (tt < 1136) { const int q = tt - 1008; const float* w = p.w_out; tcvt_tile128([=](int j) -> const float* { return w + j; }, 1024, p.WoT, 1024, q >> 3, q & 7, tile); }
    else if (tt < 1200) { const int q = tt - 1136; const float* w = p.cmp_k_w1; tcvt_tile128([=](int j) -> const float* { return w + j; }, 256, p.W1kT, 2048, q >> 1, q & 1, tile); }
    else { const int q = tt - 1200; const float* w = p.cmp_v_w1; tcvt_tile128([=](int j) -> const float* { return w + j; }, 256, p.W1vT, 2048, q >> 1, q & 1, tile); }
  }
  for (size_t i = gtid; i < (size_t)T * 96; i += gsz) {
    const int t = (int)(i / 96), r = (int)(i % 96);
    float invf; float* dst;
    if (r < 32) { invf = (float)exp2(-(double)r * (2.0 / 64.0) * 13.287712379549449); dst = p.ropeN + ((size_t)t * 32 + r) * 2; }
    else { const int q = r - 32; invf = (float)exp2(-(double)q * (2.0 / 128.0) * 13.287712379549449); dst = p.ropeR + ((size_t)t * 64 + q) * 2; }
    const double ang = (double)((float)t * invf);
    const double kk = rint(ang * 0.15915494309189535);
    const float red = (float)(ang - kk * 6.283185307179586);
    dst[0] = cosf(red); dst[1] = sinf(red);
  }
  for (size_t i = gtid; i < 32 * 512; i += gsz) {
    const int qp = (int)(i >> 9), kv = (int)((i >> 8) & 1), j = (int)(i & 255);
    const float* pos = kv ? p.cmp_pos_v : p.cmp_pos_k; const float* w1 = kv ? p.cmp_v_w1 : p.cmp_k_w1;
    float s0 = 0.f;
#pragma unroll 8
    for (int q = qp * 64; q < qp * 64 + 64; q++) s0 += pos[q] * w1[(size_t)q * 256 + j];
    p.posp[i] = s0;
  }
  if (gtid < 512) p.cnt[gtid] = 0;
}

template <bool TRANS, class PROC, class DST>
DI void epilogue_lds(const f32x4 (&acc)[4][4], PROC proc, DST dst, char* smem) {
  const int tid = opq(threadIdx.x), lane = tid & 63, wave = tid >> 6, wr = wave >> 1, wc = wave & 1, fr = lane & 15, fq = lane >> 4;
#pragma unroll
  for (int mt = 0; mt < 4; mt++)
#pragma unroll
    for (int nt = 0; nt < 4; nt++) {
      const int r = wr * 64 + mt * 16 + (TRANS ? fq * 4 : fr), c = wc * 64 + nt * 16 + (TRANS ? fr : fq * 4);
      const uint2 o = proc(r, c, acc[mt][nt]);
      *(uint2*)(smem + (TRANS ? c * 272 + r * 2 : r * 272 + c * 2)) = o;
    }
  __syncthreads();
#pragma unroll
  for (int k = 0; k < 8; k++) {
    const int id = tid + 256 * k, i = id >> 4, j8 = (id & 15) * 8;
    *(uint4*)dst(i, j8) = *(const uint4*)(smem + i * 272 + j8 * 2);
  }
  __syncthreads();
}
DI void inproj_tile(const Params& p, int mt_, int nt_, char* smem) {
  const int m0 = mt_ * 128, b = m0 >> 12, t0 = m0 & 4095;
  const bf16_t* A = p.xb + (size_t)m0 * D; const bf16_t* Bt = p.WinT + (size_t)nt_ * 128 * D;
  f32x4 acc[4][4]; zero_acc(acc);
  auto ar = [=](int r) { return A + (size_t)r * D; };
  auto br = [=](int r) { return Bt + (size_t)r * D; };
  auto plain = [](int, int, f32x4 v) { uint2 o; o.x = pack2(v[0], v[1]); o.y = pack2(v[2], v[3]); return o; };
  const bool transposed = (nt_ == 7 || nt_ == 9 || (nt_ >= 18 && nt_ < 26));
  if (transposed) {
    gemm128<false>(acc, ar, br, D, smem);
    if (nt_ < 18) { bf16_t* base = ((nt_ == 7) ? p.SVt : p.WVt) + (size_t)b * 2 * 64 * T + t0;
      epilogue_lds<true>(acc, plain, [=](int c, int r8) { return base + (size_t)c * T + r8; }, smem); }
    else { const int h = (nt_ - 18) >> 1, e0 = ((nt_ - 18) & 1) * 128; bf16_t* base = p.RVt + (size_t)(b * 4 + h) * 256 * T;
      epilogue_lds<true>(acc, plain, [=](int c, int r8) { return base + frag_off(e0 + c, t0 + r8, T); }, smem); }
    return;
  }
  gemm128<true>(acc, ar, br, D, smem);
  if (nt_ < 4 || nt_ == 6 || nt_ == 8) {
    const float sc = nt_ < 4 ? 0.18033688011112042f : 1.f;
    bf16_t* base = (nt_ < 4) ? p.Qn + ((size_t)(b * 8 + nt_ * 2) * T + t0) * 64 : ((nt_ == 6) ? p.SK : p.WK) + ((size_t)(b * 2) * T + t0) * 64;
    epilogue_lds<false>(acc, [=](int r, int c, f32x4 v) {
      const float4 cs = *(const float4*)(p.ropeN + ((size_t)(t0 + r) * 32 + ((c & 63) >> 1)) * 2);
      uint2 o; o.x = pack2((v[0] * cs.x - v[1] * cs.y) * sc, (v[0] * cs.y + v[1] * cs.x) * sc); o.y = pack2((v[2] * cs.z - v[3] * cs.w) * sc, (v[2] * cs.w + v[3] * cs.z) * sc);
      return o; }, [=](int r, int c8) { return base + ((size_t)(c8 >> 6) * T + r) * 64 + (c8 & 63); }, smem);
  } else if (nt_ == 4 || nt_ == 5) {
    bf16_t* base = (nt_ == 4 ? p.CK : p.CV) + ((size_t)(b * 2) * T + t0) * 64;
    epilogue_lds<false>(acc, plain, [=](int r, int c8) { return base + ((size_t)(c8 >> 6) * T + r) * 64 + (c8 & 63); }, smem);
  } else if (nt_ >= 10 && nt_ < 18) {
    const bool isk = nt_ >= 14; const int h = (nt_ - 10) & 3;
    const float sc = isk ? 0.08838834764831845f : 1.f;
    bf16_t* base = (isk ? p.RK : p.RQ) + (size_t)(b * 4 + h) * T * 128;
    auto roped = [=](int r, int c, f32x4 v, float z) {
      const float4 cs = *(const float4*)(p.ropeR + ((size_t)(t0 + r) * 64 + (c >> 1)) * 2);
      const float s2 = sc * z;
      uint2 o; o.x = pack2((v[0] * cs.x - v[1] * cs.y) * s2, (v[0] * cs.y + v[1] * cs.x) * s2); o.y = pack2((v[2] * cs.z - v[3] * cs.w) * s2, (v[2] * cs.w + v[3] * cs.z) * s2);
      return o; };
    epilogue_lds<false>(acc, [=](int r, int c, f32x4 v) { return roped(r, c, v, 1.f); }, [=](int r, int c8) { return base + frag_off(t0 + r, c8, 128); }, smem);
    if (isk) {
      const float lg = log2f(1.f - exp2f(-5.f - (float)h));
      bf16_t* bz = p.RKzT + (size_t)(b * 4 + h) * 128 * T;
      const int tid = opq(threadIdx.x), lane = tid & 63, wave = tid >> 6, wr = wave >> 1, wc = wave & 1, fr = lane & 15, fq = lane >> 4;
#pragma unroll
      for (int mt = 0; mt < 4; mt++)
#pragma unroll
        for (int nt = 0; nt < 4; nt++) {
          const int r = wr * 64 + mt * 16 + fr, c = wc * 64 + nt * 16 + fq * 4;
          const uint2 o = roped(r, c, acc[mt][nt], exp2f((float)(127 - ((t0 + r) & 127)) * lg));
          bf16_t* q = (bf16_t*)(smem + c * 272 + r * 2);
          q[0] = (bf16_t)(o.x & 0xffffu); q[136] = (bf16_t)(o.x >> 16); q[272] = (bf16_t)(o.y & 0xffffu); q[408] = (bf16_t)(o.y >> 16);
        }
      __syncthreads();
#pragma unroll
      for (int k = 0; k < 8; k++) {
        const int id = tid + 256 * k, i = id >> 4, j8 = (id & 15) * 8;
        *(uint4*)(bz + frag_off(i, t0 + j8, T)) = *(const uint4*)(smem + i * 272 + j8 * 2);
      }
      __syncthreads();
    }
  } else if (nt_ >= 26 && nt_ < 34) {
    bf16_t* base = p.RG + (size_t)m0 * 1024 + (nt_ - 26) * 128;
    epilogue_lds<false>(acc, plain, [=](int r, int c8) { return base + (size_t)r * 1024 + c8; }, smem);
  } else if (nt_ >= 34 && nt_ < 50) {
    bf16_t* base = p.MG + (size_t)m0 * 2048 + (nt_ - 34) * 128;
    epilogue_lds<false>(acc, plain, [=](int r, int c8) { return base + (size_t)r * 2048 + c8; }, smem);
  } else {
    epilogue<true>(acc, [&](int r, int c, f32x4 v) {
      if (c < 24) { float4 o; o.x = sigmoidf_(v[0]); o.y = sigmoidf_(v[1]); o.z = sigmoidf_(v[2]); o.w = sigmoidf_(v[3]);
        *(float4*)(p.NG + (size_t)(m0 + r) * 24 + c) = o; }
    });
  }
}
DI void phase1(const Params& p, char* smem) {
  if (blockIdx.x < 2) {
    const int i = blockIdx.x * 256 + opq(threadIdx.x), kv = i >> 8, j = i & 255;
    float s0 = (kv ? p.cmp_v_b1 : p.cmp_k_b1)[j];
    for (int qp = 0; qp < 32; qp++) s0 += p.posp[qp * 512 + i];
    p.posb[i] = s0;
  }
  const int xcd = blockIdx.x & 7, lb = blockIdx.x >> 3, nlb = gridDim.x >> 3;
  for (int li = lb; li < 16 * 51; li += nlb) {
    const int mi = li & 7, rest = li >> 3, nt_ = rest % 51, half = rest / 51;
    inproj_tile(p, xcd * 16 + half * 8 + mi, nt_, smem);
  }
}


DI void attn_unit(const Params& p, int unit, char* smem) {
  const int tid = opq(threadIdx.x), lane = tid & 63, w = tid >> 6, r = lane & 31, h2 = lane >> 5;
  const int bg = unit >> 6, jq = unit & 63, b = bg >> 1, g = bg & 1, hh = g * 4 + w, t0 = jq * 64;
  bf16x8 qf[2][4];
#pragma unroll
  for (int qt = 0; qt < 2; qt++)
#pragma unroll
    for (int ks = 0; ks < 4; ks++)
      qf[qt][ks] = *(const bf16x8*)(p.Qn + ((size_t)(b * 8 + hh) * T + t0 + qt * 32 + r) * 64 + ks * 16 + h2 * 8);
  unsigned long long* sell = (unsigned long long*)(smem + 49152) + tid * 2;
#pragma unroll
  for (int qt = 0; qt < 2; qt++) sell[qt] = p.selmask[(size_t)bg * T + t0 + qt * 32 + r];
  const int wlo = jq > 8 ? jq - 8 : 0, nwin = jq - wlo + 1, nsteps = nwin + jq + 1;
  char* Kl = smem; char* Vl = smem + 24576;
  const unsigned ldsK = (unsigned)(size_t)(LAS char*)smem;
  const int grow = lane >> 3;
  auto gload = [&](int i, int buf) {
    const int br = i < nwin ? 2 : 1, j = i < nwin ? wlo + i : i - nwin;
    const bf16_t* Kp = (br == 1 ? p.SK : p.WK) + ((size_t)bg * T + j * 64) * 64;
    const bf16_t* Vp = (br == 1 ? p.SVt : p.WVt) + (size_t)bg * 64 * T + j * 64;
#pragma unroll
    for (int pc = 0; pc < 2; pc++) {
      const int row = (w * 2 + pc) * 8 + grow;
      const int gch = (lane & 7) ^ ((row >> 1) & 7);
      const unsigned loff = __builtin_amdgcn_readfirstlane(buf * 8192 + (w * 2 + pc) * 1024);
      glds16_asm(Kp + row * 64 + gch * 8, ldsK + loff);
      glds16_asm(Vp + (size_t)row * T + gch * 8, ldsK + 24576 + loff);
    }
  };
  const int pr = perm23(r);
  float lrow[2]; unsigned mbias[2]; f32x16 O[2][2];
  float* mrow = (float*)(smem + 53248) + tid * 2;
  uint4 ao4 = {h2 == 0 ? 0x3F803F80u : 0u, 0u, 0u, 0u};
  const bf16x8 aones = __builtin_bit_cast(bf16x8, ao4);
  uint4 bb4 = {0u, 0u, 0u, 0u};
  auto reset = [&]() {
#pragma unroll
    for (int qt = 0; qt < 2; qt++) { mrow[qt] = -INFINITY; lrow[qt] = 0.f; mbias[qt] = 0u;
#pragma unroll
      for (int dt = 0; dt < 2; dt++)
#pragma unroll
        for (int i = 0; i < 16; i++) O[dt][qt][i] = 0.f; }
  };
  auto flush = [&](int br) {
#pragma unroll
    for (int qt = 0; qt < 2; qt++) {
      const int m = opq(b * T + t0 + qt * 32 + r);
      const float gate = p.NG[(size_t)m * 24 + hh * 3 + br];
      const float sc = lrow[qt] > 0.f ? gate / lrow[qt] : 0.f;
#pragma unroll
      for (int dt = 0; dt < 2; dt++)
#pragma unroll
        for (int q4 = 0; q4 < 4; q4++) {
          bf16_t* dst = p.oattn + (size_t)m * 512 + hh * 64 + dt * 32 + q4 * 8 + h2 * 4;
          const uint2 old = *(const uint2*)dst;
          uint2 o; o.x = pack2(lo2f(old.x) + sc * O[dt][qt][q4 * 4], hi2f(old.x) + sc * O[dt][qt][q4 * 4 + 1]);
          o.y = pack2(lo2f(old.y) + sc * O[dt][qt][q4 * 4 + 2], hi2f(old.y) + sc * O[dt][qt][q4 * 4 + 3]);
          *(uint2*)dst = o;
        }
    }
  };
  reset();
#pragma unroll
  for (int qt = 0; qt < 2; qt++)
#pragma unroll
    for (int ks = 0; ks < 4; ks++) asm volatile("" :: "v"(qf[qt][ks]));
  gload(0, 0);
  if (nsteps > 1) { gload(1, 1); asm volatile("s_waitcnt vmcnt(4)" ::: "memory"); } else asm volatile("s_waitcnt vmcnt(0)" ::: "memory");
  __builtin_amdgcn_s_barrier();
  int cur = 0;
  const f32x16 zero16 = {0.f, 0.f, 0.f, 0.f, 0.f, 0.f, 0.f, 0.f, 0.f, 0.f, 0.f, 0.f, 0.f, 0.f, 0.f, 0.f};
#define QK_TILE(S, QT) { \
    _Pragma("unroll") for (int kt2 = 0; kt2 < 2; kt2++) { \
      S[kt2] = MFMA32(aones, bbias, zero16); \
      _Pragma("unroll") for (int ks = 0; ks < 4; ks++) { \
        const bf16x8 a_ = *(const bf16x8*)(Kc + (kt2 * 32 + pr) * 128 + (((ks * 2 + h2) ^ ((pr >> 1) & 7)) << 4)); \
        S[kt2] = MFMA32(a_, qf[QT][ks], S[kt2]); } } \
    if (mmode == 2) { \
      const bool selb = (br == 2) || ((sell[QT] >> j) & 1ull); \
      const int khi = t, klo = (br == 2) ? t - 511 : 0; \
      _Pragma("unroll") for (int kt2 = 0; kt2 < 2; kt2++) \
        _Pragma("unroll") for (int ii = 0; ii < 16; ii++) { \
          const int key = j * 64 + kt2 * 32 + (ii & 7) + 16 * (ii >> 3) + 8 * h2; \
          S[kt2][ii] = (selb && key <= khi && key >= klo) ? S[kt2][ii] : -INFINITY; } } }
#define EXP_TILE(S, rs) { rs = 0.f; \
    _Pragma("unroll") for (int kt2 = 0; kt2 < 2; kt2++) \
      _Pragma("unroll") for (int ii = 0; ii < 16; ii++) { const float pv_ = __builtin_amdgcn_exp2f(S[kt2][ii]); S[kt2][ii] = pv_; rs += pv_; } }
#pragma unroll 1
  for (int i = 0; i < nsteps; i++) {
    const int br = i < nwin ? 2 : 1, j = i < nwin ? wlo + i : i - nwin;
    if (i == nwin) { flush(2); reset(); }
    if (i + 2 < nsteps) gload(i + 2, cur == 0 ? 2 : cur - 1);
    const char* Kc = Kl + cur * 8192; const char* Vc = Vl + cur * 8192;
    const int mmode = (br == 2) ? ((j == jq || j + 8 == jq) ? 2 : 0) : (j == jq ? 2 : 1);
#pragma unroll
    for (int qt = 0; qt < 2; qt++) {
      unsigned w0 = mbias[qt];
      if (mmode == 1) w0 = ((sell[qt] >> j) & 1ull) ? w0 : 0x0000FF80u;
      bb4.x = h2 == 0 ? w0 : 0u;
      const bf16x8 bbias = __builtin_bit_cast(bf16x8, bb4);
      const int t = t0 + qt * 32 + r;
      f32x16 S[2];
      QK_TILE(S, qt);
      float rs;
      EXP_TILE(S, rs);
      if (__any(rs > 65536.f)) {
        QK_TILE(S, qt);
        float mx = -INFINITY;
#pragma unroll
        for (int kt2 = 0; kt2 < 2; kt2++)
#pragma unroll
          for (int ii = 0; ii < 16; ii++) mx = fmaxf(mx, S[kt2][ii]);
        mx = xh_max(mx);
        const float msafe0 = (mrow[qt] == -INFINITY) ? 0.f : mrow[qt];
        const float mn = msafe0 + fmaxf(mx, 0.f);
        const float mhi = bf2f(f2bf(mn)), mlo = bf2f(f2bf(mn - mhi)), mq = mhi + mlo;
        const float dl = mq - msafe0;
        const float alpha = __builtin_amdgcn_exp2f(-dl);
        lrow[qt] *= alpha; mrow[qt] = mq; mbias[qt] = pack2(-mhi, -mlo);
#pragma unroll
        for (int dt = 0; dt < 2; dt++)
#pragma unroll
          for (int ii = 0; ii < 16; ii++) O[dt][qt][ii] *= alpha;
#pragma unroll
        for (int kt2 = 0; kt2 < 2; kt2++)
#pragma unroll
          for (int ii = 0; ii < 16; ii++) S[kt2][ii] -= dl;
        EXP_TILE(S, rs);
      }
      lrow[qt] += xh_sum(rs);
#pragma unroll
      for (int kt2 = 0; kt2 < 2; kt2++)
#pragma unroll
        for (int s2 = 0; s2 < 2; s2++) {
          uint4 u;
          u.x = pack2(S[kt2][8 * s2 + 0], S[kt2][8 * s2 + 1]); u.y = pack2(S[kt2][8 * s2 + 2], S[kt2][8 * s2 + 3]);
          u.z = pack2(S[kt2][8 * s2 + 4], S[kt2][8 * s2 + 5]); u.w = pack2(S[kt2][8 * s2 + 6], S[kt2][8 * s2 + 7]);
          const bf16x8 pfr = __builtin_bit_cast(bf16x8, u);
#pragma unroll
          for (int dt = 0; dt < 2; dt++) {
            const int d = dt * 32 + r;
            const bf16x8 vf = *(const bf16x8*)(Vc + d * 128 + (((kt2 * 4 + s2 * 2 + h2) ^ ((d >> 1) & 7)) << 4));
            O[dt][qt] = MFMA32(vf, pfr, O[dt][qt]);
          }
        }
      __builtin_amdgcn_sched_barrier(0);
    }
    if (i + 2 < nsteps) asm volatile("s_waitcnt vmcnt(4)" ::: "memory"); else asm volatile("s_waitcnt vmcnt(0)" ::: "memory");
    __builtin_amdgcn_s_barrier();
    cur = cur == 2 ? 0 : cur + 1;
  }
#undef QK_TILE
#undef EXP_TILE
  flush(1);
  __syncthreads();
}

DI void cmp_unit(const Params& p, int unit, char* smem) {
  const int tid = opq(threadIdx.x), lane = tid & 63, w = tid >> 6, r = lane & 31, h2 = lane >> 5;
  const int bg = unit >> 7, q32 = unit & 127, b = bg >> 1, g = bg & 1, hh = g * 4 + w;
  const int pr = perm23(r);
  const bf16_t* Kg = p.kcmp + (size_t)bg * 256 * 64;
  const bf16_t* Vg = p.vcmpT + (size_t)bg * 64 * 256;
  const int tb = q32 * 32, t = tb + r;
  const int nvalid = t >= 31 ? ((t - 31) >> 4) + 1 : 0;
  const int nvmax = (tb >> 4) + 1;
  const int nkt = (nvmax + 31) >> 5;
  char* Kl = smem; char* Vl = smem + 32768; float* impw = (float*)smem;
  const unsigned ldsb = (unsigned)(size_t)(LAS char*)smem;
  __syncthreads();
  for (int pc = w; pc < 4 * nkt; pc += 4) {
    const int row = pc * 8 + (lane >> 3);
    glds16_asm(Kg + row * 64 + (((lane & 7) ^ ((row >> 1) & 7)) << 3), ldsb + __builtin_amdgcn_readfirstlane(pc * 1024));
  }
#pragma unroll
  for (int i = 0; i < 8; i++) {
    const int pc = w * 8 + i, d = pc * 2 + h2;
    glds16_asm(Vg + d * 256 + (((lane & 31) ^ (d & 15)) << 3), ldsb + 32768 + __builtin_amdgcn_readfirstlane(pc * 1024));
  }
  bf16x8 qf[4];
#pragma unroll
  for (int ks = 0; ks < 4; ks++) qf[ks] = *(const bf16x8*)(p.Qn + ((size_t)(b * 8 + hh) * T + t) * 64 + ks * 16 + h2 * 8);
  asm volatile("s_waitcnt vmcnt(0)" ::: "memory");
  __syncthreads();
  float mx = -1e30f;
#pragma unroll 1
  for (int kt = 0; kt < nkt; kt++) {
    f32x16 S;
#pragma unroll
    for (int i = 0; i < 16; i++) S[i] = 0.f;
    const int row = kt * 32 + pr;
#pragma unroll
    for (int ks = 0; ks < 4; ks++) { const bf16x8 kf = *(const bf16x8*)(Kl + row * 128 + (((ks * 2 + h2) ^ ((row >> 1) & 7)) << 4)); S = MFMA32(kf, qf[ks], S); }
#pragma unroll
    for (int i = 0; i < 16; i++) { const int key = kt * 32 + (i & 7) + 16 * (i >> 3) + 8 * h2; mx = fmaxf(mx, key < nvalid ? S[i] : -1e30f); }
  }
  mx = fmaxf(mx, __shfl_xor(mx, 32));
  float sum = 0.f;
  float impo[32];
#pragma unroll
  for (int i = 0; i < 32; i++) impo[i] = 0.f;
  f32x16 O[2];
#pragma unroll
  for (int dt = 0; dt < 2; dt++)
#pragma unroll
    for (int i = 0; i < 16; i++) O[dt][i] = 0.f;
  float carry = 0.f;
#pragma unroll
  for (int kt = 0; kt < 8; kt++) {
    if (kt < nkt) {
      f32x16 S;
#pragma unroll
      for (int i = 0; i < 16; i++) S[i] = 0.f;
      const int row = kt * 32 + pr;
#pragma unroll
      for (int ks = 0; ks < 4; ks++) { const bf16x8 kf = *(const bf16x8*)(Kl + row * 128 + (((ks * 2 + h2) ^ ((row >> 1) & 7)) << 4)); S = MFMA32(kf, qf[ks], S); }
#pragma unroll
      for (int i = 0; i < 16; i++) {
        const int key = kt * 32 + (i & 7) + 16 * (i >> 3) + 8 * h2;
        const float e = key < nvalid ? __builtin_amdgcn_exp2f(S[i] - mx) : 0.f;
        S[i] = e; sum += e;
      }
      {
        const float x1 = __shfl_xor(S[7], 32), x3 = __shfl_xor(S[15], 32);
#pragma unroll
        for (int q4 = 0; q4 < 4; q4++) {
          const float mainv = 2.f * (S[q4 * 4] + S[q4 * 4 + 1] + S[q4 * 4 + 2]) + S[q4 * 4 + 3];
          const float prev = (q4 == 0) ? (h2 ? x1 : carry) : (q4 == 1) ? S[3] : (q4 == 2) ? (h2 ? x3 : x1) : S[11];
          impo[kt * 4 + q4] = mainv + prev;
        }
        carry = x3;
      }
#pragma unroll
      for (int s2 = 0; s2 < 2; s2++) {
        uint4 u;
        u.x = pack2(S[8 * s2 + 0], S[8 * s2 + 1]); u.y = pack2(S[8 * s2 + 2], S[8 * s2 + 3]);
        u.z = pack2(S[8 * s2 + 4], S[8 * s2 + 5]); u.w = pack2(S[8 * s2 + 6], S[8 * s2 + 7]);
        const bf16x8 pfr = __builtin_bit_cast(bf16x8, u);
#pragma unroll
        for (int dt = 0; dt < 2; dt++) {
          const int d = dt * 32 + r;
          const bf16x8 vf = *(const bf16x8*)(Vl + d * 512 + (((kt * 4 + s2 * 2 + h2) ^ (d & 15)) << 4));
          O[dt] = MFMA32(vf, pfr, O[dt]);
        }
      }
    }
  }
  sum += __shfl_xor(sum, 32);
  const float inv = sum > 0.f ? 1.f / sum : 0.f;
  {
    const size_t m = (size_t)b * T + t;
    const float sc = inv * p.NG[m * 24 + hh * 3 + 0];
#pragma unroll
    for (int dt = 0; dt < 2; dt++)
#pragma unroll
      for (int q4 = 0; q4 < 4; q4++) {
        uint2 o; o.x = pack2(sc * O[dt][q4 * 4], sc * O[dt][q4 * 4 + 1]); o.y = pack2(sc * O[dt][q4 * 4 + 2], sc * O[dt][q4 * 4 + 3]);
        *(uint2*)(p.oattn + m * 512 + hh * 64 + dt * 32 + q4 * 8 + h2 * 4) = o;
      }
  }
  __syncthreads();
#pragma unroll
  for (int kt = 0; kt < 8; kt++)
#pragma unroll
    for (int q4 = 0; q4 < 4; q4++)
      impw[(w * 32 + r) * 65 + 8 * kt + 4 * (q4 >> 1) + 2 * h2 + (q4 & 1)] = impo[kt * 4 + q4] * inv;
  __syncthreads();
#pragma unroll 1
  for (int k8 = 0; k8 < 8; k8++) {
    const int rr = w * 8 + k8, tt = tb + rr, blk = tt >> 6;
    const float imp = ((impw[rr * 65 + lane] + impw[(32 + rr) * 65 + lane]) + impw[(64 + rr) * 65 + lane]) + impw[(96 + rr) * 65 + lane];
    const float score = (lane == 0 || lane == blk || lane == blk - 1) ? 1e9f : (lane <= blk ? imp : -1e9f);
    int rank = 0;
#pragma unroll
    for (int i = 0; i < 64; i++) { const float si = __int_as_float(__builtin_amdgcn_readlane(__float_as_int(score), i)); rank += (si > score || (si == score && i < lane)) ? 1 : 0; }
    const unsigned long long selm = __ballot(rank < 16);
    if (lane == 0) p.selmask[(size_t)bg * T + tt] = selm;
  }
}

DI float gelu_tanh(float x) { const float u = 0.7978845608028654f * (x + 0.044715f * x * x * x); return 0.5f * x * (1.f + tanhf(u)); }
DI void compress1_tile(const Params& p, int task, char* smem) {
  const int ks = task & 3, tile = task >> 2;
  const int ntl = tile & 1, mtile = tile >> 1, half = mtile & 1, bg = (mtile >> 1) & 7, kv = mtile >> 4;
  const bf16_t* src = (kv ? p.CV : p.CK) + (size_t)bg * T * 64 + (size_t)half * 128 * 1024 + ks * 512;
  const bf16_t* Bt = (kv ? p.W1vT : p.W1kT) + (size_t)ntl * 128 * 2048 + ks * 512;
  f32x4 acc[4][4]; zero_acc(acc);
  gemm128<true>(acc, [=](int r) { return src + (size_t)r * 1024; }, [=](int r) { return Bt + (size_t)r * 2048; }, 512, smem);
  float* H1p = (float*)p.oattn + (size_t)ks * 4096 * 256;
  epilogue<true>(acc, [&](int r, int c, f32x4 v) {
    const int n = half * 128 + r;
    if (n < 255) { float4 o; o.x = v[0]; o.y = v[1]; o.z = v[2]; o.w = v[3];
      *(float4*)(H1p + ((size_t)((kv * 8 + bg) * 256 + n)) * 256 + ntl * 128 + c) = o; }
  });
}
DI void compress2(const Params& p, char* smem) {
  float* hl = (float*)smem;
  const int tid = opq(threadIdx.x);
  const float* H1p = (const float*)p.oattn;
  for (int rb = blockIdx.x; rb < 512; rb += gridDim.x) {
    const int row0 = rb * 8, kv = row0 >> 11;
    __syncthreads();
#pragma unroll
    for (int q = 0; q < 8; q++) {
      const size_t idx = (size_t)(row0 + q) * 256 + tid;
      hl[q * 256 + tid] = gelu_tanh(H1p[idx] + H1p[idx + (size_t)4096 * 256] + H1p[idx + (size_t)2 * 4096 * 256] + H1p[idx + (size_t)3 * 4096 * 256] + p.posb[kv * 256 + tid]);
    }
    __syncthreads();
    const int q = tid >> 5, ii = tid & 31, row = row0 + q, n = row & 255, bg = (row >> 8) & 7;
    float a0 = 0.f, a1 = 0.f;
    if (n < 255) {
      const float* w2 = kv ? p.cmp_v_w2 : p.cmp_k_w2; const float* b2 = kv ? p.cmp_v_b2 : p.cmp_k_b2;
      a0 = b2[ii]; a1 = b2[ii + 32];
#pragma unroll 8
      for (int j = 0; j < 256; j++) { const float hv = hl[q * 256 + j]; a0 += hv * w2[j * 64 + ii]; a1 += hv * w2[j * 64 + ii + 32]; }
    }
    if (kv == 0) {
      float r0 = 0.f, r1 = 0.f;
      if (n < 255) { const int pos = 16 * n + 31; const float c = p.ropeN[((size_t)pos * 32 + ii) * 2], s = p.ropeN[((size_t)pos * 32 + ii) * 2 + 1];
        r0 = a0 * c - a1 * s; r1 = a0 * s + a1 * c; }
      *(unsigned*)(p.kcmp + ((size_t)(bg * 256 + n)) * 64 + 2 * ii) = pack2(r0, r1);
    } else {
      p.vcmpT[((size_t)(bg * 64 + ii)) * 256 + n] = f2bf(a0);
      p.vcmpT[((size_t)(bg * 64 + ii + 32)) * 256 + n] = f2bf(a1);
    }
  }
}


DI void ret_u_unit(const Params& p, int unit) {
  const int tid = opq(threadIdx.x), lane = tid & 63, w = tid >> 6, r = lane & 31, h2 = lane >> 5;
  const int bh = unit >> 5, n = unit & 31;
  const bf16_t* kz = p.RKzT + (size_t)bh * 128 * T + ((size_t)((w * 256 + n * 8) * 2 + h2)) * 256 + r * 8;
  const bf16_t* vt = p.RVt + (size_t)bh * 256 * T + ((size_t)((n * 8) * 2 + h2)) * 256 + r * 8;
  bf16_t* ut = p.Ut + ((size_t)bh * 32 + n) * 32768 + (size_t)(w * 2) * 512 + r * 8 + 4 * h2;
  bf16x8 a[8], b0[8], b1[8];
#pragma unroll
  for (int ks = 0; ks < 8; ks++) a[ks] = *(const bf16x8*)(kz + ks * 512);
#pragma unroll
  for (int ks = 0; ks < 8; ks++) b0[ks] = *(const bf16x8*)(vt + ks * 512);
#pragma unroll
  for (int dvs = 0; dvs < 8; dvs += 2) {
#pragma unroll
    for (int ks = 0; ks < 8; ks++) b1[ks] = *(const bf16x8*)(vt + (size_t)(dvs + 1) * 32 * T + ks * 512);
    {
      f32x16 R;
#pragma unroll
      for (int i = 0; i < 16; i++) R[i] = 0.f;
#pragma unroll
      for (int ks = 0; ks < 8; ks++) R = MFMA32(a[ks], b0[ks], R);
#pragma unroll
      for (int q4 = 0; q4 < 4; q4++) { uint2 o; o.x = pack2(R[q4 * 4], R[q4 * 4 + 1]); o.y = pack2(R[q4 * 4 + 2], R[q4 * 4 + 3]);
        *(uint2*)(ut + (size_t)dvs * 4096 + (q4 >> 1) * 512 + (q4 & 1) * 256) = o; }
    }
    if (dvs + 2 < 8) {
#pragma unroll
      for (int ks = 0; ks < 8; ks++) b0[ks] = *(const bf16x8*)(vt + (size_t)(dvs + 2) * 32 * T + ks * 512);
    }
    {
      f32x16 R;
#pragma unroll
      for (int i = 0; i < 16; i++) R[i] = 0.f;
#pragma unroll
      for (int ks = 0; ks < 8; ks++) R = MFMA32(a[ks], b1[ks], R);
#pragma unroll
      for (int q4 = 0; q4 < 4; q4++) { uint2 o; o.x = pack2(R[q4 * 4], R[q4 * 4 + 1]); o.y = pack2(R[q4 * 4 + 2], R[q4 * 4 + 3]);
        *(uint2*)(ut + (size_t)(dvs + 1) * 4096 + (q4 >> 1) * 512 + (q4 & 1) * 256) = o; }
    }
  }
}
DI void ret_scan_elem(const Params& p) {
  const size_t gtid = (size_t)blockIdx.x * 256 + opq(threadIdx.x), gsz = (size_t)gridDim.x * 256;
  for (size_t i = gtid; i < (size_t)16 * 256 * 32; i += gsz) {
    const int bh = (int)(i >> 13), h = bh & 3;
    const size_t off = (size_t)(i & 8191) * 4;
    const float cd = exp2f(128.f * log2f(1.f - exp2f(-5.f - (float)h)));
    const bf16_t* up = p.Ut + (size_t)bh * 32 * 32768 + off;
    bf16_t* rp = p.Rt + (size_t)bh * 32 * 32768 + off;
    uint2 u[31];
#pragma unroll
    for (int n = 0; n < 31; n++) u[n] = *(const uint2*)(up + (size_t)n * 32768);
    float r0 = 0.f, r1 = 0.f, r2 = 0.f, r3 = 0.f;
    { uint2 z; z.x = 0u; z.y = 0u; *(uint2*)rp = z; }
#pragma unroll
    for (int n = 0; n < 31; n++) {
      r0 = r0 * cd + lo2f(u[n].x); r1 = r1 * cd + hi2f(u[n].x); r2 = r2 * cd + lo2f(u[n].y); r3 = r3 * cd + hi2f(u[n].y);
      uint2 o; o.x = pack2(r0, r1); o.y = pack2(r2, r3);
      *(uint2*)(rp + (size_t)(n + 1) * 32768) = o;
    }
  }
}

DI void ret_out_unit(const Params& p, int unit, char* smem) {
  const int tid = opq(threadIdx.x), lane = tid & 63, w = tid >> 6, r = lane & 31, h2 = lane >> 5, tq = w >> 1, dh = w & 1;
  const int th = unit & 1, n = (unit >> 1) & 31, bh = unit >> 6, b = bh >> 2, h = bh & 3;
  const int qt = th * 2 + tq, c = qt * 32 + r;
  const float lg = log2f(1.f - exp2f(-5.f - (float)h));
  const bf16_t* qp = p.RQ + (size_t)bh * T * 128 + ((size_t)(((n * 4 + qt) * 8) * 2 + h2)) * 256 + r * 8;
  f32x16 O[4];
  {
    const bf16_t* rp = p.Rt + ((size_t)bh * 32 + n) * 32768 + ((size_t)((dh * 4 * 8) * 2 + h2)) * 256 + r * 8;
#pragma unroll
    for (int dvt = 0; dvt < 4; dvt++)
#pragma unroll
      for (int i = 0; i < 16; i++) O[dvt][i] = 0.f;
#pragma unroll
    for (int ks = 0; ks < 8; ks++) {
      const bf16x8 qk = *(const bf16x8*)(qp + ks * 512);
#pragma unroll
      for (int dvt = 0; dvt < 4; dvt++) {
        const bf16x8 rf = *(const bf16x8*)(rp + (size_t)dvt * 4096 + ks * 512);
        O[dvt] = MFMA32(rf, qk, O[dvt]);
      }
    }
    const float xi = exp2f((float)(c + 1) * lg);
#pragma unroll
    for (int dvt = 0; dvt < 4; dvt++)
#pragma unroll
      for (int i = 0; i < 16; i++) O[dvt][i] *= xi;
  }
#pragma unroll 1
  for (int kt = 0; kt <= qt; kt++) {
    f32x16 S;
#pragma unroll
    for (int i = 0; i < 16; i++) S[i] = 0.f;
    const bf16_t* kp = p.RK + (size_t)bh * T * 128 + ((size_t)(((n * 4 + kt) * 8) * 2 + h2)) * 256 + perm23(r) * 8;
#pragma unroll
    for (int ks = 0; ks < 8; ks++) { const bf16x8 kf = *(const bf16x8*)(kp + ks * 512); const bf16x8 qk = *(const bf16x8*)(qp + ks * 512); S = MFMA32(kf, qk, S); }
    bf16x8 pf[2];
#pragma unroll
    for (int s2 = 0; s2 < 2; s2++) {
      float v[8];
#pragma unroll
      for (int jj = 0; jj < 8; jj++) {
        const int i = 8 * s2 + jj;
        const int mkey = kt * 32 + (i & 7) + 16 * (i >> 3) + 8 * h2;
        v[jj] = (mkey <= c) ? S[i] * exp2f((float)(c - mkey) * lg) : 0.f;
      }
      uint4 u; u.x = pack2(v[0], v[1]); u.y = pack2(v[2], v[3]); u.z = pack2(v[4], v[5]); u.w = pack2(v[6], v[7]);
      pf[s2] = __builtin_bit_cast(bf16x8, u);
    }
    const bf16_t* vp = p.RVt + (size_t)bh * 256 * T + ((size_t)(((dh * 4) * 256 + n * 8 + kt * 2) * 2 + h2)) * 256 + r * 8;
#pragma unroll
    for (int dvt = 0; dvt < 4; dvt++)
#pragma unroll
      for (int s2 = 0; s2 < 2; s2++) {
        const bf16x8 vf = *(const bf16x8*)(vp + (size_t)dvt * 32 * T + s2 * 512);
        O[dvt] = MFMA32(vf, pf[s2], O[dvt]);
      }
  }
  float s1 = 0.f, s2s = 0.f;
#pragma unroll
  for (int dvt = 0; dvt < 4; dvt++)
#pragma unroll
    for (int i = 0; i < 16; i++) { s1 += O[dvt][i]; s2s += O[dvt][i] * O[dvt][i]; }
  s1 += __shfl_xor(s1, 32); s2s += __shfl_xor(s2s, 32);
  float* red = (float*)smem;
  __syncthreads();
  if (h2 == 0) { red[(w * 32 + r) * 2] = s1; red[(w * 32 + r) * 2 + 1] = s2s; }
  __syncthreads();
  s1 += red[((w ^ 1) * 32 + r) * 2]; s2s += red[((w ^ 1) * 32 + r) * 2 + 1];
  const float mu = s1 * (1.f / 256.f);
  const float var = fmaxf(s2s * (1.f / 256.f) - mu * mu, 0.f);
  const float rs = rsqrtf(var + 1e-5f);
  const size_t m = (size_t)b * T + n * 128 + c;
#pragma unroll
  for (int dvt = 0; dvt < 4; dvt++)
#pragma unroll
    for (int q4 = 0; q4 < 4; q4++) {
      const int col = h * 256 + dh * 128 + dvt * 32 + q4 * 8 + 4 * h2;
      const float4 gg = *(const float4*)(p.gn_g + col), bb = *(const float4*)(p.gn_b + col);
      const uint2 rg = *(const uint2*)(p.RG + m * 1024 + col);
      const float g0 = lo2f(rg.x), g1 = hi2f(rg.x), g2 = lo2f(rg.y), g3 = hi2f(rg.y);
      const float y0 = ((O[dvt][q4 * 4] - mu) * rs * gg.x + bb.x) * g0 * sigmoidf_(g0);
      const float y1 = ((O[dvt][q4 * 4 + 1] - mu) * rs * gg.y + bb.y) * g1 * sigmoidf_(g1);
      const float y2 = ((O[dvt][q4 * 4 + 2] - mu) * rs * gg.z + bb.z) * g2 * sigmoidf_(g2);
      const float y3 = ((O[dvt][q4 * 4 + 3] - mu) * rs * gg.w + bb.w) * g3 * sigmoidf_(g3);
      uint2 o; o.x = pack2(y0, y1); o.y = pack2(y2, y3);
      *(uint2*)(p.oret + m * 1024 + col) = o;
    }
}

DI void lds_tile_load(const bf16_t* src, size_t ld, char* smem) {
  const int tid = opq(threadIdx.x);
#pragma unroll
  for (int k = 0; k < 8; k++) { const int id = tid + 256 * k, i = id >> 4, j8 = (id & 15) * 8; *(uint4*)(smem + i * 272 + j8 * 2) = *(const uint4*)(src + (size_t)i * ld + j8); }
}
DI void lds_tile_store(bf16_t* dstp, size_t ld, char* smem) {
  const int tid = opq(threadIdx.x);
#pragma unroll
  for (int k = 0; k < 8; k++) { const int id = tid + 256 * k, i = id >> 4, j8 = (id & 15) * 8; *(uint4*)(dstp + (size_t)i * ld + j8) = *(const uint4*)(smem + i * 272 + j8 * 2); }
}
DI void upproj_tile(const Params& p, int tile, char* smem) {
  const int nt_ = tile & 7, mt_ = tile >> 3, m0 = mt_ * 128, n0 = nt_ * 128;
  const int lane = opq(threadIdx.x) & 63, wave = opq(threadIdx.x) >> 6, wr = wave >> 1, wc = wave & 1, fr = lane & 15, fq = lane >> 4;
  f32x4 acc[4][4]; uint2 res[4][4];
  zero_acc(acc);
  { const bf16_t* A = p.oattn + (size_t)m0 * 512; const bf16_t* Bt = p.WaT + (size_t)n0 * 512;
    gemm128<true>(acc, [=](int r) { return A + (size_t)r * 512; }, [=](int r) { return Bt + (size_t)r * 512; }, 512, smem); }
  lds_tile_load(p.MG + (size_t)m0 * 2048 + n0, 2048, smem);
  __syncthreads();
#pragma unroll
  for (int mt = 0; mt < 4; mt++)
#pragma unroll
    for (int nt = 0; nt < 4; nt++) {
      const int r = wr * 64 + mt * 16 + fr, c = wc * 64 + nt * 16 + fq * 4;
      const uint2 gv = *(const uint2*)(smem + r * 272 + c * 2);
      res[mt][nt].x = pack2(sigmoidf_(lo2f(gv.x)) * acc[mt][nt][0], sigmoidf_(hi2f(gv.x)) * acc[mt][nt][1]);
      res[mt][nt].y = pack2(sigmoidf_(lo2f(gv.y)) * acc[mt][nt][2], sigmoidf_(hi2f(gv.y)) * acc[mt][nt][3]);
    }
  __syncthreads();
  zero_acc(acc);
  { const bf16_t* A = p.oret + (size_t)m0 * 1024; const bf16_t* Bt = p.WrT + (size_t)n0 * 1024;
    gemm128<true>(acc, [=](int r) { return A + (size_t)r * 1024; }, [=](int r) { return Bt + (size_t)r * 1024; }, 1024, smem); }
  lds_tile_load(p.MG + (size_t)m0 * 2048 + 1024 + n0, 2048, smem);
  __syncthreads();
#pragma unroll
  for (int mt = 0; mt < 4; mt++)
#pragma unroll
    for (int nt = 0; nt < 4; nt++) {
      const int r = wr * 64 + mt * 16 + fr, c = wc * 64 + nt * 16 + fq * 4;
      uint2* q = (uint2*)(smem + r * 272 + c * 2);
      const uint2 gv = *q;
      uint2 o; o.x = pack2(lo2f(res[mt][nt].x) + sigmoidf_(lo2f(gv.x)) * acc[mt][nt][0], hi2f(res[mt][nt].x) + sigmoidf_(hi2f(gv.x)) * acc[mt][nt][1]);
      o.y = pack2(lo2f(res[mt][nt].y) + sigmoidf_(lo2f(gv.y)) * acc[mt][nt][2], hi2f(res[mt][nt].y) + sigmoidf_(hi2f(gv.y)) * acc[mt][nt][3]);
      *q = o;
    }
  __syncthreads();
  lds_tile_store(p.merged + (size_t)m0 * 1024 + n0, 1024, smem);
  __syncthreads();
}
DI void wout_tile(const Params& p, int tile, char* smem) {
  const int nt_ = tile & 7, mt_ = tile >> 3, m0 = mt_ * 128, n0 = nt_ * 128;
  const int tid = opq(threadIdx.x), lane = tid & 63, wave = tid >> 6, wr = wave >> 1, wc = wave & 1, fr = lane & 15, fq = lane >> 4;
  f32x4 acc[4][4]; zero_acc(acc);
  const bf16_t* A = p.merged + (size_t)m0 * 1024; const bf16_t* Bt = p.WoT + (size_t)n0 * 1024;
  gemm128<true>(acc, [=](int r) { return A + (size_t)r * 1024; }, [=](int r) { return Bt + (size_t)r * 1024; }, 1024, smem);
#pragma unroll
  for (int hcol = 0; hcol < 2; hcol++) {
    const size_t g0 = (size_t)m0 * 1024 + n0 + hcol * 64;
#pragma unroll
    for (int k = 0; k < 8; k++) { const int id = tid + 256 * k, i = id >> 4, j4 = (id & 15) * 4; *(float4*)(smem + i * 272 + j4 * 4) = *(const float4*)(p.x + g0 + (size_t)i * 1024 + j4); }
    __syncthreads();
    if (wc == hcol) {
#pragma unroll
      for (int mt = 0; mt < 4; mt++)
#pragma unroll
        for (int nt = 0; nt < 4; nt++) {
          float4* q = (float4*)(smem + (wr * 64 + mt * 16 + fr) * 272 + (nt * 16 + fq * 4) * 4);
          const float4 xv = *q;
          float4 o; o.x = ALPHA * xv.x + acc[mt][nt][0]; o.y = ALPHA * xv.y + acc[mt][nt][1]; o.z = ALPHA * xv.z + acc[mt][nt][2]; o.w = ALPHA * xv.w + acc[mt][nt][3];
          *q = o;
        }
    }
    __syncthreads();
#pragma unroll
    for (int k = 0; k < 8; k++) { const int id = tid + 256 * k, i = id >> 4, j4 = (id & 15) * 4; *(float4*)(p.out + g0 + (size_t)i * 1024 + j4) = *(const float4*)(smem + i * 272 + j4 * 4); }
    __syncthreads();
  }
}
DI void expert_cvt_tile(const Params& p, int ct, float* tile) {
  const int e = ct / 192, rr = ct % 192;
  const float* wg = p.e_wg + (size_t)e * 1024 * 512; const float* wu = p.e_wu + (size_t)e * 1024 * 512; const float* wd = p.e_wd + (size_t)e * 512 * 1024;
  if (rr < 128)
    tcvt_tile128([=](int j) -> const float* { const int f = (j >> 7) * 64 + ((j >> 5) & 3) * 16 + (j & 15); return (((j >> 4) & 1) ? wu : wg) + f; },
                 512, p.EgT + (size_t)e * 1024 * 1024, 1024, rr >> 3, rr & 7, tile);
  else { const int q = rr - 128;
    tcvt_tile128([=](int j) -> const float* { return wd + j; }, 1024, p.EdT + (size_t)e * 1024 * 512, 512, q >> 3, q & 7, tile); }
}
#ifndef CVT_SPLIT
#define CVT_SPLIT 3072
#endif
DI void phase7(const Params& p, char* smem) {
  const int bid = blockIdx.x, nb = gridDim.x;
  if (bid & 1) for (int c = CVT_SPLIT + bid; c < 6144; c += nb) expert_cvt_tile(p, c, (float*)smem);
  for (int t = bid; t < 1024; t += nb) wout_tile(p, t, smem);
  if (!(bid & 1)) for (int c = CVT_SPLIT + bid; c < 6144; c += nb) expert_cvt_tile(p, c, (float*)smem);
}

template <int NT>
DI void ln1_router(const Params& p, int m0, int lane, float* xl  ) {
  float4 v[NT][4];
#pragma unroll
  for (int t = 0; t < NT; t++)
#pragma unroll
    for (int i = 0; i < 4; i++) v[t][i] = *(const float4*)(p.out + (size_t)(m0 + t) * 1024 + i * 256 + lane * 4);
  float mu[NT], rs[NT];
#pragma unroll
  for (int t = 0; t < NT; t++) {
    float s = 0.f;
#pragma unroll
    for (int i = 0; i < 4; i++) s += v[t][i].x + v[t][i].y + v[t][i].z + v[t][i].w;
    mu[t] = wsum(s) * (1.f / 1024.f);
  }
#pragma unroll
  for (int t = 0; t < NT; t++) {
    float q = 0.f;
#pragma unroll
    for (int i = 0; i < 4; i++) { const float a = v[t][i].x - mu[t], b = v[t][i].y - mu[t], c = v[t][i].z - mu[t], d = v[t][i].w - mu[t]; q += a * a + b * b + c * c + d * d; }
    rs[t] = rsqrtf(wsum(q) * (1.f / 1024.f) + 1e-5f);
  }
#pragma unroll
  for (int i = 0; i < 4; i++) {
    const int k = i * 256 + lane * 4;
    const float4 g = *(const float4*)(p.ln1_g + k), bb = *(const float4*)(p.ln1_b + k);
#pragma unroll
    for (int t = 0; t < NT; t++) {
      float4 o;
      o.x = (v[t][i].x - mu[t]) * rs[t] * g.x + bb.x; o.y = (v[t][i].y - mu[t]) * rs[t] * g.y + bb.y;
      o.z = (v[t][i].z - mu[t]) * rs[t] * g.z + bb.z; o.w = (v[t][i].w - mu[t]) * rs[t] * g.w + bb.w;
      *(float4*)(p.out + (size_t)(m0 + t) * 1024 + k) = o;
      uint2 ob; ob.x = pack2(o.x, o.y); ob.y = pack2(o.z, o.w);
      *(uint2*)(p.x1b + (size_t)(m0 + t) * 1024 + k) = ob;
      *(float4*)(xl + t * 1024 + k) = o;
    }
  }
  WSYNC();
  float gl[NT][4];
#pragma unroll
  for (int t = 0; t < NT; t++)
#pragma unroll
    for (int j = 0; j < 4; j++) gl[t][j] = 0.f;
#pragma unroll
  for (int c = 0; c < 16; c++) {
    const int k = c * 64 + lane;
    const float4 w = *(const float4*)(p.rg_w + (size_t)k * 4);
#pragma unroll
    for (int t = 0; t < NT; t++) {
      const float xk = xl[t * 1024 + k];
      gl[t][0] += xk * w.x; gl[t][1] += xk * w.y; gl[t][2] += xk * w.z; gl[t][3] += xk * w.w;
    }
  }
  int gi[NT]; float gprob[NT];
#pragma unroll
  for (int t = 0; t < NT; t++) {
#pragma unroll
    for (int j = 0; j < 4; j++) gl[t][j] = wsum(gl[t][j]) + p.rg_b[j];
    gi[t] = 0; float gm = gl[t][0];
#pragma unroll
    for (int j = 1; j < 4; j++) if (gl[t][j] > gm) { gm = gl[t][j]; gi[t] = j; }
    float gs = 0.f;
#pragma unroll
    for (int j = 0; j < 4; j++) gs += __expf(gl[t][j] - gm);
    gprob[t] = 1.f / gs;
  }
  float tq[NT][4];
#pragma unroll
  for (int t = 0; t < NT; t++)
#pragma unroll
    for (int j = 0; j < 4; j++) tq[t][j] = 0.f;
#pragma unroll 16
  for (int c = 0; c < 32; c++) {
    const int k = c * 32 + (lane >> 1);
#pragma unroll
    for (int t = 0; t < NT; t++) {
      const float xk = xl[t * 1024 + k];
      const float4 w = *(const float4*)(p.ri_w + (size_t)gi[t] * 1024 * 8 + (lane & 1) * 4 + (size_t)k * 8);
      tq[t][0] += xk * w.x; tq[t][1] += xk * w.y; tq[t][2] += xk * w.z; tq[t][3] += xk * w.w;
    }
  }
  int ea[NT], eb[NT]; float w1[NT], w2[NT];
#pragma unroll
  for (int t = 0; t < NT; t++) {
    float il[8];
#pragma unroll
    for (int j = 0; j < 4; j++) { il[j] = wsum((lane & 1) ? 0.f : tq[t][j]) + p.ri_b[gi[t] * 8 + j]; il[4 + j] = wsum((lane & 1) ? tq[t][j] : 0.f) + p.ri_b[gi[t] * 8 + 4 + j]; }
    int e1 = 0; float l1 = il[0];
#pragma unroll
    for (int j = 1; j < 8; j++) if (il[j] > l1) { l1 = il[j]; e1 = j; }
    int e2 = -1; float l2 = -3e38f;
#pragma unroll
    for (int j = 0; j < 8; j++) if (j != e1 && il[j] > l2) { l2 = il[j]; e2 = j; }
    const float ex = __expf(l2 - l1);
    w1[t] = gprob[t] / (1.f + ex); w2[t] = gprob[t] * ex / (1.f + ex);
    ea[t] = gi[t] * 8 + e1; eb[t] = gi[t] * 8 + e2;
  }
  if (lane == 0) {
    const int grp = blockIdx.x & 15;
    int pa[NT], pb[NT];
#pragma unroll
    for (int t = 0; t < NT; t++) { pa[t] = atomicAdd(p.cnt + grp * 32 + ea[t], 1); pb[t] = atomicAdd(p.cnt + grp * 32 + eb[t], 1); }
#pragma unroll
    for (int t = 0; t < NT; t++) {
      const int m = m0 + t;
      p.lists[(ea[t] * 16 + grp) * 2048 + pa[t]] = m * 2; p.lists[(eb[t] * 16 + grp) * 2048 + pb[t]] = m * 2 + 1;
      p.routew[m * 2] = w1[t]; p.routew[m * 2 + 1] = w2[t];
    }
  }
  WSYNC();
}
DI void ln2_final(const Params& p, int m, int lane) {
  float* row = p.out + (size_t)m * 1024;
  float4 v[4];
  float s = 0.f;
#pragma unroll
  for (int i = 0; i < 4; i++) {
    const int k = i * 256 + lane * 4;
    const float4 xv = *(const float4*)(row + k);
    const uint2 a = *(const uint2*)(p.part + (size_t)(2 * m) * 1024 + k), b = *(const uint2*)(p.part + (size_t)(2 * m + 1) * 1024 + k);
    v[i].x = ALPHA * xv.x + lo2f(a.x) + lo2f(b.x); v[i].y = ALPHA * xv.y + hi2f(a.x) + hi2f(b.x);
    v[i].z = ALPHA * xv.z + lo2f(a.y) + lo2f(b.y); v[i].w = ALPHA * xv.w + hi2f(a.y) + hi2f(b.y);
    s += v[i].x + v[i].y + v[i].z + v[i].w;
  }
  const float mu = wsum(s) * (1.f / 1024.f);
  float q = 0.f;
#pragma unroll
  for (int i = 0; i < 4; i++) { const float a = v[i].x - mu, b = v[i].y - mu, c = v[i].z - mu, d = v[i].w - mu; q += a * a + b * b + c * c + d * d; }
  const float rs = rsqrtf(wsum(q) * (1.f / 1024.f) + 1e-5f);
#pragma unroll
  for (int i = 0; i < 4; i++) {
    const int k = i * 256 + lane * 4;
    const float4 g = *(const float4*)(p.ln2_g + k), bb = *(const float4*)(p.ln2_b + k);
    float4 o; o.x = (v[i].x - mu) * rs * g.x + bb.x; o.y = (v[i].y - mu) * rs * g.y + bb.y; o.z = (v[i].z - mu) * rs * g.z + bb.z; o.w = (v[i].w - mu) * rs * g.w + bb.w;
    *(float4*)(row + k) = o;
  }
}

struct MoeMap { int e, mi, cnt, hoff; };
#define MOE_TAB(smem) ((int*)((smem) + 65552))
DI void moe_tables(const Params& p, char* smem) {
  int* tab = MOE_TAB(smem); int* pre = tab; int* tpre = tab + 32 * 17;
  const int tid = opq(threadIdx.x);
  __syncthreads();
  if (tid < 32) { int acc = 0; for (int g = 0; g < 16; g++) { pre[tid * 17 + g] = acc; acc += p.cnt[g * 32 + tid]; } pre[tid * 17 + 16] = acc; }
  __syncthreads();
  if (tid == 0) { int acc = 0; for (int e = 0; e < NEXP; e++) { tpre[e] = acc; acc += (pre[e * 17 + 16] + 127) >> 7; } tpre[32] = acc; }
  __syncthreads();
}
DI bool moe_map(char* smem, int mtile, MoeMap& mm) {
  const int* tab = MOE_TAB(smem); const int* pre = tab; const int* tpre = tab + 32 * 17;
  if (mtile >= tpre[32]) return false;
  int e = 0;
  while (tpre[e + 1] <= mtile) e++;
  mm.e = e; mm.mi = mtile - tpre[e]; mm.cnt = pre[e * 17 + 16]; mm.hoff = tpre[e] * 128;
  return true;
}
DI int moe_total(char* smem) { return MOE_TAB(smem)[32 * 17 + 32]; }
DI const int* moe_rows(const Params& p, const MoeMap& mm, char* smem) {
  int* tab = MOE_TAB(smem); const int* pre = tab + mm.e * 17; int* rowent = tab + 32 * 17 + 40;
  const int tid = opq(threadIdx.x);
  __syncthreads();
  if (tid < 128) {
    const int ri = mm.mi * 128 + tid; int ent = -1;
    if (ri < mm.cnt) { int g = 0; while (pre[g + 1] <= ri) g++; ent = p.lists[(mm.e * 16 + g) * 2048 + ri - pre[g]]; }
    rowent[tid] = ent;
  }
  __syncthreads();
  return rowent;
}
DI void moe_up_tile(const Params& p, const MoeMap& mm, int nt_, char* smem) {
  const int* lst = moe_rows(p, mm, smem); const int nrow = mm.cnt - mm.mi * 128;
  const bf16_t* Bt = p.EgT + ((size_t)mm.e * 1024 + nt_ * 128) * 1024;
  const bf16_t* X = p.x1b;
  f32x4 acc[4][4]; zero_acc(acc);
  gemm128<true>(acc, [=](int r) { const int tk = r < nrow ? (lst[r] >> 1) : 0; return X + (size_t)tk * 1024; }, [=](int r) { return Bt + (size_t)r * 1024; }, 1024, smem);
  const int lane = opq(threadIdx.x) & 63, wave = opq(threadIdx.x) >> 6, wr = wave >> 1, wc = wave & 1, fr = lane & 15, fq = lane >> 4;
#pragma unroll
  for (int mt = 0; mt < 4; mt++) {
    const int r = wr * 64 + mt * 16 + fr;
    if (r < nrow) {
      const float w = p.routew[lst[r]];
#pragma unroll
      for (int np = 0; np < 2; np++) {
        const f32x4 g = acc[mt][np * 2], u = acc[mt][np * 2 + 1];
        float hv[4];
#pragma unroll
        for (int i = 0; i < 4; i++) hv[i] = g[i] * sigmoidf_(g[i]) * u[i] * w;
        const int f = nt_ * 64 + wc * 32 + np * 16 + fq * 4;
        uint2 o; o.x = pack2(hv[0], hv[1]); o.y = pack2(hv[2], hv[3]);
        *(uint2*)(p.Hh + (size_t)(mm.hoff + mm.mi * 128 + r) * 512 + f) = o;
      }
    }
  }
}
DI void moe_down_tile(const Params& p, const MoeMap& mm, int nt_, char* smem) {
  const int* lst = moe_rows(p, mm, smem); const int nrow = mm.cnt - mm.mi * 128;
  const bf16_t* A = p.Hh + (size_t)(mm.hoff + mm.mi * 128) * 512;
  const bf16_t* Bt = p.EdT + ((size_t)mm.e * 1024 + nt_ * 128) * 512;
  f32x4 acc[4][4]; zero_acc(acc);
  gemm128<true>(acc, [=](int r) { return A + (size_t)r * 512; }, [=](int r) { return Bt + (size_t)r * 512; }, 512, smem);
  epilogue<true>(acc, [&](int r, int c, f32x4 v) {
    if (r < nrow) {
      const int ts = lst[r];
      uint2 o; o.x = pack2(v[0], v[1]); o.y = pack2(v[2], v[3]);
      *(uint2*)(p.part + (size_t)ts * 1024 + nt_ * 128 + c) = o;
    }
  });
}

constexpr int NPHASE = 12;
#if FUSED
#define PHFN DI
#else
#define PHFN DI
#endif
#define PH_PRE const int bid = blockIdx.x, nb = gridDim.x, tid = opq(threadIdx.x), lane = tid & 63, wave = tid >> 6; \
  const int gw = bid * 4 + wave, nw = nb * 4; char* wsm = smem + wave * 8192; (void)bid; (void)nb; (void)lane; (void)gw; (void)nw; (void)wsm;
PHFN void ph0(const Params& p, char* smem) { phase0(p, smem); }
PHFN void ph1(const Params& p, char* smem) { phase1(p, smem); }
PHFN void ph2(const Params& p, char* smem) { PH_PRE
  for (int t = bid; t < 256 + 512; t += nb) { if (t < 256) compress1_tile(p, t, smem); else if (((t - 256) & 31) != 31) ret_u_unit(p, t - 256); }
}
PHFN void ph3(const Params& p, char* smem) { compress2(p, smem); ret_scan_elem(p); }
PHFN void ph4(const Params& p, char* smem) { PH_PRE
  for (int u = bid; u < 1024; u += nb) cmp_unit(p, u, smem);
}
PHFN void ph5(const Params& p, char* smem) { PH_PRE
  for (int u = bid; u < 512; u += nb) { const int k = u >> 3; attn_unit(p, ((u & 7) << 6) | (k < 32 ? 63 - k : k - 32), smem); }
  {
    int* sh = (int*)(smem + 65552 + 3072);
    for (;;) {
      __syncthreads();
      if (tid == 0) sh[0] = (int)xb_add(&p.qctr[0], 1u);
      __syncthreads();
      const int u = sh[0];
      if (u >= 1024) break;
      ret_out_unit(p, u, smem);
    }
  }
}
PHFN void ph6(const Params& p, char* smem) { PH_PRE
  if (bid & 1) for (int c = bid; c < CVT_SPLIT; c += nb) expert_cvt_tile(p, c, (float*)smem);
  for (int t = bid; t < 1024; t += nb) upproj_tile(p, t, smem);
  if (!(bid & 1)) for (int c = bid; c < CVT_SPLIT; c += nb) expert_cvt_tile(p, c, (float*)smem);
}
PHFN void ph7(const Params& p, char* smem) { phase7(p, smem); }
PHFN void ph8(const Params& p, char* smem) { PH_PRE for (int m = gw * 2; m < M; m += nw * 2) ln1_router<2>(p, m, lane, (float*)wsm); }
PHFN void ph9(const Params& p, char* smem) { PH_PRE moe_tables(p, smem); const int tot = moe_total(smem);
  for (int t = bid; t < tot * 8; t += nb) { MoeMap mm; if (moe_map(smem, t >> 3, mm)) moe_up_tile(p, mm, t & 7, smem); } }
PHFN void ph10(const Params& p, char* smem) { PH_PRE moe_tables(p, smem); const int tot = moe_total(smem);
  for (int t = bid; t < tot * 8; t += nb) { MoeMap mm; if (moe_map(smem, t >> 3, mm)) moe_down_tile(p, mm, t & 7, smem); } }
PHFN void ph11(const Params& p, char* smem) { PH_PRE for (int m = gw; m < M; m += nw) ln2_final(p, m, lane); }
DI void run_phase(const Params& p, const int ph, char* smem) {
  switch (ph) {
    case 0: ph0(p, smem); break; case 1: ph1(p, smem); break; case 2: ph2(p, smem); break; case 3: ph3(p, smem); break;
    case 4: ph4(p, smem); break; case 5: ph5(p, smem); break; case 6: ph6(p, smem); break; case 7: ph7(p, smem); break;
    case 8: ph8(p, smem); break; case 9: ph9(p, smem); break; case 10: ph10(p, smem); break; case 11: ph11(p, smem); break;
  }
}

template <int PH>
__global__ void __launch_bounds__(256, 2) phase_kernel(Params p) {
  __shared__ __attribute__((aligned(16))) char smem[65536 + 16 + 4096];
  run_phase(p, PH, smem);
}
#if FUSED
__global__ void __launch_bounds__(256, 2) mega_kernel(Params p_arg) {
  __shared__ __attribute__((aligned(16))) char smem[65536 + 16 + 4096];
  const Params& p = *(const Params*)__builtin_amdgcn_kernarg_segment_ptr();
  volatile LAS unsigned* st = (volatile LAS unsigned*)(smem + 65536);
  if (threadIdx.x == 0) { st[0] = 0u; st[1] = 0u; }
  __syncthreads();
  const XcdBarrier xb = xcd_barrier_post(p.bar, st);
#define GSYNC() xcd_barrier(xb)
  unsigned long long tk_ = 0; (void)tk_;
#define RUNPH(N) { unsigned long long t0_ = 0; if (PROBE_PHASE == N) t0_ = __builtin_amdgcn_s_memrealtime(); ph##N(p, smem); if (PROBE_DOUBLE & (1 << N)) { GSYNC(); ph##N(p, smem); } \
    if (PROBE_PHASE == N) { GSYNC(); tk_ = __builtin_amdgcn_s_memrealtime() - t0_; } }
  RUNPH(0); GSYNC(); RUNPH(1); GSYNC(); RUNPH(2); GSYNC(); RUNPH(3); GSYNC();
  RUNPH(4); GSYNC(); RUNPH(5); GSYNC(); RUNPH(6); GSYNC(); RUNPH(7); GSYNC();
  RUNPH(8); GSYNC(); RUNPH(9); GSYNC(); RUNPH(10); GSYNC(); RUNPH(11);
  if (PROBE_PHASE >= 0 && blockIdx.x == 0) { const unsigned long long t1_ = __builtin_amdgcn_s_memrealtime(); while (__builtin_amdgcn_s_memrealtime() - t1_ < 3ull * tk_) __builtin_amdgcn_s_sleep(8); }
}
#endif

extern "C" void kernel_launch(void* const* d_in, const int* in_sizes, int n_in, void* d_out, int out_size,
                              void* d_ws, size_t ws_size, hipStream_t stream) {
  Params p{};
  const float** ins = (const float**)&p;
  for (int i = 0; i < 28; i++) ins[i] = (const float*)d_in[i];
  p.out = (float*)d_out;
  char* ws = (char*)d_ws; size_t off = 0;
  auto alloc = [&](size_t bytes) { char* r = ws + off; off += (bytes + 255) & ~(size_t)255; return r; };
  const size_t MiB = 1 << 20;
  char* regionP = ws;
  p.Qn = (bf16_t*)alloc(16 * MiB);
  p.CK = (bf16_t*)alloc(4 * MiB); p.CV = (bf16_t*)alloc(4 * MiB); p.SK = (bf16_t*)alloc(4 * MiB); p.SVt = (bf16_t*)alloc(4 * MiB);
  p.WK = (bf16_t*)alloc(4 * MiB); p.WVt = (bf16_t*)alloc(4 * MiB);
  p.NG = (float*)alloc((size_t)M * 24 * 4);
  p.RQ = (bf16_t*)alloc(16 * MiB); p.RK = (bf16_t*)alloc(16 * MiB); p.RKzT = (bf16_t*)alloc(16 * MiB);
  p.RVt = (bf16_t*)alloc(32 * MiB); p.RG = (bf16_t*)alloc(32 * MiB); p.MG = (bf16_t*)alloc(64 * MiB);
  p.oattn = (bf16_t*)alloc(16 * MiB); p.WinT = p.oattn;
  p.oret = (bf16_t*)alloc(32 * MiB);
  p.WaT = (bf16_t*)alloc(1 * MiB); p.WrT = (bf16_t*)alloc(2 * MiB); p.WoT = (bf16_t*)alloc(2 * MiB);
  p.W1kT = (bf16_t*)alloc(1 * MiB); p.W1vT = (bf16_t*)alloc(1 * MiB);
  p.ropeN = (float*)alloc((size_t)T * 32 * 8); p.ropeR = (float*)alloc((size_t)T * 64 * 8); p.posb = (float*)alloc(512 * 4); p.posp = (float*)alloc(32 * 512 * 4);
  p.H1 = (bf16_t*)alloc(2 * MiB); p.kcmp = (bf16_t*)alloc(8 * 256 * 64 * 2); p.vcmpT = (bf16_t*)alloc(8 * 64 * 256 * 2);
  p.selmask = (unsigned long long*)alloc((size_t)8 * T * 8);
  p.cnt = (int*)alloc(512 * 4); p.lists = (int*)alloc((size_t)NEXP * 16 * 2048 * 4); p.routew = (float*)alloc((size_t)M * 2 * 4);
  p.merged = (bf16_t*)(regionP); p.x1b = (bf16_t*)(regionP + 128 * MiB);
  p.EgT = (bf16_t*)(regionP + 32 * MiB); p.EdT = (bf16_t*)(regionP + 96 * MiB);
  p.Hh = (bf16_t*)(regionP + 160 * MiB); p.part = (bf16_t*)(regionP + 196 * MiB);
  p.bar = (unsigned*)alloc((XCD_BAR_WORDS + 64) * 4); p.qctr = p.bar + XCD_BAR_WORDS;
  p.xb = (bf16_t*)d_out; p.Rt = (bf16_t*)d_out; p.Ut = (bf16_t*)d_out + (size_t)16 * 1024 * 1024;
  if (off > ws_size) { fprintf(stderr, "workspace too small: need %zu have %zu\n", off, ws_size); return; }
#if FUSED
  static int grid_blocks = 0;
  if (!grid_blocks) {
    int dev = 0, cus = 0, per_cu = 0;
    (void)hipGetDevice(&dev);
    (void)hipDeviceGetAttribute(&cus, hipDeviceAttributeMultiprocessorCount, dev);
    (void)hipOccupancyMaxActiveBlocksPerMultiprocessor(&per_cu, mega_kernel, 256, 0);
    if (per_cu > 2) per_cu = 2;
    grid_blocks = cus * per_cu;
  }
  (void)hipMemsetAsync(p.bar, 0, (XCD_BAR_WORDS + 64) * 4, stream);
  void* args[] = {&p};
  hipError_t e = hipLaunchCooperativeKernel((void*)mega_kernel, dim3(grid_blocks), dim3(256), args, 0, stream);
  if (e != hipSuccess) fprintf(stderr, "coop launch failed: %s\n", hipGetErrorString(e));
#else
(void)hipMemsetAsync(p.bar, 0, (XCD_BAR_WORDS + 64) * 4, stream);
#define LAUNCH_PH(N) phase_kernel<N><<<512, 256, 0, stream>>>(p)
  LAUNCH_PH(0); LAUNCH_PH(1); LAUNCH_PH(2); LAUNCH_PH(3); LAUNCH_PH(4); LAUNCH_PH(5);
  LAUNCH_PH(6); LAUNCH_PH(7); LAUNCH_PH(8); LAUNCH_PH(9); LAUNCH_PH(10); LAUNCH_PH(11);
#endif
}
```

```cpp
#include <hip/hip_runtime.h>
#include <hip/hip_cooperative_groups.h>
#include <cstdio>
#include <cstdint>
namespace cg = cooperative_groups;

#ifndef FUSED
#define FUSED 1
#endif
#ifndef PROBE_DOUBLE
#define PROBE_DOUBLE 0
#endif
#ifndef PROBE_ROUTER
#define PROBE_ROUTER 0
#endif
#ifndef PROBE_PHASE
#define PROBE_PHASE -1
#endif

#define DI __device__ __forceinline__
typedef unsigned short bf16_t;
typedef short bf16x8 __attribute__((ext_vector_type(8)));
typedef float f32x4 __attribute__((ext_vector_type(4)));

constexpr int Bn = 4, T = 4096, D = 1024, M = Bn * T;
constexpr int NINP = 6528;
constexpr int NEXP = 32, DFF = 512;
constexpr int HROWS = 36864;
constexpr float ALPHA = 1.189207115002721f;

struct Params {
  const float *x, *w_in, *cmp_pos_k, *cmp_k_w1, *cmp_k_b1, *cmp_k_w2, *cmp_k_b2;
  const float *cmp_pos_v, *cmp_v_w1, *cmp_v_b1, *cmp_v_w2, *cmp_v_b2;
  const float *gn_g, *gn_b, *w_up_attn, *w_up_ret, *w_out, *ln1_g, *ln1_b;
  const float *rg_w, *rg_b, *ri_w, *ri_b, *e_wg, *e_wu, *e_wd, *ln2_g, *ln2_b;
  float* out;
  bf16_t *Qn, *CK, *CV, *SK, *SVt, *WK, *WVt; float* NG;
  bf16_t *RQ, *RK, *RKzT, *RVt, *RG, *MG;
  bf16_t *WinT  , *oattn, *oret;
  bf16_t *WaT, *WrT, *WoT, *W1kT, *W1vT;
  float *ropeN, *ropeR, *posb, *posp;
  bf16_t *H1, *kcmp, *vcmpT;
  unsigned long long* selmask;
  int* cnt; int* lists; float* routew;
  bf16_t *merged, *x1b, *EgT  , *EdT  , *Hh, *part;
  bf16_t *xb, *Rt, *Ut;
  unsigned* bar;
  unsigned* qctr;
};

DI float bf2f(bf16_t v) { return __uint_as_float(((unsigned)v) << 16); }
typedef __bf16 bf16x2_t __attribute__((ext_vector_type(2)));
DI bf16_t f2bf(float f) { return __builtin_bit_cast(bf16_t, (__bf16)f); }
DI unsigned pack2(float a, float b) { bf16x2_t v = {(__bf16)a, (__bf16)b}; return __builtin_bit_cast(unsigned, v); }
typedef float f32x16 __attribute__((ext_vector_type(16)));
#define MFMA32(a, b, c) __builtin_amdgcn_mfma_f32_32x32x16_bf16((a), (b), (c), 0, 0, 0)
DI float lo2f(unsigned u) { return __uint_as_float(u << 16); }
DI float hi2f(unsigned u) { return __uint_as_float(u & 0xffff0000u); }
DI float wsum(float v) {
  v += __int_as_float(__builtin_amdgcn_update_dpp(0, __float_as_int(v), 0x111, 0xf, 0xf, false));
  v += __int_as_float(__builtin_amdgcn_update_dpp(0, __float_as_int(v), 0x112, 0xf, 0xf, false));
  v += __int_as_float(__builtin_amdgcn_update_dpp(0, __float_as_int(v), 0x114, 0xf, 0xf, false));
  v += __int_as_float(__builtin_amdgcn_update_dpp(0, __float_as_int(v), 0x118, 0xf, 0xf, false));
  v += __int_as_float(__builtin_amdgcn_update_dpp(0, __float_as_int(v), 0x142, 0xa, 0xf, false));
  v += __int_as_float(__builtin_amdgcn_update_dpp(0, __float_as_int(v), 0x143, 0xc, 0xf, false));
  return __int_as_float(__builtin_amdgcn_readlane(__float_as_int(v), 63));
}
DI float wmax(float v) { for (int o = 32; o > 0; o >>= 1) v = fmaxf(v, __shfl_xor(v, o)); return v; }
DI float sigmoidf_(float x) { return 1.f / (1.f + __expf(-x)); }
#define WSYNC() asm volatile("s_waitcnt lgkmcnt(0)" ::: "memory")
DI size_t frag_off(int row, int k, int K) { return ((size_t)(((row >> 5) * (K >> 4) + (k >> 4)) * 2 + ((k >> 3) & 1))) * 256 + (row & 31) * 8 + (k & 7); }
DI float xh_max(float x) { const auto r_ = __builtin_amdgcn_permlane32_swap(__float_as_uint(x), __float_as_uint(x), false, false); return fmaxf(__uint_as_float(r_[0]), __uint_as_float(r_[1])); }
DI float xh_sum(float x) { const auto r_ = __builtin_amdgcn_permlane32_swap(__float_as_uint(x), __float_as_uint(x), false, false); return __uint_as_float(r_[0]) + __uint_as_float(r_[1]); }
DI int perm23(int r) { return (r & 0x13) | ((r & 4) << 1) | ((r & 8) >> 1); }
DI int opq(int x) { asm volatile("" : "+v"(x)); return x; }


#define XB_TMO      128
#define XB_XCNT(j)  (256  + 64 * (j))
#define XB_XSUB(j)  (1280 + 64 * (j))
#define XB_XGEN(j)  (2304 + 64 * (j))
#define XB_TOP      3328
#define XB_TOPGEN   3392
#define XCD_BAR_WORDS 3456
#define XB_SPIN_CAP (1u << 20)
#define LAS __attribute__((address_space(3)))
DI unsigned xb_ld(unsigned* p) { return __hip_atomic_load(p, __ATOMIC_RELAXED, __HIP_MEMORY_SCOPE_AGENT); }
DI unsigned xb_add(unsigned* p, unsigned v) { return __hip_atomic_fetch_add(p, v, __ATOMIC_RELAXED, __HIP_MEMORY_SCOPE_AGENT); }
DI unsigned xb_xcc_id() { return (unsigned)__builtin_amdgcn_s_getreg((3 << 11) | 20) & 0xFu; }
#define XB_SPIN(cond, bar) do { unsigned _sp = 0; while (cond) { __builtin_amdgcn_s_sleep(1); \
    if ((++_sp & 255u) == 0u) { if (xb_ld(&(bar)[XB_TMO])) break; if (_sp > XB_SPIN_CAP) { atomicAdd(&(bar)[XB_TMO], 1u); break; } } } } while (0)
struct XcdBarrier { unsigned* bar; unsigned x; volatile LAS unsigned* st; };
DI XcdBarrier xcd_barrier_post(unsigned* bar, volatile LAS unsigned* st) {
  XcdBarrier b; b.bar = bar; b.x = xb_xcc_id(); b.st = st;
  if (threadIdx.x == 0) (void)xb_add(&bar[XB_XCNT(b.x)], 1u);
  return b;
}
DI void xcd_barrier_complete(unsigned* bar, unsigned x, unsigned& nloc, unsigned& nx) {
  const unsigned G = gridDim.x * gridDim.y * gridDim.z;
  unsigned sum, cnt, mine, sp = 0u;
  for (;;) {
    sum = 0u; cnt = 0u; mine = 0u;
#pragma unroll
    for (unsigned j = 0; j < 16; ++j) { const unsigned c = xb_ld(&bar[XB_XCNT(j)]); sum += c; cnt += (c > 0u) ? 1u : 0u; mine = (j == x) ? c : mine; }
    if (sum == G) break;
    __builtin_amdgcn_s_sleep(1);
    if ((++sp & 255u) == 0u) { if (xb_ld(&bar[XB_TMO])) break; if (sp > XB_SPIN_CAP) { atomicAdd(&bar[XB_TMO], 1u); break; } }
  }
  nloc = mine > 0u ? mine : 1u; nx = cnt > 0u ? cnt : 1u;
}
DI void xcd_barrier(const XcdBarrier& b) {
  asm volatile("s_waitcnt vmcnt(0)" ::: "memory");
  __syncthreads();
  if (threadIdx.x == 0) {
    unsigned* bar = b.bar;
    __builtin_amdgcn_s_waitcnt(0);
    unsigned nloc = b.st[0], nx = b.st[1];
    if (nloc == 0u) { xcd_barrier_complete(bar, b.x, nloc, nx); b.st[0] = nloc; b.st[1] = nx; }
    const unsigned old = xb_add(&bar[XB_XSUB(b.x)], 1u);
    const unsigned gen = old / nloc;
    if (old + 1u == (gen + 1u) * nloc) {
      __builtin_amdgcn_fence(__ATOMIC_RELEASE, "agent");
      asm volatile("s_waitcnt vmcnt(0)" ::: "memory");
      const unsigned og = xb_add(&bar[XB_TOP], 1u);
      const unsigned tg = og / nx;
      if (og + 1u == (tg + 1u) * nx) xb_add(&bar[XB_TOPGEN], 1u);
      else XB_SPIN(xb_ld(&bar[XB_TOPGEN]) == tg, bar);
      __builtin_amdgcn_fence(__ATOMIC_ACQUIRE, "agent");
      xb_add(&bar[XB_XGEN(b.x)], 1u);
      asm volatile("s_waitcnt vmcnt(0)" ::: "memory");
    } else {
      XB_SPIN(xb_ld(&bar[XB_XGEN(b.x)]) == gen, bar);
      __builtin_amdgcn_fence(__ATOMIC_ACQUIRE, "agent");
      asm volatile("s_waitcnt vmcnt(0)" ::: "memory");
    }
  }
  __syncthreads();
}

DI void glds16_asm(const void* gsrc, unsigned lds_dst) {
  unsigned keep;
  asm volatile("s_mov_b32 %0, m0\n\ts_mov_b32 m0, %2\n\ts_nop 0\n\tglobal_load_lds_dwordx4 %1, off\n\ts_mov_b32 m0, %0" : "=&s"(keep) : "v"(gsrc), "s"(lds_dst) : "memory");
}
template <bool SWAP, class AR, class BR>
DI void gemm128(f32x4 (&acc)[4][4], AR arow, BR brow, int K, char* smem) {
  const int tid = opq(threadIdx.x), lane = tid & 63, wave = tid >> 6, wr = wave >> 1, wc = wave & 1;
  const int prow = lane >> 3, pch = ((lane & 7) ^ prow) << 3;
  const bf16_t* ap[4]; const bf16_t* bp[4];
#pragma unroll
  for (int i = 0; i < 4; i++) { ap[i] = arow((wave * 4 + i) * 8 + prow) + pch; bp[i] = brow((wave * 4 + i) * 8 + prow) + pch; }
  const unsigned ldsb = (unsigned)(size_t)(LAS char*)smem;
  const unsigned lpiece = __builtin_amdgcn_readfirstlane(wave * 4096);
  char* As = smem; char* Bs = smem + 32768;
  const int nk = K >> 6;
  const int fr = lane & 15, fq = lane >> 4;
  const int aoff0 = (wr * 64 + fr) * 128, boff0 = (wc * 64 + fr) * 128;
  auto gload = [&](int t, int buf) {
#pragma unroll
    for (int i = 0; i < 4; i++) {
      glds16_asm(ap[i] + t * 64, ldsb + buf * 16384 + lpiece + i * 1024);
      glds16_asm(bp[i] + t * 64, ldsb + 32768 + buf * 16384 + lpiece + i * 1024);
    }
  };
  auto gcomp = [&](int buf) {
    const char* Ac = As + buf * 16384; const char* Bc = Bs + buf * 16384;
#pragma unroll
    for (int ks = 0; ks < 2; ks++) {
      const int chs = ((ks * 4 + fq) ^ (fr & 7)) << 4;
      bf16x8 a[4], b[4];
#pragma unroll
      for (int mt = 0; mt < 4; mt++) a[mt] = *(const bf16x8*)(Ac + aoff0 + mt * 2048 + chs);
#pragma unroll
      for (int nt = 0; nt < 4; nt++) b[nt] = *(const bf16x8*)(Bc + boff0 + nt * 2048 + chs);
      __builtin_amdgcn_s_setprio(1);
#pragma unroll
      for (int mt = 0; mt < 4; mt++)
#pragma unroll
        for (int nt = 0; nt < 4; nt++)
          acc[mt][nt] = SWAP ? __builtin_amdgcn_mfma_f32_16x16x32_bf16(b[nt], a[mt], acc[mt][nt], 0, 0, 0)
                             : __builtin_amdgcn_mfma_f32_16x16x32_bf16(a[mt], b[nt], acc[mt][nt], 0, 0, 0);
      __builtin_amdgcn_s_setprio(0);
    }
  };
  asm volatile("s_waitcnt vmcnt(0)" ::: "memory");
  gload(0, 0);
  asm volatile("s_waitcnt vmcnt(0)" ::: "memory");
  __builtin_amdgcn_s_barrier();
#pragma unroll 1
  for (int kt = 0; kt < nk; kt++) {
    const int cur = kt & 1;
    if (kt + 1 < nk) gload(kt + 1, cur ^ 1);
    gcomp(cur);
    asm volatile("s_waitcnt vmcnt(0)" ::: "memory");
    __builtin_amdgcn_s_barrier();
  }
}
template <bool SWAP, class AR, class BC>
DI void gemm128f(f32x4 (&acc)[4][4], AR arow, BC bcol, int ldb, int K, char* smem) {
  const int tid = opq(threadIdx.x), lane = tid & 63, wave = tid >> 6, wr = wave >> 1, wc = wave & 1;
  const int srow = tid >> 3, sch = tid & 7;
  const int bn = tid & 127, bh = tid >> 7;
  const bf16_t* ap[4];
#pragma unroll
  for (int i = 0; i < 4; i++) ap[i] = arow(srow + 32 * i) + sch * 8;
  const float* bq = bcol(bn) + (size_t)(bh * 32) * ldb;
  const int woff = srow * 128 + ((sch ^ (srow & 7)) << 4);
  char* As = smem; char* Bs = smem + 32768;
  uint4 ra[4]; float rb[4][8];
  auto bload = [&](int kt) {
    const float* q = bq + (size_t)kt * 64 * ldb;
#pragma unroll
    for (int i = 0; i < 4; i++)
#pragma unroll
      for (int j = 0; j < 8; j++) rb[i][j] = q[(size_t)(i * 8 + j) * ldb];
  };
  auto bwrite = [&](char* Bd) {
#pragma unroll
    for (int i = 0; i < 4; i++) {
      uint4 u; u.x = pack2(rb[i][0], rb[i][1]); u.y = pack2(rb[i][2], rb[i][3]); u.z = pack2(rb[i][4], rb[i][5]); u.w = pack2(rb[i][6], rb[i][7]);
      *(uint4*)(Bd + bn * 128 + ((((bh * 4 + i)) ^ (bn & 7)) << 4)) = u;
    }
  };
#pragma unroll
  for (int i = 0; i < 4; i++) ra[i] = *(const uint4*)(ap[i]);
  bload(0);
#pragma unroll
  for (int i = 0; i < 4; i++) *(uint4*)(As + woff + i * 4096) = ra[i];
  bwrite(Bs);
  __syncthreads();
  const int nk = K >> 6;
  const int fr = lane & 15, fq = lane >> 4;
  const int aoff0 = (wr * 64 + fr) * 128, boff0 = (wc * 64 + fr) * 128;
  for (int kt = 0; kt < nk; kt++) {
    const int cur = kt & 1;
    if (kt + 1 < nk) {
#pragma unroll
      for (int i = 0; i < 4; i++) ra[i] = *(const uint4*)(ap[i] + (kt + 1) * 64);
      bload(kt + 1);
    }
    const char* Ac = As + cur * 16384; const char* Bc = Bs + cur * 16384;
#pragma unroll
    for (int ks = 0; ks < 2; ks++) {
      const int chs = ((ks * 4 + fq) ^ (fr & 7)) << 4;
      bf16x8 a[4], b[4];
#pragma unroll
      for (int mt = 0; mt < 4; mt++) a[mt] = *(const bf16x8*)(Ac + aoff0 + mt * 2048 + chs);
#pragma unroll
      for (int nt = 0; nt < 4; nt++) b[nt] = *(const bf16x8*)(Bc + boff0 + nt * 2048 + chs);
#pragma unroll
      for (int mt = 0; mt < 4; mt++)
#pragma unroll
        for (int nt = 0; nt < 4; nt++)
          acc[mt][nt] = SWAP ? __builtin_amdgcn_mfma_f32_16x16x32_bf16(b[nt], a[mt], acc[mt][nt], 0, 0, 0)
                             : __builtin_amdgcn_mfma_f32_16x16x32_bf16(a[mt], b[nt], acc[mt][nt], 0, 0, 0);
    }
    if (kt + 1 < nk) {
      char* An = As + (cur ^ 1) * 16384;
#pragma unroll
      for (int i = 0; i < 4; i++) *(uint4*)(An + woff + i * 4096) = ra[i];
      bwrite(Bs + (cur ^ 1) * 16384);
    }
    __syncthreads();
  }
}
DI void zero_acc(f32x4 (&acc)[4][4]) {
#pragma unroll
  for (int i = 0; i < 4; i++)
#pragma unroll
    for (int j = 0; j < 4; j++) acc[i][j] = (f32x4){0.f, 0.f, 0.f, 0.f};
}
template <bool SWAP, class F>
DI void epilogue(const f32x4 (&acc)[4][4], F f) {
  const int lane = opq(threadIdx.x) & 63, wave = opq(threadIdx.x) >> 6, wr = wave >> 1, wc = wave & 1, fr = lane & 15, fq = lane >> 4;
#pragma unroll
  for (int mt = 0; mt < 4; mt++)
#pragma unroll
    for (int nt = 0; nt < 4; nt++) {
      if (SWAP) f(wr * 64 + mt * 16 + fr, wc * 64 + nt * 16 + fq * 4, acc[mt][nt]);
      else f(wr * 64 + mt * 16 + fq * 4, wc * 64 + nt * 16 + fr, acc[mt][nt]);
    }
}

template <class CP>
DI void tcvt_tile(CP colptr, int ldsrc, bf16_t* dst, int K, int kt, int jt, float* tile) {
  const int tx = opq(threadIdx.x) & 63, ty = opq(threadIdx.x) >> 6;
  const float* sp = colptr(jt * 64 + tx);
  for (int i = ty; i < 64; i += 4) tile[i * 65 + tx] = sp ? sp[(size_t)(kt * 64 + i) * ldsrc] : 0.f;
  __syncthreads();
  for (int i = ty * 2 + (tx >> 5); i < 64; i += 8) {
    const int kk = (tx & 31) * 2;
    *(unsigned*)(dst + (size_t)(jt * 64 + i) * K + kt * 64 + kk) = pack2(tile[kk * 65 + i], tile[(kk + 1) * 65 + i]);
  }
  __syncthreads();
}
template <class CP>
DI void tcvt_all(CP colptr, int ldsrc, bf16_t* dst, int K, int N, float* tile, int bid, int nb) {
  const int nkt = K / 64, njt = N / 64;
  for (int t = bid; t < nkt * njt; t += nb) tcvt_tile(colptr, ldsrc, dst, K, t / njt, t % njt, tile);
}

template <class CP>
DI void tcvt_tile128(CP colptr, int ldsrc, bf16_t* dst, int K, int kt, int jt, float* tile  ) {
  const int tid = opq(threadIdx.x), tx = tid & 127, ty = tid >> 7;
  const float* sp0 = colptr(jt * 128 + tx);
  const float* sp = sp0 + (size_t)(kt * 64 + ty) * ldsrc;
  float v[32];
  if (sp0) {
#pragma unroll
    for (int i = 0; i < 32; i++) v[i] = sp[(size_t)(2 * i) * ldsrc];
  } else {
#pragma unroll
    for (int i = 0; i < 32; i++) v[i] = 0.f;
  }
#pragma unroll
  for (int i = 0; i < 32; i++) tile[(ty + 2 * i) * 129 + tx] = v[i];
  __syncthreads();
  const int pp = (tid & 31) * 2, j0 = tid >> 5;
#pragma unroll
  for (int i = 0; i < 16; i++) {
    const int j = j0 + 8 * i;
    *(unsigned*)(dst + (size_t)(jt * 128 + j) * K + kt * 64 + pp) = pack2(tile[pp * 129 + j], tile[(pp + 1) * 129 + j]);
  }
  __syncthreads();
}
DI int perm_half(int p, int d) { return (p & 1) ? (d / 2 + (p >> 1)) : (p >> 1); }
DI int inproj_col(int j) {
  if (j < 512) return (j & ~63) + perm_half(j & 63, 64);
  if (j < 1280) { const int grp = (j - 512) >> 7;
    if (grp == 2 || grp == 4) return (j & ~63) + perm_half(j & 63, 64);
    return j; }
  if (j < 1792) { const int q = j - 1280; return 1304 + (q & ~127) + perm_half(q & 127, 128); }
  if (j < 2304) { const int q = j - 1792; return 1816 + (q & ~127) + perm_half(q & 127, 128); }
  if (j < 3328) return 2328 + (j - 2304);
  if (j < 4352) return 3352 + (j - 3328);
  if (j < 6400) return 4376 + (j - 4352);
  const int q = j - 6400; return q < 24 ? 1280 + q : -1;
}

DI void phase0(const Params& p, char* smem) {
  const int bid = blockIdx.x, nb = gridDim.x, tid = opq(threadIdx.x);
  const size_t gtid = (size_t)bid * 256 + tid, gsz = (size_t)nb * 256;
  for (size_t i = gtid; i < (size_t)M * D / 4; i += gsz) {
    const float4 v = ((const float4*)p.x)[i];
    uint2 o; o.x = pack2(v.x, v.y); o.y = pack2(v.z, v.w);
    ((uint2*)p.xb)[i] = o;
  }
  float* tile = (float*)smem;
  for (int tt = bid; tt < 1264; tt += nb) {
    if (tt < 816) { const float* w = p.w_in; tcvt_tile128([=](int j) -> const float* { const int c = inproj_col(j); return c >= 0 ? w + c : nullptr; }, 6424, p.WinT, 1024, tt / 51, tt % 51, tile); }
    else if (tt < 880) { const int q = tt - 816; const float* w = p.w_up_attn; tcvt_tile128([=](int j) -> const float* { return w + j; }, 1024, p.WaT, 512, q >> 3, q & 7, tile); }
    else if (tt < 1008) { const int q = tt - 880; const float* w = p.w_up_ret; tcvt_tile128([=](int j) -> const float* { return w + j; }, 1024, p.WrT, 1024, q >> 3, q & 7, tile); }
    else if (tt < 1136) { const int q = tt - 1008; const float* w = p.w_out; tcvt_tile128([=](int j) -> const float* { return w + j; }, 1024, p.WoT, 1024, q >> 3, q & 7, tile); }
    else if (tt < 1200) { const int q = tt - 1136; const float* w = p.cmp_k_w1; tcvt_tile128([=](int j) -> const float* { return w + j; }, 256, p.W1kT, 2048, q >> 1, q & 1, tile); }
    else { const int q = tt - 1200; const float* w = p.cmp_v_w1; tcvt_tile128([=](int j) -> const float* { return w + j; }, 256, p.W1vT, 2048, q >> 1, q & 1, tile); }
  }
  for (size_t i = gtid; i < (size_t)T * 96; i += gsz) {
    const int t = (int)(i / 96), r = (int)(i % 96);
    float invf; float* dst;
    if (r < 32) { invf = (float)exp2(-(double)r * (2.0 / 64.0) * 13.287712379549449); dst = p.ropeN + ((size_t)t * 32 + r) * 2; }
    else { const int q = r - 32; invf = (float)exp2(-(double)q * (2.0 / 128.0) * 13.287712379549449); dst = p.ropeR + ((size_t)t * 64 + q) * 2; }
    const double ang = (double)((float)t * invf);
    const double kk = rint(ang * 0.15915494309189535);
    const float red = (float)(ang - kk * 6.283185307179586);
    dst[0] = cosf(red); dst[1] = sinf(red);
  }
  for (size_t i = gtid; i < 32 * 512; i += gsz) {
    const int qp = (int)(i >> 9), kv = (int)((i >> 8) & 1), j = (int)(i & 255);
    const float* pos = kv ? p.cmp_pos_v : p.cmp_pos_k; const float* w1 = kv ? p.cmp_v_w1 : p.cmp_k_w1;
    float s0 = 0.f;
#pragma unroll 8
    for (int q = qp * 64; q < qp * 64 + 64; q++) s0 += pos[q] * w1[(size_t)q * 256 + j];
    p.posp[i] = s0;
  }
  if (gtid < 512) p.cnt[gtid] = 0;
}

template <bool TRANS, class PROC, class DST>
DI void epilogue_lds(const f32x4 (&acc)[4][4], PROC proc, DST dst, char* smem) {
  const int tid = opq(threadIdx.x), lane = tid & 63, wave = tid >> 6, wr = wave >> 1, wc = wave & 1, fr = lane & 15, fq = lane >> 4;
#pragma unroll
  for (int mt = 0; mt < 4; mt++)
#pragma unroll
    for (int nt = 0; nt < 4; nt++) {
      const int r = wr * 64 + mt * 16 + (TRANS ? fq * 4 : fr), c = wc * 64 + nt * 16 + (TRANS ? fr : fq * 4);
      const uint2 o = proc(r, c, acc[mt][nt]);
      *(uint2*)(smem + (TRANS ? c * 272 + r * 2 : r * 272 + c * 2)) = o;
    }
  __syncthreads();
#pragma unroll
  for (int k = 0; k < 8; k++) {
    const int id = tid + 256 * k, i = id >> 4, j8 = (id & 15) * 8;
    *(uint4*)dst(i, j8) = *(const uint4*)(smem + i * 272 + j8 * 2);
  }
  __syncthreads();
}
DI void inproj_tile(const Params& p, int mt_, int nt_, char* smem) {
  const int m0 = mt_ * 128, b = m0 >> 12, t0 = m0 & 4095;
  const bf16_t* A = p.xb + (size_t)m0 * D; const bf16_t* Bt = p.WinT + (size_t)nt_ * 128 * D;
  f32x4 acc[4][4]; zero_acc(acc);
  auto ar = [=](int r) { return A + (size_t)r * D; };
  auto br = [=](int r) { return Bt + (size_t)r * D; };
  auto plain = [](int, int, f32x4 v) { uint2 o; o.x = pack2(v[0], v[1]); o.y = pack2(v[2], v[3]); return o; };
  const bool transposed = (nt_ == 7 || nt_ == 9 || (nt_ >= 18 && nt_ < 26));
  if (transposed) {
    gemm128<false>(acc, ar, br, D, smem);
    if (nt_ < 18) { bf16_t* base = ((nt_ == 7) ? p.SVt : p.WVt) + (size_t)b * 2 * 64 * T + t0;
      epilogue_lds<true>(acc, plain, [=](int c, int r8) { return base + (size_t)c * T + r8; }, smem); }
    else { const int h = (nt_ - 18) >> 1, e0 = ((nt_ - 18) & 1) * 128; bf16_t* base = p.RVt + (size_t)(b * 4 + h) * 256 * T;
      epilogue_lds<true>(acc, plain, [=](int c, int r8) { return base + frag_off(e0 + c, t0 + r8, T); }, smem); }
    return;
  }
  gemm128<true>(acc, ar, br, D, smem);
  if (nt_ < 4 || nt_ == 6 || nt_ == 8) {
    const float sc = nt_ < 4 ? 0.18033688011112042f : 1.f;
    bf16_t* base = (nt_ < 4) ? p.Qn + ((size_t)(b * 8 + nt_ * 2) * T + t0) * 64 : ((nt_ == 6) ? p.SK : p.WK) + ((size_t)(b * 2) * T + t0) * 64;
    epilogue_lds<false>(acc, [=](int r, int c, f32x4 v) {
      const float4 cs = *(const float4*)(p.ropeN + ((size_t)(t0 + r) * 32 + ((c & 63) >> 1)) * 2);
      uint2 o; o.x = pack2((v[0] * cs.x - v[1] * cs.y) * sc, (v[0] * cs.y + v[1] * cs.x) * sc); o.y = pack2((v[2] * cs.z - v[3] * cs.w) * sc, (v[2] * cs.w + v[3] * cs.z) * sc);
      return o; }, [=](int r, int c8) { return base + ((size_t)(c8 >> 6) * T + r) * 64 + (c8 & 63); }, smem);
  } else if (nt_ == 4 || nt_ == 5) {
    bf16_t* base = (nt_ == 4 ? p.CK : p.CV) + ((size_t)(b * 2) * T + t0) * 64;
    epilogue_lds<false>(acc, plain, [=](int r, int c8) { return base + ((size_t)(c8 >> 6) * T + r) * 64 + (c8 & 63); }, smem);
  } else if (nt_ >= 10 && nt_ < 18) {
    const bool isk = nt_ >= 14; const int h = (nt_ - 10) & 3;
    const float sc = isk ? 0.08838834764831845f : 1.f;
    bf16_t* base = (isk ? p.RK : p.RQ) + (size_t)(b * 4 + h) * T * 128;
    auto roped = [=](int r, int c, f32x4 v, float z) {
      const float4 cs = *(const float4*)(p.ropeR + ((size_t)(t0 + r) * 64 + (c >> 1)) * 2);
      const float s2 = sc * z;
      uint2 o; o.x = pack2((v[0] * cs.x - v[1] * cs.y) * s2, (v[0] * cs.y + v[1] * cs.x) * s2); o.y = pack2((v[2] * cs.z - v[3] * cs.w) * s2, (v[2] * cs.w + v[3] * cs.z) * s2);
      return o; };
    epilogue_lds<false>(acc, [=](int r, int c, f32x4 v) { return roped(r, c, v, 1.f); }, [=](int r, int c8) { return base + frag_off(t0 + r, c8, 128); }, smem);
    if (isk) {
      const float lg = log2f(1.f - exp2f(-5.f - (float)h));
      bf16_t* bz = p.RKzT + (size_t)(b * 4 + h) * 128 * T;
      const int tid = opq(threadIdx.x), lane = tid & 63, wave = tid >> 6, wr = wave >> 1, wc = wave & 1, fr = lane & 15, fq = lane >> 4;
#pragma unroll
      for (int mt = 0; mt < 4; mt++)
#pragma unroll
        for (int nt = 0; nt < 4; nt++) {
          const int r = wr * 64 + mt * 16 + fr, c = wc * 64 + nt * 16 + fq * 4;
          const uint2 o = roped(r, c, acc[mt][nt], exp2f((float)(127 - ((t0 + r) & 127)) * lg));
          bf16_t* q = (bf16_t*)(smem + c * 272 + r * 2);
          q[0] = (bf16_t)(o.x & 0xffffu); q[136] = (bf16_t)(o.x >> 16); q[272] = (bf16_t)(o.y & 0xffffu); q[408] = (bf16_t)(o.y >> 16);
        }
      __syncthreads();
#pragma unroll
      for (int k = 0; k < 8; k++) {
        const int id = tid + 256 * k, i = id >> 4, j8 = (id & 15) * 8;
        *(uint4*)(bz + frag_off(i, t0 + j8, T)) = *(const uint4*)(smem + i * 272 + j8 * 2);
      }
      __syncthreads();
    }
  } else if (nt_ >= 26 && nt_ < 34) {
    bf16_t* base = p.RG + (size_t)m0 * 1024 + (nt_ - 26) * 128;
    epilogue_lds<false>(acc, plain, [=](int r, int c8) { return base + (size_t)r * 1024 + c8; }, smem);
  } else if (nt_ >= 34 && nt_ < 50) {
    bf16_t* base = p.MG + (size_t)m0 * 2048 + (nt_ - 34) * 128;
    epilogue_lds<false>(acc, plain, [=](int r, int c8) { return base + (size_t)r * 2048 + c8; }, smem);
  } else {
    epilogue<true>(acc, [&](int r, int c, f32x4 v) {
      if (c < 24) { float4 o; o.x = sigmoidf_(v[0]); o.y = sigmoidf_(v[1]); o.z = sigmoidf_(v[2]); o.w = sigmoidf_(v[3]);
        *(float4*)(p.NG + (size_t)(m0 + r) * 24 + c) = o; }
    });
  }
}
DI void phase1(const Params& p, char* smem) {
  if (blockIdx.x < 2) {
    const int i = blockIdx.x * 256 + opq(threadIdx.x), kv = i >> 8, j = i & 255;
    float s0 = (kv ? p.cmp_v_b1 : p.cmp_k_b1)[j];
    for (int qp = 0; qp < 32; qp++) s0 += p.posp[qp * 512 + i];
    p.posb[i] = s0;
  }
  const int xcd = blockIdx.x & 7, lb = blockIdx.x >> 3, nlb = gridDim.x >> 3;
  for (int li = lb; li < 16 * 51; li += nlb) {
    const int mi = li & 7, rest = li >> 3, nt_ = rest % 51, half = rest / 51;
    inproj_tile(p, xcd * 16 + half * 8 + mi, nt_, smem);
  }
}


DI void attn_unit(const Params& p, int unit, char* smem) {
  const int tid = opq(threadIdx.x), lane = tid & 63, w = tid >> 6, r = lane & 31, h2 = lane >> 5;
  const int bg = unit >> 6, jq = unit & 63, b = bg >> 1, g = bg & 1, hh = g * 4 + w, t0 = jq * 64;
  bf16x8 qf[2][4];
#pragma unroll
  for (int qt = 0; qt < 2; qt++)
#pragma unroll
    for (int ks = 0; ks < 4; ks++)
      qf[qt][ks] = *(const bf16x8*)(p.Qn + ((size_t)(b * 8 + hh) * T + t0 + qt * 32 + r) * 64 + ks * 16 + h2 * 8);
  unsigned long long* sell = (unsigned long long*)(smem + 49152) + tid * 2;
#pragma unroll
  for (int qt = 0; qt < 2; qt++) sell[qt] = p.selmask[(size_t)bg * T + t0 + qt * 32 + r];
  const int wlo = jq > 8 ? jq - 8 : 0, nwin = jq - wlo + 1, nsteps = nwin + jq + 1;
  char* Kl = smem; char* Vl = smem + 24576;
  const unsigned ldsK = (unsigned)(size_t)(LAS char*)smem;
  auto gload = [&](int i, int buf) {
    const int ln_ = opq(lane), grow = ln_ >> 3;
    const int br = i < nwin ? 2 : 1, j = i < nwin ? wlo + i : i - nwin;
    const bf16_t* Kp = (br == 1 ? p.SK : p.WK) + ((size_t)bg * T + j * 64) * 64;
    const bf16_t* Vp = (br == 1 ? p.SVt : p.WVt) + (size_t)bg * 64 * T + j * 64;
#pragma unroll
    for (int pc = 0; pc < 2; pc++) {
      const int row = (w * 2 + pc) * 8 + grow;
      const int gch = (ln_ & 7) ^ ((row >> 1) & 7);
      const unsigned loff = __builtin_amdgcn_readfirstlane(buf * 8192 + (w * 2 + pc) * 1024);
      glds16_asm(Kp + row * 64 + gch * 8, ldsK + loff);
      glds16_asm(Vp + (size_t)row * T + gch * 8, ldsK + 24576 + loff);
    }
  };
  const int pr = perm23(r);
  unsigned mbias[2]; f32x16 O[2][2];
  float* mrow = (float*)(smem + 53248) + tid * 4;
  float* lrow = mrow + 2;
  uint4 ao4 = {h2 == 0 ? 0x3F803F80u : 0u, 0u, 0u, 0u};
  const bf16x8 aones = __builtin_bit_cast(bf16x8, ao4);
  uint4 bb4 = {0u, 0u, 0u, 0u};
  auto reset = [&]() {
#pragma unroll
    for (int qt = 0; qt < 2; qt++) { mrow[qt] = -INFINITY; lrow[qt] = 0.f; mbias[qt] = 0u;
#pragma unroll
      for (int dt = 0; dt < 2; dt++)
#pragma unroll
        for (int i = 0; i < 16; i++) O[dt][qt][i] = 0.f; }
  };
  auto flush = [&](int br) {
#pragma unroll
    for (int qt = 0; qt < 2; qt++) {
      const int m = opq(b * T + t0 + qt * 32 + r);
      const float gate = p.NG[(size_t)m * 24 + hh * 3 + br];
      const float sc = lrow[qt] > 0.f ? gate / lrow[qt] : 0.f;
#pragma unroll
      for (int dt = 0; dt < 2; dt++)
#pragma unroll
        for (int q4 = 0; q4 < 4; q4++) {
          bf16_t* dst = p.oattn + (size_t)m * 512 + hh * 64 + dt * 32 + (q4 & 1) * 4 + (q4 >> 1) * 16 + h2 * 8;
          const uint2 old = *(const uint2*)dst;
          uint2 o; o.x = pack2(lo2f(old.x) + sc * O[dt][qt][q4 * 4], hi2f(old.x) + sc * O[dt][qt][q4 * 4 + 1]);
          o.y = pack2(lo2f(old.y) + sc * O[dt][qt][q4 * 4 + 2], hi2f(old.y) + sc * O[dt][qt][q4 * 4 + 3]);
          *(uint2*)dst = o;
        }
    }
  };
  reset();
#pragma unroll
  for (int qt = 0; qt < 2; qt++)
#pragma unroll
    for (int ks = 0; ks < 4; ks++) asm volatile("" :: "v"(qf[qt][ks]));
  gload(0, 0);
  if (nsteps > 1) { gload(1, 1); asm volatile("s_waitcnt vmcnt(4)" ::: "memory"); } else asm volatile("s_waitcnt vmcnt(0)" ::: "memory");
  __builtin_amdgcn_s_barrier();
  int cur = 0;
  const f32x16 zero16 = {0.f, 0.f, 0.f, 0.f, 0.f, 0.f, 0.f, 0.f, 0.f, 0.f, 0.f, 0.f, 0.f, 0.f, 0.f, 0.f};
#define QK_ALL(S) { \
    _Pragma("unroll") for (int qt = 0; qt < 2; qt++) { \
      unsigned w0 = mbias[qt]; \
      if (mmode == 1) w0 = ((sell[qt] >> j) & 1ull) ? w0 : 0x0000FF80u;       \
      bb4.x = h2 == 0 ? w0 : 0u; \
      const bf16x8 bbias = __builtin_bit_cast(bf16x8, bb4); \
      _Pragma("unroll") for (int kt2 = 0; kt2 < 2; kt2++) S[qt][kt2] = MFMA32(aones, bbias, zero16); } \
    _Pragma("unroll") for (int kt2 = 0; kt2 < 2; kt2++) \
      _Pragma("unroll") for (int ks = 0; ks < 4; ks++) { \
        const bf16x8 a_ = *(const bf16x8*)(Kc + (kt2 * 32 + pr) * 128 + (((ks * 2 + h2) ^ ((pr >> 1) & 7)) << 4));     \
        _Pragma("unroll") for (int qt = 0; qt < 2; qt++) S[qt][kt2] = MFMA32(a_, qf[qt][ks], S[qt][kt2]); } \
    if (mmode == 2) { \
      const int kb_ = opq(j * 64 + 8 * h2);         \
      _Pragma("unroll") for (int qt = 0; qt < 2; qt++) { \
        const int t = t0 + qt * 32 + opq(r); \
        const bool selb = (br == 2) || ((sell[qt] >> j) & 1ull); \
        const int khi = t, klo = (br == 2) ? t - 511 : 0; \
        _Pragma("unroll") for (int kt2 = 0; kt2 < 2; kt2++) \
          _Pragma("unroll") for (int ii = 0; ii < 16; ii++) { \
            const int key = kb_ + kt2 * 32 + (ii & 7) + 16 * (ii >> 3); \
            S[qt][kt2][ii] = (selb && key <= khi && key >= klo) ? S[qt][kt2][ii] : -INFINITY; } } } }
#define EXP_ALL(S, rs) { \
    _Pragma("unroll") for (int qt = 0; qt < 2; qt++) { rs[qt] = 0.f; \
      _Pragma("unroll") for (int kt2 = 0; kt2 < 2; kt2++) \
        _Pragma("unroll") for (int ii = 0; ii < 16; ii++) { const float pv_ = __builtin_amdgcn_exp2f(S[qt][kt2][ii]); S[qt][kt2][ii] = pv_; rs[qt] += pv_; } } }
#pragma unroll 1
  for (int i = 0; i < nsteps; i++) {
    const int br = i < nwin ? 2 : 1, j = i < nwin ? wlo + i : i - nwin;
    if (i == nwin) { flush(2); reset(); }
    if (i + 2 < nsteps) gload(i + 2, cur == 0 ? 2 : cur - 1);
    const char* Kc = Kl + cur * 8192; const char* Vc = Vl + cur * 8192;
    const int mmode = (br == 2) ? ((j == jq || j + 8 == jq) ? 2 : 0) : (j == jq ? 2 : 1);
    f32x16 S[2][2];
    QK_ALL(S);
    float rs[2];
    EXP_ALL(S, rs);
    if (__any(fmaxf(rs[0], rs[1]) > 65536.f)) {
      QK_ALL(S);
#pragma unroll
      for (int qt = 0; qt < 2; qt++) {
        float mx = -INFINITY;
#pragma unroll
        for (int kt2 = 0; kt2 < 2; kt2++)
#pragma unroll
          for (int ii = 0; ii < 16; ii++) mx = fmaxf(mx, S[qt][kt2][ii]);
        mx = xh_max(mx);
        const float msafe0 = (mrow[qt] == -INFINITY) ? 0.f : mrow[qt];
        const float mn = msafe0 + fmaxf(mx, 0.f);
        const float mhi = bf2f(f2bf(mn)), mlo = bf2f(f2bf(mn - mhi)), mq = mhi + mlo;
        const float dl = mq - msafe0;
        const float alpha = __builtin_amdgcn_exp2f(-dl);
        lrow[qt] *= alpha; mrow[qt] = mq; mbias[qt] = pack2(-mhi, -mlo);
#pragma unroll
        for (int dt = 0; dt < 2; dt++)
#pragma unroll
          for (int ii = 0; ii < 16; ii++) O[dt][qt][ii] *= alpha;
#pragma unroll
        for (int kt2 = 0; kt2 < 2; kt2++)
#pragma unroll
          for (int ii = 0; ii < 16; ii++) S[qt][kt2][ii] -= dl;
      }
      EXP_ALL(S, rs);
    }
#pragma unroll
    for (int qt = 0; qt < 2; qt++) lrow[qt] += xh_sum(rs[qt]);
    bf16x8 P[2][4];
#pragma unroll
    for (int qt = 0; qt < 2; qt++)
#pragma unroll
      for (int kt2 = 0; kt2 < 2; kt2++)
#pragma unroll
        for (int s2 = 0; s2 < 2; s2++) {
          uint4 u;
          u.x = pack2(S[qt][kt2][8 * s2 + 0], S[qt][kt2][8 * s2 + 1]); u.y = pack2(S[qt][kt2][8 * s2 + 2], S[qt][kt2][8 * s2 + 3]);
          u.z = pack2(S[qt][kt2][8 * s2 + 4], S[qt][kt2][8 * s2 + 5]); u.w = pack2(S[qt][kt2][8 * s2 + 6], S[qt][kt2][8 * s2 + 7]);
          P[qt][kt2 * 2 + s2] = __builtin_bit_cast(bf16x8, u);
        }
#pragma unroll
    for (int f = 0; f < 4; f++)
#pragma unroll
      for (int dt = 0; dt < 2; dt++) {
        const int d = dt * 32 + pr;
        const bf16x8 vf = *(const bf16x8*)(Vc + d * 128 + (((f * 2 + h2) ^ ((d >> 1) & 7)) << 4));
#pragma unroll
        for (int qt = 0; qt < 2; qt++) O[dt][qt] = MFMA32(vf, P[qt][f], O[dt][qt]);
      }
    __builtin_amdgcn_sched_barrier(0);
    if (i + 2 < nsteps) asm volatile("s_waitcnt vmcnt(4)" ::: "memory"); else asm volatile("s_waitcnt vmcnt(0)" ::: "memory");
    __builtin_amdgcn_s_barrier();
    cur = cur == 2 ? 0 : cur + 1;
  }
#undef QK_ALL
#undef EXP_ALL
  flush(1);
  __syncthreads();
}

DI void cmp_unit(const Params& p, int unit, char* smem) {
  const int tid = opq(threadIdx.x), lane = tid & 63, w = tid >> 6, r = lane & 31, h2 = lane >> 5;
  const int bg = unit >> 7, q32 = unit & 127, b = bg >> 1, g = bg & 1, hh = g * 4 + w;
  const int pr = perm23(r);
  const bf16_t* Kg = p.kcmp + (size_t)bg * 256 * 64;
  const bf16_t* Vg = p.vcmpT + (size_t)bg * 64 * 256;
  const int tb = q32 * 32, t = tb + r;
  const int nvalid = t >= 31 ? ((t - 31) >> 4) + 1 : 0;
  const int nvmax = (tb >> 4) + 1;
  const int nkt = (nvmax + 31) >> 5;
  char* Kl = smem; char* Vl = smem + 32768; float* impw = (float*)smem;
  const unsigned ldsb = (unsigned)(size_t)(LAS char*)smem;
  __syncthreads();
  for (int pc = w; pc < 4 * nkt; pc += 4) {
    const int row = pc * 8 + (lane >> 3);
    glds16_asm(Kg + row * 64 + (((lane & 7) ^ ((row >> 1) & 7)) << 3), ldsb + __builtin_amdgcn_readfirstlane(pc * 1024));
  }
#pragma unroll
  for (int i = 0; i < 8; i++) {
    const int pc = w * 8 + i, d = pc * 2 + h2;
    glds16_asm(Vg + d * 256 + (((lane & 31) ^ (d & 15)) << 3), ldsb + 32768 + __builtin_amdgcn_readfirstlane(pc * 1024));
  }
  bf16x8 qf[4];
#pragma unroll
  for (int ks = 0; ks < 4; ks++) qf[ks] = *(const bf16x8*)(p.Qn + ((size_t)(b * 8 + hh) * T + t) * 64 + ks * 16 + h2 * 8);
  asm volatile("s_waitcnt vmcnt(0)" ::: "memory");
  __syncthreads();
  float mx = -1e30f;
#pragma unroll 1
  for (int kt = 0; kt < nkt; kt++) {
    f32x16 S;
#pragma unroll
    for (int i = 0; i < 16; i++) S[i] = 0.f;
    const int row = kt * 32 + pr;
#pragma unroll
    for (int ks = 0; ks < 4; ks++) { const bf16x8 kf = *(const bf16x8*)(Kl + row * 128 + (((ks * 2 + h2) ^ ((row >> 1) & 7)) << 4)); S = MFMA32(kf, qf[ks], S); }
#pragma unroll
    for (int i = 0; i < 16; i++) { const int key = kt * 32 + (i & 7) + 16 * (i >> 3) + 8 * h2; mx = fmaxf(mx, key < nvalid ? S[i] : -1e30f); }
  }
  mx = fmaxf(mx, __shfl_xor(mx, 32));
  float sum = 0.f;
  float impo[32];
#pragma unroll
  for (int i = 0; i < 32; i++) impo[i] = 0.f;
  f32x16 O[2];
#pragma unroll
  for (int dt = 0; dt < 2; dt++)
#pragma unroll
    for (int i = 0; i < 16; i++) O[dt][i] = 0.f;
  float carry = 0.f;
#pragma unroll
  for (int kt = 0; kt < 8; kt++) {
    if (kt < nkt) {
      f32x16 S;
#pragma unroll
      for (int i = 0; i < 16; i++) S[i] = 0.f;
      const int row = kt * 32 + pr;
#pragma unroll
      for (int ks = 0; ks < 4; ks++) { const bf16x8 kf = *(const bf16x8*)(Kl + row * 128 + (((ks * 2 + h2) ^ ((row >> 1) & 7)) << 4)); S = MFMA32(kf, qf[ks], S); }
#pragma unroll
      for (int i = 0; i < 16; i++) {
        const int key = kt * 32 + (i & 7) + 16 * (i >> 3) + 8 * h2;
        const float e = key < nvalid ? __builtin_amdgcn_exp2f(S[i] - mx) : 0.f;
        S[i] = e; sum += e;
      }
      {
        const float x1 = __shfl_xor(S[7], 32), x3 = __shfl_xor(S[15], 32);
#pragma unroll
        for (int q4 = 0; q4 < 4; q4++) {
          const float mainv = 2.f * (S[q4 * 4] + S[q4 * 4 + 1] + S[q4 * 4 + 2]) + S[q4 * 4 + 3];
          const float prev = (q4 == 0) ? (h2 ? x1 : carry) : (q4 == 1) ? S[3] : (q4 == 2) ? (h2 ? x3 : x1) : S[11];
          impo[kt * 4 + q4] = mainv + prev;
        }
        carry = x3;
      }
#pragma unroll
      for (int s2 = 0; s2 < 2; s2++) {
        uint4 u;
        u.x = pack2(S[8 * s2 + 0], S[8 * s2 + 1]); u.y = pack2(S[8 * s2 + 2], S[8 * s2 + 3]);
        u.z = pack2(S[8 * s2 + 4], S[8 * s2 + 5]); u.w = pack2(S[8 * s2 + 6], S[8 * s2 + 7]);
        const bf16x8 pfr = __builtin_bit_cast(bf16x8, u);
#pragma unroll
        for (int dt = 0; dt < 2; dt++) {
          const int d = dt * 32 + r;
          const bf16x8 vf = *(const bf16x8*)(Vl + d * 512 + (((kt * 4 + s2 * 2 + h2) ^ (d & 15)) << 4));
          O[dt] = MFMA32(vf, pfr, O[dt]);
        }
      }
    }
  }
  sum += __shfl_xor(sum, 32);
  const float inv = sum > 0.f ? 1.f / sum : 0.f;
  {
    const size_t m = (size_t)b * T + t;
    const float sc = inv * p.NG[m * 24 + hh * 3 + 0];
#pragma unroll
    for (int dt = 0; dt < 2; dt++)
#pragma unroll
      for (int q4 = 0; q4 < 4; q4++) {
        uint2 o; o.x = pack2(sc * O[dt][q4 * 4], sc * O[dt][q4 * 4 + 1]); o.y = pack2(sc * O[dt][q4 * 4 + 2], sc * O[dt][q4 * 4 + 3]);
        *(uint2*)(p.oattn + m * 512 + hh * 64 + dt * 32 + q4 * 8 + h2 * 4) = o;
      }
  }
  __syncthreads();
#pragma unroll
  for (int kt = 0; kt < 8; kt++)
#pragma unroll
    for (int q4 = 0; q4 < 4; q4++)
      impw[(w * 32 + r) * 65 + 8 * kt + 4 * (q4 >> 1) + 2 * h2 + (q4 & 1)] = impo[kt * 4 + q4] * inv;
  __syncthreads();
#pragma unroll 1
  for (int k8 = 0; k8 < 8; k8++) {
    const int rr = w * 8 + k8, tt = tb + rr, blk = tt >> 6;
    const float imp = ((impw[rr * 65 + lane] + impw[(32 + rr) * 65 + lane]) + impw[(64 + rr) * 65 + lane]) + impw[(96 + rr) * 65 + lane];
    const float score = (lane == 0 || lane == blk || lane == blk - 1) ? 1e9f : (lane <= blk ? imp : -1e9f);
    int rank = 0;
#pragma unroll
    for (int i = 0; i < 64; i++) { const float si = __int_as_float(__builtin_amdgcn_readlane(__float_as_int(score), i)); rank += (si > score || (si == score && i < lane)) ? 1 : 0; }
    const unsigned long long selm = __ballot(rank < 16);
    if (lane == 0) p.selmask[(size_t)bg * T + tt] = selm;
  }
}

DI float gelu_tanh(float x) { const float u = 0.7978845608028654f * (x + 0.044715f * x * x * x); return 0.5f * x * (1.f + tanhf(u)); }
DI void compress1_tile(const Params& p, int task, char* smem) {
  const int ks = task & 3, tile = task >> 2;
  const int ntl = tile & 1, mtile = tile >> 1, half = mtile & 1, bg = (mtile >> 1) & 7, kv = mtile >> 4;
  const bf16_t* src = (kv ? p.CV : p.CK) + (size_t)bg * T * 64 + (size_t)half * 128 * 1024 + ks * 512;
  const bf16_t* Bt = (kv ? p.W1vT : p.W1kT) + (size_t)ntl * 128 * 2048 + ks * 512;
  f32x4 acc[4][4]; zero_acc(acc);
  gemm128<true>(acc, [=](int r) { return src + (size_t)r * 1024; }, [=](int r) { return Bt + (size_t)r * 2048; }, 512, smem);
  float* H1p = (float*)p.oattn + (size_t)ks * 4096 * 256;
  epilogue<true>(acc, [&](int r, int c, f32x4 v) {
    const int n = half * 128 + r;
    if (n < 255) { float4 o; o.x = v[0]; o.y = v[1]; o.z = v[2]; o.w = v[3];
      *(float4*)(H1p + ((size_t)((kv * 8 + bg) * 256 + n)) * 256 + ntl * 128 + c) = o; }
  });
}
DI void compress2(const Params& p, char* smem) {
  float* hl = (float*)smem;
  const int tid = opq(threadIdx.x);
  const float* H1p = (const float*)p.oattn;
  for (int rb = blockIdx.x; rb < 512; rb += gridDim.x) {
    const int row0 = rb * 8, kv = row0 >> 11;
    __syncthreads();
#pragma unroll
    for (int q = 0; q < 8; q++) {
      const size_t idx = (size_t)(row0 + q) * 256 + tid;
      hl[q * 256 + tid] = gelu_tanh(H1p[idx] + H1p[idx + (size_t)4096 * 256] + H1p[idx + (size_t)2 * 4096 * 256] + H1p[idx + (size_t)3 * 4096 * 256] + p.posb[kv * 256 + tid]);
    }
    __syncthreads();
    const int q = tid >> 5, ii = tid & 31, row = row0 + q, n = row & 255, bg = (row >> 8) & 7;
    float a0 = 0.f, a1 = 0.f;
    if (n < 255) {
      const float* w2 = kv ? p.cmp_v_w2 : p.cmp_k_w2; const float* b2 = kv ? p.cmp_v_b2 : p.cmp_k_b2;
      a0 = b2[ii]; a1 = b2[ii + 32];
#pragma unroll 8
      for (int j = 0; j < 256; j++) { const float hv = hl[q * 256 + j]; a0 += hv * w2[j * 64 + ii]; a1 += hv * w2[j * 64 + ii + 32]; }
    }
    if (kv == 0) {
      float r0 = 0.f, r1 = 0.f;
      if (n < 255) { const int pos = 16 * n + 31; const float c = p.ropeN[((size_t)pos * 32 + ii) * 2], s = p.ropeN[((size_t)pos * 32 + ii) * 2 + 1];
        r0 = a0 * c - a1 * s; r1 = a0 * s + a1 * c; }
      *(unsigned*)(p.kcmp + ((size_t)(bg * 256 + n)) * 64 + 2 * ii) = pack2(r0, r1);
    } else {
      p.vcmpT[((size_t)(bg * 64 + ii)) * 256 + n] = f2bf(a0);
      p.vcmpT[((size_t)(bg * 64 + ii + 32)) * 256 + n] = f2bf(a1);
    }
  }
}


DI void ret_u_unit(const Params& p, int unit) {
  const int tid = opq(threadIdx.x), lane = tid & 63, w = tid >> 6, r = lane & 31, h2 = lane >> 5;
  const int bh = unit >> 5, n = unit & 31;
  const bf16_t* kz = p.RKzT + (size_t)bh * 128 * T + ((size_t)((w * 256 + n * 8) * 2 + h2)) * 256 + r * 8;
  const bf16_t* vt = p.RVt + (size_t)bh * 256 * T + ((size_t)((n * 8) * 2 + h2)) * 256 + r * 8;
  bf16_t* ut = p.Ut + ((size_t)bh * 32 + n) * 32768 + (size_t)(w * 2) * 512 + r * 8 + 4 * h2;
  bf16x8 a[8], b0[8], b1[8];
#pragma unroll
  for (int ks = 0; ks < 8; ks++) a[ks] = *(const bf16x8*)(kz + ks * 512);
#pragma unroll
  for (int ks = 0; ks < 8; ks++) b0[ks] = *(const bf16x8*)(vt + ks * 512);
#pragma unroll
  for (int dvs = 0; dvs < 8; dvs += 2) {
#pragma unroll
    for (int ks = 0; ks < 8; ks++) b1[ks] = *(const bf16x8*)(vt + (size_t)(dvs + 1) * 32 * T + ks * 512);
    {
      f32x16 R;
#pragma unroll
      for (int i = 0; i < 16; i++) R[i] = 0.f;
#pragma unroll
      for (int ks = 0; ks < 8; ks++) R = MFMA32(a[ks], b0[ks], R);
#pragma unroll
      for (int q4 = 0; q4 < 4; q4++) { uint2 o; o.x = pack2(R[q4 * 4], R[q4 * 4 + 1]); o.y = pack2(R[q4 * 4 + 2], R[q4 * 4 + 3]);
        *(uint2*)(ut + (size_t)dvs * 4096 + (q4 >> 1) * 512 + (q4 & 1) * 256) = o; }
    }
    if (dvs + 2 < 8) {
#pragma unroll
      for (int ks = 0; ks < 8; ks++) b0[ks] = *(const bf16x8*)(vt + (size_t)(dvs + 2) * 32 * T + ks * 512);
    }
    {
      f32x16 R;
#pragma unroll
      for (int i = 0; i < 16; i++) R[i] = 0.f;
#pragma unroll
      for (int ks = 0; ks < 8; ks++) R = MFMA32(a[ks], b1[ks], R);
#pragma unroll
      for (int q4 = 0; q4 < 4; q4++) { uint2 o; o.x = pack2(R[q4 * 4], R[q4 * 4 + 1]); o.y = pack2(R[q4 * 4 + 2], R[q4 * 4 + 3]);
        *(uint2*)(ut + (size_t)(dvs + 1) * 4096 + (q4 >> 1) * 512 + (q4 & 1) * 256) = o; }
    }
  }
}
DI void ret_scan_elem(const Params& p) {
  const size_t gtid = (size_t)blockIdx.x * 256 + opq(threadIdx.x), gsz = (size_t)gridDim.x * 256;
  for (size_t i = gtid; i < (size_t)16 * 256 * 32; i += gsz) {
    const int bh = (int)(i >> 13), h = bh & 3;
    const size_t off = (size_t)(i & 8191) * 4;
    const float cd = exp2f(128.f * log2f(1.f - exp2f(-5.f - (float)h)));
    const bf16_t* up = p.Ut + (size_t)bh * 32 * 32768 + off;
    bf16_t* rp = p.Rt + (size_t)bh * 32 * 32768 + off;
    uint2 u[31];
#pragma unroll
    for (int n = 0; n < 31; n++) u[n] = *(const uint2*)(up + (size_t)n * 32768);
    float r0 = 0.f, r1 = 0.f, r2 = 0.f, r3 = 0.f;
    { uint2 z; z.x = 0u; z.y = 0u; *(uint2*)rp = z; }
#pragma unroll
    for (int n = 0; n < 31; n++) {
      r0 = r0 * cd + lo2f(u[n].x); r1 = r1 * cd + hi2f(u[n].x); r2 = r2 * cd + lo2f(u[n].y); r3 = r3 * cd + hi2f(u[n].y);
      uint2 o; o.x = pack2(r0, r1); o.y = pack2(r2, r3);
      *(uint2*)(rp + (size_t)(n + 1) * 32768) = o;
    }
  }
}

DI void ret_out_unit(const Params& p, int unit, char* smem) {
  const int tid = opq(threadIdx.x), lane = tid & 63, w = tid >> 6, r = lane & 31, h2 = lane >> 5, tq = w >> 1, dh = w & 1;
  const int th = unit & 1, n = (unit >> 1) & 31, bh = unit >> 6, b = bh >> 2, h = bh & 3;
  const int qt = th * 2 + tq, c = qt * 32 + r;
  const float lg = log2f(1.f - exp2f(-5.f - (float)h));
  const bf16_t* qp = p.RQ + (size_t)bh * T * 128 + ((size_t)(((n * 4 + qt) * 8) * 2 + h2)) * 256 + r * 8;
  f32x16 O[4];
  {
    const bf16_t* rp = p.Rt + ((size_t)bh * 32 + n) * 32768 + ((size_t)((dh * 4 * 8) * 2 + h2)) * 256 + r * 8;
#pragma unroll
    for (int dvt = 0; dvt < 4; dvt++)
#pragma unroll
      for (int i = 0; i < 16; i++) O[dvt][i] = 0.f;
#pragma unroll
    for (int ks = 0; ks < 8; ks++) {
      const bf16x8 qk = *(const bf16x8*)(qp + ks * 512);
#pragma unroll
      for (int dvt = 0; dvt < 4; dvt++) {
        const bf16x8 rf = *(const bf16x8*)(rp + (size_t)dvt * 4096 + ks * 512);
        O[dvt] = MFMA32(rf, qk, O[dvt]);
      }
    }
    const float xi = exp2f((float)(c + 1) * lg);
#pragma unroll
    for (int dvt = 0; dvt < 4; dvt++)
#pragma unroll
      for (int i = 0; i < 16; i++) O[dvt][i] *= xi;
  }
#pragma unroll 1
  for (int kt = 0; kt <= qt; kt++) {
    f32x16 S;
#pragma unroll
    for (int i = 0; i < 16; i++) S[i] = 0.f;
    const bf16_t* kp = p.RK + (size_t)bh * T * 128 + ((size_t)(((n * 4 + kt) * 8) * 2 + h2)) * 256 + perm23(r) * 8;
#pragma unroll
    for (int ks = 0; ks < 8; ks++) { const bf16x8 kf = *(const bf16x8*)(kp + ks * 512); const bf16x8 qk = *(const bf16x8*)(qp + ks * 512); S = MFMA32(kf, qk, S); }
    bf16x8 pf[2];
#pragma unroll
    for (int s2 = 0; s2 < 2; s2++) {
      float v[8];
#pragma unroll
      for (int jj = 0; jj < 8; jj++) {
        const int i = 8 * s2 + jj;
        const int mkey = kt * 32 + (i & 7) + 16 * (i >> 3) + 8 * h2;
        v[jj] = (mkey <= c) ? S[i] * exp2f((float)(c - mkey) * lg) : 0.f;
      }
      uint4 u; u.x = pack2(v[0], v[1]); u.y = pack2(v[2], v[3]); u.z = pack2(v[4], v[5]); u.w = pack2(v[6], v[7]);
      pf[s2] = __builtin_bit_cast(bf16x8, u);
    }
    const bf16_t* vp = p.RVt + (size_t)bh * 256 * T + ((size_t)(((dh * 4) * 256 + n * 8 + kt * 2) * 2 + h2)) * 256 + r * 8;
#pragma unroll
    for (int dvt = 0; dvt < 4; dvt++)
#pragma unroll
      for (int s2 = 0; s2 < 2; s2++) {
        const bf16x8 vf = *(const bf16x8*)(vp + (size_t)dvt * 32 * T + s2 * 512);
        O[dvt] = MFMA32(vf, pf[s2], O[dvt]);
      }
  }
  float s1 = 0.f, s2s = 0.f;
#pragma unroll
  for (int dvt = 0; dvt < 4; dvt++)
#pragma unroll
    for (int i = 0; i < 16; i++) { s1 += O[dvt][i]; s2s += O[dvt][i] * O[dvt][i]; }
  s1 += __shfl_xor(s1, 32); s2s += __shfl_xor(s2s, 32);
  float* red = (float*)smem;
  __syncthreads();
  if (h2 == 0) { red[(w * 32 + r) * 2] = s1; red[(w * 32 + r) * 2 + 1] = s2s; }
  __syncthreads();
  s1 += red[((w ^ 1) * 32 + r) * 2]; s2s += red[((w ^ 1) * 32 + r) * 2 + 1];
  const float mu = s1 * (1.f / 256.f);
  const float var = fmaxf(s2s * (1.f / 256.f) - mu * mu, 0.f);
  const float rs = rsqrtf(var + 1e-5f);
  const size_t m = (size_t)b * T + n * 128 + c;
#pragma unroll
  for (int dvt = 0; dvt < 4; dvt++)
#pragma unroll
    for (int q4 = 0; q4 < 4; q4++) {
      const int col = h * 256 + dh * 128 + dvt * 32 + q4 * 8 + 4 * h2;
      const float4 gg = *(const float4*)(p.gn_g + col), bb = *(const float4*)(p.gn_b + col);
      const uint2 rg = *(const uint2*)(p.RG + m * 1024 + col);
      const float g0 = lo2f(rg.x), g1 = hi2f(rg.x), g2 = lo2f(rg.y), g3 = hi2f(rg.y);
      const float y0 = ((O[dvt][q4 * 4] - mu) * rs * gg.x + bb.x) * g0 * sigmoidf_(g0);
      const float y1 = ((O[dvt][q4 * 4 + 1] - mu) * rs * gg.y + bb.y) * g1 * sigmoidf_(g1);
      const float y2 = ((O[dvt][q4 * 4 + 2] - mu) * rs * gg.z + bb.z) * g2 * sigmoidf_(g2);
      const float y3 = ((O[dvt][q4 * 4 + 3] - mu) * rs * gg.w + bb.w) * g3 * sigmoidf_(g3);
      uint2 o; o.x = pack2(y0, y1); o.y = pack2(y2, y3);
      *(uint2*)(p.oret + m * 1024 + col) = o;
    }
}

DI void lds_tile_load(const bf16_t* src, size_t ld, char* smem) {
  const int tid = opq(threadIdx.x);
#pragma unroll
  for (int k = 0; k < 8; k++) { const int id = tid + 256 * k, i = id >> 4, j8 = (id & 15) * 8; *(uint4*)(smem + i * 272 + j8 * 2) = *(const uint4*)(src + (size_t)i * ld + j8); }
}
DI void lds_tile_store(bf16_t* dstp, size_t ld, char* smem) {
  const int tid = opq(threadIdx.x);
#pragma unroll
  for (int k = 0; k < 8; k++) { const int id = tid + 256 * k, i = id >> 4, j8 = (id & 15) * 8; *(uint4*)(dstp + (size_t)i * ld + j8) = *(const uint4*)(smem + i * 272 + j8 * 2); }
}
DI void upproj_tile(const Params& p, int tile, char* smem) {
  const int nt_ = tile & 7, mt_ = tile >> 3, m0 = mt_ * 128, n0 = nt_ * 128;
  const int lane = opq(threadIdx.x) & 63, wave = opq(threadIdx.x) >> 6, wr = wave >> 1, wc = wave & 1, fr = lane & 15, fq = lane >> 4;
  f32x4 acc[4][4]; uint2 res[4][4];
  zero_acc(acc);
  { const bf16_t* A = p.oattn + (size_t)m0 * 512; const bf16_t* Bt = p.WaT + (size_t)n0 * 512;
    gemm128<true>(acc, [=](int r) { return A + (size_t)r * 512; }, [=](int r) { return Bt + (size_t)r * 512; }, 512, smem); }
  lds_tile_load(p.MG + (size_t)m0 * 2048 + n0, 2048, smem);
  __syncthreads();
#pragma unroll
  for (int mt = 0; mt < 4; mt++)
#pragma unroll
    for (int nt = 0; nt < 4; nt++) {
      const int r = wr * 64 + mt * 16 + fr, c = wc * 64 + nt * 16 + fq * 4;
      const uint2 gv = *(const uint2*)(smem + r * 272 + c * 2);
      res[mt][nt].x = pack2(sigmoidf_(lo2f(gv.x)) * acc[mt][nt][0], sigmoidf_(hi2f(gv.x)) * acc[mt][nt][1]);
      res[mt][nt].y = pack2(sigmoidf_(lo2f(gv.y)) * acc[mt][nt][2], sigmoidf_(hi2f(gv.y)) * acc[mt][nt][3]);
    }
  __syncthreads();
  zero_acc(acc);
  { const bf16_t* A = p.oret + (size_t)m0 * 1024; const bf16_t* Bt = p.WrT + (size_t)n0 * 1024;
    gemm128<true>(acc, [=](int r) { return A + (size_t)r * 1024; }, [=](int r) { return Bt + (size_t)r * 1024; }, 1024, smem); }
  lds_tile_load(p.MG + (size_t)m0 * 2048 + 1024 + n0, 2048, smem);
  __syncthreads();
#pragma unroll
  for (int mt = 0; mt < 4; mt++)
#pragma unroll
    for (int nt = 0; nt < 4; nt++) {
      const int r = wr * 64 + mt * 16 + fr, c = wc * 64 + nt * 16 + fq * 4;
      uint2* q = (uint2*)(smem + r * 272 + c * 2);
      const uint2 gv = *q;
      uint2 o; o.x = pack2(lo2f(res[mt][nt].x) + sigmoidf_(lo2f(gv.x)) * acc[mt][nt][0], hi2f(res[mt][nt].x) + sigmoidf_(hi2f(gv.x)) * acc[mt][nt][1]);
      o.y = pack2(lo2f(res[mt][nt].y) + sigmoidf_(lo2f(gv.y)) * acc[mt][nt][2], hi2f(res[mt][nt].y) + sigmoidf_(hi2f(gv.y)) * acc[mt][nt][3]);
      *q = o;
    }
  __syncthreads();
  lds_tile_store(p.merged + (size_t)m0 * 1024 + n0, 1024, smem);
  __syncthreads();
}
DI void wout_tile(const Params& p, int tile, char* smem) {
  const int nt_ = tile & 7, mt_ = tile >> 3, m0 = mt_ * 128, n0 = nt_ * 128;
  const int tid = opq(threadIdx.x), lane = tid & 63, wave = tid >> 6, wr = wave >> 1, wc = wave & 1, fr = lane & 15, fq = lane >> 4;
  f32x4 acc[4][4]; zero_acc(acc);
  const bf16_t* A = p.merged + (size_t)m0 * 1024; const bf16_t* Bt = p.WoT + (size_t)n0 * 1024;
  gemm128<true>(acc, [=](int r) { return A + (size_t)r * 1024; }, [=](int r) { return Bt + (size_t)r * 1024; }, 1024, smem);
#pragma unroll
  for (int hcol = 0; hcol < 2; hcol++) {
    const size_t g0 = (size_t)m0 * 1024 + n0 + hcol * 64;
#pragma unroll
    for (int k = 0; k < 8; k++) { const int id = tid + 256 * k, i = id >> 4, j4 = (id & 15) * 4; *(float4*)(smem + i * 272 + j4 * 4) = *(const float4*)(p.x + g0 + (size_t)i * 1024 + j4); }
    __syncthreads();
    if (wc == hcol) {
#pragma unroll
      for (int mt = 0; mt < 4; mt++)
#pragma unroll
        for (int nt = 0; nt < 4; nt++) {
          float4* q = (float4*)(smem + (wr * 64 + mt * 16 + fr) * 272 + (nt * 16 + fq * 4) * 4);
          const float4 xv = *q;
          float4 o; o.x = ALPHA * xv.x + acc[mt][nt][0]; o.y = ALPHA * xv.y + acc[mt][nt][1]; o.z = ALPHA * xv.z + acc[mt][nt][2]; o.w = ALPHA * xv.w + acc[mt][nt][3];
          *q = o;
        }
    }
    __syncthreads();
#pragma unroll
    for (int k = 0; k < 8; k++) { const int id = tid + 256 * k, i = id >> 4, j4 = (id & 15) * 4; *(float4*)(p.out + g0 + (size_t)i * 1024 + j4) = *(const float4*)(smem + i * 272 + j4 * 4); }
    __syncthreads();
  }
}
DI void expert_cvt_tile(const Params& p, int ct, float* tile) {
  const int e = ct / 192, rr = ct % 192;
  const float* wg = p.e_wg + (size_t)e * 1024 * 512; const float* wu = p.e_wu + (size_t)e * 1024 * 512; const float* wd = p.e_wd + (size_t)e * 512 * 1024;
  if (rr < 128)
    tcvt_tile128([=](int j) -> const float* { const int f = (j >> 7) * 64 + ((j >> 5) & 3) * 16 + (j & 15); return (((j >> 4) & 1) ? wu : wg) + f; },
                 512, p.EgT + (size_t)e * 1024 * 1024, 1024, rr >> 3, rr & 7, tile);
  else { const int q = rr - 128;
    tcvt_tile128([=](int j) -> const float* { return wd + j; }, 1024, p.EdT + (size_t)e * 1024 * 512, 512, q >> 3, q & 7, tile); }
}
#ifndef CVT_SPLIT
#define CVT_SPLIT 3072
#endif
DI void phase7(const Params& p, char* smem) {
  const int bid = blockIdx.x, nb = gridDim.x;
  if (bid & 1) for (int c = CVT_SPLIT + bid; c < 6144; c += nb) expert_cvt_tile(p, c, (float*)smem);
  for (int t = bid; t < 1024; t += nb) wout_tile(p, t, smem);
  if (!(bid & 1)) for (int c = CVT_SPLIT + bid; c < 6144; c += nb) expert_cvt_tile(p, c, (float*)smem);
}

template <int NT>
DI void ln1_router(const Params& p, int m0, int lane, float* xl  ) {
  float4 v[NT][4];
#pragma unroll
  for (int t = 0; t < NT; t++)
#pragma unroll
    for (int i = 0; i < 4; i++) v[t][i] = *(const float4*)(p.out + (size_t)(m0 + t) * 1024 + i * 256 + lane * 4);
  float mu[NT], rs[NT];
#pragma unroll
  for (int t = 0; t < NT; t++) {
    float s = 0.f;
#pragma unroll
    for (int i = 0; i < 4; i++) s += v[t][i].x + v[t][i].y + v[t][i].z + v[t][i].w;
    mu[t] = wsum(s) * (1.f / 1024.f);
  }
#pragma unroll
  for (int t = 0; t < NT; t++) {
    float q = 0.f;
#pragma unroll
    for (int i = 0; i < 4; i++) { const float a = v[t][i].x - mu[t], b = v[t][i].y - mu[t], c = v[t][i].z - mu[t], d = v[t][i].w - mu[t]; q += a * a + b * b + c * c + d * d; }
    rs[t] = rsqrtf(wsum(q) * (1.f / 1024.f) + 1e-5f);
  }
#pragma unroll
  for (int i = 0; i < 4; i++) {
    const int k = i * 256 + lane * 4;
    const float4 g = *(const float4*)(p.ln1_g + k), bb = *(const float4*)(p.ln1_b + k);
#pragma unroll
    for (int t = 0; t < NT; t++) {
      float4 o;
      o.x = (v[t][i].x - mu[t]) * rs[t] * g.x + bb.x; o.y = (v[t][i].y - mu[t]) * rs[t] * g.y + bb.y;
      o.z = (v[t][i].z - mu[t]) * rs[t] * g.z + bb.z; o.w = (v[t][i].w - mu[t]) * rs[t] * g.w + bb.w;
      *(float4*)(p.out + (size_t)(m0 + t) * 1024 + k) = o;
      uint2 ob; ob.x = pack2(o.x, o.y); ob.y = pack2(o.z, o.w);
      *(uint2*)(p.x1b + (size_t)(m0 + t) * 1024 + k) = ob;
      *(float4*)(xl + t * 1024 + k) = o;
    }
  }
  WSYNC();
  float gl[NT][4];
#pragma unroll
  for (int t = 0; t < NT; t++)
#pragma unroll
    for (int j = 0; j < 4; j++) gl[t][j] = 0.f;
#pragma unroll
  for (int c = 0; c < 16; c++) {
    const int k = c * 64 + lane;
    const float4 w = *(const float4*)(p.rg_w + (size_t)k * 4);
#pragma unroll
    for (int t = 0; t < NT; t++) {
      const float xk = xl[t * 1024 + k];
      gl[t][0] += xk * w.x; gl[t][1] += xk * w.y; gl[t][2] += xk * w.z; gl[t][3] += xk * w.w;
    }
  }
  int gi[NT]; float gprob[NT];
#pragma unroll
  for (int t = 0; t < NT; t++) {
#pragma unroll
    for (int j = 0; j < 4; j++) gl[t][j] = wsum(gl[t][j]) + p.rg_b[j];
    gi[t] = 0; float gm = gl[t][0];
#pragma unroll
    for (int j = 1; j < 4; j++) if (gl[t][j] > gm) { gm = gl[t][j]; gi[t] = j; }
    float gs = 0.f;
#pragma unroll
    for (int j = 0; j < 4; j++) gs += __expf(gl[t][j] - gm);
    gprob[t] = 1.f / gs;
  }
  float tq[NT][4];
#pragma unroll
  for (int t = 0; t < NT; t++)
#pragma unroll
    for (int j = 0; j < 4; j++) tq[t][j] = 0.f;
#pragma unroll 16
  for (int c = 0; c < 32; c++) {
    const int k = c * 32 + (lane >> 1);
#pragma unroll
    for (int t = 0; t < NT; t++) {
      const float xk = xl[t * 1024 + k];
      const float4 w = *(const float4*)(p.ri_w + (size_t)gi[t] * 1024 * 8 + (lane & 1) * 4 + (size_t)k * 8);
      tq[t][0] += xk * w.x; tq[t][1] += xk * w.y; tq[t][2] += xk * w.z; tq[t][3] += xk * w.w;
    }
  }
  int ea[NT], eb[NT]; float w1[NT], w2[NT];
#pragma unroll
  for (int t = 0; t < NT; t++) {
    float il[8];
#pragma unroll
    for (int j = 0; j < 4; j++) { il[j] = wsum((lane & 1) ? 0.f : tq[t][j]) + p.ri_b[gi[t] * 8 + j]; il[4 + j] = wsum((lane & 1) ? tq[t][j] : 0.f) + p.ri_b[gi[t] * 8 + 4 + j]; }
    int e1 = 0; float l1 = il[0];
#pragma unroll
    for (int j = 1; j < 8; j++) if (il[j] > l1) { l1 = il[j]; e1 = j; }
    int e2 = -1; float l2 = -3e38f;
#pragma unroll
    for (int j = 0; j < 8; j++) if (j != e1 && il[j] > l2) { l2 = il[j]; e2 = j; }
    const float ex = __expf(l2 - l1);
    w1[t] = gprob[t] / (1.f + ex); w2[t] = gprob[t] * ex / (1.f + ex);
    ea[t] = gi[t] * 8 + e1; eb[t] = gi[t] * 8 + e2;
  }
  if (lane == 0) {
    const int grp = blockIdx.x & 15;
    int pa[NT], pb[NT];
#pragma unroll
    for (int t = 0; t < NT; t++) { pa[t] = atomicAdd(p.cnt + grp * 32 + ea[t], 1); pb[t] = atomicAdd(p.cnt + grp * 32 + eb[t], 1); }
#pragma unroll
    for (int t = 0; t < NT; t++) {
      const int m = m0 + t;
      p.lists[(ea[t] * 16 + grp) * 2048 + pa[t]] = m * 2; p.lists[(eb[t] * 16 + grp) * 2048 + pb[t]] = m * 2 + 1;
      p.routew[m * 2] = w1[t]; p.routew[m * 2 + 1] = w2[t];
    }
  }
  WSYNC();
}
DI void ln2_final(const Params& p, int m, int lane) {
  float* row = p.out + (size_t)m * 1024;
  float4 v[4];
  float s = 0.f;
#pragma unroll
  for (int i = 0; i < 4; i++) {
    const int k = i * 256 + lane * 4;
    const float4 xv = *(const float4*)(row + k);
    const uint2 a = *(const uint2*)(p.part + (size_t)(2 * m) * 1024 + k), b = *(const uint2*)(p.part + (size_t)(2 * m + 1) * 1024 + k);
    v[i].x = ALPHA * xv.x + lo2f(a.x) + lo2f(b.x); v[i].y = ALPHA * xv.y + hi2f(a.x) + hi2f(b.x);
    v[i].z = ALPHA * xv.z + lo2f(a.y) + lo2f(b.y); v[i].w = ALPHA * xv.w + hi2f(a.y) + hi2f(b.y);
    s += v[i].x + v[i].y + v[i].z + v[i].w;
  }
  const float mu = wsum(s) * (1.f / 1024.f);
  float q = 0.f;
#pragma unroll
  for (int i = 0; i < 4; i++) { const float a = v[i].x - mu, b = v[i].y - mu, c = v[i].z - mu, d = v[i].w - mu; q += a * a + b * b + c * c + d * d; }
  const float rs = rsqrtf(wsum(q) * (1.f / 1024.f) + 1e-5f);
#pragma unroll
  for (int i = 0; i < 4; i++) {
    const int k = i * 256 + lane * 4;
    const float4 g = *(const float4*)(p.ln2_g + k), bb = *(const float4*)(p.ln2_b + k);
    float4 o; o.x = (v[i].x - mu) * rs * g.x + bb.x; o.y = (v[i].y - mu) * rs * g.y + bb.y; o.z = (v[i].z - mu) * rs * g.z + bb.z; o.w = (v[i].w - mu) * rs * g.w + bb.w;
    *(float4*)(row + k) = o;
  }
}

struct MoeMap { int e, mi, cnt, hoff; };
#define MOE_TAB(smem) ((int*)((smem) + 65552))
DI void moe_tables(const Params& p, char* smem) {
  int* tab = MOE_TAB(smem); int* pre = tab; int* tpre = tab + 32 * 17;
  const int tid = opq(threadIdx.x);
  __syncthreads();
  if (tid < 32) { int acc = 0; for (int g = 0; g < 16; g++) { pre[tid * 17 + g] = acc; acc += p.cnt[g * 32 + tid]; } pre[tid * 17 + 16] = acc; }
  __syncthreads();
  if (tid == 0) { int acc = 0; for (int e = 0; e < NEXP; e++) { tpre[e] = acc; acc += (pre[e * 17 + 16] + 127) >> 7; } tpre[32] = acc; }
  __syncthreads();
}
DI bool moe_map(char* smem, int mtile, MoeMap& mm) {
  const int* tab = MOE_TAB(smem); const int* pre = tab; const int* tpre = tab + 32 * 17;
  if (mtile >= tpre[32]) return false;
  int e = 0;
  while (tpre[e + 1] <= mtile) e++;
  mm.e = e; mm.mi = mtile - tpre[e]; mm.cnt = pre[e * 17 + 16]; mm.hoff = tpre[e] * 128;
  return true;
}
DI int moe_total(char* smem) { return MOE_TAB(smem)[32 * 17 + 32]; }
DI const int* moe_rows(const Params& p, const MoeMap& mm, char* smem) {
  int* tab = MOE_TAB(smem); const int* pre = tab + mm.e * 17; int* rowent = tab + 32 * 17 + 40;
  const int tid = opq(threadIdx.x);
  __syncthreads();
  if (tid < 128) {
    const int ri = mm.mi * 128 + tid; int ent = -1;
    if (ri < mm.cnt) { int g = 0; while (pre[g + 1] <= ri) g++; ent = p.lists[(mm.e * 16 + g) * 2048 + ri - pre[g]]; }
    rowent[tid] = ent;
  }
  __syncthreads();
  return rowent;
}
DI void moe_up_tile(const Params& p, const MoeMap& mm, int nt_, char* smem) {
  const int* lst = moe_rows(p, mm, smem); const int nrow = mm.cnt - mm.mi * 128;
  const bf16_t* Bt = p.EgT + ((size_t)mm.e * 1024 + nt_ * 128) * 1024;
  const bf16_t* X = p.x1b;
  f32x4 acc[4][4]; zero_acc(acc);
  gemm128<true>(acc, [=](int r) { const int tk = r < nrow ? (lst[r] >> 1) : 0; return X + (size_t)tk * 1024; }, [=](int r) { return Bt + (size_t)r * 1024; }, 1024, smem);
  const int lane = opq(threadIdx.x) & 63, wave = opq(threadIdx.x) >> 6, wr = wave >> 1, wc = wave & 1, fr = lane & 15, fq = lane >> 4;
#pragma unroll
  for (int mt = 0; mt < 4; mt++) {
    const int r = wr * 64 + mt * 16 + fr;
    if (r < nrow) {
      const float w = p.routew[lst[r]];
#pragma unroll
      for (int np = 0; np < 2; np++) {
        const f32x4 g = acc[mt][np * 2], u = acc[mt][np * 2 + 1];
        float hv[4];
#pragma unroll
        for (int i = 0; i < 4; i++) hv[i] = g[i] * sigmoidf_(g[i]) * u[i] * w;
        const int f = nt_ * 64 + wc * 32 + np * 16 + fq * 4;
        uint2 o; o.x = pack2(hv[0], hv[1]); o.y = pack2(hv[2], hv[3]);
        *(uint2*)(p.Hh + (size_t)(mm.hoff + mm.mi * 128 + r) * 512 + f) = o;
      }
    }
  }
}
DI void moe_down_tile(const Params& p, const MoeMap& mm, int nt_, char* smem) {
  const int* lst = moe_rows(p, mm, smem); const int nrow = mm.cnt - mm.mi * 128;
  const bf16_t* A = p.Hh + (size_t)(mm.hoff + mm.mi * 128) * 512;
  const bf16_t* Bt = p.EdT + ((size_t)mm.e * 1024 + nt_ * 128) * 512;
  f32x4 acc[4][4]; zero_acc(acc);
  gemm128<true>(acc, [=](int r) { return A + (size_t)r * 512; }, [=](int r) { return Bt + (size_t)r * 512; }, 512, smem);
  epilogue<true>(acc, [&](int r, int c, f32x4 v) {
    if (r < nrow) {
      const int ts = lst[r];
      uint2 o; o.x = pack2(v[0], v[1]); o.y = pack2(v[2], v[3]);
      *(uint2*)(p.part + (size_t)ts * 1024 + nt_ * 128 + c) = o;
    }
  });
}

constexpr int NPHASE = 12;
#if FUSED
#define PHFN DI
#else
#define PHFN DI
#endif
#define PH_PRE const int bid = blockIdx.x, nb = gridDim.x, tid = opq(threadIdx.x), lane = tid & 63, wave = tid >> 6; \
  const int gw = bid * 4 + wave, nw = nb * 4; char* wsm = smem + wave * 8192; (void)bid; (void)nb; (void)lane; (void)gw; (void)nw; (void)wsm;
PHFN void ph0(const Params& p, char* smem) { phase0(p, smem); }
PHFN void ph1(const Params& p, char* smem) { phase1(p, smem); }
PHFN void ph2(const Params& p, char* smem) { PH_PRE
  for (int t = bid; t < 256 + 512; t += nb) { if (t < 256) compress1_tile(p, t, smem); else if (((t - 256) & 31) != 31) ret_u_unit(p, t - 256); }
}
PHFN void ph3(const Params& p, char* smem) { compress2(p, smem); ret_scan_elem(p); }
PHFN void ph4(const Params& p, char* smem) { PH_PRE
  for (int u = bid; u < 1024; u += nb) cmp_unit(p, u, smem);
}
PHFN void ph5(const Params& p, char* smem) { PH_PRE
  for (int u = bid; u < 512; u += nb) { const int k = u >> 3; attn_unit(p, ((u & 7) << 6) | (k < 32 ? 63 - k : k - 32), smem); }
  {
    int* sh = (int*)(smem + 65552 + 3072);
    for (;;) {
      __syncthreads();
      if (threadIdx.x == 0) sh[0] = (int)xb_add(&p.qctr[0], 1u);
      __syncthreads();
      const int u = sh[0];
      if (u >= 1024) break;
      ret_out_unit(p, u, smem);
    }
  }
}
PHFN void ph6(const Params& p, char* smem) { PH_PRE
  if (bid & 1) for (int c = bid; c < CVT_SPLIT; c += nb) expert_cvt_tile(p, c, (float*)smem);
  for (int t = bid; t < 1024; t += nb) upproj_tile(p, t, smem);
  if (!(bid & 1)) for (int c = bid; c < CVT_SPLIT; c += nb) expert_cvt_tile(p, c, (float*)smem);
}
PHFN void ph7(const Params& p, char* smem) { phase7(p, smem); }
PHFN void ph8(const Params& p, char* smem) { PH_PRE for (int m = gw * 2; m < M; m += nw * 2) ln1_router<2>(p, m, lane, (float*)wsm); }
PHFN void ph9(const Params& p, char* smem) { PH_PRE moe_tables(p, smem); const int tot = moe_total(smem);
  for (int t = bid; t < tot * 8; t += nb) { MoeMap mm; if (moe_map(smem, t >> 3, mm)) moe_up_tile(p, mm, t & 7, smem); } }
PHFN void ph10(const Params& p, char* smem) { PH_PRE moe_tables(p, smem); const int tot = moe_total(smem);
  for (int t = bid; t < tot * 8; t += nb) { MoeMap mm; if (moe_map(smem, t >> 3, mm)) moe_down_tile(p, mm, t & 7, smem); } }
PHFN void ph11(const Params& p, char* smem) { PH_PRE for (int m = gw; m < M; m += nw) ln2_final(p, m, lane); }
DI void run_phase(const Params& p, const int ph, char* smem) {
  switch (ph) {
    case 0: ph0(p, smem); break; case 1: ph1(p, smem); break; case 2: ph2(p, smem); break; case 3: ph3(p, smem); break;
    case 4: ph4(p, smem); break; case 5: ph5(p, smem); break; case 6: ph6(p, smem); break; case 7: ph7(p, smem); break;
    case 8: ph8(p, smem); break; case 9: ph9(p, smem); break; case 10: ph10(p, smem); break; case 11: ph11(p, smem); break;
  }
}

template <int PH>
__global__ void __launch_bounds__(256, 2) phase_kernel(Params p) {
  __shared__ __attribute__((aligned(16))) char smem[65536 + 16 + 4096];
  run_phase(p, PH, smem);
}
#if FUSED
__global__ void __launch_bounds__(256, 2) mega_kernel(Params p_arg) {
  __shared__ __attribute__((aligned(16))) char smem[65536 + 16 + 4096];
  const Params& p = *(const Params*)__builtin_amdgcn_kernarg_segment_ptr();
  volatile LAS unsigned* st = (volatile LAS unsigned*)(smem + 65536);
  if (threadIdx.x == 0) { st[0] = 0u; st[1] = 0u; }
  __syncthreads();
  const XcdBarrier xb = xcd_barrier_post(p.bar, st);
#define GSYNC() xcd_barrier(xb)
  unsigned long long tk_ = 0; (void)tk_;
#define RUNPH(N) { unsigned long long t0_ = 0; if (PROBE_PHASE == N) t0_ = __builtin_amdgcn_s_memrealtime(); ph##N(p, smem); if (PROBE_DOUBLE & (1 << N)) { GSYNC(); ph##N(p, smem); } \
    if (PROBE_PHASE == N) { GSYNC(); tk_ = __builtin_amdgcn_s_memrealtime() - t0_; } }
  RUNPH(0); GSYNC(); RUNPH(1); GSYNC(); RUNPH(2); GSYNC(); RUNPH(3); GSYNC();
  RUNPH(4); GSYNC(); RUNPH(5); GSYNC(); RUNPH(6); GSYNC(); RUNPH(7); GSYNC();
  RUNPH(8); GSYNC(); RUNPH(9); GSYNC(); RUNPH(10); GSYNC(); RUNPH(11);
  if (PROBE_PHASE >= 0 && blockIdx.x == 0) { const unsigned long long t1_ = __builtin_amdgcn_s_memrealtime(); while (__builtin_amdgcn_s_memrealtime() - t1_ < 3ull * tk_) __builtin_amdgcn_s_sleep(8); }
}
#endif

extern "C" void kernel_launch(void* const* d_in, const int* in_sizes, int n_in, void* d_out, int out_size,
                              void* d_ws, size_t ws_size, hipStream_t stream) {
  Params p{};
  const float** ins = (const float**)&p;
  for (int i = 0; i < 28; i++) ins[i] = (const float*)d_in[i];
  p.out = (float*)d_out;
  char* ws = (char*)d_ws; size_t off = 0;
  auto alloc = [&](size_t bytes) { char* r = ws + off; off += (bytes + 255) & ~(size_t)255; return r; };
  const size_t MiB = 1 << 20;
  char* regionP = ws;
  p.Qn = (bf16_t*)alloc(16 * MiB);
  p.CK = (bf16_t*)alloc(4 * MiB); p.CV = (bf16_t*)alloc(4 * MiB); p.SK = (bf16_t*)alloc(4 * MiB); p.SVt = (bf16_t*)alloc(4 * MiB);
  p.WK = (bf16_t*)alloc(4 * MiB); p.WVt = (bf16_t*)alloc(4 * MiB);
  p.NG = (float*)alloc((size_t)M * 24 * 4);
  p.RQ = (bf16_t*)alloc(16 * MiB); p.RK = (bf16_t*)alloc(16 * MiB); p.RKzT = (bf16_t*)alloc(16 * MiB);
  p.RVt = (bf16_t*)alloc(32 * MiB); p.RG = (bf16_t*)alloc(32 * MiB); p.MG = (bf16_t*)alloc(64 * MiB);
  p.oattn = (bf16_t*)alloc(16 * MiB); p.WinT = p.oattn;
  p.oret = (bf16_t*)alloc(32 * MiB);
  p.WaT = (bf16_t*)alloc(1 * MiB); p.WrT = (bf16_t*)alloc(2 * MiB); p.WoT = (bf16_t*)alloc(2 * MiB);
  p.W1kT = (bf16_t*)alloc(1 * MiB); p.W1vT = (bf16_t*)alloc(1 * MiB);
  p.ropeN = (float*)alloc((size_t)T * 32 * 8); p.ropeR = (float*)alloc((size_t)T * 64 * 8); p.posb = (float*)alloc(512 * 4); p.posp = (float*)alloc(32 * 512 * 4);
  p.H1 = (bf16_t*)alloc(2 * MiB); p.kcmp = (bf16_t*)alloc(8 * 256 * 64 * 2); p.vcmpT = (bf16_t*)alloc(8 * 64 * 256 * 2);
  p.selmask = (unsigned long long*)alloc((size_t)8 * T * 8);
  p.cnt = (int*)alloc(512 * 4); p.lists = (int*)alloc((size_t)NEXP * 16 * 2048 * 4); p.routew = (float*)alloc((size_t)M * 2 * 4);
  p.merged = (bf16_t*)(regionP); p.x1b = (bf16_t*)(regionP + 128 * MiB);
  p.EgT = (bf16_t*)(regionP + 32 * MiB); p.EdT = (bf16_t*)(regionP + 96 * MiB);
  p.Hh = (bf16_t*)(regionP + 160 * MiB); p.part = (bf16_t*)(regionP + 196 * MiB);
  p.bar = (unsigned*)alloc((XCD_BAR_WORDS + 64) * 4); p.qctr = p.bar + XCD_BAR_WORDS;
  p.xb = (bf16_t*)d_out; p.Rt = (bf16_t*)d_out; p.Ut = (bf16_t*)d_out + (size_t)16 * 1024 * 1024;
  if (off > ws_size) { fprintf(stderr, "workspace too small: need %zu have %zu\n", off, ws_size); return; }
#if FUSED
  static int grid_blocks = 0;
  if (!grid_blocks) {
    int dev = 0, cus = 0, per_cu = 0;
    (void)hipGetDevice(&dev);
    (void)hipDeviceGetAttribute(&cus, hipDeviceAttributeMultiprocessorCount, dev);
    (void)hipOccupancyMaxActiveBlocksPerMultiprocessor(&per_cu, mega_kernel, 256, 0);
    if (per_cu > 2) per_cu = 2;
    grid_blocks = cus * per_cu;
  }
  (void)hipMemsetAsync(p.bar, 0, (XCD_BAR_WORDS + 64) * 4, stream);
  void* args[] = {&p};
  hipError_t e = hipLaunchCooperativeKernel((void*)mega_kernel, dim3(grid_blocks), dim3(256), args, 0, stream);
  if (e != hipSuccess) fprintf(stderr, "coop launch failed: %s\n", hipGetErrorString(e));
#else
(void)hipMemsetAsync(p.bar, 0, (XCD_BAR_WORDS + 64) * 4, stream);
#define LAUNCH_PH(N) phase_kernel<N><<<512, 256, 0, stream>>>(p)
  LAUNCH_PH(0); LAUNCH_PH(1); LAUNCH_PH(2); LAUNCH_PH(3); LAUNCH_PH(4); LAUNCH_PH(5);
  LAUNCH_PH(6); LAUNCH_PH(7); LAUNCH_PH(8); LAUNCH_PH(9); LAUNCH_PH(10); LAUNCH_PH(11);
#endif
}
```
